# Optimizing an MI355X kernel written in HIP

```python
import math
import jax, jax.numpy as jnp
from jax import lax
import numpy as np

D_MODEL = 1024
BATCH = 4
SEQ = 8192
DEPTH = 2

CTX_LEN = 256
GRID_W = 64
CHUNK = 64
N_MIXERS = 2
EPS = 1e-6

DN_DK = 128
DN_HEADS = D_MODEL // DN_DK
DN_DV = 2 * DN_DK
DN_QK = DN_HEADS * DN_DK
DN_V = DN_HEADS * DN_DV
DN_QKV = 2 * DN_QK + DN_V
DN_IN = DN_QKV + DN_V + 4 * DN_HEADS
CONV_K = 3

GLA_HEADS = 4
GLA_DK = D_MODEL // (2 * GLA_HEADS)
GLA_DV = 2 * D_MODEL // GLA_HEADS
GLA_K = GLA_HEADS * GLA_DK
GLA_V = GLA_HEADS * GLA_DV
GLA_RANK = 16
GLA_TAU = 16.0
GLA_IN = 2 * GLA_K + 2 * GLA_V + 2 * GLA_RANK

N_DN = (DEPTH + 1) // 2
N_GLA = DEPTH // 2

kernel_name = 'hybrid_deltanet_gla_prefix_dit'


def rms_norm(x, g):
    xf = x.astype(jnp.float32)
    y = xf * lax.rsqrt(jnp.mean(jnp.square(xf), axis=-1, keepdims=True) + EPS)
    return y * g.astype(jnp.float32)


def l2_norm(x):
    xf = x.astype(jnp.float32)
    return xf * lax.rsqrt(jnp.sum(jnp.square(xf), axis=-1, keepdims=True) + EPS)


def ada_modulation(cond, w_mod, b_mod):
    m = jax.nn.silu(cond.astype(jnp.float32)) @ w_mod + b_mod
    shift, scale, gate = jnp.split(m, 3, axis=-1)
    return shift[..., None, :], scale[..., None, :], gate[..., None, :]


def to_chunks(u):
    b, t = u.shape[:2]
    u = u.reshape((b, t // CHUNK, CHUNK) + u.shape[2:])
    return jnp.moveaxis(u, 3, 1)


def from_chunks(o):
    o = jnp.moveaxis(o, 1, 3)
    b, n, c = o.shape[:3]
    return o.reshape((b, n * c) + o.shape[3:])


def flip_seq(u, d):
    return jnp.flip(u, axis=1) if d == 1 else u


def short_conv_grid(u, w):
    b, t, ch = u.shape
    rows = t // GRID_W
    img = u.reshape(b, rows, GRID_W, ch)
    out = lax.conv_general_dilated(img, w[:, :, None, :].astype(u.dtype), (1, 1), 'SAME',
                                   dimension_numbers=('NHWC', 'HWIO', 'NHWC'), feature_group_count=ch)
    return out.reshape(b, t, ch)


def short_conv_seq(u, w):
    ch = u.shape[-1]
    k1 = w[CONV_K // 2][:, None, :].astype(u.dtype)
    return lax.conv_general_dilated(u, k1, (1,), 'SAME',
                                    dimension_numbers=('NWC', 'WIO', 'NWC'), feature_group_count=ch)


def delta_chunk_scan(q, k, v, g, beta, s0):
    c = q.shape[-2]
    dk = q.shape[-1]
    gc = jnp.cumsum(g, axis=-1)
    idx = jnp.arange(c)
    causal = idx[:, None] >= idx[None, :]
    strict = idx[:, None] > idx[None, :]
    gam = jnp.exp(jnp.where(causal, gc[..., :, None] - gc[..., None, :], -jnp.inf))
    kk = jnp.einsum('bhnck,bhnjk->bhncj', k, k)
    m = jnp.eye(c, dtype=jnp.float32) + jnp.where(strict, beta[..., :, None] * kk * gam, 0.0)
    rhs = jnp.concatenate([k * (beta * jnp.exp(gc))[..., None], v * beta[..., None]], axis=-1)
    sol = lax.linalg.triangular_solve(m, rhs, left_side=True, lower=True)
    w_c, u_c = sol[..., :dk], sol[..., dk:]
    a_qk = jnp.einsum('bhnck,bhnjk->bhncj', q, k) * gam
    q_dec = q * jnp.exp(gc)[..., None]
    k_dec = k * jnp.exp(gc[..., -1:] - gc)[..., None]
    c_dec = jnp.exp(gc[..., -1])
    xs = tuple(jnp.moveaxis(t, 2, 0) for t in (w_c, u_c, a_qk, q_dec, k_dec, c_dec))

    def step(s, inp):
        w_n, u_n, a_n, qd_n, kd_n, cd_n = inp
        v_new = u_n - jnp.einsum('bhck,bhkv->bhcv', w_n, s)
        o = jnp.einsum('bhck,bhkv->bhcv', qd_n, s) + jnp.einsum('bhcj,bhjv->bhcv', a_n, v_new)
        s = s * cd_n[..., None, None] + jnp.einsum('bhck,bhcv->bhkv', kd_n, v_new)
        return s, o

    s_fin, o = lax.scan(step, s0, xs)
    return jnp.moveaxis(o, 0, 2), s_fin


def gla_chunk_scan(q, k, v, lg, s0):
    c = q.shape[-2]
    bc = jnp.cumsum(lg, axis=-2)
    ref = bc[..., c // 2:c // 2 + 1, :]
    idx = jnp.arange(c)
    causal = idx[:, None] >= idx[None, :]
    a = jnp.einsum('bhnck,bhnjk->bhncj', q * jnp.exp(bc - ref), k * jnp.exp(ref - bc))
    a = jnp.where(causal, a, 0.0)
    o_intra = jnp.einsum('bhncj,bhnjv->bhncv', a, v)
    q_dec = q * jnp.exp(bc)
    k_dec = k * jnp.exp(bc[..., -1:, :] - bc)
    c_dec = jnp.exp(bc[..., -1, :])
    xs = tuple(jnp.moveaxis(t, 2, 0) for t in (q_dec, k_dec, v, c_dec))

    def step(s, inp):
        qd_n, kd_n, v_n, cd_n = inp
        o = jnp.einsum('bhck,bhkv->bhcv', qd_n, s)
        s = s * cd_n[..., :, None] + jnp.einsum('bhck,bhcv->bhkv', kd_n, v_n)
        return s, o

    s_fin, o_inter = lax.scan(step, s0, xs)
    return jnp.moveaxis(o_inter, 0, 2) + o_intra, s_fin


def bidir_prefix_scan(core, ctx_dirs, lat_dirs, s0, need_ctx):
    o_ctx, o_lat = [], []
    for d in range(2):
        fc = tuple(to_chunks(flip_seq(u, d)) for u in ctx_dirs[d])
        fl = tuple(to_chunks(flip_seq(u, d)) for u in lat_dirs[d])
        oc, s_ctx = core(*fc, s0)
        ol, _ = core(*fl, s_ctx)
        o_lat.append(flip_seq(from_chunks(ol), d))
        if need_ctx:
            o_ctx.append(flip_seq(from_chunks(oc), d))
    return (o_ctx[0] + o_ctx[1]) if need_ctx else None, o_lat[0] + o_lat[1]


def gated_out(o, z, norm_g, w_out):
    b, t = o.shape[:2]
    y = rms_norm(o, norm_g).reshape(b, t, -1) * jax.nn.silu(z.astype(jnp.float32))
    return y @ w_out


def deltanet_features(h, w_in, conv_w, a_log, dt_bias, on_grid):
    b, t, _ = h.shape
    p = h @ w_in
    qkv, z, a, bt = jnp.split(p, [DN_QKV, DN_QKV + DN_V, DN_QKV + DN_V + 2 * DN_HEADS], axis=-1)
    qkv = jax.nn.silu(short_conv_grid(qkv, conv_w) if on_grid else short_conv_seq(qkv, conv_w))
    q, k, v = jnp.split(qkv, [DN_QK, 2 * DN_QK], axis=-1)
    q = l2_norm(q.reshape(b, t, DN_HEADS, DN_DK)) * (DN_DK ** -0.5)
    k = l2_norm(k.reshape(b, t, DN_HEADS, DN_DK))
    v = v.reshape(b, t, DN_HEADS, DN_DV).astype(jnp.float32)
    a = a.reshape(b, t, 2, DN_HEADS).astype(jnp.float32)
    bt = bt.reshape(b, t, 2, DN_HEADS).astype(jnp.float32)
    g = -jnp.exp(a_log.astype(jnp.float32)) * jax.nn.softplus(a + dt_bias.astype(jnp.float32))
    beta = jax.nn.sigmoid(bt)
    dirs = [(q, k, v, g[:, :, d], beta[:, :, d]) for d in range(2)]
    return dirs, z


def deltanet_mixer(h_ctx, h_lat, w_in, conv_w, a_log, dt_bias, norm_g, w_out, need_ctx):
    ctx_dirs, z_ctx = deltanet_features(h_ctx, w_in, conv_w, a_log, dt_bias, False)
    lat_dirs, z_lat = deltanet_features(h_lat, w_in, conv_w, a_log, dt_bias, True)
    s0 = jnp.zeros((h_lat.shape[0], DN_HEADS, DN_DK, DN_DV), jnp.float32)
    o_ctx, o_lat = bidir_prefix_scan(delta_chunk_scan, ctx_dirs, lat_dirs, s0, need_ctx)
    y_lat = gated_out(o_lat, z_lat, norm_g, w_out)
    y_ctx = gated_out(o_ctx, z_ctx, norm_g, w_out) if need_ctx else None
    return y_ctx, y_lat


def gla_features(h, w_in, w_g2, b_g):
    b, t, _ = h.shape
    p = h @ w_in
    q, k, v, r, gl = jnp.split(p, [GLA_K, 2 * GLA_K, 2 * GLA_K + GLA_V, 2 * GLA_K + 2 * GLA_V], axis=-1)
    q = q.reshape(b, t, GLA_HEADS, GLA_DK).astype(jnp.float32) * (GLA_DK ** -0.5)
    k = k.reshape(b, t, GLA_HEADS, GLA_DK).astype(jnp.float32)
    v = v.reshape(b, t, GLA_HEADS, GLA_DV).astype(jnp.float32)
    gl = gl.reshape(b, t, 2, GLA_RANK)
    zg = jnp.einsum('btdr,drk->btdk', gl, w_g2) + b_g
    lg = (jax.nn.log_sigmoid(zg.astype(jnp.float32)) / GLA_TAU).reshape(b, t, 2, GLA_HEADS, GLA_DK)
    dirs = [(q, k, v, lg[:, :, d]) for d in range(2)]
    return dirs, r


def gla_mixer(h_ctx, h_lat, w_in, w_g2, b_g, norm_g, w_out, need_ctx):
    ctx_dirs, r_ctx = gla_features(h_ctx, w_in, w_g2, b_g)
    lat_dirs, r_lat = gla_features(h_lat, w_in, w_g2, b_g)
    s0 = jnp.zeros((h_lat.shape[0], GLA_HEADS, GLA_DK, GLA_DV), jnp.float32)
    o_ctx, o_lat = bidir_prefix_scan(gla_chunk_scan, ctx_dirs, lat_dirs, s0, need_ctx)
    y_lat = gated_out(o_lat, r_lat, norm_g, w_out)
    y_ctx = gated_out(o_ctx, r_ctx, norm_g, w_out) if need_ctx else None
    return y_ctx, y_lat


def setup_inputs(seed: int = 0) -> dict:
    key = jax.random.key(seed)
    ks = jax.random.split(key, 20)
    f32 = jnp.float32

    def nrm(k, shape, s):
        return jax.random.normal(k, shape, f32) * s

    x = nrm(ks[0], (BATCH, SEQ, D_MODEL), 1.0)
    c = nrm(ks[1], (BATCH, D_MODEL), 1.0)
    ctx = nrm(ks[2], (BATCH, CTX_LEN, D_MODEL), 1.0)
    c_ctx = nrm(ks[3], (D_MODEL,), 1.0)
    mod_w = nrm(ks[4], (DEPTH, D_MODEL, 3 * D_MODEL), 0.5 * D_MODEL ** -0.5)
    mod_b = nrm(ks[5], (DEPTH, 3 * D_MODEL), 0.02)
    norm_g = 1.0 + nrm(ks[6], (DEPTH, D_MODEL), 0.02)
    dn_w_in = nrm(ks[7], (N_DN, D_MODEL, DN_IN), D_MODEL ** -0.5)
    dn_conv_w = nrm(ks[8], (N_DN, CONV_K, CONV_K, DN_QKV), 1.0 / CONV_K)
    dn_a_log = jnp.log(jax.random.uniform(ks[9], (N_DN, 2, DN_HEADS), f32, 1.0, 16.0))
    dt = jnp.exp(jax.random.uniform(ks[10], (N_DN, 2, DN_HEADS), f32, math.log(1e-3), math.log(1e-1)))
    dn_dt_bias = dt + jnp.log(-jnp.expm1(-dt))
    dn_norm_g = 1.0 + nrm(ks[11], (N_DN, DN_DV), 0.02)
    dn_w_out = nrm(ks[12], (N_DN, DN_V, D_MODEL), DN_V ** -0.5)
    gla_w_in = nrm(ks[13], (N_GLA, D_MODEL, GLA_IN), D_MODEL ** -0.5)
    gla_w_g2 = nrm(ks[14], (N_GLA, 2, GLA_RANK, GLA_K), GLA_RANK ** -0.5)
    gla_b_g = nrm(ks[15], (N_GLA, 2, GLA_K), 0.1)
    gla_norm_g = 1.0 + nrm(ks[16], (N_GLA, GLA_DV), 0.02)
    gla_w_out = nrm(ks[17], (N_GLA, GLA_V, D_MODEL), GLA_V ** -0.5)
    final_g = 1.0 + nrm(ks[18], (D_MODEL,), 0.02)
    return {'x': x, 'c': c, 'ctx': ctx, 'c_ctx': c_ctx, 'mod_w': mod_w, 'mod_b': mod_b, 'norm_g': norm_g,
            'dn_w_in': dn_w_in, 'dn_conv_w': dn_conv_w, 'dn_a_log': dn_a_log, 'dn_dt_bias': dn_dt_bias,
            'dn_norm_g': dn_norm_g, 'dn_w_out': dn_w_out, 'gla_w_in': gla_w_in, 'gla_w_g2': gla_w_g2,
            'gla_b_g': gla_b_g, 'gla_norm_g': gla_norm_g, 'gla_w_out': gla_w_out, 'final_g': final_g}


def reference(x, c, ctx, c_ctx, mod_w, mod_b, norm_g, dn_w_in, dn_conv_w, dn_a_log, dn_dt_bias,
              dn_norm_g, dn_w_out, gla_w_in, gla_w_g2, gla_b_g, gla_norm_g, gla_w_out, final_g):
    for i in range(DEPTH):
        need_ctx = i < DEPTH - 1
        sh_l, sc_l, gt_l = ada_modulation(c, mod_w[i], mod_b[i])
        sh_c, sc_c, gt_c = ada_modulation(c_ctx, mod_w[i], mod_b[i])
        h_lat = rms_norm(x, norm_g[i]) * (1.0 + sc_l) + sh_l
        h_ctx = rms_norm(ctx, norm_g[i]) * (1.0 + sc_c) + sh_c
        j = i // N_MIXERS
        if i % N_MIXERS == 0:
            y_ctx, y_lat = deltanet_mixer(h_ctx, h_lat, dn_w_in[j], dn_conv_w[j], dn_a_log[j], dn_dt_bias[j],
                                          dn_norm_g[j], dn_w_out[j], need_ctx)
        else:
            y_ctx, y_lat = gla_mixer(h_ctx, h_lat, gla_w_in[j], gla_w_g2[j], gla_b_g[j],
                                     gla_norm_g[j], gla_w_out[j], need_ctx)
        x = x + gt_l * y_lat
        if need_ctx:
            ctx = ctx + gt_c * y_ctx
    return rms_norm(x, final_g)
```

```cpp
#include <hip/hip_runtime.h>
#include <hip/hip_cooperative_groups.h>
#include <cstdio>
namespace cg = cooperative_groups;

#define DI __device__ __forceinline__
typedef unsigned short u16;
typedef short s16x8 __attribute__((ext_vector_type(8)));
typedef short s16x4 __attribute__((ext_vector_type(4)));
typedef float f32x2 __attribute__((ext_vector_type(2)));
typedef float f32x4 __attribute__((ext_vector_type(4)));
typedef float f32x16 __attribute__((ext_vector_type(16)));
typedef int i32x4 __attribute__((ext_vector_type(4)));
typedef unsigned u32x2 __attribute__((ext_vector_type(2)));
typedef unsigned u32x4 __attribute__((ext_vector_type(4)));
typedef __bf16 bf2_t __attribute__((ext_vector_type(2)));

constexpr int RL = 32768;
constexpr int RC = 1024;
constexpr int R = RL + RC;
constexpr int DM = 1024;
constexpr int NCHUNK = R / 64;
constexpr float EPSF = 1e-6f;
constexpr size_t MiB = 1u << 20;

constexpr size_t OFF_QK0 = 0;
constexpr size_t OFF_U0 = 132 * MiB;
constexpr size_t OFF_U1 = 264 * MiB;
constexpr size_t OFF_T = 396 * MiB;
constexpr size_t OFF_W1T = 462 * MiB;
constexpr size_t OFF_WO1T = OFF_W1T + 10 * MiB + 256 * 1024;
constexpr size_t OFF_MOD = OFF_WO1T + 4 * MiB;
constexpr size_t OFF_X = OFF_MOD + 256 * 1024;
constexpr size_t OFF_ABT = OFF_X + 8 * MiB + 256 * 1024;
constexpr size_t OFF_W0T = OFF_ABT + 4 * MiB + 256 * 1024;
constexpr size_t OFF_WO0T = OFF_W0T + 12 * MiB + 256 * 1024;
constexpr size_t OFF_V0 = 0;
constexpr size_t OFF_V1 = 132 * MiB;
constexpr size_t OFF_QK1 = 264 * MiB;
constexpr size_t OFF_QD = 330 * MiB;
constexpr size_t OFF_CD1 = OFF_X + 4 * MiB;
constexpr size_t OFF_ASUM = OFF_W0T;
constexpr size_t OFF_BAR = 506 * MiB;
constexpr size_t OFF_ZC = 507 * MiB;

struct Params {
  const float *x, *c, *ctx, *c_ctx, *mod_w, *mod_b, *norm_g, *dn_w_in, *dn_conv_w, *dn_a_log, *dn_dt_bias, *dn_norm_g,
      *dn_w_out, *gla_w_in, *gla_w_g2, *gla_b_g, *gla_norm_g, *gla_w_out, *final_g;
  float* out;
  char* ws;
};

DI unsigned pk2(float lo, float hi) { f32x2 v = {lo, hi}; return __builtin_bit_cast(unsigned, __builtin_convertvector(v, bf2_t)); }
DI float bflo(unsigned u) { return __uint_as_float(u << 16); }
DI float bfhi(unsigned u) { return __uint_as_float(u & 0xffff0000u); }
DI float bf2f(u16 v) { return __uint_as_float(((unsigned)v) << 16); }
DI u16 f2bf(float x) { return (u16)(pk2(x, 0.f) & 0xffffu); }
DI float siluf(float x) { return x / (1.f + __expf(-x)); }
DI float sigmoidf(float x) { return 1.f / (1.f + __expf(-x)); }
DI float softplusf(float x) { return fmaxf(x, 0.f) + __logf(1.f + __expf(-fabsf(x))); }
DI int crow(int reg, int h) { return (reg & 3) + 8 * (reg >> 2) + 4 * h; }
#define MFMA32(a, b, c) __builtin_amdgcn_mfma_f32_32x32x16_bf16((a), (b), (c), 0, 0, 0)
#define MFMA16(a, b, c) __builtin_amdgcn_mfma_f32_16x16x32_bf16((a), (b), (c), 0, 0, 0)

DI s16x8 cat8(u32x2 lo, u32x2 hi) { u32x4 v = {lo.x, lo.y, hi.x, hi.y}; return __builtin_bit_cast(s16x8, v); }
DI s16x8 ldA_perm(const char* base, int row, int strideB, int kofs, int h) {
  const char* p = base + row * strideB + (kofs + 4 * h) * 2;
  u32x2 lo = *(const u32x2*)p, hi = *(const u32x2*)(p + 16);
  return cat8(lo, hi);
}
DI s16x8 ldA_nat(const char* base, int row, int strideB, int kofs, int h) {
  const char* p = base + row * strideB + (kofs + 8 * h) * 2;
  u32x2 lo = *(const u32x2*)p, hi = *(const u32x2*)(p + 8);
  return cat8(lo, hi);
}
DI s16x8 pack_step(const f32x16& x, int s) {
  u32x4 p;
  p.x = pk2(x[8 * s + 0], x[8 * s + 1]); p.y = pk2(x[8 * s + 2], x[8 * s + 3]);
  p.z = pk2(x[8 * s + 4], x[8 * s + 5]); p.w = pk2(x[8 * s + 6], x[8 * s + 7]);
  return __builtin_bit_cast(s16x8, p);
}
DI void st8(char* p, u32x4 v) { *(u32x2*)p = (u32x2){v.x, v.y}; *(u32x2*)(p + 8) = (u32x2){v.z, v.w}; }
DI u32x4 scale8(u32x4 v, float s) {
  u32x4 o;
  o.x = pk2(bflo(v.x) * s, bfhi(v.x) * s); o.y = pk2(bflo(v.y) * s, bfhi(v.y) * s);
  o.z = pk2(bflo(v.z) * s, bfhi(v.z) * s); o.w = pk2(bflo(v.w) * s, bfhi(v.w) * s);
  return o;
}
DI int opq_v(int v) { asm volatile("" : "+v"(v)); return v; }
DI int lane_id() { int r; asm volatile("v_mbcnt_lo_u32_b32 %0, -1, 0\n\tv_mbcnt_hi_u32_b32 %0, -1, %0" : "=v"(r)); return r; }
#define TIDX() (wave_s_ * 64 + lane_id())
DI float wave_sum(float v) {
#pragma unroll
  for (int o = 32; o >= 1; o >>= 1) v += __shfl_xor(v, o, 64);
  return v;
}

DI void mods_phase(char* shm, const Params& p, const int wave_s_) {
  const int bid = blockIdx.x, tid = TIDX();
  float* mods = (float*)(p.ws + OFF_MOD);
  if (bid < 192) {
    float* scond = (float*)shm;
    float* red = scond + 5 * 1024;
    for (int e = tid; e < 5 * 1024; e += 512) {
      int r = e >> 10, k = e & 1023;
      float v = (r < 4) ? p.c[r * 1024 + k] : p.c_ctx[k];
      scond[e] = siluf(v);
    }
    __syncthreads();
    const int i = bid / 96, jt = bid % 96, jl = tid & 31, ks = tid >> 5;
    const float* w = p.mod_w + (size_t)i * 1024 * 3072 + jt * 32 + jl;
    float a0 = 0, a1 = 0, a2 = 0, a3 = 0, a4 = 0;
#pragma unroll 8
    for (int kk = 0; kk < 64; ++kk) {
      int k = ks * 64 + kk;
      float wv = w[(size_t)k * 3072];
      a0 += scond[k] * wv; a1 += scond[1024 + k] * wv; a2 += scond[2048 + k] * wv; a3 += scond[3072 + k] * wv; a4 += scond[4096 + k] * wv;
    }
    red[(ks * 5 + 0) * 32 + jl] = a0; red[(ks * 5 + 1) * 32 + jl] = a1; red[(ks * 5 + 2) * 32 + jl] = a2;
    red[(ks * 5 + 3) * 32 + jl] = a3; red[(ks * 5 + 4) * 32 + jl] = a4;
    __syncthreads();
    if (tid < 160) {
      int r = tid >> 5, j = tid & 31;
      float s = p.mod_b[i * 3072 + jt * 32 + j];
      for (int q = 0; q < 16; ++q) s += red[(q * 5 + r) * 32 + j];
      mods[(i * 5 + r) * 3072 + jt * 32 + j] = s;
    }
    __syncthreads();
  }
}

DI void wtrans_tile(char* shm, const float* src, int K, int N, u16* dst, int tile, const int wave_s_) {
  u16* t = (u16*)shm;
  const int tid = TIDX();
  const int tn = (N + 63) / 64;
  const int k0 = (tile / tn) * 64, n0 = (tile % tn) * 64;
#pragma unroll
  for (int q = 0; q < 8; ++q) {
    int e = tid + q * 512, kk = e >> 6, nn = e & 63;
    float v = (n0 + nn < N) ? src[(size_t)(k0 + kk) * N + n0 + nn] : 0.f;
    t[nn * 66 + kk] = f2bf(v);
  }
  __syncthreads();
#pragma unroll
  for (int q = 0; q < 8; ++q) {
    int e = tid + q * 512, nn = e >> 6, kk = e & 63;
    if (n0 + nn < N) dst[(size_t)(n0 + nn) * K + k0 + kk] = t[nn * 66 + kk];
  }
  __syncthreads();
}
DI void wtrans_phase(char* shm, const Params& p, const int wave_s_) {
  const int t0 = 16 * 97, t1 = 32 * 16, t2 = 16 * 81, t3 = 32 * 16;
  const int total = t0 + t1 + t2 + t3;
  for (int tile = blockIdx.x; tile < total; tile += gridDim.x) {
    if (tile < t0) wtrans_tile(shm, p.dn_w_in, 1024, 6176, (u16*)(p.ws + OFF_W0T), tile, wave_s_);
    else if (tile < t0 + t1) wtrans_tile(shm, p.dn_w_out, 2048, 1024, (u16*)(p.ws + OFF_WO0T), tile - t0, wave_s_);
    else if (tile < t0 + t1 + t2) wtrans_tile(shm, p.gla_w_in, 1024, 5152, (u16*)(p.ws + OFF_W1T), tile - t0 - t1, wave_s_);
    else wtrans_tile(shm, p.gla_w_out, 2048, 1024, (u16*)(p.ws + OFF_WO1T), tile - t0 - t1 - t2, wave_s_);
  }
}

DI void h_phase(const float* src_lat, const float* src_ctx, const float* g, const float* mods_i, u16* dst, int nrows, const int wave_s_) {
  const int tidx_ = TIDX();
  const int lane = tidx_ & 63, gw = blockIdx.x * 8 + (tidx_ >> 6), nw = gridDim.x * 8;
  for (int row0 = gw; row0 < nrows; row0 += 2 * nw) {
    const int rows[2] = {row0, row0 + nw};
    const bool ok1 = rows[1] < nrows;
    f32x4 v[2][4];
#pragma unroll
    for (int u = 0; u < 2; ++u) {
      const int row = (u == 0 || ok1) ? rows[u] : rows[0];
      const float* s = (row < RL) ? src_lat + (size_t)row * DM : src_ctx + (size_t)(row - RL) * DM;
#pragma unroll
      for (int q = 0; q < 4; ++q) v[u][q] = *(const f32x4*)(s + q * 256 + lane * 4);
    }
#pragma unroll
    for (int u = 0; u < 2; ++u) {
      if (u == 1 && !ok1) break;
      const int row = rows[u];
      const int mr = (row < RL) ? (row >> 13) : 4;
      const float* sh = mods_i + mr * 3072;
      const float* sc = sh + 1024;
      float ss = 0.f;
#pragma unroll
      for (int q = 0; q < 4; ++q) ss += v[u][q].x * v[u][q].x + v[u][q].y * v[u][q].y + v[u][q].z * v[u][q].z + v[u][q].w * v[u][q].w;
      ss = wave_sum(ss);
      const float rstd = rsqrtf(ss * (1.f / 1024.f) + EPSF);
#pragma unroll
      for (int q = 0; q < 4; ++q) {
        const int col = q * 256 + lane * 4;
        f32x4 gg = *(const f32x4*)(g + col), s1 = *(const f32x4*)(sc + col), s0 = *(const f32x4*)(sh + col);
        float o0 = v[u][q].x * rstd * gg.x * (1.f + s1.x) + s0.x, o1 = v[u][q].y * rstd * gg.y * (1.f + s1.y) + s0.y;
        float o2 = v[u][q].z * rstd * gg.z * (1.f + s1.z) + s0.z, o3 = v[u][q].w * rstd * gg.w * (1.f + s1.w) + s0.w;
        *(u32x2*)(dst + (size_t)row * DM + col) = (u32x2){pk2(o0, o1), pk2(o2, o3)};
      }
    }
  }
}

DI void small_gemm(const u16* A, const u16* Wt, float* out, const int wave_s_) {
  const int tidx_ = TIDX();
  if ((blockIdx.x & 7) == 0) return;
  const int bsub = (int)blockIdx.x - 1 - ((int)blockIdx.x >> 3);
  const int lane = tidx_ & 63, gw = bsub * 8 + (tidx_ >> 6), nw = (gridDim.x - (gridDim.x >> 3)) * 8;
  const int r = lane & 31, h = lane >> 5;
  for (int wt = gw; wt < R / 32; wt += nw) {
    const u16* ap = A + (size_t)(wt * 32 + r) * 1024 + 8 * h;
    const u16* bp = Wt + (size_t)r * 1024 + 8 * h;
    f32x16 acc;
    for (int i = 0; i < 16; ++i) acc[i] = 0.f;
#pragma unroll 8
    for (int s = 0; s < 64; ++s) {
      s16x8 a = *(const s16x8*)(ap + 16 * s), b = *(const s16x8*)(bp + 16 * s);
      acc = MFMA32(a, b, acc);
    }
#pragma unroll
    for (int i = 0; i < 16; ++i) out[(size_t)(wt * 32 + crow(i, h)) * 32 + r] = acc[i];
  }
}

DI int lds_byte2(int r, int c) {
  int st = (r >> 4) * 2 + (c >> 5), ob = (r & 15) * 64 + (c & 31) * 2;
  return st * 1024 + (ob ^ (((ob >> 9) & 1) << 5));
}
DI void stage_rc2(int b, int& Rr, int& Cc) {
  int st = b >> 10, sb = b & 1023, swz = sb ^ (((sb >> 9) & 1) << 5);
  Rr = (st / 2) * 16 + swz / 64;
  Cc = (st % 2) * 32 + (swz % 64) / 2;
}

struct EpiArgs {
  int mode;
  u16* lat; u16* ctx; int ld;
  u16* b1; u16* b2;
  const float* res_lat; const float* res_ctx; const float* mods_i; float* out_lat; float* out_ctx;
};

template <int MODE>
DI void gemm_epilogue(const EpiArgs& e, f32x4 (&acc)[8][4], int row0, int pn, int wr, int wc, int fr, int fq) {
#pragma unroll
  for (int m = 0; m < 8; ++m) {
    const int row = row0 + wr * 128 + m * 16 + fr;
#pragma unroll
    for (int n = 0; n < 4; ++n) {
      const int col = pn * 256 + wc * 64 + n * 16 + fq * 4;
      const f32x4 a = acc[m][n];
      if (MODE == 0) {
        u16* pr = (row < RL) ? e.lat + (size_t)row * e.ld : e.ctx + (size_t)(row - RL) * e.ld;
        *(u32x2*)(pr + col) = (u32x2){pk2(a.x, a.y), pk2(a.z, a.w)};
      } else if (MODE == 1) {
        u32x2 v = {pk2(a.x, a.y), pk2(a.z, a.w)};
        if (pn < 4) {
          *(u32x2*)(e.lat + (size_t)row * 1024 + col) = v;
        } else {
          *(u32x2*)(e.b1 + (size_t)row * 2048 + col - 1024) = v;
          *(u32x2*)(e.b2 + (size_t)row * 2048 + col - 1024) = v;
        }
      } else {
        const int mr = (row < RL) ? (row >> 13) : 4;
        const f32x4 gt = *(const f32x4*)(e.mods_i + mr * 3072 + 2048 + col);
        const float* rp = (row < RL) ? e.res_lat + (size_t)row * DM : e.res_ctx + (size_t)(row - RL) * DM;
        float* op = (row < RL) ? e.out_lat + (size_t)row * DM : e.out_ctx + (size_t)(row - RL) * DM;
        const f32x4 rv = *(const f32x4*)(rp + col);
        f32x4 o = {rv.x + gt.x * a.x, rv.y + gt.y * a.y, rv.z + gt.z * a.z, rv.w + gt.w * a.w};
        *(f32x4*)(op + col) = o;
      }
    }
  }
}

template <int MODE>
DI void gemm_epilogue8(const EpiArgs& e, f32x4 (&acc)[2][2][4][2], int row0, int pn, int wr, int wc, int fr, int fq) {
#pragma unroll
  for (int ai = 0; ai < 2; ++ai)
#pragma unroll
    for (int m = 0; m < 4; ++m) {
      const int row = row0 + ai * 128 + wr * 64 + m * 16 + fr;
#pragma unroll
      for (int bj = 0; bj < 2; ++bj)
#pragma unroll
        for (int n = 0; n < 2; ++n) {
          const int col = pn * 256 + bj * 128 + wc * 32 + n * 16 + fq * 4;
          const f32x4 a = acc[ai][bj][m][n];
          if (MODE == 0) {
            u16* pr = (row < RL) ? e.lat + (size_t)row * e.ld : e.ctx + (size_t)(row - RL) * e.ld;
            *(u32x2*)(pr + col) = (u32x2){pk2(a.x, a.y), pk2(a.z, a.w)};
          } else if (MODE == 4) {
            const size_t dsel = (pn < 8) ? 0 : (pn < 16) ? (4 * MiB / 2) : ((OFF_ZC - OFF_X) / 2);
            *(u32x2*)(e.ctx + dsel + (size_t)(row - RL) * 2048 + (col & 2047)) = (u32x2){pk2(a.x, a.y), pk2(a.z, a.w)};
          } else if (MODE == 1) {
            u32x2 v = {pk2(a.x, a.y), pk2(a.z, a.w)};
            if (pn < 4) {
              *(u32x2*)(e.lat + (size_t)row * 1024 + col) = v;
            } else {
              *(u32x2*)(e.b1 + (size_t)row * 2048 + col - 1024) = v;
              *(u32x2*)(e.b2 + (size_t)row * 2048 + col - 1024) = v;
            }
          } else {
            const int mr = (row < RL) ? (row >> 13) : 4;
            const f32x4 gt = *(const f32x4*)(e.mods_i + mr * 3072 + 2048 + col);
            const float* rp = (row < RL) ? e.res_lat + (size_t)row * DM : e.res_ctx + (size_t)(row - RL) * DM;
            float* op = (row < RL) ? e.out_lat + (size_t)row * DM : e.out_ctx + (size_t)(row - RL) * DM;
            const f32x4 rv = *(const f32x4*)(rp + col);
            f32x4 o = {rv.x + gt.x * a.x, rv.y + gt.y * a.y, rv.z + gt.z * a.z, rv.w + gt.w * a.w};
            *(f32x4*)(op + col) = o;
          }
        }
    }
}

template <int MODE>
DI void gemm_phase(char* shm_, const u16* Alat, const u16* Actx, int K, const u16* Bt, int pm0, int npm, int nN, const EpiArgs& e, const int wave_s_) {
  constexpr int BK = 64, HALF = 128, HT = HALF * BK;
  u16* shm = (u16*)shm_;
  const int tid = TIDX(), wid = tid >> 6, lane = tid & 63, wr = wid >> 2, wc = wid & 3, fr = lane & 15, fq = lane >> 4;
#define SA(b, h) (shm + ((b) * 2 + (h)) * HT)
#define SB(b, h) (shm + (4 + (b) * 2 + (h)) * HT)
#define LDSP(ptr) ((__attribute__((address_space(3))) unsigned*)(unsigned)(size_t)(ptr))
#define STAGE(P, BASE, br, kt) do { const u16* _p = (BASE) + (size_t)(br) * K + (kt) * BK + soff; \
    _Pragma("unroll") for (int _i = 0; _i < 2; ++_i) \
      __builtin_amdgcn_global_load_lds((const unsigned*)(_p + (size_t)_i * 64 * K), LDSP((char*)(P) + wid * 1024 + _i * 8192), 16, 0, 0); } while (0)
#define LDA(dst, b, h) _Pragma("unroll") for (int m = 0; m < 4; ++m) _Pragma("unroll") for (int k = 0; k < 2; ++k) \
    dst[m][k] = *(const s16x8*)((const char*)SA(b, h) + lds_byte2(wr * 64 + m * 16 + fr, k * 32 + fq * 8))
#define LDB(dst, b, h) _Pragma("unroll") for (int n = 0; n < 2; ++n) _Pragma("unroll") for (int k = 0; k < 2; ++k) \
    dst[n][k] = *(const s16x8*)((const char*)SB(b, h) + lds_byte2(wc * 32 + n * 16 + fr, k * 32 + fq * 8))
#define MMA(ai, bj, Atv, Btv) do { __builtin_amdgcn_s_setprio(1); \
    _Pragma("unroll") for (int m = 0; m < 4; ++m) _Pragma("unroll") for (int n = 0; n < 2; ++n) _Pragma("unroll") for (int k = 0; k < 2; ++k) \
      acc[ai][bj][m][n] = MFMA16(Btv[n][k], Atv[m][k], acc[ai][bj][m][n]); \
    __builtin_amdgcn_s_setprio(0); } while (0)
#define WAIT_V(n) asm volatile("s_waitcnt vmcnt(" #n ")" ::: "memory")
#define WAIT_L(n) asm volatile("s_waitcnt lgkmcnt(" #n ")" ::: "memory")
#define BAR __builtin_amdgcn_s_barrier()
#define SCHED __builtin_amdgcn_sched_barrier(0)
  int sR0, sC0;
  stage_rc2(tid * 16, sR0, sC0);
  const size_t soff = (size_t)sR0 * K + sC0;
  const int ntiles = npm * nN, nt = K / BK;
  const int xcd = blockIdx.x & 7, jj = blockIdx.x >> 3;
  const int PN = (nN % 8 == 0) ? 8 : 4, PG = 32 / PN, npg = nN / PN;
  const int ngroups = ((npm + PG - 1) / PG) * npg;
  const bool grouped = (gridDim.x == 256);
  const int nit = grouped ? (ngroups - xcd + 7) / 8 : (ntiles - (int)blockIdx.x + (int)gridDim.x - 1) / (int)gridDim.x;
  auto tile_of = [&](int it, int& pm, int& pn) -> bool {
    if (it >= nit) return false;
    if (grouped) {
      const int g = xcd + 8 * it, pmg = g / npg, png = g % npg;
      pm = pmg * PG + jj / PN; pn = png * PN + jj % PN;
      if (pm >= npm) return false;
      pm += pm0;
    } else {
      const int L = blockIdx.x + it * gridDim.x;
      pm = pm0 + L / nN; pn = L % nN;
    }
    return true;
  };
  bool prefetched = false;
  for (int it = 0; it < nit; ++it) {
    int pm, pn;
    if (!tile_of(it, pm, pn)) continue;
    const int row0 = pm * 256;
    const u16* A = (row0 < RL) ? Alat + (size_t)row0 * K : Actx + (size_t)(row0 - RL) * K;
    const u16* Bw = Bt + (size_t)pn * 256 * K;
    const int brow = 0, bcol = 0;
    f32x4 acc[2][2][4][2];
#pragma unroll
    for (int i0 = 0; i0 < 2; ++i0)
#pragma unroll
      for (int i1 = 0; i1 < 2; ++i1)
#pragma unroll
        for (int i2 = 0; i2 < 4; ++i2)
#pragma unroll
          for (int i3 = 0; i3 < 2; ++i3) acc[i0][i1][i2][i3] = (f32x4){0.f, 0.f, 0.f, 0.f};
    s16x8 At[4][2], B0[2][2], B1[2][2];
    if (!prefetched) {
      STAGE(SB(0, 0), Bw, bcol, 0); STAGE(SA(0, 0), A, brow, 0);
      STAGE(SB(0, 1), Bw, bcol + HALF, 0); STAGE(SA(0, 1), A, brow + HALF, 0);
    }
    if (wr == 1) BAR;
    WAIT_V(4); BAR;
    STAGE(SB(1, 0), Bw, bcol, 1); STAGE(SA(1, 0), A, brow, 1); STAGE(SB(1, 1), Bw, bcol + HALF, 1);
    WAIT_V(6); BAR;
    for (int t = 0; t < nt - 2; t += 2) {
      LDB(B0, 0, 0); SCHED; LDA(At, 0, 0); STAGE(SA(1, 1), A, brow + HALF, t + 1);
      WAIT_L(8); BAR; WAIT_L(0); MMA(0, 0, At, B0); BAR; SCHED;
      LDB(B1, 0, 1); STAGE(SB(0, 0), Bw, bcol, t + 2);
      BAR; WAIT_L(0); MMA(0, 1, At, B1); BAR;
      LDA(At, 0, 1); STAGE(SA(0, 0), A, brow, t + 2);
      BAR; WAIT_L(0); MMA(1, 0, At, B0); BAR; SCHED;
      STAGE(SB(0, 1), Bw, bcol + HALF, t + 2);
      WAIT_V(6); BAR; MMA(1, 1, At, B1); BAR;
      LDB(B0, 1, 0); SCHED; LDA(At, 1, 0); STAGE(SA(0, 1), A, brow + HALF, t + 2);
      WAIT_L(8); BAR; WAIT_L(0); MMA(0, 0, At, B0); BAR; SCHED;
      LDB(B1, 1, 1); STAGE(SB(1, 0), Bw, bcol, t + 3);
      BAR; WAIT_L(0); MMA(0, 1, At, B1); BAR;
      LDA(At, 1, 1); STAGE(SA(1, 0), A, brow, t + 3);
      BAR; WAIT_L(0); MMA(1, 0, At, B0); BAR; SCHED;
      STAGE(SB(1, 1), Bw, bcol + HALF, t + 3);
      WAIT_V(6); BAR; MMA(1, 1, At, B1); BAR;
    }
    { LDB(B0, 0, 0); LDA(At, 0, 0); STAGE(SA(1, 1), A, brow + HALF, nt - 1);
      BAR; WAIT_L(0); MMA(0, 0, At, B0); BAR;
      LDB(B1, 0, 1); BAR; WAIT_L(0); MMA(0, 1, At, B1); BAR;
      LDA(At, 0, 1); WAIT_V(4); BAR; WAIT_L(0); MMA(1, 0, At, B0); MMA(1, 1, At, B1); BAR; }
    { LDB(B0, 1, 0); LDA(At, 1, 0); WAIT_V(2); BAR; WAIT_L(0); MMA(0, 0, At, B0); BAR;
      LDB(B1, 1, 1); WAIT_V(0); BAR; WAIT_L(0); MMA(0, 1, At, B1); BAR;
      LDA(At, 1, 1); BAR; WAIT_L(0); MMA(1, 0, At, B0); MMA(1, 1, At, B1); BAR; }
    if (wr == 0) BAR;
    {
      int pm2, pn2;
      prefetched = tile_of(it + 1, pm2, pn2);
      if (prefetched) {
        const int r2 = pm2 * 256;
        const u16* A2 = (r2 < RL) ? Alat + (size_t)r2 * K : Actx + (size_t)(r2 - RL) * K;
        const u16* B2 = Bt + (size_t)pn2 * 256 * K;
        STAGE(SB(0, 0), B2, 0, 0); STAGE(SA(0, 0), A2, 0, 0);
        STAGE(SB(0, 1), B2, HALF, 0); STAGE(SA(0, 1), A2, HALF, 0);
      }
    }
    { const int l2 = lane_id(); gemm_epilogue8<MODE>(e, acc, row0, pn, wr, wc, l2 & 15, l2 >> 4); }
    asm volatile("s_waitcnt vmcnt(0) lgkmcnt(0)" ::: "memory");
    BAR;
  }
#undef SA
#undef SB
#undef LDSP
#undef STAGE
#undef LDA
#undef LDB
#undef MMA
#undef WAIT_V
#undef WAIT_L
#undef BAR
#undef SCHED
}

DI void conv_accum(float (&acc)[8], const u16* srow, const float* w) {
  u32x4 v = *(const u32x4*)srow;
  f32x4 w0 = *(const f32x4*)w, w1 = *(const f32x4*)(w + 4);
  acc[0] += bflo(v.x) * w0.x; acc[1] += bfhi(v.x) * w0.y; acc[2] += bflo(v.y) * w0.z; acc[3] += bfhi(v.y) * w0.w;
  acc[4] += bflo(v.z) * w1.x; acc[5] += bfhi(v.z) * w1.y; acc[6] += bflo(v.w) * w1.z; acc[7] += bfhi(v.w) * w1.w;
}
DI void fma8(float (&acc)[8], const u32x4 v, const float (&w)[8]) {
  acc[0] += bflo(v.x) * w[0]; acc[1] += bfhi(v.x) * w[1]; acc[2] += bflo(v.y) * w[2]; acc[3] += bfhi(v.y) * w[3];
  acc[4] += bflo(v.z) * w[4]; acc[5] += bfhi(v.z) * w[5]; acc[6] += bflo(v.w) * w[6]; acc[7] += bfhi(v.w) * w[7];
}
template <bool ISV>
DI void conv_store(const Params& p, float (&acc)[8], int row, int ch) {
#pragma unroll
  for (int e = 0; e < 8; ++e) acc[e] = siluf(acc[e]);
  if (!ISV) {
    u16* qk = (u16*)(p.ws + OFF_QK0);
    float ss = 0.f;
#pragma unroll
    for (int e = 0; e < 8; ++e) ss += acc[e] * acc[e];
    ss += __shfl_xor(ss, 1, 64); ss += __shfl_xor(ss, 2, 64); ss += __shfl_xor(ss, 4, 64); ss += __shfl_xor(ss, 8, 64);
    const float sc = rsqrtf(ss + EPSF) * ((ch < 1024) ? 0.08838834764831845f : 1.f);
    u32x4 o = {pk2(acc[0] * sc, acc[1] * sc), pk2(acc[2] * sc, acc[3] * sc), pk2(acc[4] * sc, acc[5] * sc), pk2(acc[6] * sc, acc[7] * sc)};
    *(u32x4*)(qk + (size_t)row * 2048 + ch) = o;
  } else {
    u16* u0 = (u16*)(p.ws + OFF_U0);
    u16* u1 = (u16*)(p.ws + OFF_U1);
    const float* abt = (const float*)(p.ws + OFF_ABT);
    const int head = ch >> 8;
    const float b0 = sigmoidf(abt[(size_t)row * 32 + 16 + head]), b1 = sigmoidf(abt[(size_t)row * 32 + 24 + head]);
    u32x4 o0 = {pk2(acc[0] * b0, acc[1] * b0), pk2(acc[2] * b0, acc[3] * b0), pk2(acc[4] * b0, acc[5] * b0), pk2(acc[6] * b0, acc[7] * b0)};
    u32x4 o1 = {pk2(acc[0] * b1, acc[1] * b1), pk2(acc[2] * b1, acc[3] * b1), pk2(acc[4] * b1, acc[5] * b1), pk2(acc[6] * b1, acc[7] * b1)};
    *(u32x4*)(u0 + (size_t)row * 2048 + ch) = o0;
    *(u32x4*)(u1 + (size_t)row * 2048 + ch) = o1;
  }
}
template <bool ISV>
DI void conv_phase(const Params& p, const int wave_s_) {
  const u16* pre_lat = (const u16*)p.out;
  const u16* pre_ctx = (const u16*)(p.ws + OFF_X + (ISV ? 4 * MiB : 0));
  const float* cw = p.dn_conv_w + (ISV ? 2048 : 0);
  const int gt = blockIdx.x * 512 + TIDX(), nthr = gridDim.x * 512;
  const u32x4 zero4 = {0u, 0u, 0u, 0u};
  for (int idx = gt; idx < 4 * 128 * 4 * 256; idx += nthr) {
    const int cg8 = idx & 255, run = (idx >> 8) & 3, gr = (idx >> 10) & 127, b = idx >> 17, ch = cg8 * 8, c0 = run * 16;
    float w[9][8];
#pragma unroll
    for (int t = 0; t < 9; ++t) {
      const f32x4 w0 = *(const f32x4*)(cw + t * 4096 + ch), w1 = *(const f32x4*)(cw + t * 4096 + ch + 4);
      w[t][0] = w0.x; w[t][1] = w0.y; w[t][2] = w0.z; w[t][3] = w0.w; w[t][4] = w1.x; w[t][5] = w1.y; w[t][6] = w1.z; w[t][7] = w1.w;
    }
    const u16* base = pre_lat + ((size_t)(b << 13) + gr * 64) * 2048 + ch;
    const bool rok[3] = {gr > 0, true, gr < 127};
    u32x4 win[3][3];
#pragma unroll
    for (int i = 0; i < 3; ++i) {
      win[i][0] = (rok[i] && c0 > 0) ? *(const u32x4*)(base + (ptrdiff_t)((i - 1) * 64 + c0 - 1) * 2048) : zero4;
      win[i][1] = rok[i] ? *(const u32x4*)(base + (ptrdiff_t)((i - 1) * 64 + c0) * 2048) : zero4;
    }
#pragma unroll
    for (int t = 0; t < 16; ++t) {
      const int c = c0 + t;
#pragma unroll
      for (int i = 0; i < 3; ++i) win[i][2] = (rok[i] && c < 63) ? *(const u32x4*)(base + (ptrdiff_t)((i - 1) * 64 + c + 1) * 2048) : zero4;
      float acc[8];
#pragma unroll
      for (int e = 0; e < 8; ++e) acc[e] = 0.f;
#pragma unroll
      for (int i = 0; i < 3; ++i)
#pragma unroll
        for (int j = 0; j < 3; ++j) fma8(acc, win[i][j], w[i * 3 + j]);
      conv_store<ISV>(p, acc, (b << 13) + gr * 64 + c, ch);
#pragma unroll
      for (int i = 0; i < 3; ++i) { win[i][0] = win[i][1]; win[i][1] = win[i][2]; }
    }
  }
  for (int idx = gt; idx < 4 * 32 * 256; idx += nthr) {
    const int cg8 = idx & 255, run = (idx >> 8) & 31, b = idx >> 13, ch = cg8 * 8, p0 = run * 8;
    float w[3][8];
#pragma unroll
    for (int t = 0; t < 3; ++t) {
      const f32x4 w0 = *(const f32x4*)(cw + (3 + t) * 4096 + ch), w1 = *(const f32x4*)(cw + (3 + t) * 4096 + ch + 4);
      w[t][0] = w0.x; w[t][1] = w0.y; w[t][2] = w0.z; w[t][3] = w0.w; w[t][4] = w1.x; w[t][5] = w1.y; w[t][6] = w1.z; w[t][7] = w1.w;
    }
    const u16* base = pre_ctx + (size_t)(b * 256) * 2048 + ch;
    u32x4 win[3];
    win[0] = (p0 > 0) ? *(const u32x4*)(base + (size_t)(p0 - 1) * 2048) : zero4;
    win[1] = *(const u32x4*)(base + (size_t)p0 * 2048);
#pragma unroll
    for (int t = 0; t < 8; ++t) {
      const int pp = p0 + t;
      win[2] = (pp < 255) ? *(const u32x4*)(base + (size_t)(pp + 1) * 2048) : zero4;
      float acc[8];
#pragma unroll
      for (int e = 0; e < 8; ++e) acc[e] = 0.f;
#pragma unroll
      for (int j = 0; j < 3; ++j) fma8(acc, win[j], w[j]);
      conv_store<ISV>(p, acc, RL + b * 256 + pp, ch);
      win[0] = win[1]; win[1] = win[2];
    }
  }
}

constexpr int lp_off(int ip) { return ip == 0 ? 0 : (8 * ((ip - 1) / 4) * ((ip - 1) / 4 + 1) + 4 * ((ip - 1) % 4) * ((ip - 1) / 4 + 1)); }
constexpr int LP_FLOATS = 2112;
DI void dn_prep_phase(char* shm, const Params& p, const int wave_s_) {
  const int tid = TIDX(), wave = tid >> 6, lane = tid & 63, r = lane & 31, hh = lane >> 5;
  char* sQ = shm;
  char* sK = shm + 16896;
  float* sKK = (float*)(shm + 33792);
  float* sQK = (float*)(shm + 50432);
  float* sg = (float*)(shm + 67072);
  float* sbeta = sg + 128;
  float* sgc = sg + 256;
  float* sLp = (float*)(shm + 68608);
  const u16* qk = (const u16*)(p.ws + OFF_QK0);
  const float* abt = (const float*)(p.ws + OFF_ABT);
  u16* Tb = (u16*)(p.ws + OFF_T);
  u16* Ab = (u16*)p.out;
  float* Eb = (float*)(p.ws + OFF_X);
  for (int grp = blockIdx.x; grp < NCHUNK * 2; grp += gridDim.x) {
    const int ci = grp >> 1, row0 = ci * 64;
    u32x4 pq[2], pk[2];
    float pa = 0.f, pbt = 0.f;
    auto load_item = [&](int h) {
#pragma unroll
      for (int u = 0; u < 2; ++u) {
        const int chunk = tid * 2 + u, c = chunk >> 4, cc = (chunk & 15) * 8;
        const u16* src = qk + (size_t)(row0 + c) * 2048 + h * 128 + cc;
        pq[u] = *(const u32x4*)src; pk[u] = *(const u32x4*)(src + 1024);
      }
      if (tid < 128) {
        const int d = tid >> 6, c = tid & 63;
        pa = abt[(size_t)(row0 + c) * 32 + d * 8 + h]; pbt = abt[(size_t)(row0 + c) * 32 + 16 + d * 8 + h];
      }
    };
    load_item((grp & 1) * 4);
    for (int sub = 0; sub < 4; ++sub) {
      const int h = (grp & 1) * 4 + sub, item = ci * 8 + h;
#pragma unroll
      for (int u = 0; u < 2; ++u) {
        const int chunk = tid * 2 + u, c = chunk >> 4, cc = (chunk & 15) * 8;
        st8(sQ + c * 264 + cc * 2, pq[u]);
        st8(sK + c * 264 + cc * 2, pk[u]);
      }
      if (tid < 128) {
        const int d = tid >> 6, c = tid & 63;
        sg[d * 64 + c] = -__expf(p.dn_a_log[d * 8 + h]) * softplusf(pa + p.dn_dt_bias[d * 8 + h]);
        sbeta[d * 64 + c] = sigmoidf(pbt);
      }
      if (sub < 3) load_item(h + 1);
      __syncthreads();
      if (wave < 2) {
        const int c = wave ? 63 - lane : lane;
        float v = sg[wave * 64 + c];
#pragma unroll
        for (int o = 1; o < 64; o <<= 1) { const float t = __shfl_up(v, o, 64); if (lane >= o) v += t; }
        sgc[wave * 64 + c] = v;
      }
      {
        const int mat = wave >> 2, tm = (wave >> 1) & 1, tn = wave & 1;
        const char* aop = mat ? sQ : sK;
        f32x16 acc;
        for (int i = 0; i < 16; ++i) acc[i] = 0.f;
#pragma unroll
        for (int s = 0; s < 8; ++s) {
          s16x8 a = ldA_nat(aop, 32 * tm + r, 264, 16 * s, hh), b = ldA_nat(sK, 32 * tn + r, 264, 16 * s, hh);
          acc = MFMA32(a, b, acc);
        }
        float* dst = mat ? sQK : sKK;
#pragma unroll
        for (int i = 0; i < 16; ++i) dst[(32 * tm + crow(i, hh)) * 65 + 32 * tn + r] = acc[i];
      }
      __syncthreads();
      for (int e = tid; e < 8192; e += 512) {
        const int d = e >> 12, ip = (e >> 6) & 63, jp = e & 63;
        if (ip > jp) {
          const int i = d ? 63 - ip : ip, j = d ? 63 - jp : jp;
          const int q4 = (ip - 1) >> 2, r4 = (ip - 1) & 3;
          const float v = sbeta[d * 64 + i] * sKK[i * 65 + j] * __expf(fminf(sgc[d * 64 + i] - sgc[d * 64 + j], 0.f));
          sLp[(sub * 2 + d) * LP_FLOATS + 8 * q4 * (q4 + 1) + 4 * r4 * (q4 + 1) + jp] = v;
        }
      }
      for (int v = tid; v < 1024; v += 512) {
        const int d = v >> 9, i = (v >> 3) & 63, j0 = (v & 7) * 8;
        float o[8];
#pragma unroll
        for (int e = 0; e < 8; ++e) {
          const int j = j0 + e;
          const bool keep = d ? (i <= j) : (i >= j);
          o[e] = keep ? sQK[i * 65 + j] * __expf(fminf(sgc[d * 64 + i] - sgc[d * 64 + j], 0.f)) : 0.f;
        }
        u32x4 ov = {pk2(o[0], o[1]), pk2(o[2], o[3]), pk2(o[4], o[5]), pk2(o[6], o[7])};
        *(u32x4*)(Ab + ((size_t)item * 2 + d) * 4096 + i * 64 + j0) = ov;
      }
      if (tid < 128) {
        const int d = tid >> 6, c = tid & 63;
        const float gl = sgc[d * 64 + (d ? 0 : 63)], gcv = sgc[d * 64 + c];
        const float e1 = __expf(gcv), be = sbeta[d * 64 + c] * e1, e2 = __expf(gl - gcv), cdv = __expf(gl);
        float* E = Eb + ((size_t)item * 2 + d) * 256;
        E[c] = e1; E[64 + c] = be; E[128 + c] = e2; E[192 + c] = cdv;
      }
      __syncthreads();
    }
    {
      const int wv = opq_v(wave), lane_l = opq_v(lane);
      const int d = wv & 1, item = ci * 8 + (grp & 1) * 4 + (wv >> 1);
      const float* Lb = sLp + wv * LP_FLOATS;
      float T[64];
#pragma unroll
      for (int ip = 0; ip < 64; ++ip) {
        f32x4 lrow[16];
#pragma unroll
        for (int j4 = 0; j4 < (ip + 3) / 4; ++j4) lrow[j4] = *(const f32x4*)(Lb + lp_off(ip) + j4 * 4);
        float a0 = (lane_l == ip) ? 1.f : 0.f, a1 = 0.f, a2 = 0.f, a3 = 0.f;
#pragma unroll
        for (int j4 = 0; j4 < (ip + 3) / 4; ++j4) {
          const f32x4 lv = lrow[j4];
          if (j4 * 4 + 0 < ip) a0 -= lv.x * T[j4 * 4 + 0];
          if (j4 * 4 + 1 < ip) a1 -= lv.y * T[j4 * 4 + 1];
          if (j4 * 4 + 2 < ip) a2 -= lv.z * T[j4 * 4 + 2];
          if (j4 * 4 + 3 < ip) a3 -= lv.w * T[j4 * 4 + 3];
        }
        T[ip] = (a0 + a1) + (a2 + a3);
        __builtin_amdgcn_sched_barrier(0);
      }
      u16* To = Tb + ((size_t)item * 2 + d) * 4096;
      const int cidx = d ? 63 - lane_l : lane_l;
#pragma unroll
      for (int ip = 0; ip < 64; ++ip) {
        const int i = d ? 63 - ip : ip;
        To[i * 64 + cidx] = f2bf(T[ip]);
      }
    }
    __syncthreads();
  }
}

constexpr int SC_QS = 272;
constexpr int SC_Q = 0, SC_K = 17408, SC_KT = 34816, SC_T = 52224, SC_A = 60928, SC_E = 69632, SC_BUF = 70656;
DI s16x8 ldA16(const char* base, int row, int strideB, int kofs, int q) {
  const char* p = base + row * strideB + (kofs + 4 * q) * 2;
  u32x2 lo = *(const u32x2*)p, hi = *(const u32x2*)(p + 32);
  return cat8(lo, hi);
}
DI s16x8 pack16(const f32x4& a, const f32x4& b) {
  u32x4 v = {pk2(a.x, a.y), pk2(a.z, a.w), pk2(b.x, b.y), pk2(b.z, b.w)};
  return __builtin_bit_cast(s16x8, v);
}

template <bool DELTA, bool DRY = false>
DI void scan_phase(char* shm, const Params& p, const int wave_s_) {
  const int bid = blockIdx.x;
  if (bid >= 256) return;
  const int tid = TIDX(), wave = tid >> 6, lane = tid & 63, n16 = lane & 15, q4 = lane >> 4;
  int cgp, d, h, b;
  if (DELTA) { cgp = (bid >> 3) & 3; const int cid = (bid & 7) + 8 * (bid >> 5); d = cid & 1; h = (cid >> 1) & 7; b = cid >> 4; }
  else { cgp = (bid >> 3) & 7; const int cid = (bid & 7) + 8 * (bid >> 6); d = cid & 1; h = (cid >> 1) & 3; b = cid >> 3; }
  const bool compute = wave < 4;
  const int col0 = (DELTA ? h * 256 : h * 512) + cgp * 64 + (wave & 3) * 16;
  u16* Ub = (u16*)(p.ws + (DELTA ? (d ? OFF_U1 : OFF_U0) : (d ? OFF_V1 : OFF_V0)));
  const u16* qk = (const u16*)(p.ws + OFF_QK0);
  const u16* Tb = (const u16*)(p.ws + OFF_T);
  const u16* Ag = (const u16*)p.out;
  const float* Eb = (const float*)(p.ws + OFF_X);
  const u16* QD = (const u16*)(p.ws + OFF_QD);
  const u16* AS = (const u16*)(p.ws + OFF_ASUM);
  const float* CD = (const float*)(p.ws + OFF_CD1);

  auto chunk_of = [&](int st) -> int {
    if (st < 4) return 512 + b * 4 + (d ? 3 - st : st);
    return b * 128 + (d ? 127 - (st - 4) : (st - 4));
  };

  auto stage_all = [&](int st, int buf) {
    const int sid = tid - 256;
    const int ci = chunk_of(st), row0 = ci * 64;
    char* sb = shm + buf * SC_BUF;
    if (DELTA) {
      const size_t it = ((size_t)ci * 8 + h) * 2 + d;
      const float* E = Eb + it * 256;
      const int c = sid >> 2, cc = (sid & 3) * 32;
      const u16* qsrc = qk + (size_t)(row0 + c) * 2048 + h * 128 + cc;
      const int c0 = (sid >> 4) * 4, dk0 = (sid & 15) * 8;
      const u16* ksrc = qk + (size_t)(row0 + c0) * 2048 + 1024 + h * 128 + dk0;
      u32x4 gq[4], gk[4], gT[2], gA[2];
#pragma unroll
      for (int u = 0; u < 4; ++u) gq[u] = *(const u32x4*)(qsrc + u * 8);
#pragma unroll
      for (int u = 0; u < 4; ++u) gk[u] = *(const u32x4*)(ksrc + (size_t)u * 2048);
#pragma unroll
      for (int u = 0; u < 2; ++u) {
        const int chunk = sid * 2 + u, tr = chunk >> 3, tc = (chunk & 7) * 8;
        gT[u] = *(const u32x4*)(Tb + it * 4096 + tr * 64 + tc);
        gA[u] = *(const u32x4*)(Ag + it * 4096 + tr * 64 + tc);
      }
      const float e1 = E[c];
      const f32x4 bev = *(const f32x4*)(E + 64 + c0), e2v = *(const f32x4*)(E + 128 + c0);
      if (sid == 0) *(float*)(sb + SC_E) = E[192];
#pragma unroll
      for (int u = 0; u < 4; ++u) st8(sb + SC_Q + c * SC_QS + (cc + u * 8) * 2, scale8(gq[u], e1));
      const float be[4] = {bev.x, bev.y, bev.z, bev.w}, e2[4] = {e2v.x, e2v.y, e2v.z, e2v.w};
      u32x4 kt[4];
#pragma unroll
      for (int u = 0; u < 4; ++u) {
        st8(sb + SC_K + (c0 + u) * SC_QS + dk0 * 2, scale8(gk[u], -be[u]));
        kt[u] = scale8(gk[u], e2[u]);
      }
      const unsigned w[4][4] = {{kt[0].x, kt[0].y, kt[0].z, kt[0].w}, {kt[1].x, kt[1].y, kt[1].z, kt[1].w},
                                {kt[2].x, kt[2].y, kt[2].z, kt[2].w}, {kt[3].x, kt[3].y, kt[3].z, kt[3].w}};
#pragma unroll
      for (int jp = 0; jp < 4; ++jp) {
        u32x2 lo = {(w[0][jp] & 0xffffu) | (w[1][jp] << 16), (w[2][jp] & 0xffffu) | (w[3][jp] << 16)};
        u32x2 hi = {(w[0][jp] >> 16) | (w[1][jp] & 0xffff0000u), (w[2][jp] >> 16) | (w[3][jp] & 0xffff0000u)};
        *(u32x2*)(sb + SC_KT + (dk0 + 2 * jp) * 136 + c0 * 2) = lo;
        *(u32x2*)(sb + SC_KT + (dk0 + 2 * jp + 1) * 136 + c0 * 2) = hi;
      }
#pragma unroll
      for (int u = 0; u < 2; ++u) {
        const int chunk = sid * 2 + u, tr = chunk >> 3, tc = (chunk & 7) * 8;
        st8(sb + SC_T + tr * 136 + tc * 2, gT[u]);
        st8(sb + SC_A + tr * 136 + tc * 2, gA[u]);
      }
    } else {
      const size_t it = ((size_t)ci * 4 + h) * 2 + d;
      const u16* qd = QD + it * 16384;
      const int c = sid >> 2, cc = (sid & 3) * 32;
      const int kr = sid >> 1, kc = (sid & 1) * 32;
      u32x4 gq[4], gk[4], gA[2];
#pragma unroll
      for (int u = 0; u < 4; ++u) gq[u] = *(const u32x4*)(qd + c * 128 + cc + u * 8);
#pragma unroll
      for (int u = 0; u < 4; ++u) gk[u] = *(const u32x4*)(qd + 8192 + kr * 64 + kc + u * 8);
      if (d == 0) {
#pragma unroll
        for (int u = 0; u < 2; ++u) {
          const int chunk = sid * 2 + u, tr = chunk >> 3, tc = (chunk & 7) * 8;
          gA[u] = *(const u32x4*)(AS + ((size_t)ci * 4 + h) * 4096 + tr * 64 + tc);
        }
      }
      if (sid < 32) *(f32x4*)(sb + SC_E + sid * 16) = *(const f32x4*)(CD + it * 128 + sid * 4);
#pragma unroll
      for (int u = 0; u < 4; ++u) st8(sb + SC_Q + c * SC_QS + (cc + u * 8) * 2, gq[u]);
#pragma unroll
      for (int u = 0; u < 4; ++u) st8(sb + SC_KT + kr * 136 + (kc + u * 8) * 2, gk[u]);
      if (d == 0) {
#pragma unroll
        for (int u = 0; u < 2; ++u) {
          const int chunk = sid * 2 + u, tr = chunk >> 3, tc = (chunk & 7) * 8;
          st8(sb + SC_A + tr * 136 + tc * 2, gA[u]);
        }
      }
    }
  };

  f32x4 S[8];
#pragma unroll
  for (int t = 0; t < 8; ++t) S[t] = (f32x4){0.f, 0.f, 0.f, 0.f};
  u16 uraw[4][4];
  const int loff = (4 * q4) * 2048 + col0 + n16;
  auto u_issue = [&](int st) {
    const u16* up = Ub + (size_t)chunk_of(st) * (64 * 2048);
    const int lo = opq_v(loff);
#pragma unroll
    for (int mt = 0; mt < 4; ++mt)
#pragma unroll
      for (int i = 0; i < 4; ++i) uraw[mt][i] = up[lo + (16 * mt + i) * 2048];
  };

  if (compute) u_issue(0); else stage_all(0, 0);
  __syncthreads();

  for (int st = 0; st < 132; ++st) {
    const int buf = st & 1;
    const char* sb = shm + buf * SC_BUF;
    if (compute) {
      const int row0 = chunk_of(st) * 64;
      f32x4 Y[4], O[4];
#pragma unroll
      for (int mt = 0; mt < 4; ++mt) {
        Y[mt] = (f32x4){bf2f(uraw[mt][0]), bf2f(uraw[mt][1]), bf2f(uraw[mt][2]), bf2f(uraw[mt][3])};
        O[mt] = (f32x4){0.f, 0.f, 0.f, 0.f};
      }
#define SCHED_FENCE() __builtin_amdgcn_sched_barrier(0)
      s16x8 fT[8];
      if (DELTA) {
#pragma unroll
        for (int mt = 0; mt < 4; ++mt)
#pragma unroll
          for (int kc = 0; kc < 2; ++kc) fT[mt * 2 + kc] = ldA16(sb + SC_T, 16 * mt + n16, 136, 32 * kc, q4);
      }
      s16x8 fa[2][8];
#pragma unroll
      for (int mt = 0; mt < 4; ++mt) {
        if (DELTA) fa[0][mt] = ldA16(sb + SC_K, 16 * mt + n16, SC_QS, 0, q4);
        fa[0][4 + mt] = ldA16(sb + SC_Q, 16 * mt + n16, SC_QS, 0, q4);
      }
      SCHED_FENCE();
#pragma unroll
      for (int t = 0; t < 4; ++t) {
        if (t < 3) {
#pragma unroll
          for (int mt = 0; mt < 4; ++mt) {
            if (DELTA) fa[(t + 1) & 1][mt] = ldA16(sb + SC_K, 16 * mt + n16, SC_QS, 32 * (t + 1), q4);
            fa[(t + 1) & 1][4 + mt] = ldA16(sb + SC_Q, 16 * mt + n16, SC_QS, 32 * (t + 1), q4);
          }
        }
        SCHED_FENCE();
        const s16x8 Sb = pack16(S[2 * t], S[2 * t + 1]);
#pragma unroll
        for (int mt = 0; mt < 4; ++mt) {
          if (DELTA) Y[mt] = MFMA16(fa[t & 1][mt], Sb, Y[mt]);
          O[mt] = MFMA16(fa[t & 1][4 + mt], Sb, O[mt]);
        }
        SCHED_FENCE();
      }
      s16x8 fA[8];
      if (DELTA || d == 0) {
#pragma unroll
        for (int mt = 0; mt < 4; ++mt)
#pragma unroll
          for (int kc = 0; kc < 2; ++kc) fA[mt * 2 + kc] = ldA16(sb + SC_A, 16 * mt + n16, 136, 32 * kc, q4);
      }
      SCHED_FENCE();
      s16x8 vnb[2];
      if (DELTA) {
        s16x8 Yb[2];
        Yb[0] = pack16(Y[0], Y[1]); Yb[1] = pack16(Y[2], Y[3]);
        f32x4 vn[4];
#pragma unroll
        for (int mt = 0; mt < 4; ++mt) {
          vn[mt] = (f32x4){0.f, 0.f, 0.f, 0.f};
#pragma unroll
          for (int kc = 0; kc < 2; ++kc) vn[mt] = MFMA16(fT[mt * 2 + kc], Yb[kc], vn[mt]);
        }
        vnb[0] = pack16(vn[0], vn[1]); vnb[1] = pack16(vn[2], vn[3]);
      } else {
        vnb[0] = pack16(Y[0], Y[1]); vnb[1] = pack16(Y[2], Y[3]);
      }
      SCHED_FENCE();
      s16x8 fK[8];
#pragma unroll
      for (int t = 0; t < 4; ++t)
#pragma unroll
        for (int kc = 0; kc < 2; ++kc) fK[t * 2 + kc] = ldA16(sb + SC_KT, 16 * t + n16, 136, 32 * kc, q4);
      if (st + 1 < 132) u_issue(st + 1);
      SCHED_FENCE();
      if (DELTA || d == 0) {
#pragma unroll
        for (int mt = 0; mt < 4; ++mt)
#pragma unroll
          for (int kc = 0; kc < 2; ++kc) O[mt] = MFMA16(fA[mt * 2 + kc], vnb[kc], O[mt]);
      }
      if (DELTA) {
        const float cd = *(const float*)(sb + SC_E);
#pragma unroll
        for (int t = 0; t < 8; ++t) S[t] *= cd;
      } else {
#pragma unroll
        for (int t = 0; t < 8; ++t) {
          const f32x4 cv = *(const f32x4*)(sb + SC_E + (16 * t + 4 * q4) * 4);
          S[t] *= cv;
        }
      }
      SCHED_FENCE();
      s16x8 fK2[8];
#pragma unroll
      for (int t = 0; t < 4; ++t)
#pragma unroll
        for (int kc = 0; kc < 2; ++kc) fK2[t * 2 + kc] = ldA16(sb + SC_KT, 16 * (4 + t) + n16, 136, 32 * kc, q4);
      SCHED_FENCE();
#pragma unroll
      for (int t = 0; t < 4; ++t)
#pragma unroll
        for (int kc = 0; kc < 2; ++kc) S[t] = MFMA16(fK[t * 2 + kc], vnb[kc], S[t]);
      SCHED_FENCE();
#pragma unroll
      for (int t = 0; t < 4; ++t)
#pragma unroll
        for (int kc = 0; kc < 2; ++kc) S[4 + t] = MFMA16(fK2[t * 2 + kc], vnb[kc], S[4 + t]);
#undef SCHED_FENCE
      if (!DRY || p.out == nullptr)
#pragma unroll
      for (int mt = 0; mt < 4; ++mt) {
        const float ov[4] = {O[mt].x, O[mt].y, O[mt].z, O[mt].w};
        u16* op = Ub + (size_t)row0 * 2048;
        const int lo = opq_v(loff);
#pragma unroll
        for (int i = 0; i < 4; ++i) op[lo + (16 * mt + i) * 2048] = f2bf(ov[i]);
      }
    }
    else if (st + 1 < 132) stage_all(st + 1, buf ^ 1);
    asm volatile("s_waitcnt lgkmcnt(0)" ::: "memory");
    __builtin_amdgcn_s_barrier();
    asm volatile("" ::: "memory");
  }
}

DI void gla_prep_phase(char* shm, const Params& p, const int wave_s_) {
  const int tid = TIDX(), wave = tid >> 6, lane = tid & 63, r = lane & 31, hh = lane >> 5;
  char* sq = shm;
  char* sk = shm + 16896;
  char* sQa = shm + 33792;
  char* sKb = shm + 50688;
  float* sBC = (float*)(shm + 67584);
  float* sgl = (float*)(shm + 133120);
  const u16* qk1 = (const u16*)(p.ws + OFF_QK1);
  const float* gl = (const float*)(p.ws + OFF_ABT);
  u16* QD = (u16*)(p.ws + OFF_QD);
  u16* AS = (u16*)(p.ws + OFF_ASUM);
  float* CD = (float*)(p.ws + OFF_CD1);
  const float qscale = 0.08838834764831845f;
  for (int item = blockIdx.x; item < NCHUNK * 4; item += gridDim.x) {
    const int ci = item >> 2, h = item & 3, row0 = ci * 64;
#pragma unroll
    for (int u = 0; u < 2; ++u) {
      const int chunk = tid * 2 + u, c = chunk >> 4, cc = (chunk & 15) * 8;
      const u16* src = qk1 + (size_t)(row0 + c) * 1024 + h * 128 + cc;
      u32x4 vq = *(const u32x4*)src, vk = *(const u32x4*)(src + 512);
      st8(sq + c * 264 + cc * 2, vq);
      st8(sk + c * 264 + cc * 2, vk);
    }
    {
      const int rr = tid >> 3, cc = (tid & 7) * 4;
      *(f32x4*)(sgl + rr * 32 + cc) = *(const f32x4*)(gl + (size_t)(row0 + rr) * 32 + cc);
    }
    __syncthreads();
    {
      const int kk = tid & 127, d = (tid >> 7) & 1, chalf = tid >> 8;
      float w[16];
#pragma unroll
      for (int q = 0; q < 16; ++q) w[q] = p.gla_w_g2[(d * 16 + q) * 512 + h * 128 + kk];
      const float bg = p.gla_b_g[d * 512 + h * 128 + kk];
#pragma unroll 4
      for (int cc = 0; cc < 32; ++cc) {
        const int c = chalf * 32 + cc;
        const f32x4* gp = (const f32x4*)(sgl + c * 32 + d * 16);
        const f32x4 g0 = gp[0], g1 = gp[1], g2 = gp[2], g3 = gp[3];
        float z = bg;
        z += g0.x * w[0] + g0.y * w[1] + g0.z * w[2] + g0.w * w[3];
        z += g1.x * w[4] + g1.y * w[5] + g1.z * w[6] + g1.w * w[7];
        z += g2.x * w[8] + g2.y * w[9] + g2.z * w[10] + g2.w * w[11];
        z += g3.x * w[12] + g3.y * w[13] + g3.z * w[14] + g3.w * w[15];
        sBC[(d * 64 + c) * 128 + kk] = (fminf(z, 0.f) - __logf(1.f + __expf(-fabsf(z)))) * (1.f / 16.f);
      }
    }
    __syncthreads();
    if (tid < 256) {
      const int d = tid >> 7, kk = tid & 127;
      float* col = sBC + d * 64 * 128 + kk;
      float v[64];
#pragma unroll
      for (int c = 0; c < 64; ++c) v[c] = col[c * 128];
      if (d == 0) {
        float acc = 0.f;
#pragma unroll
        for (int c = 0; c < 64; ++c) { acc += v[c]; col[c * 128] = acc; }
      } else {
        float acc = 0.f;
#pragma unroll
        for (int c = 63; c >= 0; --c) { acc += v[c]; col[c * 128] = acc; }
      }
    }
    __syncthreads();
    f32x16 asum;
    for (int i = 0; i < 16; ++i) asum[i] = 0.f;
    for (int d = 0; d < 2; ++d) {
      const int cref = d ? 31 : 32, clast = d ? 0 : 63;
      const float* bcd = sBC + d * 64 * 128;
      u16* qd_o = QD + ((size_t)item * 2 + d) * 16384;
      float er[8], ern[8];
      {
        const int k0 = (tid & 15) * 8;
#pragma unroll
        for (int e = 0; e < 8; ++e) { const float rf = bcd[cref * 128 + k0 + e]; er[e] = __expf(rf); ern[e] = __expf(-rf); }
      }
      for (int v = tid; v < 1024; v += 512) {
        const int c = v >> 4, k0 = (v & 15) * 8;
        const u32x4 qv = *(const u32x4*)(sq + c * 264 + k0 * 2), kv = *(const u32x4*)(sk + c * 264 + k0 * 2);
        const unsigned qa[4] = {qv.x, qv.y, qv.z, qv.w}, ka[4] = {kv.x, kv.y, kv.z, kv.w};
        float oqa[8], okb[8], oqd[8];
#pragma unroll
        for (int e = 0; e < 8; ++e) {
          const float ebc = __expf(bcd[c * 128 + k0 + e]);
          const float qf = ((e & 1) ? bfhi(qa[e >> 1]) : bflo(qa[e >> 1])) * qscale;
          const float kf = (e & 1) ? bfhi(ka[e >> 1]) : bflo(ka[e >> 1]);
          oqd[e] = qf * ebc;
          oqa[e] = oqd[e] * ern[e];
          okb[e] = kf * er[e] * __builtin_amdgcn_rcpf(ebc);
        }
        st8(sQa + c * 264 + k0 * 2, (u32x4){pk2(oqa[0], oqa[1]), pk2(oqa[2], oqa[3]), pk2(oqa[4], oqa[5]), pk2(oqa[6], oqa[7])});
        st8(sKb + c * 264 + k0 * 2, (u32x4){pk2(okb[0], okb[1]), pk2(okb[2], okb[3]), pk2(okb[4], okb[5]), pk2(okb[6], okb[7])});
        *(u32x4*)(qd_o + c * 128 + k0) = (u32x4){pk2(oqd[0], oqd[1]), pk2(oqd[2], oqd[3]), pk2(oqd[4], oqd[5]), pk2(oqd[6], oqd[7])};
      }
      for (int v = tid; v < 1024; v += 512) {
        const int kk = v >> 3, c0 = (v & 7) * 8;
        const float last = bcd[clast * 128 + kk];
        float o[8];
#pragma unroll
        for (int e = 0; e < 8; ++e) {
          const int c = c0 + e;
          const float kf = bf2f(*(const u16*)(sk + c * 264 + kk * 2));
          o[e] = kf * __expf(last - bcd[c * 128 + kk]);
        }
        *(u32x4*)(qd_o + 8192 + kk * 64 + c0) = (u32x4){pk2(o[0], o[1]), pk2(o[2], o[3]), pk2(o[4], o[5]), pk2(o[6], o[7])};
      }
      if (tid < 128) CD[((size_t)item * 2 + d) * 128 + tid] = __expf(bcd[clast * 128 + tid]);
      __syncthreads();
      if (wave < 4) {
        const int tm = wave >> 1, tn = wave & 1;
        f32x16 acc;
        for (int i = 0; i < 16; ++i) acc[i] = 0.f;
#pragma unroll
        for (int s = 0; s < 8; ++s) {
          s16x8 a = ldA_nat(sQa, 32 * tm + r, 264, 16 * s, hh), bb = ldA_nat(sKb, 32 * tn + r, 264, 16 * s, hh);
          acc = MFMA32(a, bb, acc);
        }
#pragma unroll
        for (int i = 0; i < 16; ++i) {
          const int ii = 32 * tm + crow(i, hh), jj = 32 * tn + r;
          const bool keep = d ? (ii <= jj) : (ii >= jj);
          asum[i] += keep ? acc[i] : 0.f;
        }
      }
      __syncthreads();
    }
    if (wave < 4) {
      const int tm = wave >> 1, tn = wave & 1;
#pragma unroll
      for (int i = 0; i < 16; ++i) AS[(size_t)item * 4096 + (32 * tm + crow(i, hh)) * 64 + 32 * tn + r] = f2bf(asum[i]);
    }
  }
}

template <int GROUP>
DI void yg_phase(u16* o0, const u16* o1, const u16* z, const u16* zctx, const float* ng, int nrows, const int wave_s_) {
  constexpr int NU = 4;
  const int gt = blockIdx.x * 512 + TIDX(), nthr = gridDim.x * 512;
  const int total = nrows * 256;
  for (int idx0 = gt; idx0 < total; idx0 += NU * nthr) {
    u32x4 a[NU], bq[NU], zz[NU];
#pragma unroll
    for (int u = 0; u < NU; ++u) {
      const int idx = (idx0 + u * nthr < total) ? idx0 + u * nthr : idx0;
      const size_t off = (size_t)(idx >> 8) * 2048 + (idx & 255) * 8;
      const int zrow = idx >> 8;
      const u16* zp = (zrow < RL) ? z + off : zctx + (size_t)(zrow - RL) * 2048 + (idx & 255) * 8;
      a[u] = *(const u32x4*)(o0 + off); bq[u] = *(const u32x4*)(o1 + off); zz[u] = *(const u32x4*)zp;
    }
#pragma unroll
    for (int u = 0; u < NU; ++u) {
      if (idx0 + u * nthr >= total) break;
      const int idx = idx0 + u * nthr, ch = (idx & 255) * 8;
      const size_t off = (size_t)(idx >> 8) * 2048 + ch;
      float o[8] = {bflo(a[u].x) + bflo(bq[u].x), bfhi(a[u].x) + bfhi(bq[u].x), bflo(a[u].y) + bflo(bq[u].y), bfhi(a[u].y) + bfhi(bq[u].y),
                    bflo(a[u].z) + bflo(bq[u].z), bfhi(a[u].z) + bfhi(bq[u].z), bflo(a[u].w) + bflo(bq[u].w), bfhi(a[u].w) + bfhi(bq[u].w)};
      const float zf[8] = {bflo(zz[u].x), bfhi(zz[u].x), bflo(zz[u].y), bfhi(zz[u].y), bflo(zz[u].z), bfhi(zz[u].z), bflo(zz[u].w), bfhi(zz[u].w)};
      float ss = 0.f;
#pragma unroll
      for (int e = 0; e < 8; ++e) ss += o[e] * o[e];
#pragma unroll
      for (int of = 1; of < GROUP; of <<= 1) ss += __shfl_xor(ss, of, 64);
      const float rstd = rsqrtf(ss * (1.f / (GROUP * 8)) + EPSF);
      const int gi = ch & (GROUP * 8 - 1);
      const f32x4 g0 = *(const f32x4*)(ng + gi), g1 = *(const f32x4*)(ng + gi + 4);
      const float gg[8] = {g0.x, g0.y, g0.z, g0.w, g1.x, g1.y, g1.z, g1.w};
#pragma unroll
      for (int e = 0; e < 8; ++e) o[e] = o[e] * rstd * gg[e] * siluf(zf[e]);
      *(u32x4*)(o0 + off) = (u32x4){pk2(o[0], o[1]), pk2(o[2], o[3]), pk2(o[4], o[5]), pk2(o[6], o[7])};
    }
  }
}

DI void final_phase(float* out, const float* g, const int wave_s_) {
  const int tidx_ = TIDX();
  const int lane = tidx_ & 63, gw = blockIdx.x * 8 + (tidx_ >> 6), nw = gridDim.x * 8;
  for (int row0 = gw; row0 < RL; row0 += 2 * nw) {
    const int rows[2] = {row0, row0 + nw};
    const bool ok1 = rows[1] < RL;
    f32x4 v[2][4];
#pragma unroll
    for (int u = 0; u < 2; ++u) {
      const float* s = out + (size_t)((u == 0 || ok1) ? rows[u] : rows[0]) * DM;
#pragma unroll
      for (int q = 0; q < 4; ++q) v[u][q] = *(const f32x4*)(s + q * 256 + lane * 4);
    }
#pragma unroll
    for (int u = 0; u < 2; ++u) {
      if (u == 1 && !ok1) break;
      float* s = out + (size_t)rows[u] * DM;
      float ss = 0.f;
#pragma unroll
      for (int q = 0; q < 4; ++q) ss += v[u][q].x * v[u][q].x + v[u][q].y * v[u][q].y + v[u][q].z * v[u][q].z + v[u][q].w * v[u][q].w;
      ss = wave_sum(ss);
      const float rstd = rsqrtf(ss * (1.f / 1024.f) + EPSF);
#pragma unroll
      for (int q = 0; q < 4; ++q) {
        const f32x4 gg = *(const f32x4*)(g + q * 256 + lane * 4);
        f32x4 o = {v[u][q].x * rstd * gg.x, v[u][q].y * rstd * gg.y, v[u][q].z * rstd * gg.z, v[u][q].w * rstd * gg.w};
        *(f32x4*)(s + q * 256 + lane * 4) = o;
      }
    }
  }
}

#define XB_XSUB(j)  (64 * (j))
#define XB_XGEN(j)  (1024 + 64 * (j))
#define XB_TOP      2048
#define XB_TOPGEN   2112
#define XCD_BAR_WORDS 2176
DI unsigned xb_ld(unsigned* p) { return __hip_atomic_load(p, __ATOMIC_RELAXED, __HIP_MEMORY_SCOPE_AGENT); }
DI unsigned xb_add(unsigned* p, unsigned v) { return __hip_atomic_fetch_add(p, v, __ATOMIC_RELAXED, __HIP_MEMORY_SCOPE_AGENT); }
DI void gbar(char* ws, const int wave_s_) {
  asm volatile("s_waitcnt vmcnt(0)" ::: "memory");
  __syncthreads();
  if (wave_s_ == 0 && lane_id() == 0) {
    unsigned* bar = (unsigned*)(ws + OFF_BAR);
    __builtin_amdgcn_s_waitcnt(0);
    const unsigned x = (unsigned)__builtin_amdgcn_s_getreg((3 << 11) | 20) & 0xFu;
    const unsigned nloc = gridDim.x >> 3, nx = 8u;
    const unsigned old = xb_add(&bar[XB_XSUB(x)], 1u);
    const unsigned gen = old / nloc;
    if (old + 1u == (gen + 1u) * nloc) {
      __builtin_amdgcn_fence(__ATOMIC_RELEASE, "agent");
      asm volatile("s_waitcnt vmcnt(0)" ::: "memory");
      const unsigned og = xb_add(&bar[XB_TOP], 1u);
      const unsigned tg = og / nx;
      if (og + 1u == (tg + 1u) * nx) xb_add(&bar[XB_TOPGEN], 1u);
      else while (xb_ld(&bar[XB_TOPGEN]) == tg) __builtin_amdgcn_s_sleep(1);
      __builtin_amdgcn_fence(__ATOMIC_ACQUIRE, "agent");
      xb_add(&bar[XB_XGEN(x)], 1u);
      asm volatile("s_waitcnt vmcnt(0)" ::: "memory");
    } else {
      while (xb_ld(&bar[XB_XGEN(x)]) == gen) __builtin_amdgcn_s_sleep(1);
      __builtin_amdgcn_fence(__ATOMIC_ACQUIRE, "agent");
      asm volatile("s_waitcnt vmcnt(0)" ::: "memory");
    }
  }
  __syncthreads();
}
#ifndef REP_GEMM
#define REP_GEMM 1
#endif
#ifndef REP_PREP
#define REP_PREP 1
#endif
#ifndef REP_GLP
#define REP_GLP 1
#endif
#ifndef REP_SCAN
#define REP_SCAN 0
#endif
#ifndef REP_SYNC
#define REP_SYNC 0
#endif
#ifndef REP_EW
#define REP_EW 1
#endif
__global__ void __launch_bounds__(512, 2) fwd_megakernel(Params p) {
  __shared__ __attribute__((aligned(1024))) char shm[141312];
  cg::grid_group grid = cg::this_grid();
  const int wave_s_ = __builtin_amdgcn_readfirstlane((int)(threadIdx.x >> 6));
  char* ws = p.ws;
  float* mods = (float*)(ws + OFF_MOD);
  u16* W0T = (u16*)(ws + OFF_W0T);
  u16* WO0T = (u16*)(ws + OFF_WO0T);
  u16* W1T = (u16*)(ws + OFF_W1T);
  u16* WO1T = (u16*)(ws + OFF_WO1T);
  u16* outb = (u16*)p.out;
  float* ctx1 = (float*)(ws + OFF_X);

  mods_phase(shm, p, wave_s_);
  wtrans_phase(shm, p, wave_s_);
  grid.sync();
  {
    u16* H0 = (u16*)(ws + OFF_T);
    h_phase(p.x, p.ctx, p.norm_g, mods, H0, R, wave_s_);
    gbar(ws, wave_s_);
#if REP_EW > 1
    h_phase(p.x, p.ctx, p.norm_g, mods, H0, R, wave_s_);
    gbar(ws, wave_s_);
#endif
    small_gemm(H0, W0T + (size_t)6144 * 1024, (float*)(ws + OFF_ABT), wave_s_);
    EpiArgs e{};
    e.mode = 0; e.lat = outb; e.ctx = (u16*)(ws + OFF_X); e.ld = 2048;
    gemm_phase<0>(shm, H0, H0 + (size_t)RL * 1024, 1024, W0T, 0, 128, 8, e, wave_s_);
    {
      EpiArgs ec{};
      ec.mode = 4; ec.ctx = (u16*)(ws + OFF_X);
      gemm_phase<4>(shm, H0, H0 + (size_t)RL * 1024, 1024, W0T, 128, 4, 24, ec, wave_s_);
    }
    gbar(ws, wave_s_);
#if REP_GEMM > 1
    gemm_phase<0>(shm, H0, H0 + (size_t)RL * 1024, 1024, W0T, 0, 132, 8, e, wave_s_);
    gbar(ws, wave_s_);
#endif
    conv_phase<false>(p, wave_s_);
    gbar(ws, wave_s_);
#if REP_EW > 1
    conv_phase<false>(p, wave_s_);
    gbar(ws, wave_s_);
#endif
    gemm_phase<0>(shm, H0, H0 + (size_t)RL * 1024, 1024, W0T + (size_t)2048 * 1024, 0, 128, 8, e, wave_s_);
    gbar(ws, wave_s_);
#if REP_GEMM > 1
    gemm_phase<0>(shm, H0, H0 + (size_t)RL * 1024, 1024, W0T + (size_t)2048 * 1024, 0, 132, 8, e, wave_s_);
    gbar(ws, wave_s_);
#endif
    conv_phase<true>(p, wave_s_);
    gbar(ws, wave_s_);
#if REP_EW > 1
    conv_phase<true>(p, wave_s_);
    gbar(ws, wave_s_);
#endif
    for (int rep_ = 0; rep_ < REP_PREP; ++rep_) {
    dn_prep_phase(shm, p, wave_s_);
    gbar(ws, wave_s_);
    }
    for (int rep_ = 0; rep_ < REP_SCAN; ++rep_) { scan_phase<true, true>(shm, p, wave_s_); gbar(ws, wave_s_); }
    for (int rep_ = 0; rep_ < REP_SYNC; ++rep_) gbar(ws, wave_s_);
    scan_phase<true>(shm, p, wave_s_);
    gbar(ws, wave_s_);
    u16* H0b = outb;
    h_phase(p.x, p.ctx, p.norm_g, mods, H0b, R, wave_s_);
    gbar(ws, wave_s_);
#if REP_EW > 1
    h_phase(p.x, p.ctx, p.norm_g, mods, H0b, R, wave_s_);
    gbar(ws, wave_s_);
#endif
    u16* Z = (u16*)(ws + OFF_QK0);
    EpiArgs ez{};
    ez.mode = 0; ez.lat = Z; ez.ctx = Z + (size_t)RL * 2048; ez.ld = 2048;
    gemm_phase<0>(shm, H0b, H0b + (size_t)RL * 1024, 1024, W0T + (size_t)4096 * 1024, 0, 128, 8, ez, wave_s_);
    gbar(ws, wave_s_);
#if REP_GEMM > 1
    gemm_phase<0>(shm, H0b, H0b + (size_t)RL * 1024, 1024, W0T + (size_t)4096 * 1024, 0, 132, 8, ez, wave_s_);
    gbar(ws, wave_s_);
#endif
    u16* U0 = (u16*)(ws + OFF_U0);
    yg_phase<32>(U0, (const u16*)(ws + OFF_U1), Z, (const u16*)(ws + OFF_ZC), p.dn_norm_g, R, wave_s_);
    gbar(ws, wave_s_);
    EpiArgs eo{};
    eo.mode = 2; eo.res_lat = p.x; eo.res_ctx = p.ctx; eo.mods_i = mods; eo.out_lat = p.out; eo.out_ctx = ctx1;
    gemm_phase<2>(shm, U0, U0 + (size_t)RL * 2048, 2048, WO0T, 0, 132, 4, eo, wave_s_);
    gbar(ws, wave_s_);
#if REP_GEMM > 1
    gemm_phase<2>(shm, U0, U0 + (size_t)RL * 2048, 2048, WO0T, 0, 132, 4, eo, wave_s_);
    gbar(ws, wave_s_);
#endif
  }
  {
    const float* mods1 = mods + 5 * 3072;
    u16* H1 = (u16*)(ws + OFF_QD);
    h_phase(p.out, ctx1, p.norm_g + 1024, mods1, H1, R, wave_s_);
    gbar(ws, wave_s_);
    small_gemm(H1, W1T + (size_t)5120 * 1024, (float*)(ws + OFF_ABT), wave_s_);
    EpiArgs e{};
    e.mode = 1; e.lat = (u16*)(ws + OFF_QK1); e.b1 = (u16*)(ws + OFF_V0); e.b2 = (u16*)(ws + OFF_V1);
    gemm_phase<1>(shm, H1, H1 + (size_t)RL * 1024, 1024, W1T, 0, 132, 12, e, wave_s_);
    gbar(ws, wave_s_);
    for (int rep_ = 0; rep_ < REP_GLP; ++rep_) {
    gla_prep_phase(shm, p, wave_s_);
    gbar(ws, wave_s_);
    }
    for (int rep_ = 0; rep_ < REP_SCAN; ++rep_) { scan_phase<false, true>(shm, p, wave_s_); gbar(ws, wave_s_); }
    scan_phase<false>(shm, p, wave_s_);
    gbar(ws, wave_s_);
    u16* H1b = (u16*)(ws + OFF_QK1);
    h_phase(p.out, ctx1, p.norm_g + 1024, mods1, H1b, RL, wave_s_);
    gbar(ws, wave_s_);
    u16* RB = (u16*)(ws + OFF_QD);
    EpiArgs er{};
    er.mode = 0; er.lat = RB; er.ctx = RB; er.ld = 2048;
    gemm_phase<0>(shm, H1b, H1b, 1024, W1T + (size_t)3072 * 1024, 0, 128, 8, er, wave_s_);
    gbar(ws, wave_s_);
    u16* V0 = (u16*)(ws + OFF_V0);
    yg_phase<64>(V0, (const u16*)(ws + OFF_V1), RB, RB, p.gla_norm_g, RL, wave_s_);
    gbar(ws, wave_s_);
    EpiArgs eo{};
    eo.mode = 2; eo.res_lat = p.out; eo.res_ctx = p.out; eo.mods_i = mods1; eo.out_lat = p.out; eo.out_ctx = p.out;
    gemm_phase<2>(shm, V0, V0, 2048, WO1T, 0, 128, 4, eo, wave_s_);
    gbar(ws, wave_s_);
    final_phase(p.out, p.final_g, wave_s_);
  }
}

extern "C" void kernel_launch(void* const* d_in, const int* in_sizes, int n_in, void* d_out, int out_size, void* d_ws,
                              size_t ws_size, hipStream_t stream) {
  static int grid_blocks = 0;
  if (!grid_blocks) {
    int dev = 0, cus = 0, per_cu = 0;
    hipGetDevice(&dev);
    hipDeviceGetAttribute(&cus, hipDeviceAttributeMultiprocessorCount, dev);
    hipOccupancyMaxActiveBlocksPerMultiprocessor(&per_cu, fwd_megakernel, 512, 0);
    if (per_cu < 1) per_cu = 1;
    grid_blocks = cus;
    if (grid_blocks > 256) grid_blocks = 256;
  }
  Params p{};
  p.x = (const float*)d_in[0]; p.c = (const float*)d_in[1]; p.ctx = (const float*)d_in[2]; p.c_ctx = (const float*)d_in[3];
  p.mod_w = (const float*)d_in[4]; p.mod_b = (const float*)d_in[5]; p.norm_g = (const float*)d_in[6];
  p.dn_w_in = (const float*)d_in[7]; p.dn_conv_w = (const float*)d_in[8]; p.dn_a_log = (const float*)d_in[9];
  p.dn_dt_bias = (const float*)d_in[10]; p.dn_norm_g = (const float*)d_in[11]; p.dn_w_out = (const float*)d_in[12];
  p.gla_w_in = (const float*)d_in[13]; p.gla_w_g2 = (const float*)d_in[14]; p.gla_b_g = (const float*)d_in[15];
  p.gla_norm_g = (const float*)d_in[16]; p.gla_w_out = (const float*)d_in[17]; p.final_g = (const float*)d_in[18];
  p.out = (float*)d_out;
  p.ws = (char*)d_ws;
  (void)hipMemsetAsync((char*)d_ws + OFF_BAR, 0, XCD_BAR_WORDS * sizeof(unsigned), stream);
  void* args[] = {&p};
  hipError_t e = hipLaunchCooperativeKernel((void*)fwd_megakernel, dim3(grid_blocks), dim3(512), args, 0, stream);
  if (e != hipSuccess) fprintf(stderr, "cooperative launch failed: %s (grid %d)\n", hipGetErrorString(e), grid_blocks);
}
```

```cpp
#include <hip/hip_runtime.h>
#include <hip/hip_cooperative_groups.h>
#include <cstdio>
namespace cg = cooperative_groups;

#define DI __device__ __forceinline__
typedef unsigned short u16;
typedef short s16x8 __attribute__((ext_vector_type(8)));
typedef short s16x4 __attribute__((ext_vector_type(4)));
typedef float f32x2 __attribute__((ext_vector_type(2)));
typedef float f32x4 __attribute__((ext_vector_type(4)));
typedef float f32x16 __attribute__((ext_vector_type(16)));
typedef int i32x4 __attribute__((ext_vector_type(4)));
typedef unsigned u32x2 __attribute__((ext_vector_type(2)));
typedef unsigned u32x4 __attribute__((ext_vector_type(4)));
typedef __bf16 bf2_t __attribute__((ext_vector_type(2)));

constexpr int RL = 32768;
constexpr int RC = 1024;
constexpr int R = RL + RC;
constexpr int DM = 1024;
constexpr int NCHUNK = R / 64;
constexpr float EPSF = 1e-6f;
constexpr size_t MiB = 1u << 20;

constexpr size_t OFF_QK0 = 0;
constexpr size_t OFF_U0 = 132 * MiB;
constexpr size_t OFF_U1 = 264 * MiB;
constexpr size_t OFF_T = 396 * MiB;
constexpr size_t OFF_W1T = 462 * MiB;
constexpr size_t OFF_WO1T = OFF_W1T + 10 * MiB + 256 * 1024;
constexpr size_t OFF_MOD = OFF_WO1T + 4 * MiB;
constexpr size_t OFF_X = OFF_MOD + 256 * 1024;
constexpr size_t OFF_ABT = OFF_X + 8 * MiB + 256 * 1024;
constexpr size_t OFF_W0T = OFF_ABT + 4 * MiB + 256 * 1024;
constexpr size_t OFF_WO0T = OFF_W0T + 12 * MiB + 256 * 1024;
constexpr size_t OFF_V0 = 0;
constexpr size_t OFF_V1 = 132 * MiB;
constexpr size_t OFF_QK1 = 264 * MiB;
constexpr size_t OFF_QD = 330 * MiB;
constexpr size_t OFF_CD1 = OFF_X + 4 * MiB;
constexpr size_t OFF_ASUM = OFF_W0T;
constexpr size_t OFF_BAR = 506 * MiB;
constexpr size_t OFF_ZC = 507 * MiB;

constexpr size_t TA_LAT_ITEMS = 4096;
constexpr size_t OFF_TC = 462 * MiB;
constexpr size_t OFF_AC = 464 * MiB;
DI size_t ta_off(size_t item, int d) { return ((item < TA_LAT_ITEMS ? item : item - TA_LAT_ITEMS) * 2 + d) * 4096; }
struct Params {
  const float *x, *c, *ctx, *c_ctx, *mod_w, *mod_b, *norm_g, *dn_w_in, *dn_conv_w, *dn_a_log, *dn_dt_bias, *dn_norm_g,
      *dn_w_out, *gla_w_in, *gla_w_g2, *gla_b_g, *gla_norm_g, *gla_w_out, *final_g;
  float* out;
  char* ws;
};

DI unsigned pk2(float lo, float hi) { f32x2 v = {lo, hi}; return __builtin_bit_cast(unsigned, __builtin_convertvector(v, bf2_t)); }
DI float bflo(unsigned u) { return __uint_as_float(u << 16); }
DI float bfhi(unsigned u) { return __uint_as_float(u & 0xffff0000u); }
DI float bf2f(u16 v) { return __uint_as_float(((unsigned)v) << 16); }
DI u16 f2bf(float x) { return (u16)(pk2(x, 0.f) & 0xffffu); }
DI float siluf(float x) { return x / (1.f + __expf(-x)); }
DI float sigmoidf(float x) { return 1.f / (1.f + __expf(-x)); }
DI float softplusf(float x) { return fmaxf(x, 0.f) + __logf(1.f + __expf(-fabsf(x))); }
DI int crow(int reg, int h) { return (reg & 3) + 8 * (reg >> 2) + 4 * h; }
#define MFMA32(a, b, c) __builtin_amdgcn_mfma_f32_32x32x16_bf16((a), (b), (c), 0, 0, 0)
#define MFMA16(a, b, c) __builtin_amdgcn_mfma_f32_16x16x32_bf16((a), (b), (c), 0, 0, 0)

DI s16x8 cat8(u32x2 lo, u32x2 hi) { u32x4 v = {lo.x, lo.y, hi.x, hi.y}; return __builtin_bit_cast(s16x8, v); }
DI s16x8 ldA_perm(const char* base, int row, int strideB, int kofs, int h) {
  const char* p = base + row * strideB + (kofs + 4 * h) * 2;
  u32x2 lo = *(const u32x2*)p, hi = *(const u32x2*)(p + 16);
  return cat8(lo, hi);
}
DI s16x8 ldA_nat(const char* base, int row, int strideB, int kofs, int h) {
  const char* p = base + row * strideB + (kofs + 8 * h) * 2;
  u32x2 lo = *(const u32x2*)p, hi = *(const u32x2*)(p + 8);
  return cat8(lo, hi);
}
DI s16x8 pack_step(const f32x16& x, int s) {
  u32x4 p;
  p.x = pk2(x[8 * s + 0], x[8 * s + 1]); p.y = pk2(x[8 * s + 2], x[8 * s + 3]);
  p.z = pk2(x[8 * s + 4], x[8 * s + 5]); p.w = pk2(x[8 * s + 6], x[8 * s + 7]);
  return __builtin_bit_cast(s16x8, p);
}
DI void st8(char* p, u32x4 v) { *(u32x2*)p = (u32x2){v.x, v.y}; *(u32x2*)(p + 8) = (u32x2){v.z, v.w}; }
DI u32x4 scale8(u32x4 v, float s) {
  u32x4 o;
  o.x = pk2(bflo(v.x) * s, bfhi(v.x) * s); o.y = pk2(bflo(v.y) * s, bfhi(v.y) * s);
  o.z = pk2(bflo(v.z) * s, bfhi(v.z) * s); o.w = pk2(bflo(v.w) * s, bfhi(v.w) * s);
  return o;
}
DI int opq_v(int v) { asm volatile("" : "+v"(v)); return v; }
DI int lane_id() { int r; asm volatile("v_mbcnt_lo_u32_b32 %0, -1, 0\n\tv_mbcnt_hi_u32_b32 %0, -1, %0" : "=v"(r)); return r; }
#define TIDX() (wave_s_ * 64 + lane_id())
DI float wave_sum(float v) {
#pragma unroll
  for (int o = 32; o >= 1; o >>= 1) v += __shfl_xor(v, o, 64);
  return v;
}

DI void mods_phase(char* shm, const Params& p, const int wave_s_) {
  const int bid = blockIdx.x, tid = TIDX();
  float* mods = (float*)(p.ws + OFF_MOD);
  if (bid < 192) {
    float* scond = (float*)shm;
    float* red = scond + 5 * 1024;
    for (int e = tid; e < 5 * 1024; e += 512) {
      int r = e >> 10, k = e & 1023;
      float v = (r < 4) ? p.c[r * 1024 + k] : p.c_ctx[k];
      scond[e] = siluf(v);
    }
    __syncthreads();
    const int i = bid / 96, jt = bid % 96, jl = tid & 31, ks = tid >> 5;
    const float* w = p.mod_w + (size_t)i * 1024 * 3072 + jt * 32 + jl;
    float a0 = 0, a1 = 0, a2 = 0, a3 = 0, a4 = 0;
#pragma unroll 8
    for (int kk = 0; kk < 64; ++kk) {
      int k = ks * 64 + kk;
      float wv = w[(size_t)k * 3072];
      a0 += scond[k] * wv; a1 += scond[1024 + k] * wv; a2 += scond[2048 + k] * wv; a3 += scond[3072 + k] * wv; a4 += scond[4096 + k] * wv;
    }
    red[(ks * 5 + 0) * 32 + jl] = a0; red[(ks * 5 + 1) * 32 + jl] = a1; red[(ks * 5 + 2) * 32 + jl] = a2;
    red[(ks * 5 + 3) * 32 + jl] = a3; red[(ks * 5 + 4) * 32 + jl] = a4;
    __syncthreads();
    if (tid < 160) {
      int r = tid >> 5, j = tid & 31;
      float s = p.mod_b[i * 3072 + jt * 32 + j];
      for (int q = 0; q < 16; ++q) s += red[(q * 5 + r) * 32 + j];
      mods[(i * 5 + r) * 3072 + jt * 32 + j] = s;
    }
    __syncthreads();
  }
}

DI void wtrans_tile(char* shm, const float* src, int K, int N, u16* dst, int tile, const int wave_s_) {
  u16* t = (u16*)shm;
  const int tid = TIDX();
  const int tn = (N + 63) / 64;
  const int k0 = (tile / tn) * 64, n0 = (tile % tn) * 64;
#pragma unroll
  for (int q = 0; q < 8; ++q) {
    int e = tid + q * 512, kk = e >> 6, nn = e & 63;
    float v = (n0 + nn < N) ? src[(size_t)(k0 + kk) * N + n0 + nn] : 0.f;
    t[nn * 66 + kk] = f2bf(v);
  }
  __syncthreads();
#pragma unroll
  for (int q = 0; q < 8; ++q) {
    int e = tid + q * 512, nn = e >> 6, kk = e & 63;
    if (n0 + nn < N) dst[(size_t)(n0 + nn) * K + k0 + kk] = t[nn * 66 + kk];
  }
  __syncthreads();
}
template <int LAYER>
DI void wtrans_phase(char* shm, const Params& p, const int wave_s_) {
  const int t0 = 16 * 97, t1 = 32 * 16, t2 = 16 * 81, t3 = 32 * 16;
  if (LAYER == 0) {
    for (int tile = blockIdx.x; tile < t0 + t1; tile += gridDim.x) {
      if (tile < t0) wtrans_tile(shm, p.dn_w_in, 1024, 6176, (u16*)(p.ws + OFF_W0T), tile, wave_s_);
      else wtrans_tile(shm, p.dn_w_out, 2048, 1024, (u16*)(p.ws + OFF_WO0T), tile - t0, wave_s_);
    }
  } else {
    for (int tile = blockIdx.x; tile < t2 + t3; tile += gridDim.x) {
      if (tile < t2) wtrans_tile(shm, p.gla_w_in, 1024, 5152, (u16*)(p.ws + OFF_W1T), tile, wave_s_);
      else wtrans_tile(shm, p.gla_w_out, 2048, 1024, (u16*)(p.ws + OFF_WO1T), tile - t2, wave_s_);
    }
  }
}

DI void h_phase(const float* src_lat, const float* src_ctx, const float* g, const float* mods_i, u16* dst, int nrows, const int wave_s_) {
  const int tidx_ = TIDX();
  const int lane = tidx_ & 63, gw = blockIdx.x * 8 + (tidx_ >> 6), nw = gridDim.x * 8;
  for (int row0 = gw; row0 < nrows; row0 += 2 * nw) {
    const int rows[2] = {row0, row0 + nw};
    const bool ok1 = rows[1] < nrows;
    f32x4 v[2][4];
#pragma unroll
    for (int u = 0; u < 2; ++u) {
      const int row = (u == 0 || ok1) ? rows[u] : rows[0];
      const float* s = (row < RL) ? src_lat + (size_t)row * DM : src_ctx + (size_t)(row - RL) * DM;
#pragma unroll
      for (int q = 0; q < 4; ++q) v[u][q] = *(const f32x4*)(s + q * 256 + lane * 4);
    }
#pragma unroll
    for (int u = 0; u < 2; ++u) {
      if (u == 1 && !ok1) break;
      const int row = rows[u];
      const int mr = (row < RL) ? (row >> 13) : 4;
      const float* sh = mods_i + mr * 3072;
      const float* sc = sh + 1024;
      float ss = 0.f;
#pragma unroll
      for (int q = 0; q < 4; ++q) ss += v[u][q].x * v[u][q].x + v[u][q].y * v[u][q].y + v[u][q].z * v[u][q].z + v[u][q].w * v[u][q].w;
      ss = wave_sum(ss);
      const float rstd = rsqrtf(ss * (1.f / 1024.f) + EPSF);
#pragma unroll
      for (int q = 0; q < 4; ++q) {
        const int col = q * 256 + lane * 4;
        f32x4 gg = *(const f32x4*)(g + col), s1 = *(const f32x4*)(sc + col), s0 = *(const f32x4*)(sh + col);
        float o0 = v[u][q].x * rstd * gg.x * (1.f + s1.x) + s0.x, o1 = v[u][q].y * rstd * gg.y * (1.f + s1.y) + s0.y;
        float o2 = v[u][q].z * rstd * gg.z * (1.f + s1.z) + s0.z, o3 = v[u][q].w * rstd * gg.w * (1.f + s1.w) + s0.w;
        *(u32x2*)(dst + (size_t)row * DM + col) = (u32x2){pk2(o0, o1), pk2(o2, o3)};
      }
    }
  }
}

DI void small_gemm(const u16* A, const u16* Wt, float* out, const int wave_s_) {
  const int tidx_ = TIDX();
  if ((blockIdx.x & 7) == 0) return;
  const int bsub = (int)blockIdx.x - 1 - ((int)blockIdx.x >> 3);
  const int lane = tidx_ & 63, gw = bsub * 8 + (tidx_ >> 6), nw = (gridDim.x - (gridDim.x >> 3)) * 8;
  const int r = lane & 31, h = lane >> 5;
  for (int wt = gw; wt < R / 32; wt += nw) {
    const u16* ap = A + (size_t)(wt * 32 + r) * 1024 + 8 * h;
    const u16* bp = Wt + (size_t)r * 1024 + 8 * h;
    f32x16 acc;
    for (int i = 0; i < 16; ++i) acc[i] = 0.f;
#pragma unroll 8
    for (int s = 0; s < 64; ++s) {
      s16x8 a = *(const s16x8*)(ap + 16 * s), b = *(const s16x8*)(bp + 16 * s);
      acc = MFMA32(a, b, acc);
    }
#pragma unroll
    for (int i = 0; i < 16; ++i) out[(size_t)(wt * 32 + crow(i, h)) * 32 + r] = acc[i];
  }
}

DI int lds_byte2(int r, int c) {
  int st = (r >> 4) * 2 + (c >> 5), ob = (r & 15) * 64 + (c & 31) * 2;
  return st * 1024 + (ob ^ (((ob >> 9) & 1) << 5));
}
DI void stage_rc2(int b, int& Rr, int& Cc) {
  int st = b >> 10, sb = b & 1023, swz = sb ^ (((sb >> 9) & 1) << 5);
  Rr = (st / 2) * 16 + swz / 64;
  Cc = (st % 2) * 32 + (swz % 64) / 2;
}

struct EpiArgs {
  int mode;
  u16* lat; u16* ctx; int ld;
  u16* b1; u16* b2;
  const float* res_lat; const float* res_ctx; const float* mods_i; float* out_lat; float* out_ctx;
};

template <int MODE>
DI void gemm_epilogue(const EpiArgs& e, f32x4 (&acc)[8][4], int row0, int pn, int wr, int wc, int fr, int fq) {
#pragma unroll
  for (int m = 0; m < 8; ++m) {
    const int row = row0 + wr * 128 + m * 16 + fr;
#pragma unroll
    for (int n = 0; n < 4; ++n) {
      const int col = pn * 256 + wc * 64 + n * 16 + fq * 4;
      const f32x4 a = acc[m][n];
      if (MODE == 0) {
        u16* pr = (row < RL) ? e.lat + (size_t)row * e.ld : e.ctx + (size_t)(row - RL) * e.ld;
        *(u32x2*)(pr + col) = (u32x2){pk2(a.x, a.y), pk2(a.z, a.w)};
      } else if (MODE == 1) {
        u32x2 v = {pk2(a.x, a.y), pk2(a.z, a.w)};
        if (pn < 4) {
          *(u32x2*)(e.lat + (size_t)row * 1024 + col) = v;
        } else {
          *(u32x2*)(e.b1 + (size_t)row * 2048 + col - 1024) = v;
          *(u32x2*)(e.b2 + (size_t)row * 2048 + col - 1024) = v;
        }
      } else {
        const int mr = (row < RL) ? (row >> 13) : 4;
        const f32x4 gt = *(const f32x4*)(e.mods_i + mr * 3072 + 2048 + col);
        const float* rp = (row < RL) ? e.res_lat + (size_t)row * DM : e.res_ctx + (size_t)(row - RL) * DM;
        float* op = (row < RL) ? e.out_lat + (size_t)row * DM : e.out_ctx + (size_t)(row - RL) * DM;
        const f32x4 rv = *(const f32x4*)(rp + col);
        f32x4 o = {rv.x + gt.x * a.x, rv.y + gt.y * a.y, rv.z + gt.z * a.z, rv.w + gt.w * a.w};
        *(f32x4*)(op + col) = o;
      }
    }
  }
}

template <int MODE>
DI void gemm_epilogue8(const EpiArgs& e, f32x4 (&acc)[2][2][4][2], int row0, int pn, int wr, int wc, int fr, int fq) {
#pragma unroll
  for (int ai = 0; ai < 2; ++ai)
#pragma unroll
    for (int m = 0; m < 4; ++m) {
      const int row = row0 + ai * 128 + wr * 64 + m * 16 + fr;
#pragma unroll
      for (int bj = 0; bj < 2; ++bj)
#pragma unroll
        for (int n = 0; n < 2; ++n) {
          const int col = pn * 256 + bj * 128 + wc * 32 + n * 16 + fq * 4;
          const f32x4 a = acc[ai][bj][m][n];
          if (MODE == 0) {
            u16* pr = (row < RL) ? e.lat + (size_t)row * e.ld : e.ctx + (size_t)(row - RL) * e.ld;
            *(u32x2*)(pr + col) = (u32x2){pk2(a.x, a.y), pk2(a.z, a.w)};
          } else if (MODE == 4) {
            const size_t dsel = (pn < 8) ? 0 : (pn < 16) ? (4 * MiB / 2) : ((OFF_ZC - OFF_X) / 2);
            *(u32x2*)(e.ctx + dsel + (size_t)(row - RL) * 2048 + (col & 2047)) = (u32x2){pk2(a.x, a.y), pk2(a.z, a.w)};
          } else if (MODE == 1) {
            u32x2 v = {pk2(a.x, a.y), pk2(a.z, a.w)};
            if (pn < 4) {
              *(u32x2*)(e.lat + (size_t)row * 1024 + col) = v;
            } else {
              *(u32x2*)(e.b1 + (size_t)row * 2048 + col - 1024) = v;
              *(u32x2*)(e.b2 + (size_t)row * 2048 + col - 1024) = v;
            }
          } else {
            const int mr = (row < RL) ? (row >> 13) : 4;
            const f32x4 gt = *(const f32x4*)(e.mods_i + mr * 3072 + 2048 + col);
            const float* rp = (row < RL) ? e.res_lat + (size_t)row * DM : e.res_ctx + (size_t)(row - RL) * DM;
            float* op = (row < RL) ? e.out_lat + (size_t)row * DM : e.out_ctx + (size_t)(row - RL) * DM;
            const f32x4 rv = *(const f32x4*)(rp + col);
            f32x4 o = {rv.x + gt.x * a.x, rv.y + gt.y * a.y, rv.z + gt.z * a.z, rv.w + gt.w * a.w};
            *(f32x4*)(op + col) = o;
          }
        }
    }
}

template <int MODE>
DI void gemm_phase(char* shm_, const u16* Alat, const u16* Actx, int K, const u16* Bt, int pm0, int npm, int nN, const EpiArgs& e, const int wave_s_) {
  constexpr int BK = 64, HALF = 128, HT = HALF * BK;
  u16* shm = (u16*)shm_;
  const int tid = TIDX(), wid = tid >> 6, lane = tid & 63, wr = wid >> 2, wc = wid & 3, fr = lane & 15, fq = lane >> 4;
#define SA(b, h) (shm + ((b) * 2 + (h)) * HT)
#define SB(b, h) (shm + (4 + (b) * 2 + (h)) * HT)
#define LDSP(ptr) ((__attribute__((address_space(3))) unsigned*)(unsigned)(size_t)(ptr))
#define STAGE(P, BASE, br, kt) do { const u16* _p = (BASE) + (size_t)(br) * K + (kt) * BK + soff; \
    _Pragma("unroll") for (int _i = 0; _i < 2; ++_i) \
      __builtin_amdgcn_global_load_lds((const unsigned*)(_p + (size_t)_i * 64 * K), LDSP((char*)(P) + wid * 1024 + _i * 8192), 16, 0, 0); } while (0)
#define LDA(dst, b, h) _Pragma("unroll") for (int m = 0; m < 4; ++m) _Pragma("unroll") for (int k = 0; k < 2; ++k) \
    dst[m][k] = *(const s16x8*)((const char*)SA(b, h) + lds_byte2(wr * 64 + m * 16 + fr, k * 32 + fq * 8))
#define LDB(dst, b, h) _Pragma("unroll") for (int n = 0; n < 2; ++n) _Pragma("unroll") for (int k = 0; k < 2; ++k) \
    dst[n][k] = *(const s16x8*)((const char*)SB(b, h) + lds_byte2(wc * 32 + n * 16 + fr, k * 32 + fq * 8))
#define MMA(ai, bj, Atv, Btv) do { __builtin_amdgcn_s_setprio(1); \
    _Pragma("unroll") for (int m = 0; m < 4; ++m) _Pragma("unroll") for (int n = 0; n < 2; ++n) _Pragma("unroll") for (int k = 0; k < 2; ++k) \
      acc[ai][bj][m][n] = MFMA16(Btv[n][k], Atv[m][k], acc[ai][bj][m][n]); \
    __builtin_amdgcn_s_setprio(0); } while (0)
#define WAIT_V(n) asm volatile("s_waitcnt vmcnt(" #n ")" ::: "memory")
#define WAIT_L(n) asm volatile("s_waitcnt lgkmcnt(" #n ")" ::: "memory")
#define BAR __builtin_amdgcn_s_barrier()
#define SCHED __builtin_amdgcn_sched_barrier(0)
  int sR0, sC0;
  stage_rc2(tid * 16, sR0, sC0);
  const size_t soff = (size_t)sR0 * K + sC0;
  const int ntiles = npm * nN, nt = K / BK;
  const int xcd = blockIdx.x & 7, jj = blockIdx.x >> 3;
  const int PN = (nN % 8 == 0) ? 8 : 4, PG = 32 / PN, npg = nN / PN;
  const int ngroups = ((npm + PG - 1) / PG) * npg;
  const bool grouped = (gridDim.x == 256);
  const int nit = grouped ? (ngroups - xcd + 7) / 8 : (ntiles - (int)blockIdx.x + (int)gridDim.x - 1) / (int)gridDim.x;
  auto tile_of = [&](int it, int& pm, int& pn) -> bool {
    if (it >= nit) return false;
    if (grouped) {
      const int g = xcd + 8 * it, pmg = g / npg, png = g % npg;
      pm = pmg * PG + jj / PN; pn = png * PN + jj % PN;
      if (pm >= npm) return false;
      pm += pm0;
    } else {
      const int L = blockIdx.x + it * gridDim.x;
      pm = pm0 + L / nN; pn = L % nN;
    }
    return true;
  };
  bool prefetched = false;
  for (int it = 0; it < nit; ++it) {
    int pm, pn;
    if (!tile_of(it, pm, pn)) continue;
    const int row0 = pm * 256;
    const u16* A = (row0 < RL) ? Alat + (size_t)row0 * K : Actx + (size_t)(row0 - RL) * K;
    const u16* Bw = Bt + (size_t)pn * 256 * K;
    const int brow = 0, bcol = 0;
    f32x4 acc[2][2][4][2];
#pragma unroll
    for (int i0 = 0; i0 < 2; ++i0)
#pragma unroll
      for (int i1 = 0; i1 < 2; ++i1)
#pragma unroll
        for (int i2 = 0; i2 < 4; ++i2)
#pragma unroll
          for (int i3 = 0; i3 < 2; ++i3) acc[i0][i1][i2][i3] = (f32x4){0.f, 0.f, 0.f, 0.f};
    s16x8 At[4][2], B0[2][2], B1[2][2];
    if (!prefetched) {
      STAGE(SB(0, 0), Bw, bcol, 0); STAGE(SA(0, 0), A, brow, 0);
      STAGE(SB(0, 1), Bw, bcol + HALF, 0); STAGE(SA(0, 1), A, brow + HALF, 0);
    }
    if (wr == 1) BAR;
    WAIT_V(4); BAR;
    STAGE(SB(1, 0), Bw, bcol, 1); STAGE(SA(1, 0), A, brow, 1); STAGE(SB(1, 1), Bw, bcol + HALF, 1);
    WAIT_V(6); BAR;
    for (int t = 0; t < nt - 2; t += 2) {
      LDB(B0, 0, 0); SCHED; LDA(At, 0, 0); STAGE(SA(1, 1), A, brow + HALF, t + 1);
      WAIT_L(8); BAR; WAIT_L(0); MMA(0, 0, At, B0); BAR; SCHED;
      LDB(B1, 0, 1); STAGE(SB(0, 0), Bw, bcol, t + 2);
      BAR; WAIT_L(0); MMA(0, 1, At, B1); BAR;
      LDA(At, 0, 1); STAGE(SA(0, 0), A, brow, t + 2);
      BAR; WAIT_L(0); MMA(1, 0, At, B0); BAR; SCHED;
      STAGE(SB(0, 1), Bw, bcol + HALF, t + 2);
      WAIT_V(6); BAR; MMA(1, 1, At, B1); BAR;
      LDB(B0, 1, 0); SCHED; LDA(At, 1, 0); STAGE(SA(0, 1), A, brow + HALF, t + 2);
      WAIT_L(8); BAR; WAIT_L(0); MMA(0, 0, At, B0); BAR; SCHED;
      LDB(B1, 1, 1); STAGE(SB(1, 0), Bw, bcol, t + 3);
      BAR; WAIT_L(0); MMA(0, 1, At, B1); BAR;
      LDA(At, 1, 1); STAGE(SA(1, 0), A, brow, t + 3);
      BAR; WAIT_L(0); MMA(1, 0, At, B0); BAR; SCHED;
      STAGE(SB(1, 1), Bw, bcol + HALF, t + 3);
      WAIT_V(6); BAR; MMA(1, 1, At, B1); BAR;
    }
    { LDB(B0, 0, 0); LDA(At, 0, 0); STAGE(SA(1, 1), A, brow + HALF, nt - 1);
      BAR; WAIT_L(0); MMA(0, 0, At, B0); BAR;
      LDB(B1, 0, 1); BAR; WAIT_L(0); MMA(0, 1, At, B1); BAR;
      LDA(At, 0, 1); WAIT_V(4); BAR; WAIT_L(0); MMA(1, 0, At, B0); MMA(1, 1, At, B1); BAR; }
    { LDB(B0, 1, 0); LDA(At, 1, 0); WAIT_V(2); BAR; WAIT_L(0); MMA(0, 0, At, B0); BAR;
      LDB(B1, 1, 1); WAIT_V(0); BAR; WAIT_L(0); MMA(0, 1, At, B1); BAR;
      LDA(At, 1, 1); BAR; WAIT_L(0); MMA(1, 0, At, B0); MMA(1, 1, At, B1); BAR; }
    if (wr == 0) BAR;
    {
      int pm2, pn2;
      prefetched = tile_of(it + 1, pm2, pn2);
      if (prefetched) {
        const int r2 = pm2 * 256;
        const u16* A2 = (r2 < RL) ? Alat + (size_t)r2 * K : Actx + (size_t)(r2 - RL) * K;
        const u16* B2 = Bt + (size_t)pn2 * 256 * K;
        STAGE(SB(0, 0), B2, 0, 0); STAGE(SA(0, 0), A2, 0, 0);
        STAGE(SB(0, 1), B2, HALF, 0); STAGE(SA(0, 1), A2, HALF, 0);
      }
    }
    { const int l2 = lane_id(); gemm_epilogue8<MODE>(e, acc, row0, pn, wr, wc, l2 & 15, l2 >> 4); }
    asm volatile("s_waitcnt vmcnt(0) lgkmcnt(0)" ::: "memory");
    BAR;
  }
#undef SA
#undef SB
#undef LDSP
#undef STAGE
#undef LDA
#undef LDB
#undef MMA
#undef WAIT_V
#undef WAIT_L
#undef BAR
#undef SCHED
}

DI void conv_accum(float (&acc)[8], const u16* srow, const float* w) {
  u32x4 v = *(const u32x4*)srow;
  f32x4 w0 = *(const f32x4*)w, w1 = *(const f32x4*)(w + 4);
  acc[0] += bflo(v.x) * w0.x; acc[1] += bfhi(v.x) * w0.y; acc[2] += bflo(v.y) * w0.z; acc[3] += bfhi(v.y) * w0.w;
  acc[4] += bflo(v.z) * w1.x; acc[5] += bfhi(v.z) * w1.y; acc[6] += bflo(v.w) * w1.z; acc[7] += bfhi(v.w) * w1.w;
}
DI void fma8(float (&acc)[8], const u32x4 v, const float (&w)[8]) {
  acc[0] += bflo(v.x) * w[0]; acc[1] += bfhi(v.x) * w[1]; acc[2] += bflo(v.y) * w[2]; acc[3] += bfhi(v.y) * w[3];
  acc[4] += bflo(v.z) * w[4]; acc[5] += bfhi(v.z) * w[5]; acc[6] += bflo(v.w) * w[6]; acc[7] += bfhi(v.w) * w[7];
}
template <bool ISV>
DI void conv_store(const Params& p, float (&acc)[8], int row, int ch) {
#pragma unroll
  for (int e = 0; e < 8; ++e) acc[e] = siluf(acc[e]);
  if (!ISV) {
    u16* qk = (u16*)(p.ws + OFF_QK0);
    float ss = 0.f;
#pragma unroll
    for (int e = 0; e < 8; ++e) ss += acc[e] * acc[e];
    ss += __shfl_xor(ss, 1, 64); ss += __shfl_xor(ss, 2, 64); ss += __shfl_xor(ss, 4, 64); ss += __shfl_xor(ss, 8, 64);
    const float sc = rsqrtf(ss + EPSF) * ((ch < 1024) ? 0.08838834764831845f : 1.f);
    u32x4 o = {pk2(acc[0] * sc, acc[1] * sc), pk2(acc[2] * sc, acc[3] * sc), pk2(acc[4] * sc, acc[5] * sc), pk2(acc[6] * sc, acc[7] * sc)};
    *(u32x4*)(qk + (size_t)row * 2048 + ch) = o;
  } else {
    u16* u0 = (u16*)(p.ws + OFF_U0);
    u16* u1 = (u16*)(p.ws + OFF_U1);
    const float* abt = (const float*)(p.ws + OFF_ABT);
    const int head = ch >> 8;
    const float b0 = sigmoidf(abt[(size_t)row * 32 + 16 + head]), b1 = sigmoidf(abt[(size_t)row * 32 + 24 + head]);
    u32x4 o0 = {pk2(acc[0] * b0, acc[1] * b0), pk2(acc[2] * b0, acc[3] * b0), pk2(acc[4] * b0, acc[5] * b0), pk2(acc[6] * b0, acc[7] * b0)};
    u32x4 o1 = {pk2(acc[0] * b1, acc[1] * b1), pk2(acc[2] * b1, acc[3] * b1), pk2(acc[4] * b1, acc[5] * b1), pk2(acc[6] * b1, acc[7] * b1)};
    *(u32x4*)(u0 + (size_t)row * 2048 + ch) = o0;
    *(u32x4*)(u1 + (size_t)row * 2048 + ch) = o1;
  }
}
template <bool ISV>
DI void conv_phase(const Params& p, const int wave_s_) {
  const u16* pre_lat = (const u16*)p.out;
  const u16* pre_ctx = (const u16*)(p.ws + OFF_X + (ISV ? 4 * MiB : 0));
  const float* cw = p.dn_conv_w + (ISV ? 2048 : 0);
  const int gt = blockIdx.x * 512 + TIDX(), nthr = gridDim.x * 512;
  const u32x4 zero4 = {0u, 0u, 0u, 0u};
  for (int idx = gt; idx < 4 * 128 * 4 * 256; idx += nthr) {
    const int cg8 = idx & 255, run = (idx >> 8) & 3, gr = (idx >> 10) & 127, b = idx >> 17, ch = cg8 * 8, c0 = run * 16;
    float w[9][8];
#pragma unroll
    for (int t = 0; t < 9; ++t) {
      const f32x4 w0 = *(const f32x4*)(cw + t * 4096 + ch), w1 = *(const f32x4*)(cw + t * 4096 + ch + 4);
      w[t][0] = w0.x; w[t][1] = w0.y; w[t][2] = w0.z; w[t][3] = w0.w; w[t][4] = w1.x; w[t][5] = w1.y; w[t][6] = w1.z; w[t][7] = w1.w;
    }
    const u16* base = pre_lat + ((size_t)(b << 13) + gr * 64) * 2048 + ch;
    const bool rok[3] = {gr > 0, true, gr < 127};
    u32x4 win[3][3];
#pragma unroll
    for (int i = 0; i < 3; ++i) {
      win[i][0] = (rok[i] && c0 > 0) ? *(const u32x4*)(base + (ptrdiff_t)((i - 1) * 64 + c0 - 1) * 2048) : zero4;
      win[i][1] = rok[i] ? *(const u32x4*)(base + (ptrdiff_t)((i - 1) * 64 + c0) * 2048) : zero4;
    }
#pragma unroll
    for (int t = 0; t < 16; ++t) {
      const int c = c0 + t;
#pragma unroll
      for (int i = 0; i < 3; ++i) win[i][2] = (rok[i] && c < 63) ? *(const u32x4*)(base + (ptrdiff_t)((i - 1) * 64 + c + 1) * 2048) : zero4;
      float acc[8];
#pragma unroll
      for (int e = 0; e < 8; ++e) acc[e] = 0.f;
#pragma unroll
      for (int i = 0; i < 3; ++i)
#pragma unroll
        for (int j = 0; j < 3; ++j) fma8(acc, win[i][j], w[i * 3 + j]);
      conv_store<ISV>(p, acc, (b << 13) + gr * 64 + c, ch);
#pragma unroll
      for (int i = 0; i < 3; ++i) { win[i][0] = win[i][1]; win[i][1] = win[i][2]; }
    }
  }
  for (int idx = gt; idx < 4 * 32 * 256; idx += nthr) {
    const int cg8 = idx & 255, run = (idx >> 8) & 31, b = idx >> 13, ch = cg8 * 8, p0 = run * 8;
    float w[3][8];
#pragma unroll
    for (int t = 0; t < 3; ++t) {
      const f32x4 w0 = *(const f32x4*)(cw + (3 + t) * 4096 + ch), w1 = *(const f32x4*)(cw + (3 + t) * 4096 + ch + 4);
      w[t][0] = w0.x; w[t][1] = w0.y; w[t][2] = w0.z; w[t][3] = w0.w; w[t][4] = w1.x; w[t][5] = w1.y; w[t][6] = w1.z; w[t][7] = w1.w;
    }
    const u16* base = pre_ctx + (size_t)(b * 256) * 2048 + ch;
    u32x4 win[3];
    win[0] = (p0 > 0) ? *(const u32x4*)(base + (size_t)(p0 - 1) * 2048) : zero4;
    win[1] = *(const u32x4*)(base + (size_t)p0 * 2048);
#pragma unroll
    for (int t = 0; t < 8; ++t) {
      const int pp = p0 + t;
      win[2] = (pp < 255) ? *(const u32x4*)(base + (size_t)(pp + 1) * 2048) : zero4;
      float acc[8];
#pragma unroll
      for (int e = 0; e < 8; ++e) acc[e] = 0.f;
#pragma unroll
      for (int j = 0; j < 3; ++j) fma8(acc, win[j], w[j]);
      conv_store<ISV>(p, acc, RL + b * 256 + pp, ch);
      win[0] = win[1]; win[1] = win[2];
    }
  }
}

constexpr int lp_off(int ip) { return ip == 0 ? 0 : (8 * ((ip - 1) / 4) * ((ip - 1) / 4 + 1) + 4 * ((ip - 1) % 4) * ((ip - 1) / 4 + 1)); }
constexpr int LP_FLOATS = 2112;
DI void dn_prep_phase(char* shm, const Params& p, const int wave_s_) {
  const int tid = TIDX(), wave = tid >> 6, lane = tid & 63, r = lane & 31, hh = lane >> 5;
  char* sQ = shm;
  char* sK = shm + 16896;
  float* sKK = (float*)(shm + 33792);
  float* sQK = (float*)(shm + 50432);
  float* sg = (float*)(shm + 67072);
  float* sbeta = sg + 128;
  float* sgc = sg + 256;
  float* sLp = (float*)(shm + 68608);
  const u16* qk = (const u16*)(p.ws + OFF_QK0);
  const float* abt = (const float*)(p.ws + OFF_ABT);
  u16* Ab_lat = (u16*)p.out;
  u16* Tb_lat = (u16*)p.out + (size_t)32 * MiB;
  u16* Ab_ctx = (u16*)(p.ws + OFF_AC);
  u16* Tb_ctx = (u16*)(p.ws + OFF_TC);
  float* Eb = (float*)(p.ws + OFF_X);
  for (int grp = blockIdx.x; grp < NCHUNK * 2; grp += gridDim.x) {
    const int ci = grp >> 1, row0 = ci * 64;
    u32x4 pq[2], pk[2];
    float pa = 0.f, pbt = 0.f;
    auto load_item = [&](int h) {
#pragma unroll
      for (int u = 0; u < 2; ++u) {
        const int chunk = tid * 2 + u, c = chunk >> 4, cc = (chunk & 15) * 8;
        const u16* src = qk + (size_t)(row0 + c) * 2048 + h * 128 + cc;
        pq[u] = *(const u32x4*)src; pk[u] = *(const u32x4*)(src + 1024);
      }
      if (tid < 128) {
        const int d = tid >> 6, c = tid & 63;
        pa = abt[(size_t)(row0 + c) * 32 + d * 8 + h]; pbt = abt[(size_t)(row0 + c) * 32 + 16 + d * 8 + h];
      }
    };
    load_item((grp & 1) * 4);
    for (int sub = 0; sub < 4; ++sub) {
      const int h = (grp & 1) * 4 + sub, item = ci * 8 + h;
#pragma unroll
      for (int u = 0; u < 2; ++u) {
        const int chunk = tid * 2 + u, c = chunk >> 4, cc = (chunk & 15) * 8;
        st8(sQ + c * 264 + cc * 2, pq[u]);
        st8(sK + c * 264 + cc * 2, pk[u]);
      }
      if (tid < 128) {
        const int d = tid >> 6, c = tid & 63;
        sg[d * 64 + c] = -__expf(p.dn_a_log[d * 8 + h]) * softplusf(pa + p.dn_dt_bias[d * 8 + h]);
        sbeta[d * 64 + c] = sigmoidf(pbt);
      }
      if (sub < 3) load_item(h + 1);
      __syncthreads();
      if (wave < 2) {
        const int c = wave ? 63 - lane : lane;
        float v = sg[wave * 64 + c];
#pragma unroll
        for (int o = 1; o < 64; o <<= 1) { const float t = __shfl_up(v, o, 64); if (lane >= o) v += t; }
        sgc[wave * 64 + c] = v;
      }
      {
        const int mat = wave >> 2, tm = (wave >> 1) & 1, tn = wave & 1;
        const char* aop = mat ? sQ : sK;
        f32x16 acc;
        for (int i = 0; i < 16; ++i) acc[i] = 0.f;
#pragma unroll
        for (int s = 0; s < 8; ++s) {
          s16x8 a = ldA_nat(aop, 32 * tm + r, 264, 16 * s, hh), b = ldA_nat(sK, 32 * tn + r, 264, 16 * s, hh);
          acc = MFMA32(a, b, acc);
        }
        float* dst = mat ? sQK : sKK;
#pragma unroll
        for (int i = 0; i < 16; ++i) dst[(32 * tm + crow(i, hh)) * 65 + 32 * tn + r] = acc[i];
      }
      __syncthreads();
      for (int e = tid; e < 8192; e += 512) {
        const int d = e >> 12, ip = (e >> 6) & 63, jp = e & 63;
        if (ip > jp) {
          const int i = d ? 63 - ip : ip, j = d ? 63 - jp : jp;
          const int q4 = (ip - 1) >> 2, r4 = (ip - 1) & 3;
          const float v = sbeta[d * 64 + i] * sKK[i * 65 + j] * __expf(fminf(sgc[d * 64 + i] - sgc[d * 64 + j], 0.f));
          sLp[(sub * 2 + d) * LP_FLOATS + 8 * q4 * (q4 + 1) + 4 * r4 * (q4 + 1) + jp] = v;
        }
      }
      for (int v = tid; v < 1024; v += 512) {
        const int d = v >> 9, i = (v >> 3) & 63, j0 = (v & 7) * 8;
        float o[8];
#pragma unroll
        for (int e = 0; e < 8; ++e) {
          const int j = j0 + e;
          const bool keep = d ? (i <= j) : (i >= j);
          o[e] = keep ? sQK[i * 65 + j] * __expf(fminf(sgc[d * 64 + i] - sgc[d * 64 + j], 0.f)) : 0.f;
        }
        u32x4 ov = {pk2(o[0], o[1]), pk2(o[2], o[3]), pk2(o[4], o[5]), pk2(o[6], o[7])};
        *(u32x4*)(((size_t)item < TA_LAT_ITEMS ? Ab_lat : Ab_ctx) + ta_off(item, d) + i * 64 + j0) = ov;
      }
      if (tid < 128) {
        const int d = tid >> 6, c = tid & 63;
        const float gl = sgc[d * 64 + (d ? 0 : 63)], gcv = sgc[d * 64 + c];
        const float e1 = __expf(gcv), be = sbeta[d * 64 + c] * e1, e2 = __expf(gl - gcv), cdv = __expf(gl);
        float* E = Eb + ((size_t)item * 2 + d) * 256;
        E[c] = e1; E[64 + c] = be; E[128 + c] = e2; E[192 + c] = cdv;
      }
      __syncthreads();
    }
    {
      const int wv = opq_v(wave), lane_l = opq_v(lane);
      const int d = wv & 1, item = ci * 8 + (grp & 1) * 4 + (wv >> 1);
      const float* Lb = sLp + wv * LP_FLOATS;
      float T[64];
#pragma unroll
      for (int ip = 0; ip < 64; ++ip) {
        f32x4 lrow[16];
#pragma unroll
        for (int j4 = 0; j4 < (ip + 3) / 4; ++j4) lrow[j4] = *(const f32x4*)(Lb + lp_off(ip) + j4 * 4);
        float a0 = (lane_l == ip) ? 1.f : 0.f, a1 = 0.f, a2 = 0.f, a3 = 0.f;
#pragma unroll
        for (int j4 = 0; j4 < (ip + 3) / 4; ++j4) {
          const f32x4 lv = lrow[j4];
          if (j4 * 4 + 0 < ip) a0 -= lv.x * T[j4 * 4 + 0];
          if (j4 * 4 + 1 < ip) a1 -= lv.y * T[j4 * 4 + 1];
          if (j4 * 4 + 2 < ip) a2 -= lv.z * T[j4 * 4 + 2];
          if (j4 * 4 + 3 < ip) a3 -= lv.w * T[j4 * 4 + 3];
        }
        T[ip] = (a0 + a1) + (a2 + a3);
        __builtin_amdgcn_sched_barrier(0);
      }
      u16* To = ((size_t)item < TA_LAT_ITEMS ? Tb_lat : Tb_ctx) + ta_off(item, d);
      const int cidx = d ? 63 - lane_l : lane_l;
#pragma unroll
      for (int ip = 0; ip < 64; ++ip) {
        const int i = d ? 63 - ip : ip;
        To[i * 64 + cidx] = f2bf(T[ip]);
      }
    }
    __syncthreads();
  }
}

constexpr int SC_QS = 272;
constexpr int SC_Q = 0, SC_K = 17408, SC_KT = 34816, SC_T = 52224, SC_A = 60928, SC_E = 69632, SC_BUF = 70656;
DI s16x8 ldA16(const char* base, int row, int strideB, int kofs, int q) {
  const char* p = base + row * strideB + (kofs + 4 * q) * 2;
  u32x2 lo = *(const u32x2*)p, hi = *(const u32x2*)(p + 32);
  return cat8(lo, hi);
}
DI s16x8 pack16(const f32x4& a, const f32x4& b) {
  u32x4 v = {pk2(a.x, a.y), pk2(a.z, a.w), pk2(b.x, b.y), pk2(b.z, b.w)};
  return __builtin_bit_cast(s16x8, v);
}

template <bool DELTA, bool DRY = false>
DI void scan_phase(char* shm, const Params& p, const int wave_s_) {
  const int bid = blockIdx.x;
  if (bid >= 256) return;
  const int tid = TIDX(), wave = tid >> 6, lane = tid & 63, n16 = lane & 15, q4 = lane >> 4;
  int cgp, d, h, b;
  if (DELTA) { cgp = (bid >> 3) & 3; const int cid = (bid & 7) + 8 * (bid >> 5); d = cid & 1; h = (cid >> 1) & 7; b = cid >> 4; }
  else { cgp = (bid >> 3) & 7; const int cid = (bid & 7) + 8 * (bid >> 6); d = cid & 1; h = (cid >> 1) & 3; b = cid >> 3; }
  const bool compute = wave < 4;
  const int col0 = (DELTA ? h * 256 : h * 512) + cgp * 64 + (wave & 3) * 16;
  u16* Ub = (u16*)(p.ws + (DELTA ? (d ? OFF_U1 : OFF_U0) : (d ? OFF_V1 : OFF_V0)));
  const u16* qk = (const u16*)(p.ws + OFF_QK0);
  const u16* Ag_lat = (const u16*)p.out;
  const u16* Tb_lat = (const u16*)p.out + (size_t)32 * MiB;
  const u16* Ag_ctx = (const u16*)(p.ws + OFF_AC);
  const u16* Tb_ctx = (const u16*)(p.ws + OFF_TC);
  const float* Eb = (const float*)(p.ws + OFF_X);
  const u16* QD = (const u16*)(p.ws + OFF_QD);
  const u16* AS = (const u16*)(p.ws + OFF_ASUM);
  const float* CD = (const float*)(p.ws + OFF_CD1);

  auto chunk_of = [&](int st) -> int {
    if (st < 4) return 512 + b * 4 + (d ? 3 - st : st);
    return b * 128 + (d ? 127 - (st - 4) : (st - 4));
  };

  auto stage_all = [&](int st, int buf) {
    const int sid = tid - 256;
    const int ci = chunk_of(st), row0 = ci * 64;
    char* sb = shm + buf * SC_BUF;
    if (DELTA) {
      const size_t it = ((size_t)ci * 8 + h) * 2 + d;
      const float* E = Eb + it * 256;
      const int c = sid >> 2, cc = (sid & 3) * 32;
      const u16* qsrc = qk + (size_t)(row0 + c) * 2048 + h * 128 + cc;
      const int c0 = (sid >> 4) * 4, dk0 = (sid & 15) * 8;
      const u16* ksrc = qk + (size_t)(row0 + c0) * 2048 + 1024 + h * 128 + dk0;
      u32x4 gq[4], gk[4], gT[2], gA[2];
#pragma unroll
      for (int u = 0; u < 4; ++u) gq[u] = *(const u32x4*)(qsrc + u * 8);
#pragma unroll
      for (int u = 0; u < 4; ++u) gk[u] = *(const u32x4*)(ksrc + (size_t)u * 2048);
#pragma unroll
      for (int u = 0; u < 2; ++u) {
        const int chunk = sid * 2 + u, tr = chunk >> 3, tc = (chunk & 7) * 8;
        const size_t itm = (size_t)ci * 8 + h;
        gT[u] = *(const u32x4*)((itm < TA_LAT_ITEMS ? Tb_lat : Tb_ctx) + ta_off(itm, d) + tr * 64 + tc);
        gA[u] = *(const u32x4*)((itm < TA_LAT_ITEMS ? Ag_lat : Ag_ctx) + ta_off(itm, d) + tr * 64 + tc);
      }
      const float e1 = E[c];
      const f32x4 bev = *(const f32x4*)(E + 64 + c0), e2v = *(const f32x4*)(E + 128 + c0);
      if (sid == 0) *(float*)(sb + SC_E) = E[192];
#pragma unroll
      for (int u = 0; u < 4; ++u) st8(sb + SC_Q + c * SC_QS + (cc + u * 8) * 2, scale8(gq[u], e1));
      const float be[4] = {bev.x, bev.y, bev.z, bev.w}, e2[4] = {e2v.x, e2v.y, e2v.z, e2v.w};
      u32x4 kt[4];
#pragma unroll
      for (int u = 0; u < 4; ++u) {
        st8(sb + SC_K + (c0 + u) * SC_QS + dk0 * 2, scale8(gk[u], -be[u]));
        kt[u] = scale8(gk[u], e2[u]);
      }
      const unsigned w[4][4] = {{kt[0].x, kt[0].y, kt[0].z, kt[0].w}, {kt[1].x, kt[1].y, kt[1].z, kt[1].w},
                                {kt[2].x, kt[2].y, kt[2].z, kt[2].w}, {kt[3].x, kt[3].y, kt[3].z, kt[3].w}};
#pragma unroll
      for (int jp = 0; jp < 4; ++jp) {
        u32x2 lo = {(w[0][jp] & 0xffffu) | (w[1][jp] << 16), (w[2][jp] & 0xffffu) | (w[3][jp] << 16)};
        u32x2 hi = {(w[0][jp] >> 16) | (w[1][jp] & 0xffff0000u), (w[2][jp] >> 16) | (w[3][jp] & 0xffff0000u)};
        *(u32x2*)(sb + SC_KT + (dk0 + 2 * jp) * 136 + c0 * 2) = lo;
        *(u32x2*)(sb + SC_KT + (dk0 + 2 * jp + 1) * 136 + c0 * 2) = hi;
      }
#pragma unroll
      for (int u = 0; u < 2; ++u) {
        const int chunk = sid * 2 + u, tr = chunk >> 3, tc = (chunk & 7) * 8;
        st8(sb + SC_T + tr * 136 + tc * 2, gT[u]);
        st8(sb + SC_A + tr * 136 + tc * 2, gA[u]);
      }
    } else {
      const size_t it = ((size_t)ci * 4 + h) * 2 + d;
      const u16* qd = QD + it * 16384;
      const int c = sid >> 2, cc = (sid & 3) * 32;
      const int kr = sid >> 1, kc = (sid & 1) * 32;
      u32x4 gq[4], gk[4], gA[2];
#pragma unroll
      for (int u = 0; u < 4; ++u) gq[u] = *(const u32x4*)(qd + c * 128 + cc + u * 8);
#pragma unroll
      for (int u = 0; u < 4; ++u) gk[u] = *(const u32x4*)(qd + 8192 + kr * 64 + kc + u * 8);
      if (d == 0) {
#pragma unroll
        for (int u = 0; u < 2; ++u) {
          const int chunk = sid * 2 + u, tr = chunk >> 3, tc = (chunk & 7) * 8;
          gA[u] = *(const u32x4*)(AS + ((size_t)ci * 4 + h) * 4096 + tr * 64 + tc);
        }
      }
      if (sid < 32) *(f32x4*)(sb + SC_E + sid * 16) = *(const f32x4*)(CD + it * 128 + sid * 4);
#pragma unroll
      for (int u = 0; u < 4; ++u) st8(sb + SC_Q + c * SC_QS + (cc + u * 8) * 2, gq[u]);
#pragma unroll
      for (int u = 0; u < 4; ++u) st8(sb + SC_KT + kr * 136 + (kc + u * 8) * 2, gk[u]);
      if (d == 0) {
#pragma unroll
        for (int u = 0; u < 2; ++u) {
          const int chunk = sid * 2 + u, tr = chunk >> 3, tc = (chunk & 7) * 8;
          st8(sb + SC_A + tr * 136 + tc * 2, gA[u]);
        }
      }
    }
  };

  f32x4 S[8];
#pragma unroll
  for (int t = 0; t < 8; ++t) S[t] = (f32x4){0.f, 0.f, 0.f, 0.f};
  u16 uraw[4][4];
  const int loff = (4 * q4) * 2048 + col0 + n16;
  auto u_issue = [&](int st) {
    const u16* up = Ub + (size_t)chunk_of(st) * (64 * 2048);
    const int lo = opq_v(loff);
#pragma unroll
    for (int mt = 0; mt < 4; ++mt)
#pragma unroll
      for (int i = 0; i < 4; ++i) uraw[mt][i] = up[lo + (16 * mt + i) * 2048];
  };

  if (compute) u_issue(0); else stage_all(0, 0);
  __syncthreads();

  for (int st = 0; st < 132; ++st) {
    const int buf = st & 1;
    const char* sb = shm + buf * SC_BUF;
    if (compute) {
      const int row0 = chunk_of(st) * 64;
      f32x4 Y[4], O[4];
#pragma unroll
      for (int mt = 0; mt < 4; ++mt) {
        Y[mt] = (f32x4){bf2f(uraw[mt][0]), bf2f(uraw[mt][1]), bf2f(uraw[mt][2]), bf2f(uraw[mt][3])};
        O[mt] = (f32x4){0.f, 0.f, 0.f, 0.f};
      }
#define SCHED_FENCE() __builtin_amdgcn_sched_barrier(0)
      s16x8 fT[8];
      if (DELTA) {
#pragma unroll
        for (int mt = 0; mt < 4; ++mt)
#pragma unroll
          for (int kc = 0; kc < 2; ++kc) fT[mt * 2 + kc] = ldA16(sb + SC_T, 16 * mt + n16, 136, 32 * kc, q4);
      }
      s16x8 fa[2][8];
#pragma unroll
      for (int mt = 0; mt < 4; ++mt) {
        if (DELTA) fa[0][mt] = ldA16(sb + SC_K, 16 * mt + n16, SC_QS, 0, q4);
        fa[0][4 + mt] = ldA16(sb + SC_Q, 16 * mt + n16, SC_QS, 0, q4);
      }
      SCHED_FENCE();
#pragma unroll
      for (int t = 0; t < 4; ++t) {
        if (t < 3) {
#pragma unroll
          for (int mt = 0; mt < 4; ++mt) {
            if (DELTA) fa[(t + 1) & 1][mt] = ldA16(sb + SC_K, 16 * mt + n16, SC_QS, 32 * (t + 1), q4);
            fa[(t + 1) & 1][4 + mt] = ldA16(sb + SC_Q, 16 * mt + n16, SC_QS, 32 * (t + 1), q4);
          }
        }
        SCHED_FENCE();
        const s16x8 Sb = pack16(S[2 * t], S[2 * t + 1]);
#pragma unroll
        for (int mt = 0; mt < 4; ++mt) {
          if (DELTA) Y[mt] = MFMA16(fa[t & 1][mt], Sb, Y[mt]);
          O[mt] = MFMA16(fa[t & 1][4 + mt], Sb, O[mt]);
        }
        SCHED_FENCE();
      }
      s16x8 fA[8];
      if (DELTA || d == 0) {
#pragma unroll
        for (int mt = 0; mt < 4; ++mt)
#pragma unroll
          for (int kc = 0; kc < 2; ++kc) fA[mt * 2 + kc] = ldA16(sb + SC_A, 16 * mt + n16, 136, 32 * kc, q4);
      }
      SCHED_FENCE();
      s16x8 vnb[2];
      if (DELTA) {
        s16x8 Yb[2];
        Yb[0] = pack16(Y[0], Y[1]); Yb[1] = pack16(Y[2], Y[3]);
        f32x4 vn[4];
#pragma unroll
        for (int mt = 0; mt < 4; ++mt) {
          vn[mt] = (f32x4){0.f, 0.f, 0.f, 0.f};
#pragma unroll
          for (int kc = 0; kc < 2; ++kc) vn[mt] = MFMA16(fT[mt * 2 + kc], Yb[kc], vn[mt]);
        }
        vnb[0] = pack16(vn[0], vn[1]); vnb[1] = pack16(vn[2], vn[3]);
      } else {
        vnb[0] = pack16(Y[0], Y[1]); vnb[1] = pack16(Y[2], Y[3]);
      }
      SCHED_FENCE();
      s16x8 fK[8];
#pragma unroll
      for (int t = 0; t < 4; ++t)
#pragma unroll
        for (int kc = 0; kc < 2; ++kc) fK[t * 2 + kc] = ldA16(sb + SC_KT, 16 * t + n16, 136, 32 * kc, q4);
      if (st + 1 < 132) u_issue(st + 1);
      SCHED_FENCE();
      if (DELTA || d == 0) {
#pragma unroll
        for (int mt = 0; mt < 4; ++mt)
#pragma unroll
          for (int kc = 0; kc < 2; ++kc) O[mt] = MFMA16(fA[mt * 2 + kc], vnb[kc], O[mt]);
      }
      if (DELTA) {
        const float cd = *(const float*)(sb + SC_E);
#pragma unroll
        for (int t = 0; t < 8; ++t) S[t] *= cd;
      } else {
#pragma unroll
        for (int t = 0; t < 8; ++t) {
          const f32x4 cv = *(const f32x4*)(sb + SC_E + (16 * t + 4 * q4) * 4);
          S[t] *= cv;
        }
      }
      SCHED_FENCE();
      s16x8 fK2[8];
#pragma unroll
      for (int t = 0; t < 4; ++t)
#pragma unroll
        for (int kc = 0; kc < 2; ++kc) fK2[t * 2 + kc] = ldA16(sb + SC_KT, 16 * (4 + t) + n16, 136, 32 * kc, q4);
      SCHED_FENCE();
#pragma unroll
      for (int t = 0; t < 4; ++t)
#pragma unroll
        for (int kc = 0; kc < 2; ++kc) S[t] = MFMA16(fK[t * 2 + kc], vnb[kc], S[t]);
      SCHED_FENCE();
#pragma unroll
      for (int t = 0; t < 4; ++t)
#pragma unroll
        for (int kc = 0; kc < 2; ++kc) S[4 + t] = MFMA16(fK2[t * 2 + kc], vnb[kc], S[4 + t]);
#undef SCHED_FENCE
      if (!DRY || p.out == nullptr)
#pragma unroll
      for (int mt = 0; mt < 4; ++mt) {
        const float ov[4] = {O[mt].x, O[mt].y, O[mt].z, O[mt].w};
        u16* op = Ub + (size_t)row0 * 2048;
        const int lo = opq_v(loff);
#pragma unroll
        for (int i = 0; i < 4; ++i) op[lo + (16 * mt + i) * 2048] = f2bf(ov[i]);
      }
    }
    else if (st + 1 < 132) stage_all(st + 1, buf ^ 1);
    asm volatile("s_waitcnt lgkmcnt(0)" ::: "memory");
    __builtin_amdgcn_s_barrier();
    asm volatile("" ::: "memory");
  }
}

DI void gla_prep_phase(char* shm, const Params& p, const int wave_s_) {
  const int tid = TIDX(), wave = tid >> 6, lane = tid & 63, r = lane & 31, hh = lane >> 5;
  char* sq = shm;
  char* sk = shm + 16896;
  char* sQa = shm + 33792;
  char* sKb = shm + 50688;
  float* sBC = (float*)(shm + 67584);
  float* sgl = (float*)(shm + 133120);
  const u16* qk1 = (const u16*)(p.ws + OFF_QK1);
  const float* gl = (const float*)(p.ws + OFF_ABT);
  u16* QD = (u16*)(p.ws + OFF_QD);
  u16* AS = (u16*)(p.ws + OFF_ASUM);
  float* CD = (float*)(p.ws + OFF_CD1);
  const float qscale = 0.08838834764831845f;
  for (int item = blockIdx.x; item < NCHUNK * 4; item += gridDim.x) {
    const int ci = item >> 2, h = item & 3, row0 = ci * 64;
#pragma unroll
    for (int u = 0; u < 2; ++u) {
      const int chunk = tid * 2 + u, c = chunk >> 4, cc = (chunk & 15) * 8;
      const u16* src = qk1 + (size_t)(row0 + c) * 1024 + h * 128 + cc;
      u32x4 vq = *(const u32x4*)src, vk = *(const u32x4*)(src + 512);
      st8(sq + c * 264 + cc * 2, vq);
      st8(sk + c * 264 + cc * 2, vk);
    }
    {
      const int rr = tid >> 3, cc = (tid & 7) * 4;
      *(f32x4*)(sgl + rr * 32 + cc) = *(const f32x4*)(gl + (size_t)(row0 + rr) * 32 + cc);
    }
    __syncthreads();
    {
      const int kk = tid & 127, d = (tid >> 7) & 1, chalf = tid >> 8;
      float w[16];
#pragma unroll
      for (int q = 0; q < 16; ++q) w[q] = p.gla_w_g2[(d * 16 + q) * 512 + h * 128 + kk];
      const float bg = p.gla_b_g[d * 512 + h * 128 + kk];
#pragma unroll 4
      for (int cc = 0; cc < 32; ++cc) {
        const int c = chalf * 32 + cc;
        const f32x4* gp = (const f32x4*)(sgl + c * 32 + d * 16);
        const f32x4 g0 = gp[0], g1 = gp[1], g2 = gp[2], g3 = gp[3];
        float z = bg;
        z += g0.x * w[0] + g0.y * w[1] + g0.z * w[2] + g0.w * w[3];
        z += g1.x * w[4] + g1.y * w[5] + g1.z * w[6] + g1.w * w[7];
        z += g2.x * w[8] + g2.y * w[9] + g2.z * w[10] + g2.w * w[11];
        z += g3.x * w[12] + g3.y * w[13] + g3.z * w[14] + g3.w * w[15];
        sBC[(d * 64 + c) * 128 + kk] = (fminf(z, 0.f) - __logf(1.f + __expf(-fabsf(z)))) * (1.f / 16.f);
      }
    }
    __syncthreads();
    if (tid < 256) {
      const int d = tid >> 7, kk = tid & 127;
      float* col = sBC + d * 64 * 128 + kk;
      float v[64];
#pragma unroll
      for (int c = 0; c < 64; ++c) v[c] = col[c * 128];
      if (d == 0) {
        float acc = 0.f;
#pragma unroll
        for (int c = 0; c < 64; ++c) { acc += v[c]; col[c * 128] = acc; }
      } else {
        float acc = 0.f;
#pragma unroll
        for (int c = 63; c >= 0; --c) { acc += v[c]; col[c * 128] = acc; }
      }
    }
    __syncthreads();
    f32x16 asum;
    for (int i = 0; i < 16; ++i) asum[i] = 0.f;
    for (int d = 0; d < 2; ++d) {
      const int cref = d ? 31 : 32, clast = d ? 0 : 63;
      const float* bcd = sBC + d * 64 * 128;
      u16* qd_o = QD + ((size_t)item * 2 + d) * 16384;
      float er[8], ern[8];
      {
        const int k0 = (tid & 15) * 8;
#pragma unroll
        for (int e = 0; e < 8; ++e) { const float rf = bcd[cref * 128 + k0 + e]; er[e] = __expf(rf); ern[e] = __expf(-rf); }
      }
      for (int v = tid; v < 1024; v += 512) {
        const int c = v >> 4, k0 = (v & 15) * 8;
        const u32x4 qv = *(const u32x4*)(sq + c * 264 + k0 * 2), kv = *(const u32x4*)(sk + c * 264 + k0 * 2);
        const unsigned qa[4] = {qv.x, qv.y, qv.z, qv.w}, ka[4] = {kv.x, kv.y, kv.z, kv.w};
        float oqa[8], okb[8], oqd[8];
#pragma unroll
        for (int e = 0; e < 8; ++e) {
          const float ebc = __expf(bcd[c * 128 + k0 + e]);
          const float qf = ((e & 1) ? bfhi(qa[e >> 1]) : bflo(qa[e >> 1])) * qscale;
          const float kf = (e & 1) ? bfhi(ka[e >> 1]) : bflo(ka[e >> 1]);
          oqd[e] = qf * ebc;
          oqa[e] = oqd[e] * ern[e];
          okb[e] = kf * er[e] * __builtin_amdgcn_rcpf(ebc);
        }
        st8(sQa + c * 264 + k0 * 2, (u32x4){pk2(oqa[0], oqa[1]), pk2(oqa[2], oqa[3]), pk2(oqa[4], oqa[5]), pk2(oqa[6], oqa[7])});
        st8(sKb + c * 264 + k0 * 2, (u32x4){pk2(okb[0], okb[1]), pk2(okb[2], okb[3]), pk2(okb[4], okb[5]), pk2(okb[6], okb[7])});
        *(u32x4*)(qd_o + c * 128 + k0) = (u32x4){pk2(oqd[0], oqd[1]), pk2(oqd[2], oqd[3]), pk2(oqd[4], oqd[5]), pk2(oqd[6], oqd[7])};
      }
      for (int v = tid; v < 1024; v += 512) {
        const int kk = v >> 3, c0 = (v & 7) * 8;
        const float last = bcd[clast * 128 + kk];
        float o[8];
#pragma unroll
        for (int e = 0; e < 8; ++e) {
          const int c = c0 + e;
          const float kf = bf2f(*(const u16*)(sk + c * 264 + kk * 2));
          o[e] = kf * __expf(last - bcd[c * 128 + kk]);
        }
        *(u32x4*)(qd_o + 8192 + kk * 64 + c0) = (u32x4){pk2(o[0], o[1]), pk2(o[2], o[3]), pk2(o[4], o[5]), pk2(o[6], o[7])};
      }
      if (tid < 128) CD[((size_t)item * 2 + d) * 128 + tid] = __expf(bcd[clast * 128 + tid]);
      __syncthreads();
      if (wave < 4) {
        const int tm = wave >> 1, tn = wave & 1;
        f32x16 acc;
        for (int i = 0; i < 16; ++i) acc[i] = 0.f;
#pragma unroll
        for (int s = 0; s < 8; ++s) {
          s16x8 a = ldA_nat(sQa, 32 * tm + r, 264, 16 * s, hh), bb = ldA_nat(sKb, 32 * tn + r, 264, 16 * s, hh);
          acc = MFMA32(a, bb, acc);
        }
#pragma unroll
        for (int i = 0; i < 16; ++i) {
          const int ii = 32 * tm + crow(i, hh), jj = 32 * tn + r;
          const bool keep = d ? (ii <= jj) : (ii >= jj);
          asum[i] += keep ? acc[i] : 0.f;
        }
      }
      __syncthreads();
    }
    if (wave < 4) {
      const int tm = wave >> 1, tn = wave & 1;
#pragma unroll
      for (int i = 0; i < 16; ++i) AS[(size_t)item * 4096 + (32 * tm + crow(i, hh)) * 64 + 32 * tn + r] = f2bf(asum[i]);
    }
  }
}

template <int GROUP>
DI void yg_phase(u16* o0, const u16* o1, const u16* z, const u16* zctx, const float* ng, int nrows, const int wave_s_) {
  const int gt = blockIdx.x * 512 + TIDX(), nthr = gridDim.x * 512;
  const int total = nrows * 256;
  for (int idx0 = gt; idx0 < total; idx0 += 2 * nthr) {
    const bool ok1 = idx0 + nthr < total;
    u32x4 a[2], bq[2], zz[2];
#pragma unroll
    for (int u = 0; u < 2; ++u) {
      const int idx = (u == 0 || ok1) ? idx0 + u * nthr : idx0;
      const size_t off = (size_t)(idx >> 8) * 2048 + (idx & 255) * 8;
      const int zrow = idx >> 8;
      const u16* zp = (zrow < RL) ? z + off : zctx + (size_t)(zrow - RL) * 2048 + (idx & 255) * 8;
      a[u] = *(const u32x4*)(o0 + off); bq[u] = *(const u32x4*)(o1 + off); zz[u] = *(const u32x4*)zp;
    }
#pragma unroll
    for (int u = 0; u < 2; ++u) {
      if (u == 1 && !ok1) break;
      const int idx = idx0 + u * nthr, ch = (idx & 255) * 8;
      const size_t off = (size_t)(idx >> 8) * 2048 + ch;
      float o[8] = {bflo(a[u].x) + bflo(bq[u].x), bfhi(a[u].x) + bfhi(bq[u].x), bflo(a[u].y) + bflo(bq[u].y), bfhi(a[u].y) + bfhi(bq[u].y),
                    bflo(a[u].z) + bflo(bq[u].z), bfhi(a[u].z) + bfhi(bq[u].z), bflo(a[u].w) + bflo(bq[u].w), bfhi(a[u].w) + bfhi(bq[u].w)};
      const float zf[8] = {bflo(zz[u].x), bfhi(zz[u].x), bflo(zz[u].y), bfhi(zz[u].y), bflo(zz[u].z), bfhi(zz[u].z), bflo(zz[u].w), bfhi(zz[u].w)};
      float ss = 0.f;
#pragma unroll
      for (int e = 0; e < 8; ++e) ss += o[e] * o[e];
#pragma unroll
      for (int of = 1; of < GROUP; of <<= 1) ss += __shfl_xor(ss, of, 64);
      const float rstd = rsqrtf(ss * (1.f / (GROUP * 8)) + EPSF);
      const int gi = ch & (GROUP * 8 - 1);
      const f32x4 g0 = *(const f32x4*)(ng + gi), g1 = *(const f32x4*)(ng + gi + 4);
      const float gg[8] = {g0.x, g0.y, g0.z, g0.w, g1.x, g1.y, g1.z, g1.w};
#pragma unroll
      for (int e = 0; e < 8; ++e) o[e] = o[e] * rstd * gg[e] * siluf(zf[e]);
      *(u32x4*)(o0 + off) = (u32x4){pk2(o[0], o[1]), pk2(o[2], o[3]), pk2(o[4], o[5]), pk2(o[6], o[7])};
    }
  }
}

DI void final_phase(float* out, const float* g, const int wave_s_) {
  const int tidx_ = TIDX();
  const int lane = tidx_ & 63, gw = blockIdx.x * 8 + (tidx_ >> 6), nw = gridDim.x * 8;
  for (int row0 = gw; row0 < RL; row0 += 2 * nw) {
    const int rows[2] = {row0, row0 + nw};
    const bool ok1 = rows[1] < RL;
    f32x4 v[2][4];
#pragma unroll
    for (int u = 0; u < 2; ++u) {
      const float* s = out + (size_t)((u == 0 || ok1) ? rows[u] : rows[0]) * DM;
#pragma unroll
      for (int q = 0; q < 4; ++q) v[u][q] = *(const f32x4*)(s + q * 256 + lane * 4);
    }
#pragma unroll
    for (int u = 0; u < 2; ++u) {
      if (u == 1 && !ok1) break;
      float* s = out + (size_t)rows[u] * DM;
      float ss = 0.f;
#pragma unroll
      for (int q = 0; q < 4; ++q) ss += v[u][q].x * v[u][q].x + v[u][q].y * v[u][q].y + v[u][q].z * v[u][q].z + v[u][q].w * v[u][q].w;
      ss = wave_sum(ss);
      const float rstd = rsqrtf(ss * (1.f / 1024.f) + EPSF);
#pragma unroll
      for (int q = 0; q < 4; ++q) {
        const f32x4 gg = *(const f32x4*)(g + q * 256 + lane * 4);
        f32x4 o = {v[u][q].x * rstd * gg.x, v[u][q].y * rstd * gg.y, v[u][q].z * rstd * gg.z, v[u][q].w * rstd * gg.w};
        *(f32x4*)(s + q * 256 + lane * 4) = o;
      }
    }
  }
}

#define XB_XSUB(j)  (64 * (j))
#define XB_XGEN(j)  (1024 + 64 * (j))
#define XB_TOP      2048
#define XB_TOPGEN   2112
#define XCD_BAR_WORDS 2176
DI unsigned xb_ld(unsigned* p) { return __hip_atomic_load(p, __ATOMIC_RELAXED, __HIP_MEMORY_SCOPE_AGENT); }
DI unsigned xb_add(unsigned* p, unsigned v) { return __hip_atomic_fetch_add(p, v, __ATOMIC_RELAXED, __HIP_MEMORY_SCOPE_AGENT); }
DI void gbar(char* ws, const int wave_s_) {
  asm volatile("s_waitcnt vmcnt(0)" ::: "memory");
  __syncthreads();
  if (wave_s_ == 0 && lane_id() == 0) {
    unsigned* bar = (unsigned*)(ws + OFF_BAR);
    __builtin_amdgcn_s_waitcnt(0);
    const unsigned x = (unsigned)__builtin_amdgcn_s_getreg((3 << 11) | 20) & 0xFu;
    const unsigned nloc = gridDim.x >> 3, nx = 8u;
    const unsigned old = xb_add(&bar[XB_XSUB(x)], 1u);
    const unsigned gen = old / nloc;
    if (old + 1u == (gen + 1u) * nloc) {
      __builtin_amdgcn_fence(__ATOMIC_RELEASE, "agent");
      asm volatile("s_waitcnt vmcnt(0)" ::: "memory");
      const unsigned og = xb_add(&bar[XB_TOP], 1u);
      const unsigned tg = og / nx;
      if (og + 1u == (tg + 1u) * nx) xb_add(&bar[XB_TOPGEN], 1u);
      else while (xb_ld(&bar[XB_TOPGEN]) == tg) __builtin_amdgcn_s_sleep(1);
      __builtin_amdgcn_fence(__ATOMIC_ACQUIRE, "agent");
      xb_add(&bar[XB_XGEN(x)], 1u);
      asm volatile("s_waitcnt vmcnt(0)" ::: "memory");
    } else {
      while (xb_ld(&bar[XB_XGEN(x)]) == gen) __builtin_amdgcn_s_sleep(1);
      __builtin_amdgcn_fence(__ATOMIC_ACQUIRE, "agent");
      asm volatile("s_waitcnt vmcnt(0)" ::: "memory");
    }
  }
  __syncthreads();
}
#ifndef REP_GEMM
#define REP_GEMM 1
#endif
#ifndef REP_PREP
#define REP_PREP 1
#endif
#ifndef REP_GLP
#define REP_GLP 1
#endif
#ifndef REP_SCAN
#define REP_SCAN 0
#endif
#ifndef REP_SYNC
#define REP_SYNC 0
#endif
#ifndef REP_EW
#define REP_EW 1
#endif
__global__ void __launch_bounds__(512, 2) fwd_megakernel(Params p) {
  __shared__ __attribute__((aligned(1024))) char shm[141312];
  cg::grid_group grid = cg::this_grid();
  const int wave_s_ = __builtin_amdgcn_readfirstlane((int)(threadIdx.x >> 6));
  char* ws = p.ws;
  float* mods = (float*)(ws + OFF_MOD);
  u16* W0T = (u16*)(ws + OFF_W0T);
  u16* WO0T = (u16*)(ws + OFF_WO0T);
  u16* W1T = (u16*)(ws + OFF_W1T);
  u16* WO1T = (u16*)(ws + OFF_WO1T);
  u16* outb = (u16*)p.out;
  float* ctx1 = (float*)(ws + OFF_X);

  mods_phase(shm, p, wave_s_);
  wtrans_phase<0>(shm, p, wave_s_);
  grid.sync();
  {
    u16* H0 = (u16*)(ws + OFF_T);
    h_phase(p.x, p.ctx, p.norm_g, mods, H0, R, wave_s_);
    gbar(ws, wave_s_);
#if REP_EW > 1
    h_phase(p.x, p.ctx, p.norm_g, mods, H0, R, wave_s_);
    gbar(ws, wave_s_);
#endif
    small_gemm(H0, W0T + (size_t)6144 * 1024, (float*)(ws + OFF_ABT), wave_s_);
    EpiArgs e{};
    e.mode = 0; e.lat = outb; e.ctx = (u16*)(ws + OFF_X); e.ld = 2048;
    gemm_phase<0>(shm, H0, H0 + (size_t)RL * 1024, 1024, W0T, 0, 128, 8, e, wave_s_);
    {
      EpiArgs ec{};
      ec.mode = 4; ec.ctx = (u16*)(ws + OFF_X);
      gemm_phase<4>(shm, H0, H0 + (size_t)RL * 1024, 1024, W0T, 128, 4, 24, ec, wave_s_);
    }
    gbar(ws, wave_s_);
#if REP_GEMM > 1
    gemm_phase<0>(shm, H0, H0 + (size_t)RL * 1024, 1024, W0T, 0, 132, 8, e, wave_s_);
    gbar(ws, wave_s_);
#endif
    conv_phase<false>(p, wave_s_);
    gbar(ws, wave_s_);
#if REP_EW > 1
    conv_phase<false>(p, wave_s_);
    gbar(ws, wave_s_);
#endif
    gemm_phase<0>(shm, H0, H0 + (size_t)RL * 1024, 1024, W0T + (size_t)2048 * 1024, 0, 128, 8, e, wave_s_);
    gbar(ws, wave_s_);
#if REP_GEMM > 1
    gemm_phase<0>(shm, H0, H0 + (size_t)RL * 1024, 1024, W0T + (size_t)2048 * 1024, 0, 132, 8, e, wave_s_);
    gbar(ws, wave_s_);
#endif
    conv_phase<true>(p, wave_s_);
    gbar(ws, wave_s_);
#if REP_EW > 1
    conv_phase<true>(p, wave_s_);
    gbar(ws, wave_s_);
#endif
    for (int rep_ = 0; rep_ < REP_PREP; ++rep_) {
    dn_prep_phase(shm, p, wave_s_);
    gbar(ws, wave_s_);
    }
    for (int rep_ = 0; rep_ < REP_SCAN; ++rep_) { scan_phase<true, true>(shm, p, wave_s_); gbar(ws, wave_s_); }
    for (int rep_ = 0; rep_ < REP_SYNC; ++rep_) gbar(ws, wave_s_);
    scan_phase<true>(shm, p, wave_s_);
    gbar(ws, wave_s_);
    u16* H0b = H0;
    u16* Z = (u16*)(ws + OFF_QK0);
    EpiArgs ez{};
    ez.mode = 0; ez.lat = Z; ez.ctx = Z + (size_t)RL * 2048; ez.ld = 2048;
    gemm_phase<0>(shm, H0b, H0b + (size_t)RL * 1024, 1024, W0T + (size_t)4096 * 1024, 0, 128, 8, ez, wave_s_);
    gbar(ws, wave_s_);
#if REP_GEMM > 1
    gemm_phase<0>(shm, H0b, H0b + (size_t)RL * 1024, 1024, W0T + (size_t)4096 * 1024, 0, 132, 8, ez, wave_s_);
    gbar(ws, wave_s_);
#endif
    u16* U0 = (u16*)(ws + OFF_U0);
    yg_phase<32>(U0, (const u16*)(ws + OFF_U1), Z, (const u16*)(ws + OFF_ZC), p.dn_norm_g, R, wave_s_);
    gbar(ws, wave_s_);
    EpiArgs eo{};
    eo.mode = 2; eo.res_lat = p.x; eo.res_ctx = p.ctx; eo.mods_i = mods; eo.out_lat = p.out; eo.out_ctx = ctx1;
    gemm_phase<2>(shm, U0, U0 + (size_t)RL * 2048, 2048, WO0T, 0, 132, 4, eo, wave_s_);
    gbar(ws, wave_s_);
#if REP_GEMM > 1
    gemm_phase<2>(shm, U0, U0 + (size_t)RL * 2048, 2048, WO0T, 0, 132, 4, eo, wave_s_);
    gbar(ws, wave_s_);
#endif
  }
  {
    const float* mods1 = mods + 5 * 3072;
    u16* H1 = (u16*)(ws + OFF_QD);
    h_phase(p.out, ctx1, p.norm_g + 1024, mods1, H1, R, wave_s_);
    wtrans_phase<1>(shm, p, wave_s_);
    gbar(ws, wave_s_);
    small_gemm(H1, W1T + (size_t)5120 * 1024, (float*)(ws + OFF_ABT), wave_s_);
    EpiArgs e{};
    e.mode = 1; e.lat = (u16*)(ws + OFF_QK1); e.b1 = (u16*)(ws + OFF_V0); e.b2 = (u16*)(ws + OFF_V1);
    gemm_phase<1>(shm, H1, H1 + (size_t)RL * 1024, 1024, W1T, 0, 132, 12, e, wave_s_);
    gbar(ws, wave_s_);
    for (int rep_ = 0; rep_ < REP_GLP; ++rep_) {
    gla_prep_phase(shm, p, wave_s_);
    gbar(ws, wave_s_);
    }
    for (int rep_ = 0; rep_ < REP_SCAN; ++rep_) { scan_phase<false, true>(shm, p, wave_s_); gbar(ws, wave_s_); }
    scan_phase<false>(shm, p, wave_s_);
    gbar(ws, wave_s_);
    u16* H1b = (u16*)(ws + OFF_QK1);
    h_phase(p.out, ctx1, p.norm_g + 1024, mods1, H1b, RL, wave_s_);
    gbar(ws, wave_s_);
    u16* RB = (u16*)(ws + OFF_QD);
    EpiArgs er{};
    er.mode = 0; er.lat = RB; er.ctx = RB; er.ld = 2048;
    gemm_phase<0>(shm, H1b, H1b, 1024, W1T + (size_t)3072 * 1024, 0, 128, 8, er, wave_s_);
    gbar(ws, wave_s_);
    u16* V0 = (u16*)(ws + OFF_V0);
    yg_phase<64>(V0, (const u16*)(ws + OFF_V1), RB, RB, p.gla_norm_g, RL, wave_s_);
    gbar(ws, wave_s_);
    EpiArgs eo{};
    eo.mode = 2; eo.res_lat = p.out; eo.res_ctx = p.out; eo.mods_i = mods1; eo.out_lat = p.out; eo.out_ctx = p.out;
    gemm_phase<2>(shm, V0, V0, 2048, WO1T, 0, 128, 4, eo, wave_s_);
    gbar(ws, wave_s_);
    final_phase(p.out, p.final_g, wave_s_);
  }
}

extern "C" void kernel_launch(void* const* d_in, const int* in_sizes, int n_in, void* d_out, int out_size, void* d_ws,
                              size_t ws_size, hipStream_t stream) {
  static int grid_blocks = 0;
  if (!grid_blocks) {
    int dev = 0, cus = 0, per_cu = 0;
    hipGetDevice(&dev);
    hipDeviceGetAttribute(&cus, hipDeviceAttributeMultiprocessorCount, dev);
    hipOccupancyMaxActiveBlocksPerMultiprocessor(&per_cu, fwd_megakernel, 512, 0);
    if (per_cu < 1) per_cu = 1;
    grid_blocks = cus;
    if (grid_blocks > 256) grid_blocks = 256;
  }
  Params p{};
  p.x = (const float*)d_in[0]; p.c = (const float*)d_in[1]; p.ctx = (const float*)d_in[2]; p.c_ctx = (const float*)d_in[3];
  p.mod_w = (const float*)d_in[4]; p.mod_b = (const float*)d_in[5]; p.norm_g = (const float*)d_in[6];
  p.dn_w_in = (const float*)d_in[7]; p.dn_conv_w = (const float*)d_in[8]; p.dn_a_log = (const float*)d_in[9];
  p.dn_dt_bias = (const float*)d_in[10]; p.dn_norm_g = (const float*)d_in[11]; p.dn_w_out = (const float*)d_in[12];
  p.gla_w_in = (const float*)d_in[13]; p.gla_w_g2 = (const float*)d_in[14]; p.gla_b_g = (const float*)d_in[15];
  p.gla_norm_g = (const float*)d_in[16]; p.gla_w_out = (const float*)d_in[17]; p.final_g = (const float*)d_in[18];
  p.out = (float*)d_out;
  p.ws = (char*)d_ws;
  (void)hipMemsetAsync((char*)d_ws + OFF_BAR, 0, XCD_BAR_WORDS * sizeof(unsigned), stream);
  void* args[] = {&p};
  hipError_t e = hipLaunchCooperativeKernel((void*)fwd_megakernel, dim3(grid_blocks), dim3(512), args, 0, stream);
  if (e != hipSuccess) fprintf(stderr, "cooperative launch failed: %s (grid %d)\n", hipGetErrorString(e), grid_blocks);
}
```

```cpp
#include <hip/hip_runtime.h>
#include <hip/hip_cooperative_groups.h>
#include <cstdio>
namespace cg = cooperative_groups;

#define DI __device__ __forceinline__
typedef unsigned short u16;
typedef short s16x8 __attribute__((ext_vector_type(8)));
typedef short s16x4 __attribute__((ext_vector_type(4)));
typedef float f32x2 __attribute__((ext_vector_type(2)));
typedef float f32x4 __attribute__((ext_vector_type(4)));
typedef float f32x16 __attribute__((ext_vector_type(16)));
typedef int i32x4 __attribute__((ext_vector_type(4)));
typedef unsigned u32x2 __attribute__((ext_vector_type(2)));
typedef unsigned u32x4 __attribute__((ext_vector_type(4)));
typedef __bf16 bf2_t __attribute__((ext_vector_type(2)));

constexpr int RL = 32768;
constexpr int RC = 1024;
constexpr int R = RL + RC;
constexpr int DM = 1024;
constexpr int NCHUNK = R / 64;
constexpr float EPSF = 1e-6f;
constexpr size_t MiB = 1u << 20;

constexpr size_t OFF_QK0 = 0;
constexpr size_t OFF_U0 = 132 * MiB;
constexpr size_t OFF_U1 = 264 * MiB;
constexpr size_t OFF_T = 396 * MiB;
constexpr size_t OFF_W1T = 462 * MiB;
constexpr size_t OFF_WO1T = OFF_W1T + 10 * MiB + 256 * 1024;
constexpr size_t OFF_MOD = OFF_WO1T + 4 * MiB;
constexpr size_t OFF_X = OFF_MOD + 256 * 1024;
constexpr size_t OFF_ABT = OFF_X + 8 * MiB + 256 * 1024;
constexpr size_t OFF_W0T = OFF_ABT + 4 * MiB + 256 * 1024;
constexpr size_t OFF_WO0T = OFF_W0T + 12 * MiB + 256 * 1024;
constexpr size_t OFF_V0 = 0;
constexpr size_t OFF_V1 = 132 * MiB;
constexpr size_t OFF_QK1 = 264 * MiB;
constexpr size_t OFF_QD = 330 * MiB;
constexpr size_t OFF_CD1 = OFF_X + 4 * MiB;
constexpr size_t OFF_ASUM = OFF_W0T;
constexpr size_t OFF_BAR = 506 * MiB;
constexpr size_t OFF_ZC = 507 * MiB;

constexpr size_t TA_LAT_ITEMS = 4096;
constexpr size_t OFF_TC = 462 * MiB;
constexpr size_t OFF_AC = 464 * MiB;
DI size_t ta_off(size_t item, int d) { return ((item < TA_LAT_ITEMS ? item : item - TA_LAT_ITEMS) * 2 + d) * 4096; }
struct Params {
  const float *x, *c, *ctx, *c_ctx, *mod_w, *mod_b, *norm_g, *dn_w_in, *dn_conv_w, *dn_a_log, *dn_dt_bias, *dn_norm_g,
      *dn_w_out, *gla_w_in, *gla_w_g2, *gla_b_g, *gla_norm_g, *gla_w_out, *final_g;
  float* out;
  char* ws;
};

DI unsigned pk2(float lo, float hi) { f32x2 v = {lo, hi}; return __builtin_bit_cast(unsigned, __builtin_convertvector(v, bf2_t)); }
DI float bflo(unsigned u) { return __uint_as_float(u << 16); }
DI float bfhi(unsigned u) { return __uint_as_float(u & 0xffff0000u); }
DI float bf2f(u16 v) { return __uint_as_float(((unsigned)v) << 16); }
DI u16 f2bf(float x) { return (u16)(pk2(x, 0.f) & 0xffffu); }
DI float siluf(float x) { return x / (1.f + __expf(-x)); }
DI float sigmoidf(float x) { return 1.f / (1.f + __expf(-x)); }
DI float softplusf(float x) { return fmaxf(x, 0.f) + __logf(1.f + __expf(-fabsf(x))); }
DI int crow(int reg, int h) { return (reg & 3) + 8 * (reg >> 2) + 4 * h; }
#define MFMA32(a, b, c) __builtin_amdgcn_mfma_f32_32x32x16_bf16((a), (b), (c), 0, 0, 0)
#define MFMA16(a, b, c) __builtin_amdgcn_mfma_f32_16x16x32_bf16((a), (b), (c), 0, 0, 0)

DI s16x8 cat8(u32x2 lo, u32x2 hi) { u32x4 v = {lo.x, lo.y, hi.x, hi.y}; return __builtin_bit_cast(s16x8, v); }
DI s16x8 ldA_perm(const char* base, int row, int strideB, int kofs, int h) {
  const char* p = base + row * strideB + (kofs + 4 * h) * 2;
  u32x2 lo = *(const u32x2*)p, hi = *(const u32x2*)(p + 16);
  return cat8(lo, hi);
}
DI s16x8 ldA_nat(const char* base, int row, int strideB, int kofs, int h) {
  const char* p = base + row * strideB + (kofs + 8 * h) * 2;
  u32x2 lo = *(const u32x2*)p, hi = *(const u32x2*)(p + 8);
  return cat8(lo, hi);
}
DI s16x8 pack_step(const f32x16& x, int s) {
  u32x4 p;
  p.x = pk2(x[8 * s + 0], x[8 * s + 1]); p.y = pk2(x[8 * s + 2], x[8 * s + 3]);
  p.z = pk2(x[8 * s + 4], x[8 * s + 5]); p.w = pk2(x[8 * s + 6], x[8 * s + 7]);
  return __builtin_bit_cast(s16x8, p);
}
DI void st8(char* p, u32x4 v) { *(u32x2*)p = (u32x2){v.x, v.y}; *(u32x2*)(p + 8) = (u32x2){v.z, v.w}; }
DI u32x4 scale8(u32x4 v, float s) {
  u32x4 o;
  o.x = pk2(bflo(v.x) * s, bfhi(v.x) * s); o.y = pk2(bflo(v.y) * s, bfhi(v.y) * s);
  o.z = pk2(bflo(v.z) * s, bfhi(v.z) * s); o.w = pk2(bflo(v.w) * s, bfhi(v.w) * s);
  return o;
}
DI int opq_v(int v) { asm volatile("" : "+v"(v)); return v; }
DI int lane_id() { int r; asm volatile("v_mbcnt_lo_u32_b32 %0, -1, 0\n\tv_mbcnt_hi_u32_b32 %0, -1, %0" : "=v"(r)); return r; }
#define TIDX() (wave_s_ * 64 + lane_id())
DI float wave_sum(float v) {
#pragma unroll
  for (int o = 32; o >= 1; o >>= 1) v += __shfl_xor(v, o, 64);
  return v;
}

DI void mods_phase(char* shm, const Params& p, const int wave_s_) {
  const int bid = blockIdx.x, tid = TIDX();
  float* mods = (float*)(p.ws + OFF_MOD);
  if (bid < 192) {
    float* scond = (float*)shm;
    float* red = scond + 5 * 1024;
    for (int e = tid; e < 5 * 1024; e += 512) {
      int r = e >> 10, k = e & 1023;
      float v = (r < 4) ? p.c[r * 1024 + k] : p.c_ctx[k];
      scond[e] = siluf(v);
    }
    __syncthreads();
    const int i = bid / 96, jt = bid % 96, jl = tid & 31, ks = tid >> 5;
    const float* w = p.mod_w + (size_t)i * 1024 * 3072 + jt * 32 + jl;
    float a0 = 0, a1 = 0, a2 = 0, a3 = 0, a4 = 0;
#pragma unroll 8
    for (int kk = 0; kk < 64; ++kk) {
      int k = ks * 64 + kk;
      float wv = w[(size_t)k * 3072];
      a0 += scond[k] * wv; a1 += scond[1024 + k] * wv; a2 += scond[2048 + k] * wv; a3 += scond[3072 + k] * wv; a4 += scond[4096 + k] * wv;
    }
    red[(ks * 5 + 0) * 32 + jl] = a0; red[(ks * 5 + 1) * 32 + jl] = a1; red[(ks * 5 + 2) * 32 + jl] = a2;
    red[(ks * 5 + 3) * 32 + jl] = a3; red[(ks * 5 + 4) * 32 + jl] = a4;
    __syncthreads();
    if (tid < 160) {
      int r = tid >> 5, j = tid & 31;
      float s = p.mod_b[i * 3072 + jt * 32 + j];
      for (int q = 0; q < 16; ++q) s += red[(q * 5 + r) * 32 + j];
      mods[(i * 5 + r) * 3072 + jt * 32 + j] = s;
    }
    __syncthreads();
  }
}

DI void wtrans_tile(char* shm, const float* src, int K, int N, u16* dst, int tile, const int wave_s_) {
  u16* t = (u16*)shm;
  const int tid = TIDX();
  const int tn = (N + 63) / 64;
  const int k0 = (tile / tn) * 64, n0 = (tile % tn) * 64;
#pragma unroll
  for (int q = 0; q < 8; ++q) {
    int e = tid + q * 512, kk = e >> 6, nn = e & 63;
    float v = (n0 + nn < N) ? src[(size_t)(k0 + kk) * N + n0 + nn] : 0.f;
    t[nn * 66 + kk] = f2bf(v);
  }
  __syncthreads();
#pragma unroll
  for (int q = 0; q < 8; ++q) {
    int e = tid + q * 512, nn = e >> 6, kk = e & 63;
    if (n0 + nn < N) dst[(size_t)(n0 + nn) * K + k0 + kk] = t[nn * 66 + kk];
  }
  __syncthreads();
}
template <int LAYER>
DI void wtrans_phase(char* shm, const Params& p, const int wave_s_) {
  const int t0 = 16 * 97, t1 = 32 * 16, t2 = 16 * 81, t3 = 32 * 16;
  if (LAYER == 0) {
    for (int tile = blockIdx.x; tile < t0 + t1; tile += gridDim.x) {
      if (tile < t0) wtrans_tile(shm, p.dn_w_in, 1024, 6176, (u16*)(p.ws + OFF_W0T), tile, wave_s_);
      else wtrans_tile(shm, p.dn_w_out, 2048, 1024, (u16*)(p.ws + OFF_WO0T), tile - t0, wave_s_);
    }
  } else {
    for (int tile = blockIdx.x; tile < t2 + t3; tile += gridDim.x) {
      if (tile < t2) wtrans_tile(shm, p.gla_w_in, 1024, 5152, (u16*)(p.ws + OFF_W1T), tile, wave_s_);
      else wtrans_tile(shm, p.gla_w_out, 2048, 1024, (u16*)(p.ws + OFF_WO1T), tile - t2, wave_s_);
    }
  }
}

DI void h_phase(const float* src_lat, const float* src_ctx, const float* g, const float* mods_i, u16* dst, int nrows, const int wave_s_) {
  const int tidx_ = TIDX();
  const int lane = tidx_ & 63, gw = blockIdx.x * 8 + (tidx_ >> 6), nw = gridDim.x * 8;
  for (int row0 = gw; row0 < nrows; row0 += 2 * nw) {
    const int rows[2] = {row0, row0 + nw};
    const bool ok1 = rows[1] < nrows;
    f32x4 v[2][4];
#pragma unroll
    for (int u = 0; u < 2; ++u) {
      const int row = (u == 0 || ok1) ? rows[u] : rows[0];
      const float* s = (row < RL) ? src_lat + (size_t)row * DM : src_ctx + (size_t)(row - RL) * DM;
#pragma unroll
      for (int q = 0; q < 4; ++q) v[u][q] = __builtin_nontemporal_load((const f32x4*)(s + q * 256 + lane * 4));
    }
#pragma unroll
    for (int u = 0; u < 2; ++u) {
      if (u == 1 && !ok1) break;
      const int row = rows[u];
      const int mr = (row < RL) ? (row >> 13) : 4;
      const float* sh = mods_i + mr * 3072;
      const float* sc = sh + 1024;
      float ss = 0.f;
#pragma unroll
      for (int q = 0; q < 4; ++q) ss += v[u][q].x * v[u][q].x + v[u][q].y * v[u][q].y + v[u][q].z * v[u][q].z + v[u][q].w * v[u][q].w;
      ss = wave_sum(ss);
      const float rstd = rsqrtf(ss * (1.f / 1024.f) + EPSF);
#pragma unroll
      for (int q = 0; q < 4; ++q) {
        const int col = q * 256 + lane * 4;
        f32x4 gg = *(const f32x4*)(g + col), s1 = *(const f32x4*)(sc + col), s0 = *(const f32x4*)(sh + col);
        float o0 = v[u][q].x * rstd * gg.x * (1.f + s1.x) + s0.x, o1 = v[u][q].y * rstd * gg.y * (1.f + s1.y) + s0.y;
        float o2 = v[u][q].z * rstd * gg.z * (1.f + s1.z) + s0.z, o3 = v[u][q].w * rstd * gg.w * (1.f + s1.w) + s0.w;
        *(u32x2*)(dst + (size_t)row * DM + col) = (u32x2){pk2(o0, o1), pk2(o2, o3)};
      }
    }
  }
}

DI void small_gemm(const u16* A, const u16* Wt, float* out, const int wave_s_) {
  const int tidx_ = TIDX();
  if ((blockIdx.x & 7) == 0) return;
  const int bsub = (int)blockIdx.x - 1 - ((int)blockIdx.x >> 3);
  const int lane = tidx_ & 63, gw = bsub * 8 + (tidx_ >> 6), nw = (gridDim.x - (gridDim.x >> 3)) * 8;
  const int r = lane & 31, h = lane >> 5;
  for (int wt = gw; wt < R / 32; wt += nw) {
    const u16* ap = A + (size_t)(wt * 32 + r) * 1024 + 8 * h;
    const u16* bp = Wt + (size_t)r * 1024 + 8 * h;
    f32x16 acc;
    for (int i = 0; i < 16; ++i) acc[i] = 0.f;
#pragma unroll 8
    for (int s = 0; s < 64; ++s) {
      s16x8 a = *(const s16x8*)(ap + 16 * s), b = *(const s16x8*)(bp + 16 * s);
      acc = MFMA32(a, b, acc);
    }
#pragma unroll
    for (int i = 0; i < 16; ++i) out[(size_t)(wt * 32 + crow(i, h)) * 32 + r] = acc[i];
  }
}

DI int lds_byte2(int r, int c) {
  int st = (r >> 4) * 2 + (c >> 5), ob = (r & 15) * 64 + (c & 31) * 2;
  return st * 1024 + (ob ^ (((ob >> 9) & 1) << 5));
}
DI void stage_rc2(int b, int& Rr, int& Cc) {
  int st = b >> 10, sb = b & 1023, swz = sb ^ (((sb >> 9) & 1) << 5);
  Rr = (st / 2) * 16 + swz / 64;
  Cc = (st % 2) * 32 + (swz % 64) / 2;
}

struct EpiArgs {
  int mode;
  u16* lat; u16* ctx; int ld;
  u16* b1; u16* b2;
  const float* res_lat; const float* res_ctx; const float* mods_i; float* out_lat; float* out_ctx;
};

template <int MODE>
DI void gemm_epilogue(const EpiArgs& e, f32x4 (&acc)[8][4], int row0, int pn, int wr, int wc, int fr, int fq) {
#pragma unroll
  for (int m = 0; m < 8; ++m) {
    const int row = row0 + wr * 128 + m * 16 + fr;
#pragma unroll
    for (int n = 0; n < 4; ++n) {
      const int col = pn * 256 + wc * 64 + n * 16 + fq * 4;
      const f32x4 a = acc[m][n];
      if (MODE == 0) {
        u16* pr = (row < RL) ? e.lat + (size_t)row * e.ld : e.ctx + (size_t)(row - RL) * e.ld;
        *(u32x2*)(pr + col) = (u32x2){pk2(a.x, a.y), pk2(a.z, a.w)};
      } else if (MODE == 1) {
        u32x2 v = {pk2(a.x, a.y), pk2(a.z, a.w)};
        if (pn < 4) {
          *(u32x2*)(e.lat + (size_t)row * 1024 + col) = v;
        } else {
          *(u32x2*)(e.b1 + (size_t)row * 2048 + col - 1024) = v;
          *(u32x2*)(e.b2 + (size_t)row * 2048 + col - 1024) = v;
        }
      } else {
        const int mr = (row < RL) ? (row >> 13) : 4;
        const f32x4 gt = *(const f32x4*)(e.mods_i + mr * 3072 + 2048 + col);
        const float* rp = (row < RL) ? e.res_lat + (size_t)row * DM : e.res_ctx + (size_t)(row - RL) * DM;
        float* op = (row < RL) ? e.out_lat + (size_t)row * DM : e.out_ctx + (size_t)(row - RL) * DM;
        const f32x4 rv = *(const f32x4*)(rp + col);
        f32x4 o = {rv.x + gt.x * a.x, rv.y + gt.y * a.y, rv.z + gt.z * a.z, rv.w + gt.w * a.w};
        *(f32x4*)(op + col) = o;
      }
    }
  }
}

template <int MODE>
DI void gemm_epilogue8(const EpiArgs& e, f32x4 (&acc)[2][2][4][2], int row0, int pn, int wr, int wc, int fr, int fq) {
#pragma unroll
  for (int ai = 0; ai < 2; ++ai)
#pragma unroll
    for (int m = 0; m < 4; ++m) {
      const int row = row0 + ai * 128 + wr * 64 + m * 16 + fr;
#pragma unroll
      for (int bj = 0; bj < 2; ++bj)
#pragma unroll
        for (int n = 0; n < 2; ++n) {
          const int col = pn * 256 + bj * 128 + wc * 32 + n * 16 + fq * 4;
          const f32x4 a = acc[ai][bj][m][n];
          if (MODE == 0) {
            u16* pr = (row < RL) ? e.lat + (size_t)row * e.ld : e.ctx + (size_t)(row - RL) * e.ld;
            *(u32x2*)(pr + col) = (u32x2){pk2(a.x, a.y), pk2(a.z, a.w)};
          } else if (MODE == 4) {
            const size_t dsel = (pn < 8) ? 0 : (pn < 16) ? (4 * MiB / 2) : ((OFF_ZC - OFF_X) / 2);
            *(u32x2*)(e.ctx + dsel + (size_t)(row - RL) * 2048 + (col & 2047)) = (u32x2){pk2(a.x, a.y), pk2(a.z, a.w)};
          } else if (MODE == 1) {
            u32x2 v = {pk2(a.x, a.y), pk2(a.z, a.w)};
            if (pn < 4) {
              *(u32x2*)(e.lat + (size_t)row * 1024 + col) = v;
            } else {
              *(u32x2*)(e.b1 + (size_t)row * 2048 + col - 1024) = v;
              *(u32x2*)(e.b2 + (size_t)row * 2048 + col - 1024) = v;
            }
          } else {
            const int mr = (row < RL) ? (row >> 13) : 4;
            const f32x4 gt = *(const f32x4*)(e.mods_i + mr * 3072 + 2048 + col);
            const float* rp = (row < RL) ? e.res_lat + (size_t)row * DM : e.res_ctx + (size_t)(row - RL) * DM;
            float* op = (row < RL) ? e.out_lat + (size_t)row * DM : e.out_ctx + (size_t)(row - RL) * DM;
            const f32x4 rv = *(const f32x4*)(rp + col);
            f32x4 o = {rv.x + gt.x * a.x, rv.y + gt.y * a.y, rv.z + gt.z * a.z, rv.w + gt.w * a.w};
            *(f32x4*)(op + col) = o;
          }
        }
    }
}

template <int MODE>
DI void gemm_phase(char* shm_, const u16* Alat, const u16* Actx, int K, const u16* Bt, int pm0, int npm, int nN, const EpiArgs& e, const int wave_s_) {
  constexpr int BK = 64, HALF = 128, HT = HALF * BK;
  u16* shm = (u16*)shm_;
  const int tid = TIDX(), wid = tid >> 6, lane = tid & 63, wr = wid >> 2, wc = wid & 3, fr = lane & 15, fq = lane >> 4;
#define SA(b, h) (shm + ((b) * 2 + (h)) * HT)
#define SB(b, h) (shm + (4 + (b) * 2 + (h)) * HT)
#define LDSP(ptr) ((__attribute__((address_space(3))) unsigned*)(unsigned)(size_t)(ptr))
#define STAGE(P, BASE, br, kt) do { const u16* _p = (BASE) + (size_t)(br) * K + (kt) * BK + soff; \
    _Pragma("unroll") for (int _i = 0; _i < 2; ++_i) \
      __builtin_amdgcn_global_load_lds((const unsigned*)(_p + (size_t)_i * 64 * K), LDSP((char*)(P) + wid * 1024 + _i * 8192), 16, 0, 0); } while (0)
#define LDA(dst, b, h) _Pragma("unroll") for (int m = 0; m < 4; ++m) _Pragma("unroll") for (int k = 0; k < 2; ++k) \
    dst[m][k] = *(const s16x8*)((const char*)SA(b, h) + lds_byte2(wr * 64 + m * 16 + fr, k * 32 + fq * 8))
#define LDB(dst, b, h) _Pragma("unroll") for (int n = 0; n < 2; ++n) _Pragma("unroll") for (int k = 0; k < 2; ++k) \
    dst[n][k] = *(const s16x8*)((const char*)SB(b, h) + lds_byte2(wc * 32 + n * 16 + fr, k * 32 + fq * 8))
#define MMA(ai, bj, Atv, Btv) do { __builtin_amdgcn_s_setprio(1); \
    _Pragma("unroll") for (int m = 0; m < 4; ++m) _Pragma("unroll") for (int n = 0; n < 2; ++n) _Pragma("unroll") for (int k = 0; k < 2; ++k) \
      acc[ai][bj][m][n] = MFMA16(Btv[n][k], Atv[m][k], acc[ai][bj][m][n]); \
    __builtin_amdgcn_s_setprio(0); } while (0)
#define WAIT_V(n) asm volatile("s_waitcnt vmcnt(" #n ")" ::: "memory")
#define WAIT_L(n) asm volatile("s_waitcnt lgkmcnt(" #n ")" ::: "memory")
#define BAR __builtin_amdgcn_s_barrier()
#define SCHED __builtin_amdgcn_sched_barrier(0)
  int sR0, sC0;
  stage_rc2(tid * 16, sR0, sC0);
  const size_t soff = (size_t)sR0 * K + sC0;
  const int ntiles = npm * nN, nt = K / BK;
  const int xcd = blockIdx.x & 7, jj = blockIdx.x >> 3;
  const int PN = (nN % 8 == 0) ? 8 : 4, PG = 32 / PN, npg = nN / PN;
  const int ngroups = ((npm + PG - 1) / PG) * npg;
  const bool grouped = (gridDim.x == 256);
  const int nit = grouped ? (ngroups - xcd + 7) / 8 : (ntiles - (int)blockIdx.x + (int)gridDim.x - 1) / (int)gridDim.x;
  auto tile_of = [&](int it, int& pm, int& pn) -> bool {
    if (it >= nit) return false;
    if (grouped) {
      const int g = xcd + 8 * it, pmg = g / npg, png = g % npg;
      pm = pmg * PG + jj / PN; pn = png * PN + jj % PN;
      if (pm >= npm) return false;
      pm += pm0;
    } else {
      const int L = blockIdx.x + it * gridDim.x;
      pm = pm0 + L / nN; pn = L % nN;
    }
    return true;
  };
  bool prefetched = false;
  for (int it = 0; it < nit; ++it) {
    int pm, pn;
    if (!tile_of(it, pm, pn)) continue;
    const int row0 = pm * 256;
    const u16* A = (row0 < RL) ? Alat + (size_t)row0 * K : Actx + (size_t)(row0 - RL) * K;
    const u16* Bw = Bt + (size_t)pn * 256 * K;
    const int brow = 0, bcol = 0;
    f32x4 acc[2][2][4][2];
#pragma unroll
    for (int i0 = 0; i0 < 2; ++i0)
#pragma unroll
      for (int i1 = 0; i1 < 2; ++i1)
#pragma unroll
        for (int i2 = 0; i2 < 4; ++i2)
#pragma unroll
          for (int i3 = 0; i3 < 2; ++i3) acc[i0][i1][i2][i3] = (f32x4){0.f, 0.f, 0.f, 0.f};
    s16x8 At[4][2], B0[2][2], B1[2][2];
    if (!prefetched) {
      STAGE(SB(0, 0), Bw, bcol, 0); STAGE(SA(0, 0), A, brow, 0);
      STAGE(SB(0, 1), Bw, bcol + HALF, 0); STAGE(SA(0, 1), A, brow + HALF, 0);
    }
    if (wr == 1) BAR;
    WAIT_V(4); BAR;
    STAGE(SB(1, 0), Bw, bcol, 1); STAGE(SA(1, 0), A, brow, 1); STAGE(SB(1, 1), Bw, bcol + HALF, 1);
    WAIT_V(6); BAR;
    for (int t = 0; t < nt - 2; t += 2) {
      LDB(B0, 0, 0); SCHED; LDA(At, 0, 0); STAGE(SA(1, 1), A, brow + HALF, t + 1);
      WAIT_L(8); BAR; WAIT_L(0); MMA(0, 0, At, B0); BAR; SCHED;
      LDB(B1, 0, 1); STAGE(SB(0, 0), Bw, bcol, t + 2);
      BAR; WAIT_L(0); MMA(0, 1, At, B1); BAR;
      LDA(At, 0, 1); STAGE(SA(0, 0), A, brow, t + 2);
      BAR; WAIT_L(0); MMA(1, 0, At, B0); BAR; SCHED;
      STAGE(SB(0, 1), Bw, bcol + HALF, t + 2);
      WAIT_V(6); BAR; MMA(1, 1, At, B1); BAR;
      LDB(B0, 1, 0); SCHED; LDA(At, 1, 0); STAGE(SA(0, 1), A, brow + HALF, t + 2);
      WAIT_L(8); BAR; WAIT_L(0); MMA(0, 0, At, B0); BAR; SCHED;
      LDB(B1, 1, 1); STAGE(SB(1, 0), Bw, bcol, t + 3);
      BAR; WAIT_L(0); MMA(0, 1, At, B1); BAR;
      LDA(At, 1, 1); STAGE(SA(1, 0), A, brow, t + 3);
      BAR; WAIT_L(0); MMA(1, 0, At, B0); BAR; SCHED;
      STAGE(SB(1, 1), Bw, bcol + HALF, t + 3);
      WAIT_V(6); BAR; MMA(1, 1, At, B1); BAR;
    }
    { LDB(B0, 0, 0); LDA(At, 0, 0); STAGE(SA(1, 1), A, brow + HALF, nt - 1);
      BAR; WAIT_L(0); MMA(0, 0, At, B0); BAR;
      LDB(B1, 0, 1); BAR; WAIT_L(0); MMA(0, 1, At, B1); BAR;
      LDA(At, 0, 1); WAIT_V(4); BAR; WAIT_L(0); MMA(1, 0, At, B0); MMA(1, 1, At, B1); BAR; }
    { LDB(B0, 1, 0); LDA(At, 1, 0); WAIT_V(2); BAR; WAIT_L(0); MMA(0, 0, At, B0); BAR;
      LDB(B1, 1, 1); WAIT_V(0); BAR; WAIT_L(0); MMA(0, 1, At, B1); BAR;
      LDA(At, 1, 1); BAR; WAIT_L(0); MMA(1, 0, At, B0); MMA(1, 1, At, B1); BAR; }
    if (wr == 0) BAR;
    {
      int pm2, pn2;
      prefetched = tile_of(it + 1, pm2, pn2);
      if (prefetched) {
        const int r2 = pm2 * 256;
        const u16* A2 = (r2 < RL) ? Alat + (size_t)r2 * K : Actx + (size_t)(r2 - RL) * K;
        const u16* B2 = Bt + (size_t)pn2 * 256 * K;
        STAGE(SB(0, 0), B2, 0, 0); STAGE(SA(0, 0), A2, 0, 0);
        STAGE(SB(0, 1), B2, HALF, 0); STAGE(SA(0, 1), A2, HALF, 0);
      }
    }
    { const int l2 = lane_id(); gemm_epilogue8<MODE>(e, acc, row0, pn, wr, wc, l2 & 15, l2 >> 4); }
    asm volatile("s_waitcnt vmcnt(0) lgkmcnt(0)" ::: "memory");
    BAR;
  }
#undef SA
#undef SB
#undef LDSP
#undef STAGE
#undef LDA
#undef LDB
#undef MMA
#undef WAIT_V
#undef WAIT_L
#undef BAR
#undef SCHED
}

DI void conv_accum(float (&acc)[8], const u16* srow, const float* w) {
  u32x4 v = *(const u32x4*)srow;
  f32x4 w0 = *(const f32x4*)w, w1 = *(const f32x4*)(w + 4);
  acc[0] += bflo(v.x) * w0.x; acc[1] += bfhi(v.x) * w0.y; acc[2] += bflo(v.y) * w0.z; acc[3] += bfhi(v.y) * w0.w;
  acc[4] += bflo(v.z) * w1.x; acc[5] += bfhi(v.z) * w1.y; acc[6] += bflo(v.w) * w1.z; acc[7] += bfhi(v.w) * w1.w;
}
DI void fma8(float (&acc)[8], const u32x4 v, const float (&w)[8]) {
  acc[0] += bflo(v.x) * w[0]; acc[1] += bfhi(v.x) * w[1]; acc[2] += bflo(v.y) * w[2]; acc[3] += bfhi(v.y) * w[3];
  acc[4] += bflo(v.z) * w[4]; acc[5] += bfhi(v.z) * w[5]; acc[6] += bflo(v.w) * w[6]; acc[7] += bfhi(v.w) * w[7];
}
template <bool ISV>
DI void conv_store(const Params& p, float (&acc)[8], int row, int ch) {
#pragma unroll
  for (int e = 0; e < 8; ++e) acc[e] = siluf(acc[e]);
  if (!ISV) {
    u16* qk = (u16*)(p.ws + OFF_QK0);
    float ss = 0.f;
#pragma unroll
    for (int e = 0; e < 8; ++e) ss += acc[e] * acc[e];
    ss += __shfl_xor(ss, 1, 64); ss += __shfl_xor(ss, 2, 64); ss += __shfl_xor(ss, 4, 64); ss += __shfl_xor(ss, 8, 64);
    const float sc = rsqrtf(ss + EPSF) * ((ch < 1024) ? 0.08838834764831845f : 1.f);
    u32x4 o = {pk2(acc[0] * sc, acc[1] * sc), pk2(acc[2] * sc, acc[3] * sc), pk2(acc[4] * sc, acc[5] * sc), pk2(acc[6] * sc, acc[7] * sc)};
    *(u32x4*)(qk + (size_t)row * 2048 + ch) = o;
  } else {
    u16* u0 = (u16*)(p.ws + OFF_U0);
    u16* u1 = (u16*)(p.ws + OFF_U1);
    const float* abt = (const float*)(p.ws + OFF_ABT);
    const int head = ch >> 8;
    const float b0 = sigmoidf(abt[(size_t)row * 32 + 16 + head]), b1 = sigmoidf(abt[(size_t)row * 32 + 24 + head]);
    u32x4 o0 = {pk2(acc[0] * b0, acc[1] * b0), pk2(acc[2] * b0, acc[3] * b0), pk2(acc[4] * b0, acc[5] * b0), pk2(acc[6] * b0, acc[7] * b0)};
    u32x4 o1 = {pk2(acc[0] * b1, acc[1] * b1), pk2(acc[2] * b1, acc[3] * b1), pk2(acc[4] * b1, acc[5] * b1), pk2(acc[6] * b1, acc[7] * b1)};
    __builtin_nontemporal_store(o0, (u32x4*)(u0 + (size_t)row * 2048 + ch));
    __builtin_nontemporal_store(o1, (u32x4*)(u1 + (size_t)row * 2048 + ch));
  }
}
template <bool ISV>
DI void conv_phase(const Params& p, const int wave_s_) {
  const u16* pre_lat = (const u16*)p.out;
  const u16* pre_ctx = (const u16*)(p.ws + OFF_X + (ISV ? 4 * MiB : 0));
  const float* cw = p.dn_conv_w + (ISV ? 2048 : 0);
  const int gt = blockIdx.x * 512 + TIDX(), nthr = gridDim.x * 512;
  const u32x4 zero4 = {0u, 0u, 0u, 0u};
  for (int idx = gt; idx < 4 * 128 * 4 * 256; idx += nthr) {
    const int cg8 = idx & 255, run = (idx >> 8) & 3, gr = (idx >> 10) & 127, b = idx >> 17, ch = cg8 * 8, c0 = run * 16;
    float w[9][8];
#pragma unroll
    for (int t = 0; t < 9; ++t) {
      const f32x4 w0 = *(const f32x4*)(cw + t * 4096 + ch), w1 = *(const f32x4*)(cw + t * 4096 + ch + 4);
      w[t][0] = w0.x; w[t][1] = w0.y; w[t][2] = w0.z; w[t][3] = w0.w; w[t][4] = w1.x; w[t][5] = w1.y; w[t][6] = w1.z; w[t][7] = w1.w;
    }
    const u16* base = pre_lat + ((size_t)(b << 13) + gr * 64) * 2048 + ch;
    const bool rok[3] = {gr > 0, true, gr < 127};
    u32x4 win[3][3];
#pragma unroll
    for (int i = 0; i < 3; ++i) {
      win[i][0] = (rok[i] && c0 > 0) ? *(const u32x4*)(base + (ptrdiff_t)((i - 1) * 64 + c0 - 1) * 2048) : zero4;
      win[i][1] = rok[i] ? *(const u32x4*)(base + (ptrdiff_t)((i - 1) * 64 + c0) * 2048) : zero4;
    }
#pragma unroll
    for (int t = 0; t < 16; ++t) {
      const int c = c0 + t;
#pragma unroll
      for (int i = 0; i < 3; ++i) win[i][2] = (rok[i] && c < 63) ? *(const u32x4*)(base + (ptrdiff_t)((i - 1) * 64 + c + 1) * 2048) : zero4;
      float acc[8];
#pragma unroll
      for (int e = 0; e < 8; ++e) acc[e] = 0.f;
#pragma unroll
      for (int i = 0; i < 3; ++i)
#pragma unroll
        for (int j = 0; j < 3; ++j) fma8(acc, win[i][j], w[i * 3 + j]);
      conv_store<ISV>(p, acc, (b << 13) + gr * 64 + c, ch);
#pragma unroll
      for (int i = 0; i < 3; ++i) { win[i][0] = win[i][1]; win[i][1] = win[i][2]; }
    }
  }
  for (int idx = gt; idx < 4 * 32 * 256; idx += nthr) {
    const int cg8 = idx & 255, run = (idx >> 8) & 31, b = idx >> 13, ch = cg8 * 8, p0 = run * 8;
    float w[3][8];
#pragma unroll
    for (int t = 0; t < 3; ++t) {
      const f32x4 w0 = *(const f32x4*)(cw + (3 + t) * 4096 + ch), w1 = *(const f32x4*)(cw + (3 + t) * 4096 + ch + 4);
      w[t][0] = w0.x; w[t][1] = w0.y; w[t][2] = w0.z; w[t][3] = w0.w; w[t][4] = w1.x; w[t][5] = w1.y; w[t][6] = w1.z; w[t][7] = w1.w;
    }
    const u16* base = pre_ctx + (size_t)(b * 256) * 2048 + ch;
    u32x4 win[3];
    win[0] = (p0 > 0) ? *(const u32x4*)(base + (size_t)(p0 - 1) * 2048) : zero4;
    win[1] = *(const u32x4*)(base + (size_t)p0 * 2048);
#pragma unroll
    for (int t = 0; t < 8; ++t) {
      const int pp = p0 + t;
      win[2] = (pp < 255) ? *(const u32x4*)(base + (size_t)(pp + 1) * 2048) : zero4;
      float acc[8];
#pragma unroll
      for (int e = 0; e < 8; ++e) acc[e] = 0.f;
#pragma unroll
      for (int j = 0; j < 3; ++j) fma8(acc, win[j], w[j]);
      conv_store<ISV>(p, acc, RL + b * 256 + pp, ch);
      win[0] = win[1]; win[1] = win[2];
    }
  }
}

constexpr int lp_off(int ip) { return ip == 0 ? 0 : (8 * ((ip - 1) / 4) * ((ip - 1) / 4 + 1) + 4 * ((ip - 1) % 4) * ((ip - 1) / 4 + 1)); }
constexpr int LP_FLOATS = 2112;
DI void dn_prep_phase(char* shm, const Params& p, const int wave_s_) {
  const int tid = TIDX(), wave = tid >> 6, lane = tid & 63, r = lane & 31, hh = lane >> 5;
  char* sQ = shm;
  char* sK = shm + 16896;
  float* sKK = (float*)(shm + 33792);
  float* sQK = (float*)(shm + 50432);
  float* sg = (float*)(shm + 67072);
  float* sbeta = sg + 128;
  float* sgc = sg + 256;
  float* sLp = (float*)(shm + 68608);
  const u16* qk = (const u16*)(p.ws + OFF_QK0);
  const float* abt = (const float*)(p.ws + OFF_ABT);
  u16* Ab_lat = (u16*)p.out;
  u16* Tb_lat = (u16*)p.out + (size_t)32 * MiB;
  u16* Ab_ctx = (u16*)(p.ws + OFF_AC);
  u16* Tb_ctx = (u16*)(p.ws + OFF_TC);
  float* Eb = (float*)(p.ws + OFF_X);
  for (int grp = blockIdx.x; grp < NCHUNK * 2; grp += gridDim.x) {
    const int ci = grp >> 1, row0 = ci * 64;
    u32x4 pq[2], pk[2];
    float pa = 0.f, pbt = 0.f;
    auto load_item = [&](int h) {
#pragma unroll
      for (int u = 0; u < 2; ++u) {
        const int chunk = tid * 2 + u, c = chunk >> 4, cc = (chunk & 15) * 8;
        const u16* src = qk + (size_t)(row0 + c) * 2048 + h * 128 + cc;
        pq[u] = *(const u32x4*)src; pk[u] = *(const u32x4*)(src + 1024);
      }
      if (tid < 128) {
        const int d = tid >> 6, c = tid & 63;
        pa = abt[(size_t)(row0 + c) * 32 + d * 8 + h]; pbt = abt[(size_t)(row0 + c) * 32 + 16 + d * 8 + h];
      }
    };
    load_item((grp & 1) * 4);
    for (int sub = 0; sub < 4; ++sub) {
      const int h = (grp & 1) * 4 + sub, item = ci * 8 + h;
#pragma unroll
      for (int u = 0; u < 2; ++u) {
        const int chunk = tid * 2 + u, c = chunk >> 4, cc = (chunk & 15) * 8;
        st8(sQ + c * 264 + cc * 2, pq[u]);
        st8(sK + c * 264 + cc * 2, pk[u]);
      }
      if (tid < 128) {
        const int d = tid >> 6, c = tid & 63;
        sg[d * 64 + c] = -__expf(p.dn_a_log[d * 8 + h]) * softplusf(pa + p.dn_dt_bias[d * 8 + h]);
        sbeta[d * 64 + c] = sigmoidf(pbt);
      }
      if (sub < 3) load_item(h + 1);
      __syncthreads();
      if (wave < 2) {
        const int c = wave ? 63 - lane : lane;
        float v = sg[wave * 64 + c];
#pragma unroll
        for (int o = 1; o < 64; o <<= 1) { const float t = __shfl_up(v, o, 64); if (lane >= o) v += t; }
        sgc[wave * 64 + c] = v;
      }
      {
        const int mat = wave >> 2, tm = (wave >> 1) & 1, tn = wave & 1;
        const char* aop = mat ? sQ : sK;
        f32x16 acc;
        for (int i = 0; i < 16; ++i) acc[i] = 0.f;
#pragma unroll
        for (int s = 0; s < 8; ++s) {
          s16x8 a = ldA_nat(aop, 32 * tm + r, 264, 16 * s, hh), b = ldA_nat(sK, 32 * tn + r, 264, 16 * s, hh);
          acc = MFMA32(a, b, acc);
        }
        float* dst = mat ? sQK : sKK;
#pragma unroll
        for (int i = 0; i < 16; ++i) dst[(32 * tm + crow(i, hh)) * 65 + 32 * tn + r] = acc[i];
      }
      __syncthreads();
      for (int e = tid; e < 8192; e += 512) {
        const int d = e >> 12, ip = (e >> 6) & 63, jp = e & 63;
        if (ip > jp) {
          const int i = d ? 63 - ip : ip, j = d ? 63 - jp : jp;
          const int q4 = (ip - 1) >> 2, r4 = (ip - 1) & 3;
          const float v = sbeta[d * 64 + i] * sKK[i * 65 + j] * __expf(fminf(sgc[d * 64 + i] - sgc[d * 64 + j], 0.f));
          sLp[(sub * 2 + d) * LP_FLOATS + 8 * q4 * (q4 + 1) + 4 * r4 * (q4 + 1) + jp] = v;
        }
      }
      for (int v = tid; v < 1024; v += 512) {
        const int d = v >> 9, i = (v >> 3) & 63, j0 = (v & 7) * 8;
        float o[8];
#pragma unroll
        for (int e = 0; e < 8; ++e) {
          const int j = j0 + e;
          const bool keep = d ? (i <= j) : (i >= j);
          o[e] = keep ? sQK[i * 65 + j] * __expf(fminf(sgc[d * 64 + i] - sgc[d * 64 + j], 0.f)) : 0.f;
        }
        u32x4 ov = {pk2(o[0], o[1]), pk2(o[2], o[3]), pk2(o[4], o[5]), pk2(o[6], o[7])};
        *(u32x4*)(((size_t)item < TA_LAT_ITEMS ? Ab_lat : Ab_ctx) + ta_off(item, d) + i * 64 + j0) = ov;
      }
      if (tid < 128) {
        const int d = tid >> 6, c = tid & 63;
        const float gl = sgc[d * 64 + (d ? 0 : 63)], gcv = sgc[d * 64 + c];
        const float e1 = __expf(gcv), be = sbeta[d * 64 + c] * e1, e2 = __expf(gl - gcv), cdv = __expf(gl);
        float* E = Eb + ((size_t)item * 2 + d) * 256;
        E[c] = e1; E[64 + c] = be; E[128 + c] = e2; E[192 + c] = cdv;
      }
      __syncthreads();
    }
    {
      const int wv = opq_v(wave), lane_l = opq_v(lane);
      const int d = wv & 1, item = ci * 8 + (grp & 1) * 4 + (wv >> 1);
      const float* Lb = sLp + wv * LP_FLOATS;
      float T[64];
#pragma unroll
      for (int ip = 0; ip < 64; ++ip) {
        f32x4 lrow[16];
#pragma unroll
        for (int j4 = 0; j4 < (ip + 3) / 4; ++j4) lrow[j4] = *(const f32x4*)(Lb + lp_off(ip) + j4 * 4);
        float a0 = (lane_l == ip) ? 1.f : 0.f, a1 = 0.f, a2 = 0.f, a3 = 0.f;
#pragma unroll
        for (int j4 = 0; j4 < (ip + 3) / 4; ++j4) {
          const f32x4 lv = lrow[j4];
          if (j4 * 4 + 0 < ip) a0 -= lv.x * T[j4 * 4 + 0];
          if (j4 * 4 + 1 < ip) a1 -= lv.y * T[j4 * 4 + 1];
          if (j4 * 4 + 2 < ip) a2 -= lv.z * T[j4 * 4 + 2];
          if (j4 * 4 + 3 < ip) a3 -= lv.w * T[j4 * 4 + 3];
        }
        T[ip] = (a0 + a1) + (a2 + a3);
        __builtin_amdgcn_sched_barrier(0);
      }
      u16* To = ((size_t)item < TA_LAT_ITEMS ? Tb_lat : Tb_ctx) + ta_off(item, d);
      const int cidx = d ? 63 - lane_l : lane_l;
#pragma unroll
      for (int ip = 0; ip < 64; ++ip) {
        const int i = d ? 63 - ip : ip;
        To[i * 64 + cidx] = f2bf(T[ip]);
      }
    }
    __syncthreads();
  }
}

constexpr int SC_QS = 272;
constexpr int SC_Q = 0, SC_K = 17408, SC_KT = 34816, SC_T = 52224, SC_A = 60928, SC_E = 69632, SC_BUF = 70656;
DI s16x8 ldA16(const char* base, int row, int strideB, int kofs, int q) {
  const char* p = base + row * strideB + (kofs + 4 * q) * 2;
  u32x2 lo = *(const u32x2*)p, hi = *(const u32x2*)(p + 32);
  return cat8(lo, hi);
}
DI s16x8 pack16(const f32x4& a, const f32x4& b) {
  u32x4 v = {pk2(a.x, a.y), pk2(a.z, a.w), pk2(b.x, b.y), pk2(b.z, b.w)};
  return __builtin_bit_cast(s16x8, v);
}

template <bool DELTA, bool DRY = false>
DI void scan_phase(char* shm, const Params& p, const int wave_s_) {
  const int bid = blockIdx.x;
  if (bid >= 256) return;
  const int tid = TIDX(), wave = tid >> 6, lane = tid & 63, n16 = lane & 15, q4 = lane >> 4;
  int cgp, d, h, b;
  if (DELTA) { cgp = (bid >> 3) & 3; const int cid = (bid & 7) + 8 * (bid >> 5); d = cid & 1; h = (cid >> 1) & 7; b = cid >> 4; }
  else { cgp = (bid >> 3) & 7; const int cid = (bid & 7) + 8 * (bid >> 6); d = cid & 1; h = (cid >> 1) & 3; b = cid >> 3; }
  const bool compute = wave < 4;
  const int col0 = (DELTA ? h * 256 : h * 512) + cgp * 64 + (wave & 3) * 16;
  u16* Ub = (u16*)(p.ws + (DELTA ? (d ? OFF_U1 : OFF_U0) : (d ? OFF_V1 : OFF_V0)));
  const u16* qk = (const u16*)(p.ws + OFF_QK0);
  const u16* Ag_lat = (const u16*)p.out;
  const u16* Tb_lat = (const u16*)p.out + (size_t)32 * MiB;
  const u16* Ag_ctx = (const u16*)(p.ws + OFF_AC);
  const u16* Tb_ctx = (const u16*)(p.ws + OFF_TC);
  const float* Eb = (const float*)(p.ws + OFF_X);
  const u16* QD = (const u16*)(p.ws + OFF_QD);
  const u16* AS = (const u16*)(p.ws + OFF_ASUM);
  const float* CD = (const float*)(p.ws + OFF_CD1);

  auto chunk_of = [&](int st) -> int {
    if (st < 4) return 512 + b * 4 + (d ? 3 - st : st);
    return b * 128 + (d ? 127 - (st - 4) : (st - 4));
  };

  auto stage_all = [&](int st, int buf) {
    const int sid = tid - 256;
    const int ci = chunk_of(st), row0 = ci * 64;
    char* sb = shm + buf * SC_BUF;
    if (DELTA) {
      const size_t it = ((size_t)ci * 8 + h) * 2 + d;
      const float* E = Eb + it * 256;
      const int c = sid >> 2, cc = (sid & 3) * 32;
      const u16* qsrc = qk + (size_t)(row0 + c) * 2048 + h * 128 + cc;
      const int c0 = (sid >> 4) * 4, dk0 = (sid & 15) * 8;
      const u16* ksrc = qk + (size_t)(row0 + c0) * 2048 + 1024 + h * 128 + dk0;
      u32x4 gq[4], gk[4], gT[2], gA[2];
#pragma unroll
      for (int u = 0; u < 4; ++u) gq[u] = *(const u32x4*)(qsrc + u * 8);
#pragma unroll
      for (int u = 0; u < 4; ++u) gk[u] = *(const u32x4*)(ksrc + (size_t)u * 2048);
#pragma unroll
      for (int u = 0; u < 2; ++u) {
        const int chunk = sid * 2 + u, tr = chunk >> 3, tc = (chunk & 7) * 8;
        const size_t itm = (size_t)ci * 8 + h;
        gT[u] = *(const u32x4*)((itm < TA_LAT_ITEMS ? Tb_lat : Tb_ctx) + ta_off(itm, d) + tr * 64 + tc);
        gA[u] = *(const u32x4*)((itm < TA_LAT_ITEMS ? Ag_lat : Ag_ctx) + ta_off(itm, d) + tr * 64 + tc);
      }
      const float e1 = E[c];
      const f32x4 bev = *(const f32x4*)(E + 64 + c0), e2v = *(const f32x4*)(E + 128 + c0);
      if (sid == 0) *(float*)(sb + SC_E) = E[192];
#pragma unroll
      for (int u = 0; u < 4; ++u) st8(sb + SC_Q + c * SC_QS + (cc + u * 8) * 2, scale8(gq[u], e1));
      const float be[4] = {bev.x, bev.y, bev.z, bev.w}, e2[4] = {e2v.x, e2v.y, e2v.z, e2v.w};
      u32x4 kt[4];
#pragma unroll
      for (int u = 0; u < 4; ++u) {
        st8(sb + SC_K + (c0 + u) * SC_QS + dk0 * 2, scale8(gk[u], -be[u]));
        kt[u] = scale8(gk[u], e2[u]);
      }
      const unsigned w[4][4] = {{kt[0].x, kt[0].y, kt[0].z, kt[0].w}, {kt[1].x, kt[1].y, kt[1].z, kt[1].w},
                                {kt[2].x, kt[2].y, kt[2].z, kt[2].w}, {kt[3].x, kt[3].y, kt[3].z, kt[3].w}};
#pragma unroll
      for (int jp = 0; jp < 4; ++jp) {
        u32x2 lo = {(w[0][jp] & 0xffffu) | (w[1][jp] << 16), (w[2][jp] & 0xffffu) | (w[3][jp] << 16)};
        u32x2 hi = {(w[0][jp] >> 16) | (w[1][jp] & 0xffff0000u), (w[2][jp] >> 16) | (w[3][jp] & 0xffff0000u)};
        *(u32x2*)(sb + SC_KT + (dk0 + 2 * jp) * 136 + c0 * 2) = lo;
        *(u32x2*)(sb + SC_KT + (dk0 + 2 * jp + 1) * 136 + c0 * 2) = hi;
      }
#pragma unroll
      for (int u = 0; u < 2; ++u) {
        const int chunk = sid * 2 + u, tr = chunk >> 3, tc = (chunk & 7) * 8;
        st8(sb + SC_T + tr * 136 + tc * 2, gT[u]);
        st8(sb + SC_A + tr * 136 + tc * 2, gA[u]);
      }
    } else {
      const size_t it = ((size_t)ci * 4 + h) * 2 + d;
      const u16* qd = QD + it * 16384;
      const int c = sid >> 2, cc = (sid & 3) * 32;
      const int kr = sid >> 1, kc = (sid & 1) * 32;
      u32x4 gq[4], gk[4], gA[2];
#pragma unroll
      for (int u = 0; u < 4; ++u) gq[u] = *(const u32x4*)(qd + c * 128 + cc + u * 8);
#pragma unroll
      for (int u = 0; u < 4; ++u) gk[u] = *(const u32x4*)(qd + 8192 + kr * 64 + kc + u * 8);
      if (d == 0) {
#pragma unroll
        for (int u = 0; u < 2; ++u) {
          const int chunk = sid * 2 + u, tr = chunk >> 3, tc = (chunk & 7) * 8;
          gA[u] = *(const u32x4*)(AS + ((size_t)ci * 4 + h) * 4096 + tr * 64 + tc);
        }
      }
      if (sid < 32) *(f32x4*)(sb + SC_E + sid * 16) = *(const f32x4*)(CD + it * 128 + sid * 4);
#pragma unroll
      for (int u = 0; u < 4; ++u) st8(sb + SC_Q + c * SC_QS + (cc + u * 8) * 2, gq[u]);
#pragma unroll
      for (int u = 0; u < 4; ++u) st8(sb + SC_KT + kr * 136 + (kc + u * 8) * 2, gk[u]);
      if (d == 0) {
#pragma unroll
        for (int u = 0; u < 2; ++u) {
          const int chunk = sid * 2 + u, tr = chunk >> 3, tc = (chunk & 7) * 8;
          st8(sb + SC_A + tr * 136 + tc * 2, gA[u]);
        }
      }
    }
  };

  f32x4 S[8];
#pragma unroll
  for (int t = 0; t < 8; ++t) S[t] = (f32x4){0.f, 0.f, 0.f, 0.f};
  u16 uraw[4][4];
  const int loff = (4 * q4) * 2048 + col0 + n16;
  auto u_issue = [&](int st) {
    const u16* up = Ub + (size_t)chunk_of(st) * (64 * 2048);
    const int lo = opq_v(loff);
#pragma unroll
    for (int mt = 0; mt < 4; ++mt)
#pragma unroll
      for (int i = 0; i < 4; ++i) uraw[mt][i] = up[lo + (16 * mt + i) * 2048];
  };

  if (compute) u_issue(0); else stage_all(0, 0);
  __syncthreads();

  for (int st = 0; st < 132; ++st) {
    const int buf = st & 1;
    const char* sb = shm + buf * SC_BUF;
    if (compute) {
      const int row0 = chunk_of(st) * 64;
      f32x4 Y[4], O[4];
#pragma unroll
      for (int mt = 0; mt < 4; ++mt) {
        Y[mt] = (f32x4){bf2f(uraw[mt][0]), bf2f(uraw[mt][1]), bf2f(uraw[mt][2]), bf2f(uraw[mt][3])};
        O[mt] = (f32x4){0.f, 0.f, 0.f, 0.f};
      }
#define SCHED_FENCE() __builtin_amdgcn_sched_barrier(0)
      s16x8 fT[8];
      if (DELTA) {
#pragma unroll
        for (int mt = 0; mt < 4; ++mt)
#pragma unroll
          for (int kc = 0; kc < 2; ++kc) fT[mt * 2 + kc] = ldA16(sb + SC_T, 16 * mt + n16, 136, 32 * kc, q4);
      }
      s16x8 fa[2][8];
#pragma unroll
      for (int mt = 0; mt < 4; ++mt) {
        if (DELTA) fa[0][mt] = ldA16(sb + SC_K, 16 * mt + n16, SC_QS, 0, q4);
        fa[0][4 + mt] = ldA16(sb + SC_Q, 16 * mt + n16, SC_QS, 0, q4);
      }
      SCHED_FENCE();
#pragma unroll
      for (int t = 0; t < 4; ++t) {
        if (t < 3) {
#pragma unroll
          for (int mt = 0; mt < 4; ++mt) {
            if (DELTA) fa[(t + 1) & 1][mt] = ldA16(sb + SC_K, 16 * mt + n16, SC_QS, 32 * (t + 1), q4);
            fa[(t + 1) & 1][4 + mt] = ldA16(sb + SC_Q, 16 * mt + n16, SC_QS, 32 * (t + 1), q4);
          }
        }
        SCHED_FENCE();
        const s16x8 Sb = pack16(S[2 * t], S[2 * t + 1]);
#pragma unroll
        for (int mt = 0; mt < 4; ++mt) {
          if (DELTA) Y[mt] = MFMA16(fa[t & 1][mt], Sb, Y[mt]);
          O[mt] = MFMA16(fa[t & 1][4 + mt], Sb, O[mt]);
        }
        SCHED_FENCE();
      }
      s16x8 fA[8];
      if (DELTA || d == 0) {
#pragma unroll
        for (int mt = 0; mt < 4; ++mt)
#pragma unroll
          for (int kc = 0; kc < 2; ++kc) fA[mt * 2 + kc] = ldA16(sb + SC_A, 16 * mt + n16, 136, 32 * kc, q4);
      }
      SCHED_FENCE();
      s16x8 vnb[2];
      if (DELTA) {
        s16x8 Yb[2];
        Yb[0] = pack16(Y[0], Y[1]); Yb[1] = pack16(Y[2], Y[3]);
        f32x4 vn[4];
#pragma unroll
        for (int mt = 0; mt < 4; ++mt) {
          vn[mt] = (f32x4){0.f, 0.f, 0.f, 0.f};
#pragma unroll
          for (int kc = 0; kc < 2; ++kc) vn[mt] = MFMA16(fT[mt * 2 + kc], Yb[kc], vn[mt]);
        }
        vnb[0] = pack16(vn[0], vn[1]); vnb[1] = pack16(vn[2], vn[3]);
      } else {
        vnb[0] = pack16(Y[0], Y[1]); vnb[1] = pack16(Y[2], Y[3]);
      }
      SCHED_FENCE();
      s16x8 fK[8];
#pragma unroll
      for (int t = 0; t < 4; ++t)
#pragma unroll
        for (int kc = 0; kc < 2; ++kc) fK[t * 2 + kc] = ldA16(sb + SC_KT, 16 * t + n16, 136, 32 * kc, q4);
      if (st + 1 < 132) u_issue(st + 1);
      SCHED_FENCE();
      if (DELTA || d == 0) {
#pragma unroll
        for (int mt = 0; mt < 4; ++mt)
#pragma unroll
          for (int kc = 0; kc < 2; ++kc) O[mt] = MFMA16(fA[mt * 2 + kc], vnb[kc], O[mt]);
      }
      if (DELTA) {
        const float cd = *(const float*)(sb + SC_E);
#pragma unroll
        for (int t = 0; t < 8; ++t) S[t] *= cd;
      } else {
#pragma unroll
        for (int t = 0; t < 8; ++t) {
          const f32x4 cv = *(const f32x4*)(sb + SC_E + (16 * t + 4 * q4) * 4);
          S[t] *= cv;
        }
      }
      SCHED_FENCE();
      s16x8 fK2[8];
#pragma unroll
      for (int t = 0; t < 4; ++t)
#pragma unroll
        for (int kc = 0; kc < 2; ++kc) fK2[t * 2 + kc] = ldA16(sb + SC_KT, 16 * (4 + t) + n16, 136, 32 * kc, q4);
      SCHED_FENCE();
#pragma unroll
      for (int t = 0; t < 4; ++t)
#pragma unroll
        for (int kc = 0; kc < 2; ++kc) S[t] = MFMA16(fK[t * 2 + kc], vnb[kc], S[t]);
      SCHED_FENCE();
#pragma unroll
      for (int t = 0; t < 4; ++t)
#pragma unroll
        for (int kc = 0; kc < 2; ++kc) S[4 + t] = MFMA16(fK2[t * 2 + kc], vnb[kc], S[4 + t]);
#undef SCHED_FENCE
      if (!DRY || p.out == nullptr)
#pragma unroll
      for (int mt = 0; mt < 4; ++mt) {
        const float ov[4] = {O[mt].x, O[mt].y, O[mt].z, O[mt].w};
        u16* op = Ub + (size_t)row0 * 2048;
        const int lo = opq_v(loff);
#pragma unroll
        for (int i = 0; i < 4; ++i) op[lo + (16 * mt + i) * 2048] = f2bf(ov[i]);
      }
    }
    else if (st + 1 < 132) stage_all(st + 1, buf ^ 1);
    asm volatile("s_waitcnt lgkmcnt(0)" ::: "memory");
    __builtin_amdgcn_s_barrier();
    asm volatile("" ::: "memory");
  }
}

DI void gla_prep_phase(char* shm, const Params& p, const int wave_s_) {
  const int tid = TIDX(), wave = tid >> 6, lane = tid & 63, r = lane & 31, hh = lane >> 5;
  char* sq = shm;
  char* sk = shm + 16896;
  char* sQa = shm + 33792;
  char* sKb = shm + 50688;
  float* sBC = (float*)(shm + 67584);
  float* sgl = (float*)(shm + 133120);
  const u16* qk1 = (const u16*)(p.ws + OFF_QK1);
  const float* gl = (const float*)(p.ws + OFF_ABT);
  u16* QD = (u16*)(p.ws + OFF_QD);
  u16* AS = (u16*)(p.ws + OFF_ASUM);
  float* CD = (float*)(p.ws + OFF_CD1);
  const float qscale = 0.08838834764831845f;
  for (int item = blockIdx.x; item < NCHUNK * 4; item += gridDim.x) {
    const int ci = item >> 2, h = item & 3, row0 = ci * 64;
#pragma unroll
    for (int u = 0; u < 2; ++u) {
      const int chunk = tid * 2 + u, c = chunk >> 4, cc = (chunk & 15) * 8;
      const u16* src = qk1 + (size_t)(row0 + c) * 1024 + h * 128 + cc;
      u32x4 vq = *(const u32x4*)src, vk = *(const u32x4*)(src + 512);
      st8(sq + c * 264 + cc * 2, vq);
      st8(sk + c * 264 + cc * 2, vk);
    }
    {
      const int rr = tid >> 3, cc = (tid & 7) * 4;
      *(f32x4*)(sgl + rr * 32 + cc) = *(const f32x4*)(gl + (size_t)(row0 + rr) * 32 + cc);
    }
    __syncthreads();
    {
      const int kk = tid & 127, d = (tid >> 7) & 1, chalf = tid >> 8;
      float w[16];
#pragma unroll
      for (int q = 0; q < 16; ++q) w[q] = p.gla_w_g2[(d * 16 + q) * 512 + h * 128 + kk];
      const float bg = p.gla_b_g[d * 512 + h * 128 + kk];
#pragma unroll 4
      for (int cc = 0; cc < 32; ++cc) {
        const int c = chalf * 32 + cc;
        const f32x4* gp = (const f32x4*)(sgl + c * 32 + d * 16);
        const f32x4 g0 = gp[0], g1 = gp[1], g2 = gp[2], g3 = gp[3];
        float z = bg;
        z += g0.x * w[0] + g0.y * w[1] + g0.z * w[2] + g0.w * w[3];
        z += g1.x * w[4] + g1.y * w[5] + g1.z * w[6] + g1.w * w[7];
        z += g2.x * w[8] + g2.y * w[9] + g2.z * w[10] + g2.w * w[11];
        z += g3.x * w[12] + g3.y * w[13] + g3.z * w[14] + g3.w * w[15];
        sBC[(d * 64 + c) * 128 + kk] = (fminf(z, 0.f) - __logf(1.f + __expf(-fabsf(z)))) * (1.f / 16.f);
      }
    }
    __syncthreads();
    if (tid < 256) {
      const int d = tid >> 7, kk = tid & 127;
      float* col = sBC + d * 64 * 128 + kk;
      float v[64];
#pragma unroll
      for (int c = 0; c < 64; ++c) v[c] = col[c * 128];
      if (d == 0) {
        float acc = 0.f;
#pragma unroll
        for (int c = 0; c < 64; ++c) { acc += v[c]; col[c * 128] = acc; }
      } else {
        float acc = 0.f;
#pragma unroll
        for (int c = 63; c >= 0; --c) { acc += v[c]; col[c * 128] = acc; }
      }
    }
    __syncthreads();
    f32x16 asum;
    for (int i = 0; i < 16; ++i) asum[i] = 0.f;
    for (int d = 0; d < 2; ++d) {
      const int cref = d ? 31 : 32, clast = d ? 0 : 63;
      const float* bcd = sBC + d * 64 * 128;
      u16* qd_o = QD + ((size_t)item * 2 + d) * 16384;
      float er[8], ern[8];
      {
        const int k0 = (tid & 15) * 8;
#pragma unroll
        for (int e = 0; e < 8; ++e) { const float rf = bcd[cref * 128 + k0 + e]; er[e] = __expf(rf); ern[e] = __expf(-rf); }
      }
      for (int v = tid; v < 1024; v += 512) {
        const int c = v >> 4, k0 = (v & 15) * 8;
        const u32x4 qv = *(const u32x4*)(sq + c * 264 + k0 * 2), kv = *(const u32x4*)(sk + c * 264 + k0 * 2);
        const unsigned qa[4] = {qv.x, qv.y, qv.z, qv.w}, ka[4] = {kv.x, kv.y, kv.z, kv.w};
        float oqa[8], okb[8], oqd[8];
#pragma unroll
        for (int e = 0; e < 8; ++e) {
          const float ebc = __expf(bcd[c * 128 + k0 + e]);
          const float qf = ((e & 1) ? bfhi(qa[e >> 1]) : bflo(qa[e >> 1])) * qscale;
          const float kf = (e & 1) ? bfhi(ka[e >> 1]) : bflo(ka[e >> 1]);
          oqd[e] = qf * ebc;
          oqa[e] = oqd[e] * ern[e];
          okb[e] = kf * er[e] * __builtin_amdgcn_rcpf(ebc);
        }
        st8(sQa + c * 264 + k0 * 2, (u32x4){pk2(oqa[0], oqa[1]), pk2(oqa[2], oqa[3]), pk2(oqa[4], oqa[5]), pk2(oqa[6], oqa[7])});
        st8(sKb + c * 264 + k0 * 2, (u32x4){pk2(okb[0], okb[1]), pk2(okb[2], okb[3]), pk2(okb[4], okb[5]), pk2(okb[6], okb[7])});
        *(u32x4*)(qd_o + c * 128 + k0) = (u32x4){pk2(oqd[0], oqd[1]), pk2(oqd[2], oqd[3]), pk2(oqd[4], oqd[5]), pk2(oqd[6], oqd[7])};
      }
      for (int v = tid; v < 1024; v += 512) {
        const int kk = v >> 3, c0 = (v & 7) * 8;
        const float last = bcd[clast * 128 + kk];
        float o[8];
#pragma unroll
        for (int e = 0; e < 8; ++e) {
          const int c = c0 + e;
          const float kf = bf2f(*(const u16*)(sk + c * 264 + kk * 2));
          o[e] = kf * __expf(last - bcd[c * 128 + kk]);
        }
        *(u32x4*)(qd_o + 8192 + kk * 64 + c0) = (u32x4){pk2(o[0], o[1]), pk2(o[2], o[3]), pk2(o[4], o[5]), pk2(o[6], o[7])};
      }
      if (tid < 128) CD[((size_t)item * 2 + d) * 128 + tid] = __expf(bcd[clast * 128 + tid]);
      __syncthreads();
      if (wave < 4) {
        const int tm = wave >> 1, tn = wave & 1;
        f32x16 acc;
        for (int i = 0; i < 16; ++i) acc[i] = 0.f;
#pragma unroll
        for (int s = 0; s < 8; ++s) {
          s16x8 a = ldA_nat(sQa, 32 * tm + r, 264, 16 * s, hh), bb = ldA_nat(sKb, 32 * tn + r, 264, 16 * s, hh);
          acc = MFMA32(a, bb, acc);
        }
#pragma unroll
        for (int i = 0; i < 16; ++i) {
          const int ii = 32 * tm + crow(i, hh), jj = 32 * tn + r;
          const bool keep = d ? (ii <= jj) : (ii >= jj);
          asum[i] += keep ? acc[i] : 0.f;
        }
      }
      __syncthreads();
    }
    if (wave < 4) {
      const int tm = wave >> 1, tn = wave & 1;
#pragma unroll
      for (int i = 0; i < 16; ++i) AS[(size_t)item * 4096 + (32 * tm + crow(i, hh)) * 64 + 32 * tn + r] = f2bf(asum[i]);
    }
  }
}

template <int GROUP>
DI void yg_phase(u16* o0, const u16* o1, const u16* z, const u16* zctx, const float* ng, int nrows, const int wave_s_) {
  const int gt = blockIdx.x * 512 + TIDX(), nthr = gridDim.x * 512;
  const int total = nrows * 256;
  for (int idx0 = gt; idx0 < total; idx0 += 2 * nthr) {
    const bool ok1 = idx0 + nthr < total;
    u32x4 a[2], bq[2], zz[2];
#pragma unroll
    for (int u = 0; u < 2; ++u) {
      const int idx = (u == 0 || ok1) ? idx0 + u * nthr : idx0;
      const size_t off = (size_t)(idx >> 8) * 2048 + (idx & 255) * 8;
      const int zrow = idx >> 8;
      const u16* zp = (zrow < RL) ? z + off : zctx + (size_t)(zrow - RL) * 2048 + (idx & 255) * 8;
      a[u] = __builtin_nontemporal_load((const u32x4*)(o0 + off)); bq[u] = __builtin_nontemporal_load((const u32x4*)(o1 + off)); zz[u] = __builtin_nontemporal_load((const u32x4*)zp);
    }
#pragma unroll
    for (int u = 0; u < 2; ++u) {
      if (u == 1 && !ok1) break;
      const int idx = idx0 + u * nthr, ch = (idx & 255) * 8;
      const size_t off = (size_t)(idx >> 8) * 2048 + ch;
      float o[8] = {bflo(a[u].x) + bflo(bq[u].x), bfhi(a[u].x) + bfhi(bq[u].x), bflo(a[u].y) + bflo(bq[u].y), bfhi(a[u].y) + bfhi(bq[u].y),
                    bflo(a[u].z) + bflo(bq[u].z), bfhi(a[u].z) + bfhi(bq[u].z), bflo(a[u].w) + bflo(bq[u].w), bfhi(a[u].w) + bfhi(bq[u].w)};
      const float zf[8] = {bflo(zz[u].x), bfhi(zz[u].x), bflo(zz[u].y), bfhi(zz[u].y), bflo(zz[u].z), bfhi(zz[u].z), bflo(zz[u].w), bfhi(zz[u].w)};
      float ss = 0.f;
#pragma unroll
      for (int e = 0; e < 8; ++e) ss += o[e] * o[e];
#pragma unroll
      for (int of = 1; of < GROUP; of <<= 1) ss += __shfl_xor(ss, of, 64);
      const float rstd = rsqrtf(ss * (1.f / (GROUP * 8)) + EPSF);
      const int gi = ch & (GROUP * 8 - 1);
      const f32x4 g0 = *(const f32x4*)(ng + gi), g1 = *(const f32x4*)(ng + gi + 4);
      const float gg[8] = {g0.x, g0.y, g0.z, g0.w, g1.x, g1.y, g1.z, g1.w};
#pragma unroll
      for (int e = 0; e < 8; ++e) o[e] = o[e] * rstd * gg[e] * siluf(zf[e]);
      *(u32x4*)(o0 + off) = (u32x4){pk2(o[0], o[1]), pk2(o[2], o[3]), pk2(o[4], o[5]), pk2(o[6], o[7])};
    }
  }
}

DI void final_phase(float* out, const float* g, const int wave_s_) {
  const int tidx_ = TIDX();
  const int lane = tidx_ & 63, gw = blockIdx.x * 8 + (tidx_ >> 6), nw = gridDim.x * 8;
  for (int row0 = gw; row0 < RL; row0 += 2 * nw) {
    const int rows[2] = {row0, row0 + nw};
    const bool ok1 = rows[1] < RL;
    f32x4 v[2][4];
#pragma unroll
    for (int u = 0; u < 2; ++u) {
      const float* s = out + (size_t)((u == 0 || ok1) ? rows[u] : rows[0]) * DM;
#pragma unroll
      for (int q = 0; q < 4; ++q) v[u][q] = __builtin_nontemporal_load((const f32x4*)(s + q * 256 + lane * 4));
    }
#pragma unroll
    for (int u = 0; u < 2; ++u) {
      if (u == 1 && !ok1) break;
      float* s = out + (size_t)rows[u] * DM;
      float ss = 0.f;
#pragma unroll
      for (int q = 0; q < 4; ++q) ss += v[u][q].x * v[u][q].x + v[u][q].y * v[u][q].y + v[u][q].z * v[u][q].z + v[u][q].w * v[u][q].w;
      ss = wave_sum(ss);
      const float rstd = rsqrtf(ss * (1.f / 1024.f) + EPSF);
#pragma unroll
      for (int q = 0; q < 4; ++q) {
        const f32x4 gg = *(const f32x4*)(g + q * 256 + lane * 4);
        f32x4 o = {v[u][q].x * rstd * gg.x, v[u][q].y * rstd * gg.y, v[u][q].z * rstd * gg.z, v[u][q].w * rstd * gg.w};
        __builtin_nontemporal_store(o, (f32x4*)(s + q * 256 + lane * 4));
      }
    }
  }
}

#define XB_XSUB(j)  (64 * (j))
#define XB_XGEN(j)  (1024 + 64 * (j))
#define XB_TOP      2048
#define XB_TOPGEN   2112
#define XCD_BAR_WORDS 2176
DI unsigned xb_ld(unsigned* p) { return __hip_atomic_load(p, __ATOMIC_RELAXED, __HIP_MEMORY_SCOPE_AGENT); }
DI unsigned xb_add(unsigned* p, unsigned v) { return __hip_atomic_fetch_add(p, v, __ATOMIC_RELAXED, __HIP_MEMORY_SCOPE_AGENT); }
DI void gbar(char* ws, const int wave_s_) {
  asm volatile("s_waitcnt vmcnt(0)" ::: "memory");
  __syncthreads();
  if (wave_s_ == 0 && lane_id() == 0) {
    unsigned* bar = (unsigned*)(ws + OFF_BAR);
    __builtin_amdgcn_s_waitcnt(0);
    const unsigned x = (unsigned)__builtin_amdgcn_s_getreg((3 << 11) | 20) & 0xFu;
    const unsigned nloc = gridDim.x >> 3, nx = 8u;
    const unsigned old = xb_add(&bar[XB_XSUB(x)], 1u);
    const unsigned gen = old / nloc;
    if (old + 1u == (gen + 1u) * nloc) {
      __builtin_amdgcn_fence(__ATOMIC_RELEASE, "agent");
      asm volatile("s_waitcnt vmcnt(0)" ::: "memory");
      const unsigned og = xb_add(&bar[XB_TOP], 1u);
      const unsigned tg = og / nx;
      if (og + 1u == (tg + 1u) * nx) xb_add(&bar[XB_TOPGEN], 1u);
      else while (xb_ld(&bar[XB_TOPGEN]) == tg) __builtin_amdgcn_s_sleep(1);
      __builtin_amdgcn_fence(__ATOMIC_ACQUIRE, "agent");
      xb_add(&bar[XB_XGEN(x)], 1u);
      asm volatile("s_waitcnt vmcnt(0)" ::: "memory");
    } else {
      while (xb_ld(&bar[XB_XGEN(x)]) == gen) __builtin_amdgcn_s_sleep(1);
      __builtin_amdgcn_fence(__ATOMIC_ACQUIRE, "agent");
      asm volatile("s_waitcnt vmcnt(0)" ::: "memory");
    }
  }
  __syncthreads();
}
#ifndef REP_GEMM
#define REP_GEMM 1
#endif
#ifndef REP_PREP
#define REP_PREP 1
#endif
#ifndef REP_GLP
#define REP_GLP 1
#endif
#ifndef REP_SCAN
#define REP_SCAN 0
#endif
#ifndef REP_SYNC
#define REP_SYNC 0
#endif
#ifndef REP_EW
#define REP_EW 1
#endif
__global__ void __launch_bounds__(512, 2) fwd_megakernel(Params p) {
  __shared__ __attribute__((aligned(1024))) char shm[141312];
  cg::grid_group grid = cg::this_grid();
  const int wave_s_ = __builtin_amdgcn_readfirstlane((int)(threadIdx.x >> 6));
  char* ws = p.ws;
  float* mods = (float*)(ws + OFF_MOD);
  u16* W0T = (u16*)(ws + OFF_W0T);
  u16* WO0T = (u16*)(ws + OFF_WO0T);
  u16* W1T = (u16*)(ws + OFF_W1T);
  u16* WO1T = (u16*)(ws + OFF_WO1T);
  u16* outb = (u16*)p.out;
  float* ctx1 = (float*)(ws + OFF_X);

  mods_phase(shm, p, wave_s_);
  wtrans_phase<0>(shm, p, wave_s_);
  grid.sync();
  {
    u16* H0 = (u16*)(ws + OFF_T);
    h_phase(p.x, p.ctx, p.norm_g, mods, H0, R, wave_s_);
    gbar(ws, wave_s_);
#if REP_EW > 1
    h_phase(p.x, p.ctx, p.norm_g, mods, H0, R, wave_s_);
    gbar(ws, wave_s_);
#endif
    small_gemm(H0, W0T + (size_t)6144 * 1024, (float*)(ws + OFF_ABT), wave_s_);
    EpiArgs e{};
    e.mode = 0; e.lat = outb; e.ctx = (u16*)(ws + OFF_X); e.ld = 2048;
    gemm_phase<0>(shm, H0, H0 + (size_t)RL * 1024, 1024, W0T, 0, 128, 8, e, wave_s_);
    {
      EpiArgs ec{};
      ec.mode = 4; ec.ctx = (u16*)(ws + OFF_X);
      gemm_phase<4>(shm, H0, H0 + (size_t)RL * 1024, 1024, W0T, 128, 4, 24, ec, wave_s_);
    }
    gbar(ws, wave_s_);
#if REP_GEMM > 1
    gemm_phase<0>(shm, H0, H0 + (size_t)RL * 1024, 1024, W0T, 0, 132, 8, e, wave_s_);
    gbar(ws, wave_s_);
#endif
    conv_phase<false>(p, wave_s_);
    gbar(ws, wave_s_);
#if REP_EW > 1
    conv_phase<false>(p, wave_s_);
    gbar(ws, wave_s_);
#endif
    gemm_phase<0>(shm, H0, H0 + (size_t)RL * 1024, 1024, W0T + (size_t)2048 * 1024, 0, 128, 8, e, wave_s_);
    gbar(ws, wave_s_);
#if REP_GEMM > 1
    gemm_phase<0>(shm, H0, H0 + (size_t)RL * 1024, 1024, W0T + (size_t)2048 * 1024, 0, 132, 8, e, wave_s_);
    gbar(ws, wave_s_);
#endif
    conv_phase<true>(p, wave_s_);
    gbar(ws, wave_s_);
#if REP_EW > 1
    conv_phase<true>(p, wave_s_);
    gbar(ws, wave_s_);
#endif
    for (int rep_ = 0; rep_ < REP_PREP; ++rep_) {
    dn_prep_phase(shm, p, wave_s_);
    gbar(ws, wave_s_);
    }
    for (int rep_ = 0; rep_ < REP_SCAN; ++rep_) { scan_phase<true, true>(shm, p, wave_s_); gbar(ws, wave_s_); }
    for (int rep_ = 0; rep_ < REP_SYNC; ++rep_) gbar(ws, wave_s_);
    scan_phase<true>(shm, p, wave_s_);
    gbar(ws, wave_s_);
    u16* H0b = H0;
    u16* Z = (u16*)(ws + OFF_QK0);
    EpiArgs ez{};
    ez.mode = 0; ez.lat = Z; ez.ctx = Z + (size_t)RL * 2048; ez.ld = 2048;
    gemm_phase<0>(shm, H0b, H0b + (size_t)RL * 1024, 1024, W0T + (size_t)4096 * 1024, 0, 128, 8, ez, wave_s_);
    gbar(ws, wave_s_);
#if REP_GEMM > 1
    gemm_phase<0>(shm, H0b, H0b + (size_t)RL * 1024, 1024, W0T + (size_t)4096 * 1024, 0, 132, 8, ez, wave_s_);
    gbar(ws, wave_s_);
#endif
    u16* U0 = (u16*)(ws + OFF_U0);
    yg_phase<32>(U0, (const u16*)(ws + OFF_U1), Z, (const u16*)(ws + OFF_ZC), p.dn_norm_g, R, wave_s_);
    gbar(ws, wave_s_);
    EpiArgs eo{};
    eo.mode = 2; eo.res_lat = p.x; eo.res_ctx = p.ctx; eo.mods_i = mods; eo.out_lat = p.out; eo.out_ctx = ctx1;
    gemm_phase<2>(shm, U0, U0 + (size_t)RL * 2048, 2048, WO0T, 0, 132, 4, eo, wave_s_);
    gbar(ws, wave_s_);
#if REP_GEMM > 1
    gemm_phase<2>(shm, U0, U0 + (size_t)RL * 2048, 2048, WO0T, 0, 132, 4, eo, wave_s_);
    gbar(ws, wave_s_);
#endif
  }
  {
    const float* mods1 = mods + 5 * 3072;
    u16* H1 = (u16*)(ws + OFF_QD);
    h_phase(p.out, ctx1, p.norm_g + 1024, mods1, H1, R, wave_s_);
    wtrans_phase<1>(shm, p, wave_s_);
    gbar(ws, wave_s_);
    small_gemm(H1, W1T + (size_t)5120 * 1024, (float*)(ws + OFF_ABT), wave_s_);
    EpiArgs e{};
    e.mode = 1; e.lat = (u16*)(ws + OFF_QK1); e.b1 = (u16*)(ws + OFF_V0); e.b2 = (u16*)(ws + OFF_V1);
    gemm_phase<1>(shm, H1, H1 + (size_t)RL * 1024, 1024, W1T, 0, 132, 12, e, wave_s_);
    gbar(ws, wave_s_);
    for (int rep_ = 0; rep_ < REP_GLP; ++rep_) {
    gla_prep_phase(shm, p, wave_s_);
    gbar(ws, wave_s_);
    }
    for (int rep_ = 0; rep_ < REP_SCAN; ++rep_) { scan_phase<false, true>(shm, p, wave_s_); gbar(ws, wave_s_); }
    scan_phase<false>(shm, p, wave_s_);
    gbar(ws, wave_s_);
    u16* H1b = (u16*)(ws + OFF_QK1);
    h_phase(p.out, ctx1, p.norm_g + 1024, mods1, H1b, RL, wave_s_);
    gbar(ws, wave_s_);
    u16* RB = (u16*)(ws + OFF_QD);
    EpiArgs er{};
    er.mode = 0; er.lat = RB; er.ctx = RB; er.ld = 2048;
    gemm_phase<0>(shm, H1b, H1b, 1024, W1T + (size_t)3072 * 1024, 0, 128, 8, er, wave_s_);
    gbar(ws, wave_s_);
    u16* V0 = (u16*)(ws + OFF_V0);
    yg_phase<64>(V0, (const u16*)(ws + OFF_V1), RB, RB, p.gla_norm_g, RL, wave_s_);
    gbar(ws, wave_s_);
    EpiArgs eo{};
    eo.mode = 2; eo.res_lat = p.out; eo.res_ctx = p.out; eo.mods_i = mods1; eo.out_lat = p.out; eo.out_ctx = p.out;
    gemm_phase<2>(shm, V0, V0, 2048, WO1T, 0, 128, 4, eo, wave_s_);
    gbar(ws, wave_s_);
    final_phase(p.out, p.final_g, wave_s_);
  }
}

extern "C" void kernel_launch(void* const* d_in, const int* in_sizes, int n_in, void* d_out, int out_size, void* d_ws,
                              size_t ws_size, hipStream_t stream) {
  static int grid_blocks = 0;
  if (!grid_blocks) {
    int dev = 0, cus = 0, per_cu = 0;
    hipGetDevice(&dev);
    hipDeviceGetAttribute(&cus, hipDeviceAttributeMultiprocessorCount, dev);
    hipOccupancyMaxActiveBlocksPerMultiprocessor(&per_cu, fwd_megakernel, 512, 0);
    if (per_cu < 1) per_cu = 1;
    grid_blocks = cus;
    if (grid_blocks > 256) grid_blocks = 256;
  }
  Params p{};
  p.x = (const float*)d_in[0]; p.c = (const float*)d_in[1]; p.ctx = (const float*)d_in[2]; p.c_ctx = (const float*)d_in[3];
  p.mod_w = (const float*)d_in[4]; p.mod_b = (const float*)d_in[5]; p.norm_g = (const float*)d_in[6];
  p.dn_w_in = (const float*)d_in[7]; p.dn_conv_w = (const float*)d_in[8]; p.dn_a_log = (const float*)d_in[9];
  p.dn_dt_bias = (const float*)d_in[10]; p.dn_norm_g = (const float*)d_in[11]; p.dn_w_out = (const float*)d_in[12];
  p.gla_w_in = (const float*)d_in[13]; p.gla_w_g2 = (const float*)d_in[14]; p.gla_b_g = (const float*)d_in[15];
  p.gla_norm_g = (const float*)d_in[16]; p.gla_w_out = (const float*)d_in[17]; p.final_g = (const float*)d_in[18];
  p.out = (float*)d_out;
  p.ws = (char*)d_ws;
  (void)hipMemsetAsync((char*)d_ws + OFF_BAR, 0, XCD_BAR_WORDS * sizeof(unsigned), stream);
  void* args[] = {&p};
  hipError_t e = hipLaunchCooperativeKernel((void*)fwd_megakernel, dim3(grid_blocks), dim3(512), args, 0, stream);
  if (e != hipSuccess) fprintf(stderr, "cooperative launch failed: %s (grid %d)\n", hipGetErrorString(e), grid_blocks);
}
```

```cpp
#include <hip/hip_runtime.h>
#include <hip/hip_cooperative_groups.h>
#include <cstdio>
namespace cg = cooperative_groups;

#define DI __device__ __forceinline__
typedef unsigned short u16;
typedef short s16x8 __attribute__((ext_vector_type(8)));
typedef short s16x4 __attribute__((ext_vector_type(4)));
typedef float f32x2 __attribute__((ext_vector_type(2)));
typedef float f32x4 __attribute__((ext_vector_type(4)));
typedef float f32x16 __attribute__((ext_vector_type(16)));
typedef int i32x4 __attribute__((ext_vector_type(4)));
typedef unsigned u32x2 __attribute__((ext_vector_type(2)));
typedef unsigned u32x4 __attribute__((ext_vector_type(4)));
typedef __bf16 bf2_t __attribute__((ext_vector_type(2)));

constexpr int RL = 32768;
constexpr int RC = 1024;
constexpr int R = RL + RC;
constexpr int DM = 1024;
constexpr int NCHUNK = R / 64;
constexpr float EPSF = 1e-6f;
constexpr size_t MiB = 1u << 20;

constexpr size_t OFF_QK0 = 0;
constexpr size_t OFF_U0 = 132 * MiB;
constexpr size_t OFF_U1 = 264 * MiB;
constexpr size_t OFF_T = 396 * MiB;
constexpr size_t OFF_W1T = 462 * MiB;
constexpr size_t OFF_WO1T = OFF_W1T + 10 * MiB + 256 * 1024;
constexpr size_t OFF_MOD = OFF_WO1T + 4 * MiB;
constexpr size_t OFF_X = OFF_MOD + 256 * 1024;
constexpr size_t OFF_ABT = OFF_X + 8 * MiB + 256 * 1024;
constexpr size_t OFF_W0T = OFF_ABT + 4 * MiB + 256 * 1024;
constexpr size_t OFF_WO0T = OFF_W0T + 12 * MiB + 256 * 1024;
constexpr size_t OFF_V0 = 0;
constexpr size_t OFF_V1 = 132 * MiB;
constexpr size_t OFF_QK1 = 264 * MiB;
constexpr size_t OFF_QD = 330 * MiB;
constexpr size_t OFF_CD1 = OFF_X + 4 * MiB;
constexpr size_t OFF_ASUM = OFF_W0T;
constexpr size_t OFF_BAR = 506 * MiB;
constexpr size_t OFF_ZC = 507 * MiB;

constexpr size_t TA_LAT_ITEMS = 4096;
constexpr size_t OFF_TC = 462 * MiB;
constexpr size_t OFF_AC = 464 * MiB;
DI size_t ta_off(size_t item, int d) { return ((item < TA_LAT_ITEMS ? item : item - TA_LAT_ITEMS) * 2 + d) * 4096; }
struct Params {
  const float *x, *c, *ctx, *c_ctx, *mod_w, *mod_b, *norm_g, *dn_w_in, *dn_conv_w, *dn_a_log, *dn_dt_bias, *dn_norm_g,
      *dn_w_out, *gla_w_in, *gla_w_g2, *gla_b_g, *gla_norm_g, *gla_w_out, *final_g;
  float* out;
  char* ws;
};

DI unsigned pk2(float lo, float hi) { f32x2 v = {lo, hi}; return __builtin_bit_cast(unsigned, __builtin_convertvector(v, bf2_t)); }
DI float bflo(unsigned u) { return __uint_as_float(u << 16); }
DI float bfhi(unsigned u) { return __uint_as_float(u & 0xffff0000u); }
DI float bf2f(u16 v) { return __uint_as_float(((unsigned)v) << 16); }
DI u16 f2bf(float x) { return (u16)(pk2(x, 0.f) & 0xffffu); }
DI float siluf(float x) { return x / (1.f + __expf(-x)); }
DI float sigmoidf(float x) { return 1.f / (1.f + __expf(-x)); }
DI float softplusf(float x) { return fmaxf(x, 0.f) + __logf(1.f + __expf(-fabsf(x))); }
DI int crow(int reg, int h) { return (reg & 3) + 8 * (reg >> 2) + 4 * h; }
#define MFMA32(a, b, c) __builtin_amdgcn_mfma_f32_32x32x16_bf16((a), (b), (c), 0, 0, 0)
#define MFMA16(a, b, c) __builtin_amdgcn_mfma_f32_16x16x32_bf16((a), (b), (c), 0, 0, 0)

DI s16x8 cat8(u32x2 lo, u32x2 hi) { u32x4 v = {lo.x, lo.y, hi.x, hi.y}; return __builtin_bit_cast(s16x8, v); }
DI s16x8 ldA_perm(const char* base, int row, int strideB, int kofs, int h) {
  const char* p = base + row * strideB + (kofs + 4 * h) * 2;
  u32x2 lo = *(const u32x2*)p, hi = *(const u32x2*)(p + 16);
  return cat8(lo, hi);
}
DI s16x8 ldA_nat(const char* base, int row, int strideB, int kofs, int h) {
  const char* p = base + row * strideB + (kofs + 8 * h) * 2;
  u32x2 lo = *(const u32x2*)p, hi = *(const u32x2*)(p + 8);
  return cat8(lo, hi);
}
DI s16x8 pack_step(const f32x16& x, int s) {
  u32x4 p;
  p.x = pk2(x[8 * s + 0], x[8 * s + 1]); p.y = pk2(x[8 * s + 2], x[8 * s + 3]);
  p.z = pk2(x[8 * s + 4], x[8 * s + 5]); p.w = pk2(x[8 * s + 6], x[8 * s + 7]);
  return __builtin_bit_cast(s16x8, p);
}
DI void st8(char* p, u32x4 v) { *(u32x2*)p = (u32x2){v.x, v.y}; *(u32x2*)(p + 8) = (u32x2){v.z, v.w}; }
DI u32x4 scale8(u32x4 v, float s) {
  u32x4 o;
  o.x = pk2(bflo(v.x) * s, bfhi(v.x) * s); o.y = pk2(bflo(v.y) * s, bfhi(v.y) * s);
  o.z = pk2(bflo(v.z) * s, bfhi(v.z) * s); o.w = pk2(bflo(v.w) * s, bfhi(v.w) * s);
  return o;
}
DI int opq_v(int v) { asm volatile("" : "+v"(v)); return v; }
DI int lane_id() { int r; asm volatile("v_mbcnt_lo_u32_b32 %0, -1, 0\n\tv_mbcnt_hi_u32_b32 %0, -1, %0" : "=v"(r)); return r; }
#define TIDX() (wave_s_ * 64 + lane_id())
DI float wave_sum(float v) {
#pragma unroll
  for (int o = 32; o >= 1; o >>= 1) v += __shfl_xor(v, o, 64);
  return v;
}

DI void mods_phase(char* shm, const Params& p, const int wave_s_) {
  const int bid = blockIdx.x, tid = TIDX();
  float* mods = (float*)(p.ws + OFF_MOD);
  if (bid < 192) {
    float* scond = (float*)shm;
    float* red = scond + 5 * 1024;
    for (int e = tid; e < 5 * 1024; e += 512) {
      int r = e >> 10, k = e & 1023;
      float v = (r < 4) ? p.c[r * 1024 + k] : p.c_ctx[k];
      scond[e] = siluf(v);
    }
    __syncthreads();
    const int i = bid / 96, jt = bid % 96, jl = tid & 31, ks = tid >> 5;
    const float* w = p.mod_w + (size_t)i * 1024 * 3072 + jt * 32 + jl;
    float a0 = 0, a1 = 0, a2 = 0, a3 = 0, a4 = 0;
#pragma unroll 8
    for (int kk = 0; kk < 64; ++kk) {
      int k = ks * 64 + kk;
      float wv = __builtin_nontemporal_load(w + (size_t)k * 3072);
      a0 += scond[k] * wv; a1 += scond[1024 + k] * wv; a2 += scond[2048 + k] * wv; a3 += scond[3072 + k] * wv; a4 += scond[4096 + k] * wv;
    }
    red[(ks * 5 + 0) * 32 + jl] = a0; red[(ks * 5 + 1) * 32 + jl] = a1; red[(ks * 5 + 2) * 32 + jl] = a2;
    red[(ks * 5 + 3) * 32 + jl] = a3; red[(ks * 5 + 4) * 32 + jl] = a4;
    __syncthreads();
    if (tid < 160) {
      int r = tid >> 5, j = tid & 31;
      float s = p.mod_b[i * 3072 + jt * 32 + j];
      for (int q = 0; q < 16; ++q) s += red[(q * 5 + r) * 32 + j];
      mods[(i * 5 + r) * 3072 + jt * 32 + j] = s;
    }
    __syncthreads();
  }
}

DI void wtrans_tile(char* shm, const float* src, int K, int N, u16* dst, int tile, const int wave_s_) {
  u16* t = (u16*)shm;
  const int tid = TIDX();
  const int tn = (N + 63) / 64;
  const int k0 = (tile / tn) * 64, n0 = (tile % tn) * 64;
#pragma unroll
  for (int q = 0; q < 8; ++q) {
    int e = tid + q * 512, kk = e >> 6, nn = e & 63;
    float v = (n0 + nn < N) ? __builtin_nontemporal_load(src + (size_t)(k0 + kk) * N + n0 + nn) : 0.f;
    t[nn * 66 + kk] = f2bf(v);
  }
  __syncthreads();
#pragma unroll
  for (int q = 0; q < 8; ++q) {
    int e = tid + q * 512, nn = e >> 6, kk = e & 63;
    if (n0 + nn < N) dst[(size_t)(n0 + nn) * K + k0 + kk] = t[nn * 66 + kk];
  }
  __syncthreads();
}
template <int LAYER>
DI void wtrans_phase(char* shm, const Params& p, const int wave_s_) {
  const int t0 = 16 * 97, t1 = 32 * 16, t2 = 16 * 81, t3 = 32 * 16;
  if (LAYER == 0) {
    for (int tile = blockIdx.x; tile < t0 + t1; tile += gridDim.x) {
      if (tile < t0) wtrans_tile(shm, p.dn_w_in, 1024, 6176, (u16*)(p.ws + OFF_W0T), tile, wave_s_);
      else wtrans_tile(shm, p.dn_w_out, 2048, 1024, (u16*)(p.ws + OFF_WO0T), tile - t0, wave_s_);
    }
  } else {
    for (int tile = blockIdx.x; tile < t2 + t3; tile += gridDim.x) {
      if (tile < t2) wtrans_tile(shm, p.gla_w_in, 1024, 5152, (u16*)(p.ws + OFF_W1T), tile, wave_s_);
      else wtrans_tile(shm, p.gla_w_out, 2048, 1024, (u16*)(p.ws + OFF_WO1T), tile - t2, wave_s_);
    }
  }
}

DI void h_phase(const float* src_lat, const float* src_ctx, const float* g, const float* mods_i, u16* dst, int nrows, const int wave_s_) {
  const int tidx_ = TIDX();
  const int lane = tidx_ & 63, gw = blockIdx.x * 8 + (tidx_ >> 6), nw = gridDim.x * 8;
  for (int row0 = gw; row0 < nrows; row0 += 2 * nw) {
    const int rows[2] = {row0, row0 + nw};
    const bool ok1 = rows[1] < nrows;
    f32x4 v[2][4];
#pragma unroll
    for (int u = 0; u < 2; ++u) {
      const int row = (u == 0 || ok1) ? rows[u] : rows[0];
      const float* s = (row < RL) ? src_lat + (size_t)row * DM : src_ctx + (size_t)(row - RL) * DM;
#pragma unroll
      for (int q = 0; q < 4; ++q) v[u][q] = __builtin_nontemporal_load((const f32x4*)(s + q * 256 + lane * 4));
    }
#pragma unroll
    for (int u = 0; u < 2; ++u) {
      if (u == 1 && !ok1) break;
      const int row = rows[u];
      const int mr = (row < RL) ? (row >> 13) : 4;
      const float* sh = mods_i + mr * 3072;
      const float* sc = sh + 1024;
      float ss = 0.f;
#pragma unroll
      for (int q = 0; q < 4; ++q) ss += v[u][q].x * v[u][q].x + v[u][q].y * v[u][q].y + v[u][q].z * v[u][q].z + v[u][q].w * v[u][q].w;
      ss = wave_sum(ss);
      const float rstd = rsqrtf(ss * (1.f / 1024.f) + EPSF);
#pragma unroll
      for (int q = 0; q < 4; ++q) {
        const int col = q * 256 + lane * 4;
        f32x4 gg = *(const f32x4*)(g + col), s1 = *(const f32x4*)(sc + col), s0 = *(const f32x4*)(sh + col);
        float o0 = v[u][q].x * rstd * gg.x * (1.f + s1.x) + s0.x, o1 = v[u][q].y * rstd * gg.y * (1.f + s1.y) + s0.y;
        float o2 = v[u][q].z * rstd * gg.z * (1.f + s1.z) + s0.z, o3 = v[u][q].w * rstd * gg.w * (1.f + s1.w) + s0.w;
        *(u32x2*)(dst + (size_t)row * DM + col) = (u32x2){pk2(o0, o1), pk2(o2, o3)};
      }
    }
  }
}

DI void small_gemm(const u16* A, const u16* Wt, float* out, const int wave_s_) {
  const int tidx_ = TIDX();
  if ((blockIdx.x & 7) == 0) return;
  const int bsub = (int)blockIdx.x - 1 - ((int)blockIdx.x >> 3);
  const int lane = tidx_ & 63, gw = bsub * 8 + (tidx_ >> 6), nw = (gridDim.x - (gridDim.x >> 3)) * 8;
  const int r = lane & 31, h = lane >> 5;
  for (int wt = gw; wt < R / 32; wt += nw) {
    const u16* ap = A + (size_t)(wt * 32 + r) * 1024 + 8 * h;
    const u16* bp = Wt + (size_t)r * 1024 + 8 * h;
    f32x16 acc;
    for (int i = 0; i < 16; ++i) acc[i] = 0.f;
#pragma unroll 8
    for (int s = 0; s < 64; ++s) {
      s16x8 a = *(const s16x8*)(ap + 16 * s), b = *(const s16x8*)(bp + 16 * s);
      acc = MFMA32(a, b, acc);
    }
#pragma unroll
    for (int i = 0; i < 16; ++i) out[(size_t)(wt * 32 + crow(i, h)) * 32 + r] = acc[i];
  }
}

DI int lds_byte2(int r, int c) {
  int st = (r >> 4) * 2 + (c >> 5), ob = (r & 15) * 64 + (c & 31) * 2;
  return st * 1024 + (ob ^ (((ob >> 9) & 1) << 5));
}
DI void stage_rc2(int b, int& Rr, int& Cc) {
  int st = b >> 10, sb = b & 1023, swz = sb ^ (((sb >> 9) & 1) << 5);
  Rr = (st / 2) * 16 + swz / 64;
  Cc = (st % 2) * 32 + (swz % 64) / 2;
}

struct EpiArgs {
  int mode;
  u16* lat; u16* ctx; int ld;
  u16* b1; u16* b2;
  const float* res_lat; const float* res_ctx; const float* mods_i; float* out_lat; float* out_ctx;
};

template <int MODE>
DI void gemm_epilogue(const EpiArgs& e, f32x4 (&acc)[8][4], int row0, int pn, int wr, int wc, int fr, int fq) {
#pragma unroll
  for (int m = 0; m < 8; ++m) {
    const int row = row0 + wr * 128 + m * 16 + fr;
#pragma unroll
    for (int n = 0; n < 4; ++n) {
      const int col = pn * 256 + wc * 64 + n * 16 + fq * 4;
      const f32x4 a = acc[m][n];
      if (MODE == 0) {
        u16* pr = (row < RL) ? e.lat + (size_t)row * e.ld : e.ctx + (size_t)(row - RL) * e.ld;
        *(u32x2*)(pr + col) = (u32x2){pk2(a.x, a.y), pk2(a.z, a.w)};
      } else if (MODE == 1) {
        u32x2 v = {pk2(a.x, a.y), pk2(a.z, a.w)};
        if (pn < 4) {
          *(u32x2*)(e.lat + (size_t)row * 1024 + col) = v;
        } else {
          *(u32x2*)(e.b1 + (size_t)row * 2048 + col - 1024) = v;
          *(u32x2*)(e.b2 + (size_t)row * 2048 + col - 1024) = v;
        }
      } else {
        const int mr = (row < RL) ? (row >> 13) : 4;
        const f32x4 gt = *(const f32x4*)(e.mods_i + mr * 3072 + 2048 + col);
        const float* rp = (row < RL) ? e.res_lat + (size_t)row * DM : e.res_ctx + (size_t)(row - RL) * DM;
        float* op = (row < RL) ? e.out_lat + (size_t)row * DM : e.out_ctx + (size_t)(row - RL) * DM;
        const f32x4 rv = *(const f32x4*)(rp + col);
        f32x4 o = {rv.x + gt.x * a.x, rv.y + gt.y * a.y, rv.z + gt.z * a.z, rv.w + gt.w * a.w};
        *(f32x4*)(op + col) = o;
      }
    }
  }
}

template <int MODE>
DI void gemm_epilogue8(const EpiArgs& e, f32x4 (&acc)[2][2][4][2], int row0, int pn, int wr, int wc, int fr, int fq) {
#pragma unroll
  for (int ai = 0; ai < 2; ++ai)
#pragma unroll
    for (int m = 0; m < 4; ++m) {
      const int row = row0 + ai * 128 + wr * 64 + m * 16 + fr;
#pragma unroll
      for (int bj = 0; bj < 2; ++bj)
#pragma unroll
        for (int n = 0; n < 2; ++n) {
          const int col = pn * 256 + bj * 128 + wc * 32 + n * 16 + fq * 4;
          const f32x4 a = acc[ai][bj][m][n];
          if (MODE == 0) {
            u16* pr = (row < RL) ? e.lat + (size_t)row * e.ld : e.ctx + (size_t)(row - RL) * e.ld;
            *(u32x2*)(pr + col) = (u32x2){pk2(a.x, a.y), pk2(a.z, a.w)};
          } else if (MODE == 4) {
            const size_t dsel = (pn < 8) ? 0 : (pn < 16) ? (4 * MiB / 2) : ((OFF_ZC - OFF_X) / 2);
            *(u32x2*)(e.ctx + dsel + (size_t)(row - RL) * 2048 + (col & 2047)) = (u32x2){pk2(a.x, a.y), pk2(a.z, a.w)};
          } else if (MODE == 1) {
            u32x2 v = {pk2(a.x, a.y), pk2(a.z, a.w)};
            if (pn < 4) {
              *(u32x2*)(e.lat + (size_t)row * 1024 + col) = v;
            } else {
              *(u32x2*)(e.b1 + (size_t)row * 2048 + col - 1024) = v;
              *(u32x2*)(e.b2 + (size_t)row * 2048 + col - 1024) = v;
            }
          } else {
            const int mr = (row < RL) ? (row >> 13) : 4;
            const f32x4 gt = *(const f32x4*)(e.mods_i + mr * 3072 + 2048 + col);
            const float* rp = (row < RL) ? e.res_lat + (size_t)row * DM : e.res_ctx + (size_t)(row - RL) * DM;
            float* op = (row < RL) ? e.out_lat + (size_t)row * DM : e.out_ctx + (size_t)(row - RL) * DM;
            const f32x4 rv = __builtin_nontemporal_load((const f32x4*)(rp + col));
            f32x4 o = {rv.x + gt.x * a.x, rv.y + gt.y * a.y, rv.z + gt.z * a.z, rv.w + gt.w * a.w};
            *(f32x4*)(op + col) = o;
          }
        }
    }
}

template <int MODE>
DI void gemm_phase(char* shm_, const u16* Alat, const u16* Actx, int K, const u16* Bt, int pm0, int npm, int nN, const EpiArgs& e, const int wave_s_) {
  constexpr int BK = 64, HALF = 128, HT = HALF * BK;
  u16* shm = (u16*)shm_;
  const int tid = TIDX(), wid = tid >> 6, lane = tid & 63, wr = wid >> 2, wc = wid & 3, fr = lane & 15, fq = lane >> 4;
#define SA(b, h) (shm + ((b) * 2 + (h)) * HT)
#define SB(b, h) (shm + (4 + (b) * 2 + (h)) * HT)
#define LDSP(ptr) ((__attribute__((address_space(3))) unsigned*)(unsigned)(size_t)(ptr))
#define STAGE(P, BASE, br, kt) do { const u16* _p = (BASE) + (size_t)(br) * K + (kt) * BK + soff; \
    _Pragma("unroll") for (int _i = 0; _i < 2; ++_i) \
      __builtin_amdgcn_global_load_lds((const unsigned*)(_p + (size_t)_i * 64 * K), LDSP((char*)(P) + wid * 1024 + _i * 8192), 16, 0, 0); } while (0)
#define LDA(dst, b, h) _Pragma("unroll") for (int m = 0; m < 4; ++m) _Pragma("unroll") for (int k = 0; k < 2; ++k) \
    dst[m][k] = *(const s16x8*)((const char*)SA(b, h) + lds_byte2(wr * 64 + m * 16 + fr, k * 32 + fq * 8))
#define LDB(dst, b, h) _Pragma("unroll") for (int n = 0; n < 2; ++n) _Pragma("unroll") for (int k = 0; k < 2; ++k) \
    dst[n][k] = *(const s16x8*)((const char*)SB(b, h) + lds_byte2(wc * 32 + n * 16 + fr, k * 32 + fq * 8))
#define MMA(ai, bj, Atv, Btv) do { __builtin_amdgcn_s_setprio(1); \
    _Pragma("unroll") for (int m = 0; m < 4; ++m) _Pragma("unroll") for (int n = 0; n < 2; ++n) _Pragma("unroll") for (int k = 0; k < 2; ++k) \
      acc[ai][bj][m][n] = MFMA16(Btv[n][k], Atv[m][k], acc[ai][bj][m][n]); \
    __builtin_amdgcn_s_setprio(0); } while (0)
#define WAIT_V(n) asm volatile("s_waitcnt vmcnt(" #n ")" ::: "memory")
#define WAIT_L(n) asm volatile("s_waitcnt lgkmcnt(" #n ")" ::: "memory")
#define BAR __builtin_amdgcn_s_barrier()
#define SCHED __builtin_amdgcn_sched_barrier(0)
  int sR0, sC0;
  stage_rc2(tid * 16, sR0, sC0);
  const size_t soff = (size_t)sR0 * K + sC0;
  const int ntiles = npm * nN, nt = K / BK;
  const int xcd = blockIdx.x & 7, jj = blockIdx.x >> 3;
  const int PN = (nN % 8 == 0) ? 8 : 4, PG = 32 / PN, npg = nN / PN;
  const int ngroups = ((npm + PG - 1) / PG) * npg;
  const bool grouped = (gridDim.x == 256);
  const int nit = grouped ? (ngroups - xcd + 7) / 8 : (ntiles - (int)blockIdx.x + (int)gridDim.x - 1) / (int)gridDim.x;
  auto tile_of = [&](int it, int& pm, int& pn) -> bool {
    if (it >= nit) return false;
    if (grouped) {
      const int g = xcd + 8 * it, pmg = g / npg, png = g % npg;
      pm = pmg * PG + jj / PN; pn = png * PN + jj % PN;
      if (pm >= npm) return false;
      pm += pm0;
    } else {
      const int L = blockIdx.x + it * gridDim.x;
      pm = pm0 + L / nN; pn = L % nN;
    }
    return true;
  };
  bool prefetched = false;
  for (int it = 0; it < nit; ++it) {
    int pm, pn;
    if (!tile_of(it, pm, pn)) continue;
    const int row0 = pm * 256;
    const u16* A = (row0 < RL) ? Alat + (size_t)row0 * K : Actx + (size_t)(row0 - RL) * K;
    const u16* Bw = Bt + (size_t)pn * 256 * K;
    const int brow = 0, bcol = 0;
    f32x4 acc[2][2][4][2];
#pragma unroll
    for (int i0 = 0; i0 < 2; ++i0)
#pragma unroll
      for (int i1 = 0; i1 < 2; ++i1)
#pragma unroll
        for (int i2 = 0; i2 < 4; ++i2)
#pragma unroll
          for (int i3 = 0; i3 < 2; ++i3) acc[i0][i1][i2][i3] = (f32x4){0.f, 0.f, 0.f, 0.f};
    s16x8 At[4][2], B0[2][2], B1[2][2];
    if (!prefetched) {
      STAGE(SB(0, 0), Bw, bcol, 0); STAGE(SA(0, 0), A, brow, 0);
      STAGE(SB(0, 1), Bw, bcol + HALF, 0); STAGE(SA(0, 1), A, brow + HALF, 0);
    }
    if (wr == 1) BAR;
    WAIT_V(4); BAR;
    STAGE(SB(1, 0), Bw, bcol, 1); STAGE(SA(1, 0), A, brow, 1); STAGE(SB(1, 1), Bw, bcol + HALF, 1);
    WAIT_V(6); BAR;
    for (int t = 0; t < nt - 2; t += 2) {
      LDB(B0, 0, 0); SCHED; LDA(At, 0, 0); STAGE(SA(1, 1), A, brow + HALF, t + 1);
      WAIT_L(8); BAR; WAIT_L(0); MMA(0, 0, At, B0); BAR; SCHED;
      LDB(B1, 0, 1); STAGE(SB(0, 0), Bw, bcol, t + 2);
      BAR; WAIT_L(0); MMA(0, 1, At, B1); BAR;
      LDA(At, 0, 1); STAGE(SA(0, 0), A, brow, t + 2);
      BAR; WAIT_L(0); MMA(1, 0, At, B0); BAR; SCHED;
      STAGE(SB(0, 1), Bw, bcol + HALF, t + 2);
      WAIT_V(6); BAR; MMA(1, 1, At, B1); BAR;
      LDB(B0, 1, 0); SCHED; LDA(At, 1, 0); STAGE(SA(0, 1), A, brow + HALF, t + 2);
      WAIT_L(8); BAR; WAIT_L(0); MMA(0, 0, At, B0); BAR; SCHED;
      LDB(B1, 1, 1); STAGE(SB(1, 0), Bw, bcol, t + 3);
      BAR; WAIT_L(0); MMA(0, 1, At, B1); BAR;
      LDA(At, 1, 1); STAGE(SA(1, 0), A, brow, t + 3);
      BAR; WAIT_L(0); MMA(1, 0, At, B0); BAR; SCHED;
      STAGE(SB(1, 1), Bw, bcol + HALF, t + 3);
      WAIT_V(6); BAR; MMA(1, 1, At, B1); BAR;
    }
    { LDB(B0, 0, 0); LDA(At, 0, 0); STAGE(SA(1, 1), A, brow + HALF, nt - 1);
      BAR; WAIT_L(0); MMA(0, 0, At, B0); BAR;
      LDB(B1, 0, 1); BAR; WAIT_L(0); MMA(0, 1, At, B1); BAR;
      LDA(At, 0, 1); WAIT_V(4); BAR; WAIT_L(0); MMA(1, 0, At, B0); MMA(1, 1, At, B1); BAR; }
    { LDB(B0, 1, 0); LDA(At, 1, 0); WAIT_V(2); BAR; WAIT_L(0); MMA(0, 0, At, B0); BAR;
      LDB(B1, 1, 1); WAIT_V(0); BAR; WAIT_L(0); MMA(0, 1, At, B1); BAR;
      LDA(At, 1, 1); BAR; WAIT_L(0); MMA(1, 0, At, B0); MMA(1, 1, At, B1); BAR; }
    if (wr == 0) BAR;
    {
      int pm2, pn2;
      prefetched = tile_of(it + 1, pm2, pn2);
      if (prefetched) {
        const int r2 = pm2 * 256;
        const u16* A2 = (r2 < RL) ? Alat + (size_t)r2 * K : Actx + (size_t)(r2 - RL) * K;
        const u16* B2 = Bt + (size_t)pn2 * 256 * K;
        STAGE(SB(0, 0), B2, 0, 0); STAGE(SA(0, 0), A2, 0, 0);
        STAGE(SB(0, 1), B2, HALF, 0); STAGE(SA(0, 1), A2, HALF, 0);
      }
    }
    { const int l2 = lane_id(); gemm_epilogue8<MODE>(e, acc, row0, pn, wr, wc, l2 & 15, l2 >> 4); }
    asm volatile("s_waitcnt vmcnt(0) lgkmcnt(0)" ::: "memory");
    BAR;
  }
#undef SA
#undef SB
#undef LDSP
#undef STAGE
#undef LDA
#undef LDB
#undef MMA
#undef WAIT_V
#undef WAIT_L
#undef BAR
#undef SCHED
}

DI void conv_accum(float (&acc)[8], const u16* srow, const float* w) {
  u32x4 v = *(const u32x4*)srow;
  f32x4 w0 = *(const f32x4*)w, w1 = *(const f32x4*)(w + 4);
  acc[0] += bflo(v.x) * w0.x; acc[1] += bfhi(v.x) * w0.y; acc[2] += bflo(v.y) * w0.z; acc[3] += bfhi(v.y) * w0.w;
  acc[4] += bflo(v.z) * w1.x; acc[5] += bfhi(v.z) * w1.y; acc[6] += bflo(v.w) * w1.z; acc[7] += bfhi(v.w) * w1.w;
}
DI void fma8(float (&acc)[8], const u32x4 v, const float (&w)[8]) {
  acc[0] += bflo(v.x) * w[0]; acc[1] += bfhi(v.x) * w[1]; acc[2] += bflo(v.y) * w[2]; acc[3] += bfhi(v.y) * w[3];
  acc[4] += bflo(v.z) * w[4]; acc[5] += bfhi(v.z) * w[5]; acc[6] += bflo(v.w) * w[6]; acc[7] += bfhi(v.w) * w[7];
}
template <bool ISV>
DI void conv_store(const Params& p, float (&acc)[8], int row, int ch) {
#pragma unroll
  for (int e = 0; e < 8; ++e) acc[e] = siluf(acc[e]);
  if (!ISV) {
    u16* qk = (u16*)(p.ws + OFF_QK0);
    float ss = 0.f;
#pragma unroll
    for (int e = 0; e < 8; ++e) ss += acc[e] * acc[e];
    ss += __shfl_xor(ss, 1, 64); ss += __shfl_xor(ss, 2, 64); ss += __shfl_xor(ss, 4, 64); ss += __shfl_xor(ss, 8, 64);
    const float sc = rsqrtf(ss + EPSF) * ((ch < 1024) ? 0.08838834764831845f : 1.f);
    u32x4 o = {pk2(acc[0] * sc, acc[1] * sc), pk2(acc[2] * sc, acc[3] * sc), pk2(acc[4] * sc, acc[5] * sc), pk2(acc[6] * sc, acc[7] * sc)};
    __builtin_nontemporal_store(o, (u32x4*)(qk + (size_t)row * 2048 + ch));
  } else {
    u16* u0 = (u16*)(p.ws + OFF_U0);
    u16* u1 = (u16*)(p.ws + OFF_U1);
    const float* abt = (const float*)(p.ws + OFF_ABT);
    const int head = ch >> 8;
    const float b0 = sigmoidf(abt[(size_t)row * 32 + 16 + head]), b1 = sigmoidf(abt[(size_t)row * 32 + 24 + head]);
    u32x4 o0 = {pk2(acc[0] * b0, acc[1] * b0), pk2(acc[2] * b0, acc[3] * b0), pk2(acc[4] * b0, acc[5] * b0), pk2(acc[6] * b0, acc[7] * b0)};
    u32x4 o1 = {pk2(acc[0] * b1, acc[1] * b1), pk2(acc[2] * b1, acc[3] * b1), pk2(acc[4] * b1, acc[5] * b1), pk2(acc[6] * b1, acc[7] * b1)};
    __builtin_nontemporal_store(o0, (u32x4*)(u0 + (size_t)row * 2048 + ch));
    __builtin_nontemporal_store(o1, (u32x4*)(u1 + (size_t)row * 2048 + ch));
  }
}
template <bool ISV>
DI void conv_phase(const Params& p, const int wave_s_) {
  const u16* pre_lat = (const u16*)p.out;
  const u16* pre_ctx = (const u16*)(p.ws + OFF_X + (ISV ? 4 * MiB : 0));
  const float* cw = p.dn_conv_w + (ISV ? 2048 : 0);
  const int gt = blockIdx.x * 512 + TIDX(), nthr = gridDim.x * 512;
  const u32x4 zero4 = {0u, 0u, 0u, 0u};
  for (int idx = gt; idx < 4 * 128 * 4 * 256; idx += nthr) {
    const int cg8 = idx & 255, run = (idx >> 8) & 3, gr = (idx >> 10) & 127, b = idx >> 17, ch = cg8 * 8, c0 = run * 16;
    float w[9][8];
#pragma unroll
    for (int t = 0; t < 9; ++t) {
      const f32x4 w0 = *(const f32x4*)(cw + t * 4096 + ch), w1 = *(const f32x4*)(cw + t * 4096 + ch + 4);
      w[t][0] = w0.x; w[t][1] = w0.y; w[t][2] = w0.z; w[t][3] = w0.w; w[t][4] = w1.x; w[t][5] = w1.y; w[t][6] = w1.z; w[t][7] = w1.w;
    }
    const u16* base = pre_lat + ((size_t)(b << 13) + gr * 64) * 2048 + ch;
    const bool rok[3] = {gr > 0, true, gr < 127};
    u32x4 win[3][3];
#pragma unroll
    for (int i = 0; i < 3; ++i) {
      win[i][0] = (rok[i] && c0 > 0) ? *(const u32x4*)(base + (ptrdiff_t)((i - 1) * 64 + c0 - 1) * 2048) : zero4;
      win[i][1] = rok[i] ? *(const u32x4*)(base + (ptrdiff_t)((i - 1) * 64 + c0) * 2048) : zero4;
    }
#pragma unroll
    for (int t = 0; t < 16; ++t) {
      const int c = c0 + t;
#pragma unroll
      for (int i = 0; i < 3; ++i) win[i][2] = (rok[i] && c < 63) ? *(const u32x4*)(base + (ptrdiff_t)((i - 1) * 64 + c + 1) * 2048) : zero4;
      float acc[8];
#pragma unroll
      for (int e = 0; e < 8; ++e) acc[e] = 0.f;
#pragma unroll
      for (int i = 0; i < 3; ++i)
#pragma unroll
        for (int j = 0; j < 3; ++j) fma8(acc, win[i][j], w[i * 3 + j]);
      conv_store<ISV>(p, acc, (b << 13) + gr * 64 + c, ch);
#pragma unroll
      for (int i = 0; i < 3; ++i) { win[i][0] = win[i][1]; win[i][1] = win[i][2]; }
    }
  }
  for (int idx = gt; idx < 4 * 32 * 256; idx += nthr) {
    const int cg8 = idx & 255, run = (idx >> 8) & 31, b = idx >> 13, ch = cg8 * 8, p0 = run * 8;
    float w[3][8];
#pragma unroll
    for (int t = 0; t < 3; ++t) {
      const f32x4 w0 = *(const f32x4*)(cw + (3 + t) * 4096 + ch), w1 = *(const f32x4*)(cw + (3 + t) * 4096 + ch + 4);
      w[t][0] = w0.x; w[t][1] = w0.y; w[t][2] = w0.z; w[t][3] = w0.w; w[t][4] = w1.x; w[t][5] = w1.y; w[t][6] = w1.z; w[t][7] = w1.w;
    }
    const u16* base = pre_ctx + (size_t)(b * 256) * 2048 + ch;
    u32x4 win[3];
    win[0] = (p0 > 0) ? *(const u32x4*)(base + (size_t)(p0 - 1) * 2048) : zero4;
    win[1] = *(const u32x4*)(base + (size_t)p0 * 2048);
#pragma unroll
    for (int t = 0; t < 8; ++t) {
      const int pp = p0 + t;
      win[2] = (pp < 255) ? *(const u32x4*)(base + (size_t)(pp + 1) * 2048) : zero4;
      float acc[8];
#pragma unroll
      for (int e = 0; e < 8; ++e) acc[e] = 0.f;
#pragma unroll
      for (int j = 0; j < 3; ++j) fma8(acc, win[j], w[j]);
      conv_store<ISV>(p, acc, RL + b * 256 + pp, ch);
      win[0] = win[1]; win[1] = win[2];
    }
  }
}

constexpr int lp_off(int ip) { return ip == 0 ? 0 : (8 * ((ip - 1) / 4) * ((ip - 1) / 4 + 1) + 4 * ((ip - 1) % 4) * ((ip - 1) / 4 + 1)); }
constexpr int LP_FLOATS = 2112;
DI void dn_prep_phase(char* shm, const Params& p, const int wave_s_) {
  const int tid = TIDX(), wave = tid >> 6, lane = tid & 63, r = lane & 31, hh = lane >> 5;
  char* sQ = shm;
  char* sK = shm + 16896;
  float* sKK = (float*)(shm + 33792);
  float* sQK = (float*)(shm + 50432);
  float* sg = (float*)(shm + 67072);
  float* sbeta = sg + 128;
  float* sgc = sg + 256;
  float* sLp = (float*)(shm + 68608);
  const u16* qk = (const u16*)(p.ws + OFF_QK0);
  const float* abt = (const float*)(p.ws + OFF_ABT);
  u16* Ab_lat = (u16*)p.out;
  u16* Tb_lat = (u16*)p.out + (size_t)32 * MiB;
  u16* Ab_ctx = (u16*)(p.ws + OFF_AC);
  u16* Tb_ctx = (u16*)(p.ws + OFF_TC);
  float* Eb = (float*)(p.ws + OFF_X);
  for (int grp = blockIdx.x; grp < NCHUNK * 2; grp += gridDim.x) {
    const int ci = grp >> 1, row0 = ci * 64;
    u32x4 pq[2], pk[2];
    float pa = 0.f, pbt = 0.f;
    auto load_item = [&](int h) {
#pragma unroll
      for (int u = 0; u < 2; ++u) {
        const int chunk = tid * 2 + u, c = chunk >> 4, cc = (chunk & 15) * 8;
        const u16* src = qk + (size_t)(row0 + c) * 2048 + h * 128 + cc;
        pq[u] = *(const u32x4*)src; pk[u] = *(const u32x4*)(src + 1024);
      }
      if (tid < 128) {
        const int d = tid >> 6, c = tid & 63;
        pa = abt[(size_t)(row0 + c) * 32 + d * 8 + h]; pbt = abt[(size_t)(row0 + c) * 32 + 16 + d * 8 + h];
      }
    };
    load_item((grp & 1) * 4);
    for (int sub = 0; sub < 4; ++sub) {
      const int h = (grp & 1) * 4 + sub, item = ci * 8 + h;
#pragma unroll
      for (int u = 0; u < 2; ++u) {
        const int chunk = tid * 2 + u, c = chunk >> 4, cc = (chunk & 15) * 8;
        st8(sQ + c * 264 + cc * 2, pq[u]);
        st8(sK + c * 264 + cc * 2, pk[u]);
      }
      if (tid < 128) {
        const int d = tid >> 6, c = tid & 63;
        sg[d * 64 + c] = -__expf(p.dn_a_log[d * 8 + h]) * softplusf(pa + p.dn_dt_bias[d * 8 + h]);
        sbeta[d * 64 + c] = sigmoidf(pbt);
      }
      if (sub < 3) load_item(h + 1);
      __syncthreads();
      if (wave < 2) {
        const int c = wave ? 63 - lane : lane;
        float v = sg[wave * 64 + c];
#pragma unroll
        for (int o = 1; o < 64; o <<= 1) { const float t = __shfl_up(v, o, 64); if (lane >= o) v += t; }
        sgc[wave * 64 + c] = v;
      }
      {
        const int mat = wave >> 2, tm = (wave >> 1) & 1, tn = wave & 1;
        const char* aop = mat ? sQ : sK;
        f32x16 acc;
        for (int i = 0; i < 16; ++i) acc[i] = 0.f;
#pragma unroll
        for (int s = 0; s < 8; ++s) {
          s16x8 a = ldA_nat(aop, 32 * tm + r, 264, 16 * s, hh), b = ldA_nat(sK, 32 * tn + r, 264, 16 * s, hh);
          acc = MFMA32(a, b, acc);
        }
        float* dst = mat ? sQK : sKK;
#pragma unroll
        for (int i = 0; i < 16; ++i) dst[(32 * tm + crow(i, hh)) * 65 + 32 * tn + r] = acc[i];
      }
      __syncthreads();
      for (int e = tid; e < 8192; e += 512) {
        const int d = e >> 12, ip = (e >> 6) & 63, jp = e & 63;
        if (ip > jp) {
          const int i = d ? 63 - ip : ip, j = d ? 63 - jp : jp;
          const int q4 = (ip - 1) >> 2, r4 = (ip - 1) & 3;
          const float v = sbeta[d * 64 + i] * sKK[i * 65 + j] * __expf(fminf(sgc[d * 64 + i] - sgc[d * 64 + j], 0.f));
          sLp[(sub * 2 + d) * LP_FLOATS + 8 * q4 * (q4 + 1) + 4 * r4 * (q4 + 1) + jp] = v;
        }
      }
      for (int v = tid; v < 1024; v += 512) {
        const int d = v >> 9, i = (v >> 3) & 63, j0 = (v & 7) * 8;
        float o[8];
#pragma unroll
        for (int e = 0; e < 8; ++e) {
          const int j = j0 + e;
          const bool keep = d ? (i <= j) : (i >= j);
          o[e] = keep ? sQK[i * 65 + j] * __expf(fminf(sgc[d * 64 + i] - sgc[d * 64 + j], 0.f)) : 0.f;
        }
        u32x4 ov = {pk2(o[0], o[1]), pk2(o[2], o[3]), pk2(o[4], o[5]), pk2(o[6], o[7])};
        *(u32x4*)(((size_t)item < TA_LAT_ITEMS ? Ab_lat : Ab_ctx) + ta_off(item, d) + i * 64 + j0) = ov;
      }
      if (tid < 128) {
        const int d = tid >> 6, c = tid & 63;
        const float gl = sgc[d * 64 + (d ? 0 : 63)], gcv = sgc[d * 64 + c];
        const float e1 = __expf(gcv), be = sbeta[d * 64 + c] * e1, e2 = __expf(gl - gcv), cdv = __expf(gl);
        float* E = Eb + ((size_t)item * 2 + d) * 256;
        E[c] = e1; E[64 + c] = be; E[128 + c] = e2; E[192 + c] = cdv;
      }
      __syncthreads();
    }
    {
      const int wv = opq_v(wave), lane_l = opq_v(lane);
      const int d = wv & 1, item = ci * 8 + (grp & 1) * 4 + (wv >> 1);
      const float* Lb = sLp + wv * LP_FLOATS;
      float T[64];
#pragma unroll
      for (int ip = 0; ip < 64; ++ip) {
        f32x4 lrow[16];
#pragma unroll
        for (int j4 = 0; j4 < (ip + 3) / 4; ++j4) lrow[j4] = *(const f32x4*)(Lb + lp_off(ip) + j4 * 4);
        float a0 = (lane_l == ip) ? 1.f : 0.f, a1 = 0.f, a2 = 0.f, a3 = 0.f;
#pragma unroll
        for (int j4 = 0; j4 < (ip + 3) / 4; ++j4) {
          const f32x4 lv = lrow[j4];
          if (j4 * 4 + 0 < ip) a0 -= lv.x * T[j4 * 4 + 0];
          if (j4 * 4 + 1 < ip) a1 -= lv.y * T[j4 * 4 + 1];
          if (j4 * 4 + 2 < ip) a2 -= lv.z * T[j4 * 4 + 2];
          if (j4 * 4 + 3 < ip) a3 -= lv.w * T[j4 * 4 + 3];
        }
        T[ip] = (a0 + a1) + (a2 + a3);
        __builtin_amdgcn_sched_barrier(0);
      }
      u16* To = ((size_t)item < TA_LAT_ITEMS ? Tb_lat : Tb_ctx) + ta_off(item, d);
      const int cidx = d ? 63 - lane_l : lane_l;
#pragma unroll
      for (int ip = 0; ip < 64; ++ip) {
        const int i = d ? 63 - ip : ip;
        To[i * 64 + cidx] = f2bf(T[ip]);
      }
    }
    __syncthreads();
  }
}

constexpr int SC_QS = 272;
constexpr int SC_Q = 0, SC_K = 17408, SC_KT = 34816, SC_T = 52224, SC_A = 60928, SC_E = 69632, SC_BUF = 70656;
DI s16x8 ldA16(const char* base, int row, int strideB, int kofs, int q) {
  const char* p = base + row * strideB + (kofs + 4 * q) * 2;
  u32x2 lo = *(const u32x2*)p, hi = *(const u32x2*)(p + 32);
  return cat8(lo, hi);
}
DI s16x8 pack16(const f32x4& a, const f32x4& b) {
  u32x4 v = {pk2(a.x, a.y), pk2(a.z, a.w), pk2(b.x, b.y), pk2(b.z, b.w)};
  return __builtin_bit_cast(s16x8, v);
}

template <bool DELTA, bool DRY = false>
DI void scan_phase(char* shm, const Params& p, const int wave_s_) {
  const int bid = blockIdx.x;
  if (bid >= 256) return;
  const int tid = TIDX(), wave = tid >> 6, lane = tid & 63, n16 = lane & 15, q4 = lane >> 4;
  int cgp, d, h, b;
  if (DELTA) { cgp = (bid >> 3) & 3; const int cid = (bid & 7) + 8 * (bid >> 5); d = cid & 1; h = (cid >> 1) & 7; b = cid >> 4; }
  else { cgp = (bid >> 3) & 7; const int cid = (bid & 7) + 8 * (bid >> 6); d = cid & 1; h = (cid >> 1) & 3; b = cid >> 3; }
  const bool compute = wave < 4;
  const int col0 = (DELTA ? h * 256 : h * 512) + cgp * 64 + (wave & 3) * 16;
  u16* Ub = (u16*)(p.ws + (DELTA ? (d ? OFF_U1 : OFF_U0) : (d ? OFF_V1 : OFF_V0)));
  const u16* qk = (const u16*)(p.ws + OFF_QK0);
  const u16* Ag_lat = (const u16*)p.out;
  const u16* Tb_lat = (const u16*)p.out + (size_t)32 * MiB;
  const u16* Ag_ctx = (const u16*)(p.ws + OFF_AC);
  const u16* Tb_ctx = (const u16*)(p.ws + OFF_TC);
  const float* Eb = (const float*)(p.ws + OFF_X);
  const u16* QD = (const u16*)(p.ws + OFF_QD);
  const u16* AS = (const u16*)(p.ws + OFF_ASUM);
  const float* CD = (const float*)(p.ws + OFF_CD1);

  auto chunk_of = [&](int st) -> int {
    if (st < 4) return 512 + b * 4 + (d ? 3 - st : st);
    return b * 128 + (d ? 127 - (st - 4) : (st - 4));
  };

  auto stage_all = [&](int st, int buf) {
    const int sid = tid - 256;
    const int ci = chunk_of(st), row0 = ci * 64;
    char* sb = shm + buf * SC_BUF;
    if (DELTA) {
      const size_t it = ((size_t)ci * 8 + h) * 2 + d;
      const float* E = Eb + it * 256;
      const int c = sid >> 2, cc = (sid & 3) * 32;
      const u16* qsrc = qk + (size_t)(row0 + c) * 2048 + h * 128 + cc;
      const int c0 = (sid >> 4) * 4, dk0 = (sid & 15) * 8;
      const u16* ksrc = qk + (size_t)(row0 + c0) * 2048 + 1024 + h * 128 + dk0;
      u32x4 gq[4], gk[4], gT[2], gA[2];
#pragma unroll
      for (int u = 0; u < 4; ++u) gq[u] = *(const u32x4*)(qsrc + u * 8);
#pragma unroll
      for (int u = 0; u < 4; ++u) gk[u] = *(const u32x4*)(ksrc + (size_t)u * 2048);
#pragma unroll
      for (int u = 0; u < 2; ++u) {
        const int chunk = sid * 2 + u, tr = chunk >> 3, tc = (chunk & 7) * 8;
        const size_t itm = (size_t)ci * 8 + h;
        gT[u] = *(const u32x4*)((itm < TA_LAT_ITEMS ? Tb_lat : Tb_ctx) + ta_off(itm, d) + tr * 64 + tc);
        gA[u] = *(const u32x4*)((itm < TA_LAT_ITEMS ? Ag_lat : Ag_ctx) + ta_off(itm, d) + tr * 64 + tc);
      }
      const float e1 = E[c];
      const f32x4 bev = *(const f32x4*)(E + 64 + c0), e2v = *(const f32x4*)(E + 128 + c0);
      if (sid == 0) *(float*)(sb + SC_E) = E[192];
#pragma unroll
      for (int u = 0; u < 4; ++u) st8(sb + SC_Q + c * SC_QS + (cc + u * 8) * 2, scale8(gq[u], e1));
      const float be[4] = {bev.x, bev.y, bev.z, bev.w}, e2[4] = {e2v.x, e2v.y, e2v.z, e2v.w};
      u32x4 kt[4];
#pragma unroll
      for (int u = 0; u < 4; ++u) {
        st8(sb + SC_K + (c0 + u) * SC_QS + dk0 * 2, scale8(gk[u], -be[u]));
        kt[u] = scale8(gk[u], e2[u]);
      }
      const unsigned w[4][4] = {{kt[0].x, kt[0].y, kt[0].z, kt[0].w}, {kt[1].x, kt[1].y, kt[1].z, kt[1].w},
                                {kt[2].x, kt[2].y, kt[2].z, kt[2].w}, {kt[3].x, kt[3].y, kt[3].z, kt[3].w}};
#pragma unroll
      for (int jp = 0; jp < 4; ++jp) {
        u32x2 lo = {(w[0][jp] & 0xffffu) | (w[1][jp] << 16), (w[2][jp] & 0xffffu) | (w[3][jp] << 16)};
        u32x2 hi = {(w[0][jp] >> 16) | (w[1][jp] & 0xffff0000u), (w[2][jp] >> 16) | (w[3][jp] & 0xffff0000u)};
        *(u32x2*)(sb + SC_KT + (dk0 + 2 * jp) * 136 + c0 * 2) = lo;
        *(u32x2*)(sb + SC_KT + (dk0 + 2 * jp + 1) * 136 + c0 * 2) = hi;
      }
#pragma unroll
      for (int u = 0; u < 2; ++u) {
        const int chunk = sid * 2 + u, tr = chunk >> 3, tc = (chunk & 7) * 8;
        st8(sb + SC_T + tr * 136 + tc * 2, gT[u]);
        st8(sb + SC_A + tr * 136 + tc * 2, gA[u]);
      }
    } else {
      const size_t it = ((size_t)ci * 4 + h) * 2 + d;
      const u16* qd = QD + it * 16384;
      const int c = sid >> 2, cc = (sid & 3) * 32;
      const int kr = sid >> 1, kc = (sid & 1) * 32;
      u32x4 gq[4], gk[4], gA[2];
#pragma unroll
      for (int u = 0; u < 4; ++u) gq[u] = *(const u32x4*)(qd + c * 128 + cc + u * 8);
#pragma unroll
      for (int u = 0; u < 4; ++u) gk[u] = *(const u32x4*)(qd + 8192 + kr * 64 + kc + u * 8);
      if (d == 0) {
#pragma unroll
        for (int u = 0; u < 2; ++u) {
          const int chunk = sid * 2 + u, tr = chunk >> 3, tc = (chunk & 7) * 8;
          gA[u] = *(const u32x4*)(AS + ((size_t)ci * 4 + h) * 4096 + tr * 64 + tc);
        }
      }
      if (sid < 32) *(f32x4*)(sb + SC_E + sid * 16) = *(const f32x4*)(CD + it * 128 + sid * 4);
#pragma unroll
      for (int u = 0; u < 4; ++u) st8(sb + SC_Q + c * SC_QS + (cc + u * 8) * 2, gq[u]);
#pragma unroll
      for (int u = 0; u < 4; ++u) st8(sb + SC_KT + kr * 136 + (kc + u * 8) * 2, gk[u]);
      if (d == 0) {
#pragma unroll
        for (int u = 0; u < 2; ++u) {
          const int chunk = sid * 2 + u, tr = chunk >> 3, tc = (chunk & 7) * 8;
          st8(sb + SC_A + tr * 136 + tc * 2, gA[u]);
        }
      }
    }
  };

  f32x4 S[8];
#pragma unroll
  for (int t = 0; t < 8; ++t) S[t] = (f32x4){0.f, 0.f, 0.f, 0.f};
  u16 uraw[4][4];
  const int loff = (4 * q4) * 2048 + col0 + n16;
  auto u_issue = [&](int st) {
    const u16* up = Ub + (size_t)chunk_of(st) * (64 * 2048);
    const int lo = opq_v(loff);
#pragma unroll
    for (int mt = 0; mt < 4; ++mt)
#pragma unroll
      for (int i = 0; i < 4; ++i) uraw[mt][i] = up[lo + (16 * mt + i) * 2048];
  };

  if (compute) u_issue(0); else stage_all(0, 0);
  __syncthreads();

  for (int st = 0; st < 132; ++st) {
    const int buf = st & 1;
    const char* sb = shm + buf * SC_BUF;
    if (compute) {
      const int row0 = chunk_of(st) * 64;
      f32x4 Y[4], O[4];
#pragma unroll
      for (int mt = 0; mt < 4; ++mt) {
        Y[mt] = (f32x4){bf2f(uraw[mt][0]), bf2f(uraw[mt][1]), bf2f(uraw[mt][2]), bf2f(uraw[mt][3])};
        O[mt] = (f32x4){0.f, 0.f, 0.f, 0.f};
      }
#define SCHED_FENCE() __builtin_amdgcn_sched_barrier(0)
      s16x8 fT[8];
      if (DELTA) {
#pragma unroll
        for (int mt = 0; mt < 4; ++mt)
#pragma unroll
          for (int kc = 0; kc < 2; ++kc) fT[mt * 2 + kc] = ldA16(sb + SC_T, 16 * mt + n16, 136, 32 * kc, q4);
      }
      s16x8 fa[2][8];
#pragma unroll
      for (int mt = 0; mt < 4; ++mt) {
        if (DELTA) fa[0][mt] = ldA16(sb + SC_K, 16 * mt + n16, SC_QS, 0, q4);
        fa[0][4 + mt] = ldA16(sb + SC_Q, 16 * mt + n16, SC_QS, 0, q4);
      }
      SCHED_FENCE();
#pragma unroll
      for (int t = 0; t < 4; ++t) {
        if (t < 3) {
#pragma unroll
          for (int mt = 0; mt < 4; ++mt) {
            if (DELTA) fa[(t + 1) & 1][mt] = ldA16(sb + SC_K, 16 * mt + n16, SC_QS, 32 * (t + 1), q4);
            fa[(t + 1) & 1][4 + mt] = ldA16(sb + SC_Q, 16 * mt + n16, SC_QS, 32 * (t + 1), q4);
          }
        }
        SCHED_FENCE();
        const s16x8 Sb = pack16(S[2 * t], S[2 * t + 1]);
#pragma unroll
        for (int mt = 0; mt < 4; ++mt) {
          if (DELTA) Y[mt] = MFMA16(fa[t & 1][mt], Sb, Y[mt]);
          O[mt] = MFMA16(fa[t & 1][4 + mt], Sb, O[mt]);
        }
        SCHED_FENCE();
      }
      s16x8 fA[8];
      if (DELTA || d == 0) {
#pragma unroll
        for (int mt = 0; mt < 4; ++mt)
#pragma unroll
          for (int kc = 0; kc < 2; ++kc) fA[mt * 2 + kc] = ldA16(sb + SC_A, 16 * mt + n16, 136, 32 * kc, q4);
      }
      SCHED_FENCE();
      s16x8 vnb[2];
      if (DELTA) {
        s16x8 Yb[2];
        Yb[0] = pack16(Y[0], Y[1]); Yb[1] = pack16(Y[2], Y[3]);
        f32x4 vn[4];
#pragma unroll
        for (int mt = 0; mt < 4; ++mt) {
          vn[mt] = (f32x4){0.f, 0.f, 0.f, 0.f};
#pragma unroll
          for (int kc = 0; kc < 2; ++kc) vn[mt] = MFMA16(fT[mt * 2 + kc], Yb[kc], vn[mt]);
        }
        vnb[0] = pack16(vn[0], vn[1]); vnb[1] = pack16(vn[2], vn[3]);
      } else {
        vnb[0] = pack16(Y[0], Y[1]); vnb[1] = pack16(Y[2], Y[3]);
      }
      SCHED_FENCE();
      s16x8 fK[8];
#pragma unroll
      for (int t = 0; t < 4; ++t)
#pragma unroll
        for (int kc = 0; kc < 2; ++kc) fK[t * 2 + kc] = ldA16(sb + SC_KT, 16 * t + n16, 136, 32 * kc, q4);
      if (st + 1 < 132) u_issue(st + 1);
      SCHED_FENCE();
      if (DELTA || d == 0) {
#pragma unroll
        for (int mt = 0; mt < 4; ++mt)
#pragma unroll
          for (int kc = 0; kc < 2; ++kc) O[mt] = MFMA16(fA[mt * 2 + kc], vnb[kc], O[mt]);
      }
      if (DELTA) {
        const float cd = *(const float*)(sb + SC_E);
#pragma unroll
        for (int t = 0; t < 8; ++t) S[t] *= cd;
      } else {
#pragma unroll
        for (int t = 0; t < 8; ++t) {
          const f32x4 cv = *(const f32x4*)(sb + SC_E + (16 * t + 4 * q4) * 4);
          S[t] *= cv;
        }
      }
      SCHED_FENCE();
      s16x8 fK2[8];
#pragma unroll
      for (int t = 0; t < 4; ++t)
#pragma unroll
        for (int kc = 0; kc < 2; ++kc) fK2[t * 2 + kc] = ldA16(sb + SC_KT, 16 * (4 + t) + n16, 136, 32 * kc, q4);
      SCHED_FENCE();
#pragma unroll
      for (int t = 0; t < 4; ++t)
#pragma unroll
        for (int kc = 0; kc < 2; ++kc) S[t] = MFMA16(fK[t * 2 + kc], vnb[kc], S[t]);
      SCHED_FENCE();
#pragma unroll
      for (int t = 0; t < 4; ++t)
#pragma unroll
        for (int kc = 0; kc < 2; ++kc) S[4 + t] = MFMA16(fK2[t * 2 + kc], vnb[kc], S[4 + t]);
#undef SCHED_FENCE
      if (!DRY || p.out == nullptr)
#pragma unroll
      for (int mt = 0; mt < 4; ++mt) {
        const float ov[4] = {O[mt].x, O[mt].y, O[mt].z, O[mt].w};
        u16* op = Ub + (size_t)row0 * 2048;
        const int lo = opq_v(loff);
#pragma unroll
        for (int i = 0; i < 4; ++i) op[lo + (16 * mt + i) * 2048] = f2bf(ov[i]);
      }
    }
    else if (st + 1 < 132) stage_all(st + 1, buf ^ 1);
    asm volatile("s_waitcnt lgkmcnt(0)" ::: "memory");
    __builtin_amdgcn_s_barrier();
    asm volatile("" ::: "memory");
  }
}

DI void gla_prep_phase(char* shm, const Params& p, const int wave_s_) {
  const int tid = TIDX(), wave = tid >> 6, lane = tid & 63, r = lane & 31, hh = lane >> 5;
  char* sq = shm;
  char* sk = shm + 16896;
  char* sQa = shm + 33792;
  char* sKb = shm + 50688;
  float* sBC = (float*)(shm + 67584);
  float* sgl = (float*)(shm + 133120);
  const u16* qk1 = (const u16*)(p.ws + OFF_QK1);
  const float* gl = (const float*)(p.ws + OFF_ABT);
  u16* QD = (u16*)(p.ws + OFF_QD);
  u16* AS = (u16*)(p.ws + OFF_ASUM);
  float* CD = (float*)(p.ws + OFF_CD1);
  const float qscale = 0.08838834764831845f;
  for (int item = blockIdx.x; item < NCHUNK * 4; item += gridDim.x) {
    const int ci = item >> 2, h = item & 3, row0 = ci * 64;
#pragma unroll
    for (int u = 0; u < 2; ++u) {
      const int chunk = tid * 2 + u, c = chunk >> 4, cc = (chunk & 15) * 8;
      const u16* src = qk1 + (size_t)(row0 + c) * 1024 + h * 128 + cc;
      u32x4 vq = *(const u32x4*)src, vk = *(const u32x4*)(src + 512);
      st8(sq + c * 264 + cc * 2, vq);
      st8(sk + c * 264 + cc * 2, vk);
    }
    {
      const int rr = tid >> 3, cc = (tid & 7) * 4;
      *(f32x4*)(sgl + rr * 32 + cc) = *(const f32x4*)(gl + (size_t)(row0 + rr) * 32 + cc);
    }
    __syncthreads();
    {
      const int kk = tid & 127, d = (tid >> 7) & 1, chalf = tid >> 8;
      float w[16];
#pragma unroll
      for (int q = 0; q < 16; ++q) w[q] = p.gla_w_g2[(d * 16 + q) * 512 + h * 128 + kk];
      const float bg = p.gla_b_g[d * 512 + h * 128 + kk];
#pragma unroll 4
      for (int cc = 0; cc < 32; ++cc) {
        const int c = chalf * 32 + cc;
        const f32x4* gp = (const f32x4*)(sgl + c * 32 + d * 16);
        const f32x4 g0 = gp[0], g1 = gp[1], g2 = gp[2], g3 = gp[3];
        float z = bg;
        z += g0.x * w[0] + g0.y * w[1] + g0.z * w[2] + g0.w * w[3];
        z += g1.x * w[4] + g1.y * w[5] + g1.z * w[6] + g1.w * w[7];
        z += g2.x * w[8] + g2.y * w[9] + g2.z * w[10] + g2.w * w[11];
        z += g3.x * w[12] + g3.y * w[13] + g3.z * w[14] + g3.w * w[15];
        sBC[(d * 64 + c) * 128 + kk] = (fminf(z, 0.f) - __logf(1.f + __expf(-fabsf(z)))) * (1.f / 16.f);
      }
    }
    __syncthreads();
    if (tid < 256) {
      const int d = tid >> 7, kk = tid & 127;
      float* col = sBC + d * 64 * 128 + kk;
      float v[64];
#pragma unroll
      for (int c = 0; c < 64; ++c) v[c] = col[c * 128];
      if (d == 0) {
        float acc = 0.f;
#pragma unroll
        for (int c = 0; c < 64; ++c) { acc += v[c]; col[c * 128] = acc; }
      } else {
        float acc = 0.f;
#pragma unroll
        for (int c = 63; c >= 0; --c) { acc += v[c]; col[c * 128] = acc; }
      }
    }
    __syncthreads();
    f32x16 asum;
    for (int i = 0; i < 16; ++i) asum[i] = 0.f;
    for (int d = 0; d < 2; ++d) {
      const int cref = d ? 31 : 32, clast = d ? 0 : 63;
      const float* bcd = sBC + d * 64 * 128;
      u16* qd_o = QD + ((size_t)item * 2 + d) * 16384;
      float er[8], ern[8];
      {
        const int k0 = (tid & 15) * 8;
#pragma unroll
        for (int e = 0; e < 8; ++e) { const float rf = bcd[cref * 128 + k0 + e]; er[e] = __expf(rf); ern[e] = __expf(-rf); }
      }
      for (int v = tid; v < 1024; v += 512) {
        const int c = v >> 4, k0 = (v & 15) * 8;
        const u32x4 qv = *(const u32x4*)(sq + c * 264 + k0 * 2), kv = *(const u32x4*)(sk + c * 264 + k0 * 2);
        const unsigned qa[4] = {qv.x, qv.y, qv.z, qv.w}, ka[4] = {kv.x, kv.y, kv.z, kv.w};
        float oqa[8], okb[8], oqd[8];
#pragma unroll
        for (int e = 0; e < 8; ++e) {
          const float ebc = __expf(bcd[c * 128 + k0 + e]);
          const float qf = ((e & 1) ? bfhi(qa[e >> 1]) : bflo(qa[e >> 1])) * qscale;
          const float kf = (e & 1) ? bfhi(ka[e >> 1]) : bflo(ka[e >> 1]);
          oqd[e] = qf * ebc;
          oqa[e] = oqd[e] * ern[e];
          okb[e] = kf * er[e] * __builtin_amdgcn_rcpf(ebc);
        }
        st8(sQa + c * 264 + k0 * 2, (u32x4){pk2(oqa[0], oqa[1]), pk2(oqa[2], oqa[3]), pk2(oqa[4], oqa[5]), pk2(oqa[6], oqa[7])});
        st8(sKb + c * 264 + k0 * 2, (u32x4){pk2(okb[0], okb[1]), pk2(okb[2], okb[3]), pk2(okb[4], okb[5]), pk2(okb[6], okb[7])});
        *(u32x4*)(qd_o + c * 128 + k0) = (u32x4){pk2(oqd[0], oqd[1]), pk2(oqd[2], oqd[3]), pk2(oqd[4], oqd[5]), pk2(oqd[6], oqd[7])};
      }
      for (int v = tid; v < 1024; v += 512) {
        const int kk = v >> 3, c0 = (v & 7) * 8;
        const float last = bcd[clast * 128 + kk];
        float o[8];
#pragma unroll
        for (int e = 0; e < 8; ++e) {
          const int c = c0 + e;
          const float kf = bf2f(*(const u16*)(sk + c * 264 + kk * 2));
          o[e] = kf * __expf(last - bcd[c * 128 + kk]);
        }
        *(u32x4*)(qd_o + 8192 + kk * 64 + c0) = (u32x4){pk2(o[0], o[1]), pk2(o[2], o[3]), pk2(o[4], o[5]), pk2(o[6], o[7])};
      }
      if (tid < 128) CD[((size_t)item * 2 + d) * 128 + tid] = __expf(bcd[clast * 128 + tid]);
      __syncthreads();
      if (wave < 4) {
        const int tm = wave >> 1, tn = wave & 1;
        f32x16 acc;
        for (int i = 0; i < 16; ++i) acc[i] = 0.f;
#pragma unroll
        for (int s = 0; s < 8; ++s) {
          s16x8 a = ldA_nat(sQa, 32 * tm + r, 264, 16 * s, hh), bb = ldA_nat(sKb, 32 * tn + r, 264, 16 * s, hh);
          acc = MFMA32(a, bb, acc);
        }
#pragma unroll
        for (int i = 0; i < 16; ++i) {
          const int ii = 32 * tm + crow(i, hh), jj = 32 * tn + r;
          const bool keep = d ? (ii <= jj) : (ii >= jj);
          asum[i] += keep ? acc[i] : 0.f;
        }
      }
      __syncthreads();
    }
    if (wave < 4) {
      const int tm = wave >> 1, tn = wave & 1;
#pragma unroll
      for (int i = 0; i < 16; ++i) AS[(size_t)item * 4096 + (32 * tm + crow(i, hh)) * 64 + 32 * tn + r] = f2bf(asum[i]);
    }
  }
}

template <int GROUP>
DI void yg_phase(u16* o0, const u16* o1, const u16* z, const u16* zctx, const float* ng, int nrows, const int wave_s_) {
  const int gt = blockIdx.x * 512 + TIDX(), nthr = gridDim.x * 512;
  const int total = nrows * 256;
  for (int idx0 = gt; idx0 < total; idx0 += 2 * nthr) {
    const bool ok1 = idx0 + nthr < total;
    u32x4 a[2], bq[2], zz[2];
#pragma unroll
    for (int u = 0; u < 2; ++u) {
      const int idx = (u == 0 || ok1) ? idx0 + u * nthr : idx0;
      const size_t off = (size_t)(idx >> 8) * 2048 + (idx & 255) * 8;
      const int zrow = idx >> 8;
      const u16* zp = (zrow < RL) ? z + off : zctx + (size_t)(zrow - RL) * 2048 + (idx & 255) * 8;
      a[u] = __builtin_nontemporal_load((const u32x4*)(o0 + off)); bq[u] = __builtin_nontemporal_load((const u32x4*)(o1 + off)); zz[u] = __builtin_nontemporal_load((const u32x4*)zp);
    }
#pragma unroll
    for (int u = 0; u < 2; ++u) {
      if (u == 1 && !ok1) break;
      const int idx = idx0 + u * nthr, ch = (idx & 255) * 8;
      const size_t off = (size_t)(idx >> 8) * 2048 + ch;
      float o[8] = {bflo(a[u].x) + bflo(bq[u].x), bfhi(a[u].x) + bfhi(bq[u].x), bflo(a[u].y) + bflo(bq[u].y), bfhi(a[u].y) + bfhi(bq[u].y),
                    bflo(a[u].z) + bflo(bq[u].z), bfhi(a[u].z) + bfhi(bq[u].z), bflo(a[u].w) + bflo(bq[u].w), bfhi(a[u].w) + bfhi(bq[u].w)};
      const float zf[8] = {bflo(zz[u].x), bfhi(zz[u].x), bflo(zz[u].y), bfhi(zz[u].y), bflo(zz[u].z), bfhi(zz[u].z), bflo(zz[u].w), bfhi(zz[u].w)};
      float ss = 0.f;
#pragma unroll
      for (int e = 0; e < 8; ++e) ss += o[e] * o[e];
#pragma unroll
      for (int of = 1; of < GROUP; of <<= 1) ss += __shfl_xor(ss, of, 64);
      const float rstd = rsqrtf(ss * (1.f / (GROUP * 8)) + EPSF);
      const int gi = ch & (GROUP * 8 - 1);
      const f32x4 g0 = *(const f32x4*)(ng + gi), g1 = *(const f32x4*)(ng + gi + 4);
      const float gg[8] = {g0.x, g0.y, g0.z, g0.w, g1.x, g1.y, g1.z, g1.w};
#pragma unroll
      for (int e = 0; e < 8; ++e) o[e] = o[e] * rstd * gg[e] * siluf(zf[e]);
      *(u32x4*)(o0 + off) = (u32x4){pk2(o[0], o[1]), pk2(o[2], o[3]), pk2(o[4], o[5]), pk2(o[6], o[7])};
    }
  }
}

DI void final_phase(float* out, const float* g, const int wave_s_) {
  const int tidx_ = TIDX();
  const int lane = tidx_ & 63, gw = blockIdx.x * 8 + (tidx_ >> 6), nw = gridDim.x * 8;
  for (int row0 = gw; row0 < RL; row0 += 2 * nw) {
    const int rows[2] = {row0, row0 + nw};
    const bool ok1 = rows[1] < RL;
    f32x4 v[2][4];
#pragma unroll
    for (int u = 0; u < 2; ++u) {
      const float* s = out + (size_t)((u == 0 || ok1) ? rows[u] : rows[0]) * DM;
#pragma unroll
      for (int q = 0; q < 4; ++q) v[u][q] = __builtin_nontemporal_load((const f32x4*)(s + q * 256 + lane * 4));
    }
#pragma unroll
    for (int u = 0; u < 2; ++u) {
      if (u == 1 && !ok1) break;
      float* s = out + (size_t)rows[u] * DM;
      float ss = 0.f;
#pragma unroll
      for (int q = 0; q < 4; ++q) ss += v[u][q].x * v[u][q].x + v[u][q].y * v[u][q].y + v[u][q].z * v[u][q].z + v[u][q].w * v[u][q].w;
      ss = wave_sum(ss);
      const float rstd = rsqrtf(ss * (1.f / 1024.f) + EPSF);
#pragma unroll
      for (int q = 0; q < 4; ++q) {
        const f32x4 gg = *(const f32x4*)(g + q * 256 + lane * 4);
        f32x4 o = {v[u][q].x * rstd * gg.x, v[u][q].y * rstd * gg.y, v[u][q].z * rstd * gg.z, v[u][q].w * rstd * gg.w};
        __builtin_nontemporal_store(o, (f32x4*)(s + q * 256 + lane * 4));
      }
    }
  }
}

#define XB_XSUB(j)  (64 * (j))
#define XB_XGEN(j)  (1024 + 64 * (j))
#define XB_TOP      2048
#define XB_TOPGEN   2112
#define XCD_BAR_WORDS 2176
DI unsigned xb_ld(unsigned* p) { return __hip_atomic_load(p, __ATOMIC_RELAXED, __HIP_MEMORY_SCOPE_AGENT); }
DI unsigned xb_add(unsigned* p, unsigned v) { return __hip_atomic_fetch_add(p, v, __ATOMIC_RELAXED, __HIP_MEMORY_SCOPE_AGENT); }
DI void gbar(char* ws, const int wave_s_) {
  asm volatile("s_waitcnt vmcnt(0)" ::: "memory");
  __syncthreads();
  if (wave_s_ == 0 && lane_id() == 0) {
    unsigned* bar = (unsigned*)(ws + OFF_BAR);
    __builtin_amdgcn_s_waitcnt(0);
    const unsigned x = (unsigned)__builtin_amdgcn_s_getreg((3 << 11) | 20) & 0xFu;
    const unsigned nloc = gridDim.x >> 3, nx = 8u;
    const unsigned old = xb_add(&bar[XB_XSUB(x)], 1u);
    const unsigned gen = old / nloc;
    if (old + 1u == (gen + 1u) * nloc) {
      __builtin_amdgcn_fence(__ATOMIC_RELEASE, "agent");
      asm volatile("s_waitcnt vmcnt(0)" ::: "memory");
      const unsigned og = xb_add(&bar[XB_TOP], 1u);
      const unsigned tg = og / nx;
      if (og + 1u == (tg + 1u) * nx) xb_add(&bar[XB_TOPGEN], 1u);
      else while (xb_ld(&bar[XB_TOPGEN]) == tg) __builtin_amdgcn_s_sleep(1);
      __builtin_amdgcn_fence(__ATOMIC_ACQUIRE, "agent");
      xb_add(&bar[XB_XGEN(x)], 1u);
      asm volatile("s_waitcnt vmcnt(0)" ::: "memory");
    } else {
      while (xb_ld(&bar[XB_XGEN(x)]) == gen) __builtin_amdgcn_s_sleep(1);
      __builtin_amdgcn_fence(__ATOMIC_ACQUIRE, "agent");
      asm volatile("s_waitcnt vmcnt(0)" ::: "memory");
    }
  }
  __syncthreads();
}
#ifndef REP_GEMM
#define REP_GEMM 1
#endif
#ifndef REP_PREP
#define REP_PREP 1
#endif
#ifndef REP_GLP
#define REP_GLP 1
#endif
#ifndef REP_SCAN
#define REP_SCAN 0
#endif
#ifndef REP_SYNC
#define REP_SYNC 0
#endif
#ifndef REP_EW
#define REP_EW 1
#endif
__global__ void __launch_bounds__(512, 2) fwd_megakernel(Params p) {
  __shared__ __attribute__((aligned(1024))) char shm[141312];
  cg::grid_group grid = cg::this_grid();
  const int wave_s_ = __builtin_amdgcn_readfirstlane((int)(threadIdx.x >> 6));
  char* ws = p.ws;
  float* mods = (float*)(ws + OFF_MOD);
  u16* W0T = (u16*)(ws + OFF_W0T);
  u16* WO0T = (u16*)(ws + OFF_WO0T);
  u16* W1T = (u16*)(ws + OFF_W1T);
  u16* WO1T = (u16*)(ws + OFF_WO1T);
  u16* outb = (u16*)p.out;
  float* ctx1 = (float*)(ws + OFF_X);

  mods_phase(shm, p, wave_s_);
  wtrans_phase<0>(shm, p, wave_s_);
  grid.sync();
  {
    u16* H0 = (u16*)(ws + OFF_T);
    h_phase(p.x, p.ctx, p.norm_g, mods, H0, R, wave_s_);
    gbar(ws, wave_s_);
#if REP_EW > 1
    h_phase(p.x, p.ctx, p.norm_g, mods, H0, R, wave_s_);
    gbar(ws, wave_s_);
#endif
    small_gemm(H0, W0T + (size_t)6144 * 1024, (float*)(ws + OFF_ABT), wave_s_);
    EpiArgs e{};
    e.mode = 0; e.lat = outb; e.ctx = (u16*)(ws + OFF_X); e.ld = 2048;
    gemm_phase<0>(shm, H0, H0 + (size_t)RL * 1024, 1024, W0T, 0, 128, 8, e, wave_s_);
    {
      EpiArgs ec{};
      ec.mode = 4; ec.ctx = (u16*)(ws + OFF_X);
      gemm_phase<4>(shm, H0, H0 + (size_t)RL * 1024, 1024, W0T, 128, 4, 24, ec, wave_s_);
    }
    gbar(ws, wave_s_);
#if REP_GEMM > 1
    gemm_phase<0>(shm, H0, H0 + (size_t)RL * 1024, 1024, W0T, 0, 132, 8, e, wave_s_);
    gbar(ws, wave_s_);
#endif
    conv_phase<false>(p, wave_s_);
    gbar(ws, wave_s_);
#if REP_EW > 1
    conv_phase<false>(p, wave_s_);
    gbar(ws, wave_s_);
#endif
    gemm_phase<0>(shm, H0, H0 + (size_t)RL * 1024, 1024, W0T + (size_t)2048 * 1024, 0, 128, 8, e, wave_s_);
    gbar(ws, wave_s_);
#if REP_GEMM > 1
    gemm_phase<0>(shm, H0, H0 + (size_t)RL * 1024, 1024, W0T + (size_t)2048 * 1024, 0, 132, 8, e, wave_s_);
    gbar(ws, wave_s_);
#endif
    conv_phase<true>(p, wave_s_);
    gbar(ws, wave_s_);
#if REP_EW > 1
    conv_phase<true>(p, wave_s_);
    gbar(ws, wave_s_);
#endif
    for (int rep_ = 0; rep_ < REP_PREP; ++rep_) {
    dn_prep_phase(shm, p, wave_s_);
    gbar(ws, wave_s_);
    }
    for (int rep_ = 0; rep_ < REP_SCAN; ++rep_) { scan_phase<true, true>(shm, p, wave_s_); gbar(ws, wave_s_); }
    for (int rep_ = 0; rep_ < REP_SYNC; ++rep_) gbar(ws, wave_s_);
    scan_phase<true>(shm, p, wave_s_);
    gbar(ws, wave_s_);
    u16* H0b = H0;
    u16* Z = (u16*)(ws + OFF_QK0);
    EpiArgs ez{};
    ez.mode = 0; ez.lat = Z; ez.ctx = Z + (size_t)RL * 2048; ez.ld = 2048;
    gemm_phase<0>(shm, H0b, H0b + (size_t)RL * 1024, 1024, W0T + (size_t)4096 * 1024, 0, 128, 8, ez, wave_s_);
    gbar(ws, wave_s_);
#if REP_GEMM > 1
    gemm_phase<0>(shm, H0b, H0b + (size_t)RL * 1024, 1024, W0T + (size_t)4096 * 1024, 0, 132, 8, ez, wave_s_);
    gbar(ws, wave_s_);
#endif
    u16* U0 = (u16*)(ws + OFF_U0);
    yg_phase<32>(U0, (const u16*)(ws + OFF_U1), Z, (const u16*)(ws + OFF_ZC), p.dn_norm_g, R, wave_s_);
    gbar(ws, wave_s_);
    EpiArgs eo{};
    eo.mode = 2; eo.res_lat = p.x; eo.res_ctx = p.ctx; eo.mods_i = mods; eo.out_lat = p.out; eo.out_ctx = ctx1;
    gemm_phase<2>(shm, U0, U0 + (size_t)RL * 2048, 2048, WO0T, 0, 132, 4, eo, wave_s_);
    gbar(ws, wave_s_);
#if REP_GEMM > 1
    gemm_phase<2>(shm, U0, U0 + (size_t)RL * 2048, 2048, WO0T, 0, 132, 4, eo, wave_s_);
    gbar(ws, wave_s_);
#endif
  }
  {
    const float* mods1 = mods + 5 * 3072;
    u16* H1 = (u16*)(ws + OFF_QD);
    h_phase(p.out, ctx1, p.norm_g + 1024, mods1, H1, R, wave_s_);
    wtrans_phase<1>(shm, p, wave_s_);
    gbar(ws, wave_s_);
    small_gemm(H1, W1T + (size_t)5120 * 1024, (float*)(ws + OFF_ABT), wave_s_);
    EpiArgs e{};
    e.mode = 1; e.lat = (u16*)(ws + OFF_QK1); e.b1 = (u16*)(ws + OFF_V0); e.b2 = (u16*)(ws + OFF_V1);
    gemm_phase<1>(shm, H1, H1 + (size_t)RL * 1024, 1024, W1T, 0, 132, 12, e, wave_s_);
    gbar(ws, wave_s_);
    for (int rep_ = 0; rep_ < REP_GLP; ++rep_) {
    gla_prep_phase(shm, p, wave_s_);
    gbar(ws, wave_s_);
    }
    for (int rep_ = 0; rep_ < REP_SCAN; ++rep_) { scan_phase<false, true>(shm, p, wave_s_); gbar(ws, wave_s_); }
    scan_phase<false>(shm, p, wave_s_);
    gbar(ws, wave_s_);
    u16* H1b = (u16*)(ws + OFF_QK1);
    h_phase(p.out, ctx1, p.norm_g + 1024, mods1, H1b, RL, wave_s_);
    gbar(ws, wave_s_);
    u16* RB = (u16*)(ws + OFF_QD);
    EpiArgs er{};
    er.mode = 0; er.lat = RB; er.ctx = RB; er.ld = 2048;
    gemm_phase<0>(shm, H1b, H1b, 1024, W1T + (size_t)3072 * 1024, 0, 128, 8, er, wave_s_);
    gbar(ws, wave_s_);
    u16* V0 = (u16*)(ws + OFF_V0);
    yg_phase<64>(V0, (const u16*)(ws + OFF_V1), RB, RB, p.gla_norm_g, RL, wave_s_);
    gbar(ws, wave_s_);
    EpiArgs eo{};
    eo.mode = 2; eo.res_lat = p.out; eo.res_ctx = p.out; eo.mods_i = mods1; eo.out_lat = p.out; eo.out_ctx = p.out;
    gemm_phase<2>(shm, V0, V0, 2048, WO1T, 0, 128, 4, eo, wave_s_);
    gbar(ws, wave_s_);
    final_phase(p.out, p.final_g, wave_s_);
  }
}

extern "C" void kernel_launch(void* const* d_in, const int* in_sizes, int n_in, void* d_out, int out_size, void* d_ws,
                              size_t ws_size, hipStream_t stream) {
  static int grid_blocks = 0;
  if (!grid_blocks) {
    int dev = 0, cus = 0, per_cu = 0;
    hipGetDevice(&dev);
    hipDeviceGetAttribute(&cus, hipDeviceAttributeMultiprocessorCount, dev);
    hipOccupancyMaxActiveBlocksPerMultiprocessor(&per_cu, fwd_megakernel, 512, 0);
    if (per_cu < 1) per_cu = 1;
    grid_blocks = cus;
    if (grid_blocks > 256) grid_blocks = 256;
  }
  Params p{};
  p.x = (const float*)d_in[0]; p.c = (const float*)d_in[1]; p.ctx = (const float*)d_in[2]; p.c_ctx = (const float*)d_in[3];
  p.mod_w = (const float*)d_in[4]; p.mod_b = (const float*)d_in[5]; p.norm_g = (const float*)d_in[6];
  p.dn_w_in = (const float*)d_in[7]; p.dn_conv_w = (const float*)d_in[8]; p.dn_a_log = (const float*)d_in[9];
  p.dn_dt_bias = (const float*)d_in[10]; p.dn_norm_g = (const float*)d_in[11]; p.dn_w_out = (const float*)d_in[12];
  p.gla_w_in = (const float*)d_in[13]; p.gla_w_g2 = (const float*)d_in[14]; p.gla_b_g = (const float*)d_in[15];
  p.gla_norm_g = (const float*)d_in[16]; p.gla_w_out = (const float*)d_in[17]; p.final_g = (const float*)d_in[18];
  p.out = (float*)d_out;
  p.ws = (char*)d_ws;
  (void)hipMemsetAsync((char*)d_ws + OFF_BAR, 0, XCD_BAR_WORDS * sizeof(unsigned), stream);
  void* args[] = {&p};
  hipError_t e = hipLaunchCooperativeKernel((void*)fwd_megakernel, dim3(grid_blocks), dim3(512), args, 0, stream);
  if (e != hipSuccess) fprintf(stderr, "cooperative launch failed: %s (grid %d)\n", hipGetErrorString(e), grid_blocks);
}
```

```cpp
#include <hip/hip_runtime.h>
#include <hip/hip_cooperative_groups.h>
#include <cstdio>
namespace cg = cooperative_groups;

#define DI __device__ __forceinline__
typedef unsigned short u16;
typedef short s16x8 __attribute__((ext_vector_type(8)));
typedef short s16x4 __attribute__((ext_vector_type(4)));
typedef float f32x2 __attribute__((ext_vector_type(2)));
typedef float f32x4 __attribute__((ext_vector_type(4)));
typedef float f32x16 __attribute__((ext_vector_type(16)));
typedef int i32x4 __attribute__((ext_vector_type(4)));
typedef unsigned u32x2 __attribute__((ext_vector_type(2)));
typedef unsigned u32x4 __attribute__((ext_vector_type(4)));
typedef __bf16 bf2_t __attribute__((ext_vector_type(2)));

constexpr int RL = 32768;
constexpr int RC = 1024;
constexpr int R = RL + RC;
constexpr int DM = 1024;
constexpr int NCHUNK = R / 64;
constexpr float EPSF = 1e-6f;
constexpr size_t MiB = 1u << 20;

constexpr size_t OFF_QK0 = 0;
constexpr size_t OFF_U0 = 132 * MiB;
constexpr size_t OFF_U1 = 264 * MiB;
constexpr size_t OFF_T = 396 * MiB;
constexpr size_t OFF_W1T = 462 * MiB;
constexpr size_t OFF_WO1T = OFF_W1T + 10 * MiB + 256 * 1024;
constexpr size_t OFF_MOD = OFF_WO1T + 4 * MiB;
constexpr size_t OFF_X = OFF_MOD + 256 * 1024;
constexpr size_t OFF_ABT = OFF_X + 8 * MiB + 256 * 1024;
constexpr size_t OFF_W0T = OFF_ABT + 4 * MiB + 256 * 1024;
constexpr size_t OFF_WO0T = OFF_W0T + 12 * MiB + 256 * 1024;
constexpr size_t OFF_V0 = 0;
constexpr size_t OFF_V1 = 132 * MiB;
constexpr size_t OFF_QK1 = 264 * MiB;
constexpr size_t OFF_QD = 330 * MiB;
constexpr size_t OFF_CD1 = OFF_X + 4 * MiB;
constexpr size_t OFF_ASUM = OFF_W0T;
constexpr size_t OFF_BAR = 506 * MiB;
constexpr size_t OFF_ZC = 507 * MiB;

constexpr size_t TA_LAT_ITEMS = 4096;
constexpr size_t OFF_TC = 462 * MiB;
constexpr size_t OFF_AC = 464 * MiB;
DI size_t ta_off(size_t item, int d) { return ((item < TA_LAT_ITEMS ? item : item - TA_LAT_ITEMS) * 2 + d) * 4096; }
struct Params {
  const float *x, *c, *ctx, *c_ctx, *mod_w, *mod_b, *norm_g, *dn_w_in, *dn_conv_w, *dn_a_log, *dn_dt_bias, *dn_norm_g,
      *dn_w_out, *gla_w_in, *gla_w_g2, *gla_b_g, *gla_norm_g, *gla_w_out, *final_g;
  float* out;
  char* ws;
};

DI unsigned pk2(float lo, float hi) { f32x2 v = {lo, hi}; return __builtin_bit_cast(unsigned, __builtin_convertvector(v, bf2_t)); }
DI float bflo(unsigned u) { return __uint_as_float(u << 16); }
DI float bfhi(unsigned u) { return __uint_as_float(u & 0xffff0000u); }
DI float bf2f(u16 v) { return __uint_as_float(((unsigned)v) << 16); }
DI u16 f2bf(float x) { return (u16)(pk2(x, 0.f) & 0xffffu); }
DI float siluf(float x) { return x / (1.f + __expf(-x)); }
DI float sigmoidf(float x) { return 1.f / (1.f + __expf(-x)); }
DI float softplusf(float x) { return fmaxf(x, 0.f) + __logf(1.f + __expf(-fabsf(x))); }
DI int crow(int reg, int h) { return (reg & 3) + 8 * (reg >> 2) + 4 * h; }
#define MFMA32(a, b, c) __builtin_amdgcn_mfma_f32_32x32x16_bf16((a), (b), (c), 0, 0, 0)
#define MFMA16(a, b, c) __builtin_amdgcn_mfma_f32_16x16x32_bf16((a), (b), (c), 0, 0, 0)

DI s16x8 cat8(u32x2 lo, u32x2 hi) { u32x4 v = {lo.x, lo.y, hi.x, hi.y}; return __builtin_bit_cast(s16x8, v); }
DI s16x8 ldA_perm(const char* base, int row, int strideB, int kofs, int h) {
  const char* p = base + row * strideB + (kofs + 4 * h) * 2;
  u32x2 lo = *(const u32x2*)p, hi = *(const u32x2*)(p + 16);
  return cat8(lo, hi);
}
DI s16x8 ldA_nat(const char* base, int row, int strideB, int kofs, int h) {
  const char* p = base + row * strideB + (kofs + 8 * h) * 2;
  u32x2 lo = *(const u32x2*)p, hi = *(const u32x2*)(p + 8);
  return cat8(lo, hi);
}
DI s16x8 pack_step(const f32x16& x, int s) {
  u32x4 p;
  p.x = pk2(x[8 * s + 0], x[8 * s + 1]); p.y = pk2(x[8 * s + 2], x[8 * s + 3]);
  p.z = pk2(x[8 * s + 4], x[8 * s + 5]); p.w = pk2(x[8 * s + 6], x[8 * s + 7]);
  return __builtin_bit_cast(s16x8, p);
}
DI void st8(char* p, u32x4 v) { *(u32x2*)p = (u32x2){v.x, v.y}; *(u32x2*)(p + 8) = (u32x2){v.z, v.w}; }
DI u32x4 scale8(u32x4 v, float s) {
  u32x4 o;
  o.x = pk2(bflo(v.x) * s, bfhi(v.x) * s); o.y = pk2(bflo(v.y) * s, bfhi(v.y) * s);
  o.z = pk2(bflo(v.z) * s, bfhi(v.z) * s); o.w = pk2(bflo(v.w) * s, bfhi(v.w) * s);
  return o;
}
DI int opq_v(int v) { asm volatile("" : "+v"(v)); return v; }
DI int lane_id() { int r; asm volatile("v_mbcnt_lo_u32_b32 %0, -1, 0\n\tv_mbcnt_hi_u32_b32 %0, -1, %0" : "=v"(r)); return r; }
#define TIDX() (wave_s_ * 64 + lane_id())
DI float wave_sum(float v) {
#pragma unroll
  for (int o = 32; o >= 1; o >>= 1) v += __shfl_xor(v, o, 64);
  return v;
}

DI void mods_phase(char* shm, const Params& p, const int wave_s_) {
  const int bid = blockIdx.x, tid = TIDX();
  float* mods = (float*)(p.ws + OFF_MOD);
  if (bid < 192) {
    float* scond = (float*)shm;
    float* red = scond + 5 * 1024;
    for (int e = tid; e < 5 * 1024; e += 512) {
      int r = e >> 10, k = e & 1023;
      float v = (r < 4) ? p.c[r * 1024 + k] : p.c_ctx[k];
      scond[e] = siluf(v);
    }
    __syncthreads();
    const int i = bid / 96, jt = bid % 96, jl = tid & 31, ks = tid >> 5;
    const float* w = p.mod_w + (size_t)i * 1024 * 3072 + jt * 32 + jl;
    float a0 = 0, a1 = 0, a2 = 0, a3 = 0, a4 = 0;
#pragma unroll 8
    for (int kk = 0; kk < 64; ++kk) {
      int k = ks * 64 + kk;
      float wv = __builtin_nontemporal_load(w + (size_t)k * 3072);
      a0 += scond[k] * wv; a1 += scond[1024 + k] * wv; a2 += scond[2048 + k] * wv; a3 += scond[3072 + k] * wv; a4 += scond[4096 + k] * wv;
    }
    red[(ks * 5 + 0) * 32 + jl] = a0; red[(ks * 5 + 1) * 32 + jl] = a1; red[(ks * 5 + 2) * 32 + jl] = a2;
    red[(ks * 5 + 3) * 32 + jl] = a3; red[(ks * 5 + 4) * 32 + jl] = a4;
    __syncthreads();
    if (tid < 160) {
      int r = tid >> 5, j = tid & 31;
      float s = p.mod_b[i * 3072 + jt * 32 + j];
      for (int q = 0; q < 16; ++q) s += red[(q * 5 + r) * 32 + j];
      mods[(i * 5 + r) * 3072 + jt * 32 + j] = s;
    }
    __syncthreads();
  }
}

DI void wtrans_tile(char* shm, const float* src, int K, int N, u16* dst, int tile, const int wave_s_) {
  u16* t = (u16*)shm;
  const int tid = TIDX();
  const int tn = (N + 63) / 64;
  const int k0 = (tile / tn) * 64, n0 = (tile % tn) * 64;
#pragma unroll
  for (int q = 0; q < 2; ++q) {
    const int e = tid + q * 512, kk = e >> 4, nn = (e & 15) * 4;
    f32x4 v = {0.f, 0.f, 0.f, 0.f};
    if (n0 + nn < N) v = __builtin_nontemporal_load((const f32x4*)(src + (size_t)(k0 + kk) * N + n0 + nn));
    t[(nn + 0) * 72 + kk] = f2bf(v.x); t[(nn + 1) * 72 + kk] = f2bf(v.y);
    t[(nn + 2) * 72 + kk] = f2bf(v.z); t[(nn + 3) * 72 + kk] = f2bf(v.w);
  }
  __syncthreads();
  {
    const int nn = tid >> 3, kk = (tid & 7) * 8;
    if (n0 + nn < N) *(u32x4*)(dst + (size_t)(n0 + nn) * K + k0 + kk) = *(const u32x4*)(t + nn * 72 + kk);
  }
  __syncthreads();
}
template <int LAYER>
DI void wtrans_phase(char* shm, const Params& p, const int wave_s_) {
  const int t0 = 16 * 97, t1 = 32 * 16, t2 = 16 * 81, t3 = 32 * 16;
  if (LAYER == 0) {
    for (int tile = blockIdx.x; tile < t0 + t1; tile += gridDim.x) {
      if (tile < t0) wtrans_tile(shm, p.dn_w_in, 1024, 6176, (u16*)(p.ws + OFF_W0T), tile, wave_s_);
      else wtrans_tile(shm, p.dn_w_out, 2048, 1024, (u16*)(p.ws + OFF_WO0T), tile - t0, wave_s_);
    }
  } else {
    for (int tile = blockIdx.x; tile < t2 + t3; tile += gridDim.x) {
      if (tile < t2) wtrans_tile(shm, p.gla_w_in, 1024, 5152, (u16*)(p.ws + OFF_W1T), tile, wave_s_);
      else wtrans_tile(shm, p.gla_w_out, 2048, 1024, (u16*)(p.ws + OFF_WO1T), tile - t2, wave_s_);
    }
  }
}

DI void h_phase(const float* src_lat, const float* src_ctx, const float* g, const float* mods_i, u16* dst, int nrows, const int wave_s_) {
  const int tidx_ = TIDX();
  const int lane = tidx_ & 63, gw = blockIdx.x * 8 + (tidx_ >> 6), nw = gridDim.x * 8;
  for (int row0 = gw; row0 < nrows; row0 += 2 * nw) {
    const int rows[2] = {row0, row0 + nw};
    const bool ok1 = rows[1] < nrows;
    f32x4 v[2][4];
#pragma unroll
    for (int u = 0; u < 2; ++u) {
      const int row = (u == 0 || ok1) ? rows[u] : rows[0];
      const float* s = (row < RL) ? src_lat + (size_t)row * DM : src_ctx + (size_t)(row - RL) * DM;
#pragma unroll
      for (int q = 0; q < 4; ++q) v[u][q] = __builtin_nontemporal_load((const f32x4*)(s + q * 256 + lane * 4));
    }
#pragma unroll
    for (int u = 0; u < 2; ++u) {
      if (u == 1 && !ok1) break;
      const int row = rows[u];
      const int mr = (row < RL) ? (row >> 13) : 4;
      const float* sh = mods_i + mr * 3072;
      const float* sc = sh + 1024;
      float ss = 0.f;
#pragma unroll
      for (int q = 0; q < 4; ++q) ss += v[u][q].x * v[u][q].x + v[u][q].y * v[u][q].y + v[u][q].z * v[u][q].z + v[u][q].w * v[u][q].w;
      ss = wave_sum(ss);
      const float rstd = rsqrtf(ss * (1.f / 1024.f) + EPSF);
#pragma unroll
      for (int q = 0; q < 4; ++q) {
        const int col = q * 256 + lane * 4;
        f32x4 gg = *(const f32x4*)(g + col), s1 = *(const f32x4*)(sc + col), s0 = *(const f32x4*)(sh + col);
        float o0 = v[u][q].x * rstd * gg.x * (1.f + s1.x) + s0.x, o1 = v[u][q].y * rstd * gg.y * (1.f + s1.y) + s0.y;
        float o2 = v[u][q].z * rstd * gg.z * (1.f + s1.z) + s0.z, o3 = v[u][q].w * rstd * gg.w * (1.f + s1.w) + s0.w;
        *(u32x2*)(dst + (size_t)row * DM + col) = (u32x2){pk2(o0, o1), pk2(o2, o3)};
      }
    }
  }
}

DI void small_gemm(const u16* A, const u16* Wt, float* out, const int wave_s_) {
  const int tidx_ = TIDX();
  if ((blockIdx.x & 7) == 0) return;
  const int bsub = (int)blockIdx.x - 1 - ((int)blockIdx.x >> 3);
  const int lane = tidx_ & 63, gw = bsub * 8 + (tidx_ >> 6), nw = (gridDim.x - (gridDim.x >> 3)) * 8;
  const int r = lane & 31, h = lane >> 5;
  for (int wt = gw; wt < R / 32; wt += nw) {
    const u16* ap = A + (size_t)(wt * 32 + r) * 1024 + 8 * h;
    const u16* bp = Wt + (size_t)r * 1024 + 8 * h;
    f32x16 acc;
    for (int i = 0; i < 16; ++i) acc[i] = 0.f;
#pragma unroll 8
    for (int s = 0; s < 64; ++s) {
      s16x8 a = *(const s16x8*)(ap + 16 * s), b = *(const s16x8*)(bp + 16 * s);
      acc = MFMA32(a, b, acc);
    }
#pragma unroll
    for (int i = 0; i < 16; ++i) out[(size_t)(wt * 32 + crow(i, h)) * 32 + r] = acc[i];
  }
}

DI int lds_byte2(int r, int c) {
  int st = (r >> 4) * 2 + (c >> 5), ob = (r & 15) * 64 + (c & 31) * 2;
  return st * 1024 + (ob ^ (((ob >> 9) & 1) << 5));
}
DI void stage_rc2(int b, int& Rr, int& Cc) {
  int st = b >> 10, sb = b & 1023, swz = sb ^ (((sb >> 9) & 1) << 5);
  Rr = (st / 2) * 16 + swz / 64;
  Cc = (st % 2) * 32 + (swz % 64) / 2;
}

struct EpiArgs {
  int mode;
  u16* lat; u16* ctx; int ld;
  u16* b1; u16* b2;
  const float* res_lat; const float* res_ctx; const float* mods_i; float* out_lat; float* out_ctx;
};

template <int MODE>
DI void gemm_epilogue(const EpiArgs& e, f32x4 (&acc)[8][4], int row0, int pn, int wr, int wc, int fr, int fq) {
#pragma unroll
  for (int m = 0; m < 8; ++m) {
    const int row = row0 + wr * 128 + m * 16 + fr;
#pragma unroll
    for (int n = 0; n < 4; ++n) {
      const int col = pn * 256 + wc * 64 + n * 16 + fq * 4;
      const f32x4 a = acc[m][n];
      if (MODE == 0) {
        u16* pr = (row < RL) ? e.lat + (size_t)row * e.ld : e.ctx + (size_t)(row - RL) * e.ld;
        *(u32x2*)(pr + col) = (u32x2){pk2(a.x, a.y), pk2(a.z, a.w)};
      } else if (MODE == 1) {
        u32x2 v = {pk2(a.x, a.y), pk2(a.z, a.w)};
        if (pn < 4) {
          *(u32x2*)(e.lat + (size_t)row * 1024 + col) = v;
        } else {
          *(u32x2*)(e.b1 + (size_t)row * 2048 + col - 1024) = v;
          *(u32x2*)(e.b2 + (size_t)row * 2048 + col - 1024) = v;
        }
      } else {
        const int mr = (row < RL) ? (row >> 13) : 4;
        const f32x4 gt = *(const f32x4*)(e.mods_i + mr * 3072 + 2048 + col);
        const float* rp = (row < RL) ? e.res_lat + (size_t)row * DM : e.res_ctx + (size_t)(row - RL) * DM;
        float* op = (row < RL) ? e.out_lat + (size_t)row * DM : e.out_ctx + (size_t)(row - RL) * DM;
        const f32x4 rv = *(const f32x4*)(rp + col);
        f32x4 o = {rv.x + gt.x * a.x, rv.y + gt.y * a.y, rv.z + gt.z * a.z, rv.w + gt.w * a.w};
        *(f32x4*)(op + col) = o;
      }
    }
  }
}

template <int MODE>
DI void gemm_epilogue8(const EpiArgs& e, f32x4 (&acc)[2][2][4][2], int row0, int pn, int wr, int wc, int fr, int fq) {
#pragma unroll
  for (int ai = 0; ai < 2; ++ai)
#pragma unroll
    for (int m = 0; m < 4; ++m) {
      const int row = row0 + ai * 128 + wr * 64 + m * 16 + fr;
#pragma unroll
      for (int bj = 0; bj < 2; ++bj)
#pragma unroll
        for (int n = 0; n < 2; ++n) {
          const int col = pn * 256 + bj * 128 + wc * 32 + n * 16 + fq * 4;
          const f32x4 a = acc[ai][bj][m][n];
          if (MODE == 0) {
            u16* pr = (row < RL) ? e.lat + (size_t)row * e.ld : e.ctx + (size_t)(row - RL) * e.ld;
            *(u32x2*)(pr + col) = (u32x2){pk2(a.x, a.y), pk2(a.z, a.w)};
          } else if (MODE == 4) {
            const size_t dsel = (pn < 8) ? 0 : (pn < 16) ? (4 * MiB / 2) : ((OFF_ZC - OFF_X) / 2);
            *(u32x2*)(e.ctx + dsel + (size_t)(row - RL) * 2048 + (col & 2047)) = (u32x2){pk2(a.x, a.y), pk2(a.z, a.w)};
          } else if (MODE == 1) {
            u32x2 v = {pk2(a.x, a.y), pk2(a.z, a.w)};
            if (pn < 4) {
              *(u32x2*)(e.lat + (size_t)row * 1024 + col) = v;
            } else {
              *(u32x2*)(e.b1 + (size_t)row * 2048 + col - 1024) = v;
              *(u32x2*)(e.b2 + (size_t)row * 2048 + col - 1024) = v;
            }
          } else {
            const int mr = (row < RL) ? (row >> 13) : 4;
            const f32x4 gt = *(const f32x4*)(e.mods_i + mr * 3072 + 2048 + col);
            const float* rp = (row < RL) ? e.res_lat + (size_t)row * DM : e.res_ctx + (size_t)(row - RL) * DM;
            float* op = (row < RL) ? e.out_lat + (size_t)row * DM : e.out_ctx + (size_t)(row - RL) * DM;
            const f32x4 rv = __builtin_nontemporal_load((const f32x4*)(rp + col));
            f32x4 o = {rv.x + gt.x * a.x, rv.y + gt.y * a.y, rv.z + gt.z * a.z, rv.w + gt.w * a.w};
            *(f32x4*)(op + col) = o;
          }
        }
    }
}

template <int MODE>
DI void gemm_phase(char* shm_, const u16* Alat, const u16* Actx, int K, const u16* Bt, int pm0, int npm, int nN, const EpiArgs& e, const int wave_s_) {
  constexpr int BK = 64, HALF = 128, HT = HALF * BK;
  u16* shm = (u16*)shm_;
  const int tid = TIDX(), wid = tid >> 6, lane = tid & 63, wr = wid >> 2, wc = wid & 3, fr = lane & 15, fq = lane >> 4;
#define SA(b, h) (shm + ((b) * 2 + (h)) * HT)
#define SB(b, h) (shm + (4 + (b) * 2 + (h)) * HT)
#define LDSP(ptr) ((__attribute__((address_space(3))) unsigned*)(unsigned)(size_t)(ptr))
#define STAGE(P, BASE, br, kt) do { const u16* _p = (BASE) + (size_t)(br) * K + (kt) * BK + soff; \
    _Pragma("unroll") for (int _i = 0; _i < 2; ++_i) \
      __builtin_amdgcn_global_load_lds((const unsigned*)(_p + (size_t)_i * 64 * K), LDSP((char*)(P) + wid * 1024 + _i * 8192), 16, 0, 0); } while (0)
#define LDA(dst, b, h) _Pragma("unroll") for (int m = 0; m < 4; ++m) _Pragma("unroll") for (int k = 0; k < 2; ++k) \
    dst[m][k] = *(const s16x8*)((const char*)SA(b, h) + lds_byte2(wr * 64 + m * 16 + fr, k * 32 + fq * 8))
#define LDB(dst, b, h) _Pragma("unroll") for (int n = 0; n < 2; ++n) _Pragma("unroll") for (int k = 0; k < 2; ++k) \
    dst[n][k] = *(const s16x8*)((const char*)SB(b, h) + lds_byte2(wc * 32 + n * 16 + fr, k * 32 + fq * 8))
#define MMA(ai, bj, Atv, Btv) do { __builtin_amdgcn_s_setprio(1); \
    _Pragma("unroll") for (int m = 0; m < 4; ++m) _Pragma("unroll") for (int n = 0; n < 2; ++n) _Pragma("unroll") for (int k = 0; k < 2; ++k) \
      acc[ai][bj][m][n] = MFMA16(Btv[n][k], Atv[m][k], acc[ai][bj][m][n]); \
    __builtin_amdgcn_s_setprio(0); } while (0)
#define WAIT_V(n) asm volatile("s_waitcnt vmcnt(" #n ")" ::: "memory")
#define WAIT_L(n) asm volatile("s_waitcnt lgkmcnt(" #n ")" ::: "memory")
#define BAR __builtin_amdgcn_s_barrier()
#define SCHED __builtin_amdgcn_sched_barrier(0)
  int sR0, sC0;
  stage_rc2(tid * 16, sR0, sC0);
  const size_t soff = (size_t)sR0 * K + sC0;
  const int ntiles = npm * nN, nt = K / BK;
  const int xcd = blockIdx.x & 7, jj = blockIdx.x >> 3;
  const int PN = (nN % 8 == 0) ? 8 : 4, PG = 32 / PN, npg = nN / PN;
  const int ngroups = ((npm + PG - 1) / PG) * npg;
  const bool grouped = (gridDim.x == 256);
  const int nit = grouped ? (ngroups - xcd + 7) / 8 : (ntiles - (int)blockIdx.x + (int)gridDim.x - 1) / (int)gridDim.x;
  auto tile_of = [&](int it, int& pm, int& pn) -> bool {
    if (it >= nit) return false;
    if (grouped) {
      const int g = xcd + 8 * it, pmg = g / npg, png = g % npg;
      pm = pmg * PG + jj / PN; pn = png * PN + jj % PN;
      if (pm >= npm) return false;
      pm += pm0;
    } else {
      const int L = blockIdx.x + it * gridDim.x;
      pm = pm0 + L / nN; pn = L % nN;
    }
    return true;
  };
  bool prefetched = false;
  for (int it = 0; it < nit; ++it) {
    int pm, pn;
    if (!tile_of(it, pm, pn)) continue;
    const int row0 = pm * 256;
    const u16* A = (row0 < RL) ? Alat + (size_t)row0 * K : Actx + (size_t)(row0 - RL) * K;
    const u16* Bw = Bt + (size_t)pn * 256 * K;
    const int brow = 0, bcol = 0;
    f32x4 acc[2][2][4][2];
#pragma unroll
    for (int i0 = 0; i0 < 2; ++i0)
#pragma unroll
      for (int i1 = 0; i1 < 2; ++i1)
#pragma unroll
        for (int i2 = 0; i2 < 4; ++i2)
#pragma unroll
          for (int i3 = 0; i3 < 2; ++i3) acc[i0][i1][i2][i3] = (f32x4){0.f, 0.f, 0.f, 0.f};
    s16x8 At[4][2], B0[2][2], B1[2][2];
    if (!prefetched) {
      STAGE(SB(0, 0), Bw, bcol, 0); STAGE(SA(0, 0), A, brow, 0);
      STAGE(SB(0, 1), Bw, bcol + HALF, 0); STAGE(SA(0, 1), A, brow + HALF, 0);
    }
    if (wr == 1) BAR;
    WAIT_V(4); BAR;
    STAGE(SB(1, 0), Bw, bcol, 1); STAGE(SA(1, 0), A, brow, 1); STAGE(SB(1, 1), Bw, bcol + HALF, 1);
    WAIT_V(6); BAR;
    for (int t = 0; t < nt - 2; t += 2) {
      LDB(B0, 0, 0); SCHED; LDA(At, 0, 0); STAGE(SA(1, 1), A, brow + HALF, t + 1);
      WAIT_L(8); BAR; WAIT_L(0); MMA(0, 0, At, B0); BAR; SCHED;
      LDB(B1, 0, 1); STAGE(SB(0, 0), Bw, bcol, t + 2);
      BAR; WAIT_L(0); MMA(0, 1, At, B1); BAR;
      LDA(At, 0, 1); STAGE(SA(0, 0), A, brow, t + 2);
      BAR; WAIT_L(0); MMA(1, 0, At, B0); BAR; SCHED;
      STAGE(SB(0, 1), Bw, bcol + HALF, t + 2);
      WAIT_V(6); BAR; MMA(1, 1, At, B1); BAR;
      LDB(B0, 1, 0); SCHED; LDA(At, 1, 0); STAGE(SA(0, 1), A, brow + HALF, t + 2);
      WAIT_L(8); BAR; WAIT_L(0); MMA(0, 0, At, B0); BAR; SCHED;
      LDB(B1, 1, 1); STAGE(SB(1, 0), Bw, bcol, t + 3);
      BAR; WAIT_L(0); MMA(0, 1, At, B1); BAR;
      LDA(At, 1, 1); STAGE(SA(1, 0), A, brow, t + 3);
      BAR; WAIT_L(0); MMA(1, 0, At, B0); BAR; SCHED;
      STAGE(SB(1, 1), Bw, bcol + HALF, t + 3);
      WAIT_V(6); BAR; MMA(1, 1, At, B1); BAR;
    }
    { LDB(B0, 0, 0); LDA(At, 0, 0); STAGE(SA(1, 1), A, brow + HALF, nt - 1);
      BAR; WAIT_L(0); MMA(0, 0, At, B0); BAR;
      LDB(B1, 0, 1); BAR; WAIT_L(0); MMA(0, 1, At, B1); BAR;
      LDA(At, 0, 1); WAIT_V(4); BAR; WAIT_L(0); MMA(1, 0, At, B0); MMA(1, 1, At, B1); BAR; }
    { LDB(B0, 1, 0); LDA(At, 1, 0); WAIT_V(2); BAR; WAIT_L(0); MMA(0, 0, At, B0); BAR;
      LDB(B1, 1, 1); WAIT_V(0); BAR; WAIT_L(0); MMA(0, 1, At, B1); BAR;
      LDA(At, 1, 1); BAR; WAIT_L(0); MMA(1, 0, At, B0); MMA(1, 1, At, B1); BAR; }
    if (wr == 0) BAR;
    {
      int pm2, pn2;
      prefetched = tile_of(it + 1, pm2, pn2);
      if (prefetched) {
        const int r2 = pm2 * 256;
        const u16* A2 = (r2 < RL) ? Alat + (size_t)r2 * K : Actx + (size_t)(r2 - RL) * K;
        const u16* B2 = Bt + (size_t)pn2 * 256 * K;
        STAGE(SB(0, 0), B2, 0, 0); STAGE(SA(0, 0), A2, 0, 0);
        STAGE(SB(0, 1), B2, HALF, 0); STAGE(SA(0, 1), A2, HALF, 0);
      }
    }
    { const int l2 = lane_id(); gemm_epilogue8<MODE>(e, acc, row0, pn, wr, wc, l2 & 15, l2 >> 4); }
    asm volatile("s_waitcnt vmcnt(0) lgkmcnt(0)" ::: "memory");
    BAR;
  }
#undef SA
#undef SB
#undef LDSP
#undef STAGE
#undef LDA
#undef LDB
#undef MMA
#undef WAIT_V
#undef WAIT_L
#undef BAR
#undef SCHED
}

DI void conv_accum(float (&acc)[8], const u16* srow, const float* w) {
  u32x4 v = *(const u32x4*)srow;
  f32x4 w0 = *(const f32x4*)w, w1 = *(const f32x4*)(w + 4);
  acc[0] += bflo(v.x) * w0.x; acc[1] += bfhi(v.x) * w0.y; acc[2] += bflo(v.y) * w0.z; acc[3] += bfhi(v.y) * w0.w;
  acc[4] += bflo(v.z) * w1.x; acc[5] += bfhi(v.z) * w1.y; acc[6] += bflo(v.w) * w1.z; acc[7] += bfhi(v.w) * w1.w;
}
DI void fma8(float (&acc)[8], const u32x4 v, const float (&w)[8]) {
  acc[0] += bflo(v.x) * w[0]; acc[1] += bfhi(v.x) * w[1]; acc[2] += bflo(v.y) * w[2]; acc[3] += bfhi(v.y) * w[3];
  acc[4] += bflo(v.z) * w[4]; acc[5] += bfhi(v.z) * w[5]; acc[6] += bflo(v.w) * w[6]; acc[7] += bfhi(v.w) * w[7];
}
template <bool ISV>
DI void conv_store(const Params& p, float (&acc)[8], int row, int ch) {
#pragma unroll
  for (int e = 0; e < 8; ++e) acc[e] = siluf(acc[e]);
  if (!ISV) {
    u16* qk = (u16*)(p.ws + OFF_QK0);
    float ss = 0.f;
#pragma unroll
    for (int e = 0; e < 8; ++e) ss += acc[e] * acc[e];
    ss += __shfl_xor(ss, 1, 64); ss += __shfl_xor(ss, 2, 64); ss += __shfl_xor(ss, 4, 64); ss += __shfl_xor(ss, 8, 64);
    const float sc = rsqrtf(ss + EPSF) * ((ch < 1024) ? 0.08838834764831845f : 1.f);
    u32x4 o = {pk2(acc[0] * sc, acc[1] * sc), pk2(acc[2] * sc, acc[3] * sc), pk2(acc[4] * sc, acc[5] * sc), pk2(acc[6] * sc, acc[7] * sc)};
    __builtin_nontemporal_store(o, (u32x4*)(qk + (size_t)row * 2048 + ch));
  } else {
    u16* u0 = (u16*)(p.ws + OFF_U0);
    u16* u1 = (u16*)(p.ws + OFF_U1);
    const float* abt = (const float*)(p.ws + OFF_ABT);
    const int head = ch >> 8;
    const float b0 = sigmoidf(abt[(size_t)row * 32 + 16 + head]), b1 = sigmoidf(abt[(size_t)row * 32 + 24 + head]);
    u32x4 o0 = {pk2(acc[0] * b0, acc[1] * b0), pk2(acc[2] * b0, acc[3] * b0), pk2(acc[4] * b0, acc[5] * b0), pk2(acc[6] * b0, acc[7] * b0)};
    u32x4 o1 = {pk2(acc[0] * b1, acc[1] * b1), pk2(acc[2] * b1, acc[3] * b1), pk2(acc[4] * b1, acc[5] * b1), pk2(acc[6] * b1, acc[7] * b1)};
    __builtin_nontemporal_store(o0, (u32x4*)(u0 + (size_t)row * 2048 + ch));
    __builtin_nontemporal_store(o1, (u32x4*)(u1 + (size_t)row * 2048 + ch));
  }
}
template <bool ISV>
DI void conv_phase(const Params& p, const int wave_s_) {
  const u16* pre_lat = (const u16*)p.out;
  const u16* pre_ctx = (const u16*)(p.ws + OFF_X + (ISV ? 4 * MiB : 0));
  const float* cw = p.dn_conv_w + (ISV ? 2048 : 0);
  const int gt = blockIdx.x * 512 + TIDX(), nthr = gridDim.x * 512;
  const u32x4 zero4 = {0u, 0u, 0u, 0u};
  for (int idx = gt; idx < 4 * 128 * 4 * 256; idx += nthr) {
    const int cg8 = idx & 255, run = (idx >> 8) & 3, gr = (idx >> 10) & 127, b = idx >> 17, ch = cg8 * 8, c0 = run * 16;
    float w[9][8];
#pragma unroll
    for (int t = 0; t < 9; ++t) {
      const f32x4 w0 = *(const f32x4*)(cw + t * 4096 + ch), w1 = *(const f32x4*)(cw + t * 4096 + ch + 4);
      w[t][0] = w0.x; w[t][1] = w0.y; w[t][2] = w0.z; w[t][3] = w0.w; w[t][4] = w1.x; w[t][5] = w1.y; w[t][6] = w1.z; w[t][7] = w1.w;
    }
    const u16* base = pre_lat + ((size_t)(b << 13) + gr * 64) * 2048 + ch;
    const bool rok[3] = {gr > 0, true, gr < 127};
    u32x4 win[3][3];
#pragma unroll
    for (int i = 0; i < 3; ++i) {
      win[i][0] = (rok[i] && c0 > 0) ? *(const u32x4*)(base + (ptrdiff_t)((i - 1) * 64 + c0 - 1) * 2048) : zero4;
      win[i][1] = rok[i] ? *(const u32x4*)(base + (ptrdiff_t)((i - 1) * 64 + c0) * 2048) : zero4;
    }
#pragma unroll
    for (int t = 0; t < 16; ++t) {
      const int c = c0 + t;
#pragma unroll
      for (int i = 0; i < 3; ++i) win[i][2] = (rok[i] && c < 63) ? *(const u32x4*)(base + (ptrdiff_t)((i - 1) * 64 + c + 1) * 2048) : zero4;
      float acc[8];
#pragma unroll
      for (int e = 0; e < 8; ++e) acc[e] = 0.f;
#pragma unroll
      for (int i = 0; i < 3; ++i)
#pragma unroll
        for (int j = 0; j < 3; ++j) fma8(acc, win[i][j], w[i * 3 + j]);
      conv_store<ISV>(p, acc, (b << 13) + gr * 64 + c, ch);
#pragma unroll
      for (int i = 0; i < 3; ++i) { win[i][0] = win[i][1]; win[i][1] = win[i][2]; }
    }
  }
  for (int idx = gt; idx < 4 * 32 * 256; idx += nthr) {
    const int cg8 = idx & 255, run = (idx >> 8) & 31, b = idx >> 13, ch = cg8 * 8, p0 = run * 8;
    float w[3][8];
#pragma unroll
    for (int t = 0; t < 3; ++t) {
      const f32x4 w0 = *(const f32x4*)(cw + (3 + t) * 4096 + ch), w1 = *(const f32x4*)(cw + (3 + t) * 4096 + ch + 4);
      w[t][0] = w0.x; w[t][1] = w0.y; w[t][2] = w0.z; w[t][3] = w0.w; w[t][4] = w1.x; w[t][5] = w1.y; w[t][6] = w1.z; w[t][7] = w1.w;
    }
    const u16* base = pre_ctx + (size_t)(b * 256) * 2048 + ch;
    u32x4 win[3];
    win[0] = (p0 > 0) ? *(const u32x4*)(base + (size_t)(p0 - 1) * 2048) : zero4;
    win[1] = *(const u32x4*)(base + (size_t)p0 * 2048);
#pragma unroll
    for (int t = 0; t < 8; ++t) {
      const int pp = p0 + t;
      win[2] = (pp < 255) ? *(const u32x4*)(base + (size_t)(pp + 1) * 2048) : zero4;
      float acc[8];
#pragma unroll
      for (int e = 0; e < 8; ++e) acc[e] = 0.f;
#pragma unroll
      for (int j = 0; j < 3; ++j) fma8(acc, win[j], w[j]);
      conv_store<ISV>(p, acc, RL + b * 256 + pp, ch);
      win[0] = win[1]; win[1] = win[2];
    }
  }
}

constexpr int lp_off(int ip) { return ip == 0 ? 0 : (8 * ((ip - 1) / 4) * ((ip - 1) / 4 + 1) + 4 * ((ip - 1) % 4) * ((ip - 1) / 4 + 1)); }
constexpr int LP_FLOATS = 2112;
DI void dn_prep_phase(char* shm, const Params& p, const int wave_s_) {
  const int tid = TIDX(), wave = tid >> 6, lane = tid & 63, r = lane & 31, hh = lane >> 5;
  char* sQ = shm;
  char* sK = shm + 16896;
  float* sKK = (float*)(shm + 33792);
  float* sQK = (float*)(shm + 50432);
  float* sg = (float*)(shm + 67072);
  float* sbeta = sg + 128;
  float* sgc = sg + 256;
  float* sLp = (float*)(shm + 68608);
  const u16* qk = (const u16*)(p.ws + OFF_QK0);
  const float* abt = (const float*)(p.ws + OFF_ABT);
  u16* Ab_lat = (u16*)p.out;
  u16* Tb_lat = (u16*)p.out + (size_t)32 * MiB;
  u16* Ab_ctx = (u16*)(p.ws + OFF_AC);
  u16* Tb_ctx = (u16*)(p.ws + OFF_TC);
  float* Eb = (float*)(p.ws + OFF_X);
  for (int grp = blockIdx.x; grp < NCHUNK * 2; grp += gridDim.x) {
    const int ci = grp >> 1, row0 = ci * 64;
    u32x4 pq[2], pk[2];
    float pa = 0.f, pbt = 0.f;
    auto load_item = [&](int h) {
#pragma unroll
      for (int u = 0; u < 2; ++u) {
        const int chunk = tid * 2 + u, c = chunk >> 4, cc = (chunk & 15) * 8;
        const u16* src = qk + (size_t)(row0 + c) * 2048 + h * 128 + cc;
        pq[u] = *(const u32x4*)src; pk[u] = *(const u32x4*)(src + 1024);
      }
      if (tid < 128) {
        const int d = tid >> 6, c = tid & 63;
        pa = abt[(size_t)(row0 + c) * 32 + d * 8 + h]; pbt = abt[(size_t)(row0 + c) * 32 + 16 + d * 8 + h];
      }
    };
    load_item((grp & 1) * 4);
    for (int sub = 0; sub < 4; ++sub) {
      const int h = (grp & 1) * 4 + sub, item = ci * 8 + h;
#pragma unroll
      for (int u = 0; u < 2; ++u) {
        const int chunk = tid * 2 + u, c = chunk >> 4, cc = (chunk & 15) * 8;
        st8(sQ + c * 264 + cc * 2, pq[u]);
        st8(sK + c * 264 + cc * 2, pk[u]);
      }
      if (tid < 128) {
        const int d = tid >> 6, c = tid & 63;
        sg[d * 64 + c] = -__expf(p.dn_a_log[d * 8 + h]) * softplusf(pa + p.dn_dt_bias[d * 8 + h]);
        sbeta[d * 64 + c] = sigmoidf(pbt);
      }
      if (sub < 3) load_item(h + 1);
      __syncthreads();
      if (wave < 2) {
        const int c = wave ? 63 - lane : lane;
        float v = sg[wave * 64 + c];
#pragma unroll
        for (int o = 1; o < 64; o <<= 1) { const float t = __shfl_up(v, o, 64); if (lane >= o) v += t; }
        sgc[wave * 64 + c] = v;
      }
      {
        const int mat = wave >> 2, tm = (wave >> 1) & 1, tn = wave & 1;
        const char* aop = mat ? sQ : sK;
        f32x16 acc;
        for (int i = 0; i < 16; ++i) acc[i] = 0.f;
#pragma unroll
        for (int s = 0; s < 8; ++s) {
          s16x8 a = ldA_nat(aop, 32 * tm + r, 264, 16 * s, hh), b = ldA_nat(sK, 32 * tn + r, 264, 16 * s, hh);
          acc = MFMA32(a, b, acc);
        }
        float* dst = mat ? sQK : sKK;
#pragma unroll
        for (int i = 0; i < 16; ++i) dst[(32 * tm + crow(i, hh)) * 65 + 32 * tn + r] = acc[i];
      }
      __syncthreads();
      for (int e = tid; e < 8192; e += 512) {
        const int d = e >> 12, ip = (e >> 6) & 63, jp = e & 63;
        if (ip > jp) {
          const int i = d ? 63 - ip : ip, j = d ? 63 - jp : jp;
          const int q4 = (ip - 1) >> 2, r4 = (ip - 1) & 3;
          const float v = sbeta[d * 64 + i] * sKK[i * 65 + j] * __expf(fminf(sgc[d * 64 + i] - sgc[d * 64 + j], 0.f));
          sLp[(sub * 2 + d) * LP_FLOATS + 8 * q4 * (q4 + 1) + 4 * r4 * (q4 + 1) + jp] = v;
        }
      }
      for (int v = tid; v < 1024; v += 512) {
        const int d = v >> 9, i = (v >> 3) & 63, j0 = (v & 7) * 8;
        float o[8];
#pragma unroll
        for (int e = 0; e < 8; ++e) {
          const int j = j0 + e;
          const bool keep = d ? (i <= j) : (i >= j);
          o[e] = keep ? sQK[i * 65 + j] * __expf(fminf(sgc[d * 64 + i] - sgc[d * 64 + j], 0.f)) : 0.f;
        }
        u32x4 ov = {pk2(o[0], o[1]), pk2(o[2], o[3]), pk2(o[4], o[5]), pk2(o[6], o[7])};
        *(u32x4*)(((size_t)item < TA_LAT_ITEMS ? Ab_lat : Ab_ctx) + ta_off(item, d) + i * 64 + j0) = ov;
      }
      if (tid < 128) {
        const int d = tid >> 6, c = tid & 63;
        const float gl = sgc[d * 64 + (d ? 0 : 63)], gcv = sgc[d * 64 + c];
        const float e1 = __expf(gcv), be = sbeta[d * 64 + c] * e1, e2 = __expf(gl - gcv), cdv = __expf(gl);
        float* E = Eb + ((size_t)item * 2 + d) * 256;
        E[c] = e1; E[64 + c] = be; E[128 + c] = e2; E[192 + c] = cdv;
      }
      __syncthreads();
    }
    {
      const int wv = opq_v(wave), lane_l = opq_v(lane);
      const int d = wv & 1, item = ci * 8 + (grp & 1) * 4 + (wv >> 1);
      const float* Lb = sLp + wv * LP_FLOATS;
      float T[64];
#pragma unroll
      for (int ip = 0; ip < 64; ++ip) {
        f32x4 lrow[16];
#pragma unroll
        for (int j4 = 0; j4 < (ip + 3) / 4; ++j4) lrow[j4] = *(const f32x4*)(Lb + lp_off(ip) + j4 * 4);
        float a0 = (lane_l == ip) ? 1.f : 0.f, a1 = 0.f, a2 = 0.f, a3 = 0.f;
#pragma unroll
        for (int j4 = 0; j4 < (ip + 3) / 4; ++j4) {
          const f32x4 lv = lrow[j4];
          if (j4 * 4 + 0 < ip) a0 -= lv.x * T[j4 * 4 + 0];
          if (j4 * 4 + 1 < ip) a1 -= lv.y * T[j4 * 4 + 1];
          if (j4 * 4 + 2 < ip) a2 -= lv.z * T[j4 * 4 + 2];
          if (j4 * 4 + 3 < ip) a3 -= lv.w * T[j4 * 4 + 3];
        }
        T[ip] = (a0 + a1) + (a2 + a3);
        __builtin_amdgcn_sched_barrier(0);
      }
      u16* To = ((size_t)item < TA_LAT_ITEMS ? Tb_lat : Tb_ctx) + ta_off(item, d);
      const int cidx = d ? 63 - lane_l : lane_l;
#pragma unroll
      for (int ip = 0; ip < 64; ++ip) {
        const int i = d ? 63 - ip : ip;
        To[i * 64 + cidx] = f2bf(T[ip]);
      }
    }
    __syncthreads();
  }
}

constexpr int SC_QS = 272;
constexpr int SC_Q = 0, SC_K = 17408, SC_KT = 34816, SC_T = 52224, SC_A = 60928, SC_E = 69632, SC_BUF = 70656;
DI s16x8 ldA16(const char* base, int row, int strideB, int kofs, int q) {
  const char* p = base + row * strideB + (kofs + 4 * q) * 2;
  u32x2 lo = *(const u32x2*)p, hi = *(const u32x2*)(p + 32);
  return cat8(lo, hi);
}
DI s16x8 pack16(const f32x4& a, const f32x4& b) {
  u32x4 v = {pk2(a.x, a.y), pk2(a.z, a.w), pk2(b.x, b.y), pk2(b.z, b.w)};
  return __builtin_bit_cast(s16x8, v);
}

template <bool DELTA, bool DRY = false>
DI void scan_phase(char* shm, const Params& p, const int wave_s_) {
  const int bid = blockIdx.x;
  if (bid >= 256) return;
  const int tid = TIDX(), wave = tid >> 6, lane = tid & 63, n16 = lane & 15, q4 = lane >> 4;
  int cgp, d, h, b;
  if (DELTA) { cgp = (bid >> 3) & 3; const int cid = (bid & 7) + 8 * (bid >> 5); d = cid & 1; h = (cid >> 1) & 7; b = cid >> 4; }
  else { cgp = (bid >> 3) & 7; const int cid = (bid & 7) + 8 * (bid >> 6); d = cid & 1; h = (cid >> 1) & 3; b = cid >> 3; }
  const bool compute = wave < 4;
  const int col0 = (DELTA ? h * 256 : h * 512) + cgp * 64 + (wave & 3) * 16;
  u16* Ub = (u16*)(p.ws + (DELTA ? (d ? OFF_U1 : OFF_U0) : (d ? OFF_V1 : OFF_V0)));
  const u16* qk = (const u16*)(p.ws + OFF_QK0);
  const u16* Ag_lat = (const u16*)p.out;
  const u16* Tb_lat = (const u16*)p.out + (size_t)32 * MiB;
  const u16* Ag_ctx = (const u16*)(p.ws + OFF_AC);
  const u16* Tb_ctx = (const u16*)(p.ws + OFF_TC);
  const float* Eb = (const float*)(p.ws + OFF_X);
  const u16* QD = (const u16*)(p.ws + OFF_QD);
  const u16* AS = (const u16*)(p.ws + OFF_ASUM);
  const float* CD = (const float*)(p.ws + OFF_CD1);

  auto chunk_of = [&](int st) -> int {
    if (st < 4) return 512 + b * 4 + (d ? 3 - st : st);
    return b * 128 + (d ? 127 - (st - 4) : (st - 4));
  };

  auto stage_all = [&](int st, int buf) {
    const int sid = tid - 256;
    const int ci = chunk_of(st), row0 = ci * 64;
    char* sb = shm + buf * SC_BUF;
    if (DELTA) {
      const size_t it = ((size_t)ci * 8 + h) * 2 + d;
      const float* E = Eb + it * 256;
      const int c = sid >> 2, cc = (sid & 3) * 32;
      const u16* qsrc = qk + (size_t)(row0 + c) * 2048 + h * 128 + cc;
      const int c0 = (sid >> 4) * 4, dk0 = (sid & 15) * 8;
      const u16* ksrc = qk + (size_t)(row0 + c0) * 2048 + 1024 + h * 128 + dk0;
      u32x4 gq[4], gk[4], gT[2], gA[2];
#pragma unroll
      for (int u = 0; u < 4; ++u) gq[u] = *(const u32x4*)(qsrc + u * 8);
#pragma unroll
      for (int u = 0; u < 4; ++u) gk[u] = *(const u32x4*)(ksrc + (size_t)u * 2048);
#pragma unroll
      for (int u = 0; u < 2; ++u) {
        const int chunk = sid * 2 + u, tr = chunk >> 3, tc = (chunk & 7) * 8;
        const size_t itm = (size_t)ci * 8 + h;
        gT[u] = *(const u32x4*)((itm < TA_LAT_ITEMS ? Tb_lat : Tb_ctx) + ta_off(itm, d) + tr * 64 + tc);
        gA[u] = *(const u32x4*)((itm < TA_LAT_ITEMS ? Ag_lat : Ag_ctx) + ta_off(itm, d) + tr * 64 + tc);
      }
      const float e1 = E[c];
      const f32x4 bev = *(const f32x4*)(E + 64 + c0), e2v = *(const f32x4*)(E + 128 + c0);
      if (sid == 0) *(float*)(sb + SC_E) = E[192];
#pragma unroll
      for (int u = 0; u < 4; ++u) st8(sb + SC_Q + c * SC_QS + (cc + u * 8) * 2, scale8(gq[u], e1));
      const float be[4] = {bev.x, bev.y, bev.z, bev.w}, e2[4] = {e2v.x, e2v.y, e2v.z, e2v.w};
      u32x4 kt[4];
#pragma unroll
      for (int u = 0; u < 4; ++u) {
        st8(sb + SC_K + (c0 + u) * SC_QS + dk0 * 2, scale8(gk[u], -be[u]));
        kt[u] = scale8(gk[u], e2[u]);
      }
      const unsigned w[4][4] = {{kt[0].x, kt[0].y, kt[0].z, kt[0].w}, {kt[1].x, kt[1].y, kt[1].z, kt[1].w},
                                {kt[2].x, kt[2].y, kt[2].z, kt[2].w}, {kt[3].x, kt[3].y, kt[3].z, kt[3].w}};
#pragma unroll
      for (int jp = 0; jp < 4; ++jp) {
        u32x2 lo = {(w[0][jp] & 0xffffu) | (w[1][jp] << 16), (w[2][jp] & 0xffffu) | (w[3][jp] << 16)};
        u32x2 hi = {(w[0][jp] >> 16) | (w[1][jp] & 0xffff0000u), (w[2][jp] >> 16) | (w[3][jp] & 0xffff0000u)};
        *(u32x2*)(sb + SC_KT + (dk0 + 2 * jp) * 136 + c0 * 2) = lo;
        *(u32x2*)(sb + SC_KT + (dk0 + 2 * jp + 1) * 136 + c0 * 2) = hi;
      }
#pragma unroll
      for (int u = 0; u < 2; ++u) {
        const int chunk = sid * 2 + u, tr = chunk >> 3, tc = (chunk & 7) * 8;
        st8(sb + SC_T + tr * 136 + tc * 2, gT[u]);
        st8(sb + SC_A + tr * 136 + tc * 2, gA[u]);
      }
    } else {
      const size_t it = ((size_t)ci * 4 + h) * 2 + d;
      const u16* qd = QD + it * 16384;
      const int c = sid >> 2, cc = (sid & 3) * 32;
      const int kr = sid >> 1, kc = (sid & 1) * 32;
      u32x4 gq[4], gk[4], gA[2];
#pragma unroll
      for (int u = 0; u < 4; ++u) gq[u] = *(const u32x4*)(qd + c * 128 + cc + u * 8);
#pragma unroll
      for (int u = 0; u < 4; ++u) gk[u] = *(const u32x4*)(qd + 8192 + kr * 64 + kc + u * 8);
      if (d == 0) {
#pragma unroll
        for (int u = 0; u < 2; ++u) {
          const int chunk = sid * 2 + u, tr = chunk >> 3, tc = (chunk & 7) * 8;
          gA[u] = *(const u32x4*)(AS + ((size_t)ci * 4 + h) * 4096 + tr * 64 + tc);
        }
      }
      if (sid < 32) *(f32x4*)(sb + SC_E + sid * 16) = *(const f32x4*)(CD + it * 128 + sid * 4);
#pragma unroll
      for (int u = 0; u < 4; ++u) st8(sb + SC_Q + c * SC_QS + (cc + u * 8) * 2, gq[u]);
#pragma unroll
      for (int u = 0; u < 4; ++u) st8(sb + SC_KT + kr * 136 + (kc + u * 8) * 2, gk[u]);
      if (d == 0) {
#pragma unroll
        for (int u = 0; u < 2; ++u) {
          const int chunk = sid * 2 + u, tr = chunk >> 3, tc = (chunk & 7) * 8;
          st8(sb + SC_A + tr * 136 + tc * 2, gA[u]);
        }
      }
    }
  };

  f32x4 S[8];
#pragma unroll
  for (int t = 0; t < 8; ++t) S[t] = (f32x4){0.f, 0.f, 0.f, 0.f};
  u16 uraw[4][4];
  const int loff = (4 * q4) * 2048 + col0 + n16;
  auto u_issue = [&](int st) {
    const u16* up = Ub + (size_t)chunk_of(st) * (64 * 2048);
    const int lo = opq_v(loff);
#pragma unroll
    for (int mt = 0; mt < 4; ++mt)
#pragma unroll
      for (int i = 0; i < 4; ++i) uraw[mt][i] = up[lo + (16 * mt + i) * 2048];
  };

  if (compute) u_issue(0); else stage_all(0, 0);
  __syncthreads();

  for (int st = 0; st < 132; ++st) {
    const int buf = st & 1;
    const char* sb = shm + buf * SC_BUF;
    if (compute) {
      const int row0 = chunk_of(st) * 64;
      f32x4 Y[4], O[4];
#pragma unroll
      for (int mt = 0; mt < 4; ++mt) {
        Y[mt] = (f32x4){bf2f(uraw[mt][0]), bf2f(uraw[mt][1]), bf2f(uraw[mt][2]), bf2f(uraw[mt][3])};
        O[mt] = (f32x4){0.f, 0.f, 0.f, 0.f};
      }
#define SCHED_FENCE() __builtin_amdgcn_sched_barrier(0)
      s16x8 fT[8];
      if (DELTA) {
#pragma unroll
        for (int mt = 0; mt < 4; ++mt)
#pragma unroll
          for (int kc = 0; kc < 2; ++kc) fT[mt * 2 + kc] = ldA16(sb + SC_T, 16 * mt + n16, 136, 32 * kc, q4);
      }
      s16x8 fa[2][8];
#pragma unroll
      for (int mt = 0; mt < 4; ++mt) {
        if (DELTA) fa[0][mt] = ldA16(sb + SC_K, 16 * mt + n16, SC_QS, 0, q4);
        fa[0][4 + mt] = ldA16(sb + SC_Q, 16 * mt + n16, SC_QS, 0, q4);
      }
      SCHED_FENCE();
#pragma unroll
      for (int t = 0; t < 4; ++t) {
        if (t < 3) {
#pragma unroll
          for (int mt = 0; mt < 4; ++mt) {
            if (DELTA) fa[(t + 1) & 1][mt] = ldA16(sb + SC_K, 16 * mt + n16, SC_QS, 32 * (t + 1), q4);
            fa[(t + 1) & 1][4 + mt] = ldA16(sb + SC_Q, 16 * mt + n16, SC_QS, 32 * (t + 1), q4);
          }
        }
        SCHED_FENCE();
        const s16x8 Sb = pack16(S[2 * t], S[2 * t + 1]);
#pragma unroll
        for (int mt = 0; mt < 4; ++mt) {
          if (DELTA) Y[mt] = MFMA16(fa[t & 1][mt], Sb, Y[mt]);
          O[mt] = MFMA16(fa[t & 1][4 + mt], Sb, O[mt]);
        }
        SCHED_FENCE();
      }
      s16x8 fA[8];
      if (DELTA || d == 0) {
#pragma unroll
        for (int mt = 0; mt < 4; ++mt)
#pragma unroll
          for (int kc = 0; kc < 2; ++kc) fA[mt * 2 + kc] = ldA16(sb + SC_A, 16 * mt + n16, 136, 32 * kc, q4);
      }
      SCHED_FENCE();
      s16x8 vnb[2];
      if (DELTA) {
        s16x8 Yb[2];
        Yb[0] = pack16(Y[0], Y[1]); Yb[1] = pack16(Y[2], Y[3]);
        f32x4 vn[4];
#pragma unroll
        for (int mt = 0; mt < 4; ++mt) {
          vn[mt] = (f32x4){0.f, 0.f, 0.f, 0.f};
#pragma unroll
          for (int kc = 0; kc < 2; ++kc) vn[mt] = MFMA16(fT[mt * 2 + kc], Yb[kc], vn[mt]);
        }
        vnb[0] = pack16(vn[0], vn[1]); vnb[1] = pack16(vn[2], vn[3]);
      } else {
        vnb[0] = pack16(Y[0], Y[1]); vnb[1] = pack16(Y[2], Y[3]);
      }
      SCHED_FENCE();
      s16x8 fK[8];
#pragma unroll
      for (int t = 0; t < 4; ++t)
#pragma unroll
        for (int kc = 0; kc < 2; ++kc) fK[t * 2 + kc] = ldA16(sb + SC_KT, 16 * t + n16, 136, 32 * kc, q4);
      if (st + 1 < 132) u_issue(st + 1);
      SCHED_FENCE();
      if (DELTA || d == 0) {
#pragma unroll
        for (int mt = 0; mt < 4; ++mt)
#pragma unroll
          for (int kc = 0; kc < 2; ++kc) O[mt] = MFMA16(fA[mt * 2 + kc], vnb[kc], O[mt]);
      }
      if (DELTA) {
        const float cd = *(const float*)(sb + SC_E);
#pragma unroll
        for (int t = 0; t < 8; ++t) S[t] *= cd;
      } else {
#pragma unroll
        for (int t = 0; t < 8; ++t) {
          const f32x4 cv = *(const f32x4*)(sb + SC_E + (16 * t + 4 * q4) * 4);
          S[t] *= cv;
        }
      }
      SCHED_FENCE();
      s16x8 fK2[8];
#pragma unroll
      for (int t = 0; t < 4; ++t)
#pragma unroll
        for (int kc = 0; kc < 2; ++kc) fK2[t * 2 + kc] = ldA16(sb + SC_KT, 16 * (4 + t) + n16, 136, 32 * kc, q4);
      SCHED_FENCE();
#pragma unroll
      for (int t = 0; t < 4; ++t)
#pragma unroll
        for (int kc = 0; kc < 2; ++kc) S[t] = MFMA16(fK[t * 2 + kc], vnb[kc], S[t]);
      SCHED_FENCE();
#pragma unroll
      for (int t = 0; t < 4; ++t)
#pragma unroll
        for (int kc = 0; kc < 2; ++kc) S[4 + t] = MFMA16(fK2[t * 2 + kc], vnb[kc], S[4 + t]);
#undef SCHED_FENCE
      if (!DRY || p.out == nullptr)
#pragma unroll
      for (int mt = 0; mt < 4; ++mt) {
        const float ov[4] = {O[mt].x, O[mt].y, O[mt].z, O[mt].w};
        u16* op = Ub + (size_t)row0 * 2048;
        const int lo = opq_v(loff);
#pragma unroll
        for (int i = 0; i < 4; ++i) op[lo + (16 * mt + i) * 2048] = f2bf(ov[i]);
      }
    }
    else if (st + 1 < 132) stage_all(st + 1, buf ^ 1);
    asm volatile("s_waitcnt lgkmcnt(0)" ::: "memory");
    __builtin_amdgcn_s_barrier();
    asm volatile("" ::: "memory");
  }
}

DI void gla_prep_phase(char* shm, const Params& p, const int wave_s_) {
  const int tid = TIDX(), wave = tid >> 6, lane = tid & 63, r = lane & 31, hh = lane >> 5;
  char* sq = shm;
  char* sk = shm + 16896;
  char* sQa = shm + 33792;
  char* sKb = shm + 50688;
  float* sBC = (float*)(shm + 67584);
  float* sgl = (float*)(shm + 133120);
  const u16* qk1 = (const u16*)(p.ws + OFF_QK1);
  const float* gl = (const float*)(p.ws + OFF_ABT);
  u16* QD = (u16*)(p.ws + OFF_QD);
  u16* AS = (u16*)(p.ws + OFF_ASUM);
  float* CD = (float*)(p.ws + OFF_CD1);
  const float qscale = 0.08838834764831845f;
  for (int item = blockIdx.x; item < NCHUNK * 4; item += gridDim.x) {
    const int ci = item >> 2, h = item & 3, row0 = ci * 64;
#pragma unroll
    for (int u = 0; u < 2; ++u) {
      const int chunk = tid * 2 + u, c = chunk >> 4, cc = (chunk & 15) * 8;
      const u16* src = qk1 + (size_t)(row0 + c) * 1024 + h * 128 + cc;
      u32x4 vq = *(const u32x4*)src, vk = *(const u32x4*)(src + 512);
      st8(sq + c * 264 + cc * 2, vq);
      st8(sk + c * 264 + cc * 2, vk);
    }
    {
      const int rr = tid >> 3, cc = (tid & 7) * 4;
      *(f32x4*)(sgl + rr * 32 + cc) = *(const f32x4*)(gl + (size_t)(row0 + rr) * 32 + cc);
    }
    __syncthreads();
    {
      const int kk = tid & 127, d = (tid >> 7) & 1, chalf = tid >> 8;
      float w[16];
#pragma unroll
      for (int q = 0; q < 16; ++q) w[q] = p.gla_w_g2[(d * 16 + q) * 512 + h * 128 + kk];
      const float bg = p.gla_b_g[d * 512 + h * 128 + kk];
#pragma unroll 4
      for (int cc = 0; cc < 32; ++cc) {
        const int c = chalf * 32 + cc;
        const f32x4* gp = (const f32x4*)(sgl + c * 32 + d * 16);
        const f32x4 g0 = gp[0], g1 = gp[1], g2 = gp[2], g3 = gp[3];
        float z = bg;
        z += g0.x * w[0] + g0.y * w[1] + g0.z * w[2] + g0.w * w[3];
        z += g1.x * w[4] + g1.y * w[5] + g1.z * w[6] + g1.w * w[7];
        z += g2.x * w[8] + g2.y * w[9] + g2.z * w[10] + g2.w * w[11];
        z += g3.x * w[12] + g3.y * w[13] + g3.z * w[14] + g3.w * w[15];
        sBC[(d * 64 + c) * 128 + kk] = (fminf(z, 0.f) - __logf(1.f + __expf(-fabsf(z)))) * (1.f / 16.f);
      }
    }
    __syncthreads();
    if (tid < 256) {
      const int d = tid >> 7, kk = tid & 127;
      float* col = sBC + d * 64 * 128 + kk;
      float v[64];
#pragma unroll
      for (int c = 0; c < 64; ++c) v[c] = col[c * 128];
      if (d == 0) {
        float acc = 0.f;
#pragma unroll
        for (int c = 0; c < 64; ++c) { acc += v[c]; col[c * 128] = acc; }
      } else {
        float acc = 0.f;
#pragma unroll
        for (int c = 63; c >= 0; --c) { acc += v[c]; col[c * 128] = acc; }
      }
    }
    __syncthreads();
    f32x16 asum;
    for (int i = 0; i < 16; ++i) asum[i] = 0.f;
    for (int d = 0; d < 2; ++d) {
      const int cref = d ? 31 : 32, clast = d ? 0 : 63;
      const float* bcd = sBC + d * 64 * 128;
      u16* qd_o = QD + ((size_t)item * 2 + d) * 16384;
      float er[8], ern[8];
      {
        const int k0 = (tid & 15) * 8;
#pragma unroll
        for (int e = 0; e < 8; ++e) { const float rf = bcd[cref * 128 + k0 + e]; er[e] = __expf(rf); ern[e] = __expf(-rf); }
      }
      for (int v = tid; v < 1024; v += 512) {
        const int c = v >> 4, k0 = (v & 15) * 8;
        const u32x4 qv = *(const u32x4*)(sq + c * 264 + k0 * 2), kv = *(const u32x4*)(sk + c * 264 + k0 * 2);
        const unsigned qa[4] = {qv.x, qv.y, qv.z, qv.w}, ka[4] = {kv.x, kv.y, kv.z, kv.w};
        float oqa[8], okb[8], oqd[8];
#pragma unroll
        for (int e = 0; e < 8; ++e) {
          const float ebc = __expf(bcd[c * 128 + k0 + e]);
          const float qf = ((e & 1) ? bfhi(qa[e >> 1]) : bflo(qa[e >> 1])) * qscale;
          const float kf = (e & 1) ? bfhi(ka[e >> 1]) : bflo(ka[e >> 1]);
          oqd[e] = qf * ebc;
          oqa[e] = oqd[e] * ern[e];
          okb[e] = kf * er[e] * __builtin_amdgcn_rcpf(ebc);
        }
        st8(sQa + c * 264 + k0 * 2, (u32x4){pk2(oqa[0], oqa[1]), pk2(oqa[2], oqa[3]), pk2(oqa[4], oqa[5]), pk2(oqa[6], oqa[7])});
        st8(sKb + c * 264 + k0 * 2, (u32x4){pk2(okb[0], okb[1]), pk2(okb[2], okb[3]), pk2(okb[4], okb[5]), pk2(okb[6], okb[7])});
        *(u32x4*)(qd_o + c * 128 + k0) = (u32x4){pk2(oqd[0], oqd[1]), pk2(oqd[2], oqd[3]), pk2(oqd[4], oqd[5]), pk2(oqd[6], oqd[7])};
      }
      for (int v = tid; v < 1024; v += 512) {
        const int kk = v >> 3, c0 = (v & 7) * 8;
        const float last = bcd[clast * 128 + kk];
        float o[8];
#pragma unroll
        for (int e = 0; e < 8; ++e) {
          const int c = c0 + e;
          const float kf = bf2f(*(const u16*)(sk + c * 264 + kk * 2));
          o[e] = kf * __expf(last - bcd[c * 128 + kk]);
        }
        *(u32x4*)(qd_o + 8192 + kk * 64 + c0) = (u32x4){pk2(o[0], o[1]), pk2(o[2], o[3]), pk2(o[4], o[5]), pk2(o[6], o[7])};
      }
      if (tid < 128) CD[((size_t)item * 2 + d) * 128 + tid] = __expf(bcd[clast * 128 + tid]);
      __syncthreads();
      if (wave < 4) {
        const int tm = wave >> 1, tn = wave & 1;
        f32x16 acc;
        for (int i = 0; i < 16; ++i) acc[i] = 0.f;
#pragma unroll
        for (int s = 0; s < 8; ++s) {
          s16x8 a = ldA_nat(sQa, 32 * tm + r, 264, 16 * s, hh), bb = ldA_nat(sKb, 32 * tn + r, 264, 16 * s, hh);
          acc = MFMA32(a, bb, acc);
        }
#pragma unroll
        for (int i = 0; i < 16; ++i) {
          const int ii = 32 * tm + crow(i, hh), jj = 32 * tn + r;
          const bool keep = d ? (ii <= jj) : (ii >= jj);
          asum[i] += keep ? acc[i] : 0.f;
        }
      }
      __syncthreads();
    }
    if (wave < 4) {
      const int tm = wave >> 1, tn = wave & 1;
#pragma unroll
      for (int i = 0; i < 16; ++i) AS[(size_t)item * 4096 + (32 * tm + crow(i, hh)) * 64 + 32 * tn + r] = f2bf(asum[i]);
    }
  }
}

template <int GROUP>
DI void yg_phase(u16* o0, const u16* o1, const u16* z, const u16* zctx, const float* ng, int nrows, const int wave_s_) {
  const int gt = blockIdx.x * 512 + TIDX(), nthr = gridDim.x * 512;
  const int total = nrows * 256;
  for (int idx0 = gt; idx0 < total; idx0 += 2 * nthr) {
    const bool ok1 = idx0 + nthr < total;
    u32x4 a[2], bq[2], zz[2];
#pragma unroll
    for (int u = 0; u < 2; ++u) {
      const int idx = (u == 0 || ok1) ? idx0 + u * nthr : idx0;
      const size_t off = (size_t)(idx >> 8) * 2048 + (idx & 255) * 8;
      const int zrow = idx >> 8;
      const u16* zp = (zrow < RL) ? z + off : zctx + (size_t)(zrow - RL) * 2048 + (idx & 255) * 8;
      a[u] = __builtin_nontemporal_load((const u32x4*)(o0 + off)); bq[u] = __builtin_nontemporal_load((const u32x4*)(o1 + off)); zz[u] = __builtin_nontemporal_load((const u32x4*)zp);
    }
#pragma unroll
    for (int u = 0; u < 2; ++u) {
      if (u == 1 && !ok1) break;
      const int idx = idx0 + u * nthr, ch = (idx & 255) * 8;
      const size_t off = (size_t)(idx >> 8) * 2048 + ch;
      float o[8] = {bflo(a[u].x) + bflo(bq[u].x), bfhi(a[u].x) + bfhi(bq[u].x), bflo(a[u].y) + bflo(bq[u].y), bfhi(a[u].y) + bfhi(bq[u].y),
                    bflo(a[u].z) + bflo(bq[u].z), bfhi(a[u].z) + bfhi(bq[u].z), bflo(a[u].w) + bflo(bq[u].w), bfhi(a[u].w) + bfhi(bq[u].w)};
      const float zf[8] = {bflo(zz[u].x), bfhi(zz[u].x), bflo(zz[u].y), bfhi(zz[u].y), bflo(zz[u].z), bfhi(zz[u].z), bflo(zz[u].w), bfhi(zz[u].w)};
      float ss = 0.f;
#pragma unroll
      for (int e = 0; e < 8; ++e) ss += o[e] * o[e];
#pragma unroll
      for (int of = 1; of < GROUP; of <<= 1) ss += __shfl_xor(ss, of, 64);
      const float rstd = rsqrtf(ss * (1.f / (GROUP * 8)) + EPSF);
      const int gi = ch & (GROUP * 8 - 1);
      const f32x4 g0 = *(const f32x4*)(ng + gi), g1 = *(const f32x4*)(ng + gi + 4);
      const float gg[8] = {g0.x, g0.y, g0.z, g0.w, g1.x, g1.y, g1.z, g1.w};
#pragma unroll
      for (int e = 0; e < 8; ++e) o[e] = o[e] * rstd * gg[e] * siluf(zf[e]);
      *(u32x4*)(o0 + off) = (u32x4){pk2(o[0], o[1]), pk2(o[2], o[3]), pk2(o[4], o[5]), pk2(o[6], o[7])};
    }
  }
}

DI void final_phase(float* out, const float* g, const int wave_s_) {
  const int tidx_ = TIDX();
  const int lane = tidx_ & 63, gw = blockIdx.x * 8 + (tidx_ >> 6), nw = gridDim.x * 8;
  for (int row0 = gw; row0 < RL; row0 += 2 * nw) {
    const int rows[2] = {row0, row0 + nw};
    const bool ok1 = rows[1] < RL;
    f32x4 v[2][4];
#pragma unroll
    for (int u = 0; u < 2; ++u) {
      const float* s = out + (size_t)((u == 0 || ok1) ? rows[u] : rows[0]) * DM;
#pragma unroll
      for (int q = 0; q < 4; ++q) v[u][q] = __builtin_nontemporal_load((const f32x4*)(s + q * 256 + lane * 4));
    }
#pragma unroll
    for (int u = 0; u < 2; ++u) {
      if (u == 1 && !ok1) break;
      float* s = out + (size_t)rows[u] * DM;
      float ss = 0.f;
#pragma unroll
      for (int q = 0; q < 4; ++q) ss += v[u][q].x * v[u][q].x + v[u][q].y * v[u][q].y + v[u][q].z * v[u][q].z + v[u][q].w * v[u][q].w;
      ss = wave_sum(ss);
      const float rstd = rsqrtf(ss * (1.f / 1024.f) + EPSF);
#pragma unroll
      for (int q = 0; q < 4; ++q) {
        const f32x4 gg = *(const f32x4*)(g + q * 256 + lane * 4);
        f32x4 o = {v[u][q].x * rstd * gg.x, v[u][q].y * rstd * gg.y, v[u][q].z * rstd * gg.z, v[u][q].w * rstd * gg.w};
        __builtin_nontemporal_store(o, (f32x4*)(s + q * 256 + lane * 4));
      }
    }
  }
}

#define XB_XSUB(j)  (64 * (j))
#define XB_XGEN(j)  (1024 + 64 * (j))
#define XB_TOP      2048
#define XB_TOPGEN   2112
#define XCD_BAR_WORDS 2176
DI unsigned xb_ld(unsigned* p) { return __hip_atomic_load(p, __ATOMIC_RELAXED, __HIP_MEMORY_SCOPE_AGENT); }
DI unsigned xb_add(unsigned* p, unsigned v) { return __hip_atomic_fetch_add(p, v, __ATOMIC_RELAXED, __HIP_MEMORY_SCOPE_AGENT); }
DI void gbar(char* ws, const int wave_s_) {
  asm volatile("s_waitcnt vmcnt(0)" ::: "memory");
  __syncthreads();
  if (wave_s_ == 0 && lane_id() == 0) {
    unsigned* bar = (unsigned*)(ws + OFF_BAR);
    __builtin_amdgcn_s_waitcnt(0);
    const unsigned x = (unsigned)__builtin_amdgcn_s_getreg((3 << 11) | 20) & 0xFu;
    const unsigned nloc = gridDim.x >> 3, nx = 8u;
    const unsigned old = xb_add(&bar[XB_XSUB(x)], 1u);
    const unsigned gen = old / nloc;
    if (old + 1u == (gen + 1u) * nloc) {
      __builtin_amdgcn_fence(__ATOMIC_RELEASE, "agent");
      asm volatile("s_waitcnt vmcnt(0)" ::: "memory");
      const unsigned og = xb_add(&bar[XB_TOP], 1u);
      const unsigned tg = og / nx;
      if (og + 1u == (tg + 1u) * nx) xb_add(&bar[XB_TOPGEN], 1u);
      else while (xb_ld(&bar[XB_TOPGEN]) == tg) __builtin_amdgcn_s_sleep(1);
      __builtin_amdgcn_fence(__ATOMIC_ACQUIRE, "agent");
      xb_add(&bar[XB_XGEN(x)], 1u);
      asm volatile("s_waitcnt vmcnt(0)" ::: "memory");
    } else {
      while (xb_ld(&bar[XB_XGEN(x)]) == gen) __builtin_amdgcn_s_sleep(1);
      __builtin_amdgcn_fence(__ATOMIC_ACQUIRE, "agent");
      asm volatile("s_waitcnt vmcnt(0)" ::: "memory");
    }
  }
  __syncthreads();
}
#ifndef REP_GEMM
#define REP_GEMM 1
#endif
#ifndef REP_PREP
#define REP_PREP 1
#endif
#ifndef REP_GLP
#define REP_GLP 1
#endif
#ifndef REP_SCAN
#define REP_SCAN 0
#endif
#ifndef REP_SYNC
#define REP_SYNC 0
#endif
#ifndef REP_EW
#define REP_EW 1
#endif
__global__ void __launch_bounds__(512, 2) fwd_megakernel(Params p) {
  __shared__ __attribute__((aligned(1024))) char shm[141312];
  cg::grid_group grid = cg::this_grid();
  const int wave_s_ = __builtin_amdgcn_readfirstlane((int)(threadIdx.x >> 6));
  char* ws = p.ws;
  float* mods = (float*)(ws + OFF_MOD);
  u16* W0T = (u16*)(ws + OFF_W0T);
  u16* WO0T = (u16*)(ws + OFF_WO0T);
  u16* W1T = (u16*)(ws + OFF_W1T);
  u16* WO1T = (u16*)(ws + OFF_WO1T);
  u16* outb = (u16*)p.out;
  float* ctx1 = (float*)(ws + OFF_X);

  mods_phase(shm, p, wave_s_);
  wtrans_phase<0>(shm, p, wave_s_);
  grid.sync();
  {
    u16* H0 = (u16*)(ws + OFF_T);
    h_phase(p.x, p.ctx, p.norm_g, mods, H0, R, wave_s_);
    gbar(ws, wave_s_);
#if REP_EW > 1
    h_phase(p.x, p.ctx, p.norm_g, mods, H0, R, wave_s_);
    gbar(ws, wave_s_);
#endif
    small_gemm(H0, W0T + (size_t)6144 * 1024, (float*)(ws + OFF_ABT), wave_s_);
    EpiArgs e{};
    e.mode = 0; e.lat = outb; e.ctx = (u16*)(ws + OFF_X); e.ld = 2048;
    gemm_phase<0>(shm, H0, H0 + (size_t)RL * 1024, 1024, W0T, 0, 128, 8, e, wave_s_);
    {
      EpiArgs ec{};
      ec.mode = 4; ec.ctx = (u16*)(ws + OFF_X);
      gemm_phase<4>(shm, H0, H0 + (size_t)RL * 1024, 1024, W0T, 128, 4, 24, ec, wave_s_);
    }
    gbar(ws, wave_s_);
#if REP_GEMM > 1
    gemm_phase<0>(shm, H0, H0 + (size_t)RL * 1024, 1024, W0T, 0, 132, 8, e, wave_s_);
    gbar(ws, wave_s_);
#endif
    conv_phase<false>(p, wave_s_);
    gbar(ws, wave_s_);
#if REP_EW > 1
    conv_phase<false>(p, wave_s_);
    gbar(ws, wave_s_);
#endif
    gemm_phase<0>(shm, H0, H0 + (size_t)RL * 1024, 1024, W0T + (size_t)2048 * 1024, 0, 128, 8, e, wave_s_);
    gbar(ws, wave_s_);
#if REP_GEMM > 1
    gemm_phase<0>(shm, H0, H0 + (size_t)RL * 1024, 1024, W0T + (size_t)2048 * 1024, 0, 132, 8, e, wave_s_);
    gbar(ws, wave_s_);
#endif
    conv_phase<true>(p, wave_s_);
    gbar(ws, wave_s_);
#if REP_EW > 1
    conv_phase<true>(p, wave_s_);
    gbar(ws, wave_s_);
#endif
    for (int rep_ = 0; rep_ < REP_PREP; ++rep_) {
    dn_prep_phase(shm, p, wave_s_);
    gbar(ws, wave_s_);
    }
    for (int rep_ = 0; rep_ < REP_SCAN; ++rep_) { scan_phase<true, true>(shm, p, wave_s_); gbar(ws, wave_s_); }
    for (int rep_ = 0; rep_ < REP_SYNC; ++rep_) gbar(ws, wave_s_);
    scan_phase<true>(shm, p, wave_s_);
    gbar(ws, wave_s_);
    u16* H0b = H0;
    u16* Z = (u16*)(ws + OFF_QK0);
    EpiArgs ez{};
    ez.mode = 0; ez.lat = Z; ez.ctx = Z + (size_t)RL * 2048; ez.ld = 2048;
    gemm_phase<0>(shm, H0b, H0b + (size_t)RL * 1024, 1024, W0T + (size_t)4096 * 1024, 0, 128, 8, ez, wave_s_);
    gbar(ws, wave_s_);
#if REP_GEMM > 1
    gemm_phase<0>(shm, H0b, H0b + (size_t)RL * 1024, 1024, W0T + (size_t)4096 * 1024, 0, 132, 8, ez, wave_s_);
    gbar(ws, wave_s_);
#endif
    u16* U0 = (u16*)(ws + OFF_U0);
    yg_phase<32>(U0, (const u16*)(ws + OFF_U1), Z, (const u16*)(ws + OFF_ZC), p.dn_norm_g, R, wave_s_);
    gbar(ws, wave_s_);
    EpiArgs eo{};
    eo.mode = 2; eo.res_lat = p.x; eo.res_ctx = p.ctx; eo.mods_i = mods; eo.out_lat = p.out; eo.out_ctx = ctx1;
    gemm_phase<2>(shm, U0, U0 + (size_t)RL * 2048, 2048, WO0T, 0, 132, 4, eo, wave_s_);
    gbar(ws, wave_s_);
#if REP_GEMM > 1
    gemm_phase<2>(shm, U0, U0 + (size_t)RL * 2048, 2048, WO0T, 0, 132, 4, eo, wave_s_);
    gbar(ws, wave_s_);
#endif
  }
  {
    const float* mods1 = mods + 5 * 3072;
    u16* H1 = (u16*)(ws + OFF_QD);
    h_phase(p.out, ctx1, p.norm_g + 1024, mods1, H1, R, wave_s_);
    wtrans_phase<1>(shm, p, wave_s_);
    gbar(ws, wave_s_);
    small_gemm(H1, W1T + (size_t)5120 * 1024, (float*)(ws + OFF_ABT), wave_s_);
    EpiArgs e{};
    e.mode = 1; e.lat = (u16*)(ws + OFF_QK1); e.b1 = (u16*)(ws + OFF_V0); e.b2 = (u16*)(ws + OFF_V1);
    gemm_phase<1>(shm, H1, H1 + (size_t)RL * 1024, 1024, W1T, 0, 132, 12, e, wave_s_);
    gbar(ws, wave_s_);
    for (int rep_ = 0; rep_ < REP_GLP; ++rep_) {
    gla_prep_phase(shm, p, wave_s_);
    gbar(ws, wave_s_);
    }
    for (int rep_ = 0; rep_ < REP_SCAN; ++rep_) { scan_phase<false, true>(shm, p, wave_s_); gbar(ws, wave_s_); }
    scan_phase<false>(shm, p, wave_s_);
    gbar(ws, wave_s_);
    u16* H1b = (u16*)(ws + OFF_QK1);
    h_phase(p.out, ctx1, p.norm_g + 1024, mods1, H1b, RL, wave_s_);
    gbar(ws, wave_s_);
    u16* RB = (u16*)(ws + OFF_QD);
    EpiArgs er{};
    er.mode = 0; er.lat = RB; er.ctx = RB; er.ld = 2048;
    gemm_phase<0>(shm, H1b, H1b, 1024, W1T + (size_t)3072 * 1024, 0, 128, 8, er, wave_s_);
    gbar(ws, wave_s_);
    u16* V0 = (u16*)(ws + OFF_V0);
    yg_phase<64>(V0, (const u16*)(ws + OFF_V1), RB, RB, p.gla_norm_g, RL, wave_s_);
    gbar(ws, wave_s_);
    EpiArgs eo{};
    eo.mode = 2; eo.res_lat = p.out; eo.res_ctx = p.out; eo.mods_i = mods1; eo.out_lat = p.out; eo.out_ctx = p.out;
    gemm_phase<2>(shm, V0, V0, 2048, WO1T, 0, 128, 4, eo, wave_s_);
    gbar(ws, wave_s_);
    final_phase(p.out, p.final_g, wave_s_);
  }
}

extern "C" void kernel_launch(void* const* d_in, const int* in_sizes, int n_in, void* d_out, int out_size, void* d_ws,
                              size_t ws_size, hipStream_t stream) {
  static int grid_blocks = 0;
  if (!grid_blocks) {
    int dev = 0, cus = 0, per_cu = 0;
    hipGetDevice(&dev);
    hipDeviceGetAttribute(&cus, hipDeviceAttributeMultiprocessorCount, dev);
    hipOccupancyMaxActiveBlocksPerMultiprocessor(&per_cu, fwd_megakernel, 512, 0);
    if (per_cu < 1) per_cu = 1;
    grid_blocks = cus;
    if (grid_blocks > 256) grid_blocks = 256;
  }
  Params p{};
  p.x = (const float*)d_in[0]; p.c = (const float*)d_in[1]; p.ctx = (const float*)d_in[2]; p.c_ctx = (const float*)d_in[3];
  p.mod_w = (const float*)d_in[4]; p.mod_b = (const float*)d_in[5]; p.norm_g = (const float*)d_in[6];
  p.dn_w_in = (const float*)d_in[7]; p.dn_conv_w = (const float*)d_in[8]; p.dn_a_log = (const float*)d_in[9];
  p.dn_dt_bias = (const float*)d_in[10]; p.dn_norm_g = (const float*)d_in[11]; p.dn_w_out = (const float*)d_in[12];
  p.gla_w_in = (const float*)d_in[13]; p.gla_w_g2 = (const float*)d_in[14]; p.gla_b_g = (const float*)d_in[15];
  p.gla_norm_g = (const float*)d_in[16]; p.gla_w_out = (const float*)d_in[17]; p.final_g = (const float*)d_in[18];
  p.out = (float*)d_out;
  p.ws = (char*)d_ws;
  (void)hipMemsetAsync((char*)d_ws + OFF_BAR, 0, XCD_BAR_WORDS * sizeof(unsigned), stream);
  void* args[] = {&p};
  hipError_t e = hipLaunchCooperativeKernel((void*)fwd_megakernel, dim3(grid_blocks), dim3(512), args, 0, stream);
  if (e != hipSuccess) fprintf(stderr, "cooperative launch failed: %s (grid %d)\n", hipGetErrorString(e), grid_blocks);
}
```

```cpp
#include <hip/hip_runtime.h>
#include <hip/hip_cooperative_groups.h>
#include <cstdio>
namespace cg = cooperative_groups;

#define DI __device__ __forceinline__
typedef unsigned short u16;
typedef short s16x8 __attribute__((ext_vector_type(8)));
typedef short s16x4 __attribute__((ext_vector_type(4)));
typedef float f32x2 __attribute__((ext_vector_type(2)));
typedef float f32x4 __attribute__((ext_vector_type(4)));
typedef float f32x16 __attribute__((ext_vector_type(16)));
typedef int i32x4 __attribute__((ext_vector_type(4)));
typedef unsigned u32x2 __attribute__((ext_vector_type(2)));
typedef unsigned u32x4 __attribute__((ext_vector_type(4)));
typedef __bf16 bf2_t __attribute__((ext_vector_type(2)));

constexpr int RL = 32768;
constexpr int RC = 1024;
constexpr int R = RL + RC;
constexpr int DM = 1024;
constexpr int NCHUNK = R / 64;
constexpr float EPSF = 1e-6f;
constexpr size_t MiB = 1u << 20;

constexpr size_t OFF_QK0 = 0;
constexpr size_t OFF_U0 = 132 * MiB;
constexpr size_t OFF_U1 = 264 * MiB;
constexpr size_t OFF_T = 396 * MiB;
constexpr size_t OFF_W1T = 462 * MiB;
constexpr size_t OFF_WO1T = OFF_W1T + 10 * MiB + 256 * 1024;
constexpr size_t OFF_MOD = OFF_WO1T + 4 * MiB;
constexpr size_t OFF_X = OFF_MOD + 256 * 1024;
constexpr size_t OFF_ABT = OFF_X + 8 * MiB + 256 * 1024;
constexpr size_t OFF_W0T = OFF_ABT + 4 * MiB + 256 * 1024;
constexpr size_t OFF_WO0T = OFF_W0T + 12 * MiB + 256 * 1024;
constexpr size_t OFF_V0 = 0;
constexpr size_t OFF_V1 = 132 * MiB;
constexpr size_t OFF_QK1 = 264 * MiB;
constexpr size_t OFF_QD = 330 * MiB;
constexpr size_t OFF_CD1 = OFF_X + 4 * MiB;
constexpr size_t OFF_ASUM = OFF_W0T;
constexpr size_t OFF_BAR = 506 * MiB;
constexpr size_t OFF_ZC = 507 * MiB;

constexpr size_t TA_LAT_ITEMS = 4096;
constexpr size_t OFF_TC = 462 * MiB;
constexpr size_t OFF_AC = 464 * MiB;
DI size_t ta_off(size_t item, int d) { return ((item < TA_LAT_ITEMS ? item : item - TA_LAT_ITEMS) * 2 + d) * 4096; }
struct Params {
  const float *x, *c, *ctx, *c_ctx, *mod_w, *mod_b, *norm_g, *dn_w_in, *dn_conv_w, *dn_a_log, *dn_dt_bias, *dn_norm_g,
      *dn_w_out, *gla_w_in, *gla_w_g2, *gla_b_g, *gla_norm_g, *gla_w_out, *final_g;
  float* out;
  char* ws;
};

DI unsigned pk2(float lo, float hi) { f32x2 v = {lo, hi}; return __builtin_bit_cast(unsigned, __builtin_convertvector(v, bf2_t)); }
DI float bflo(unsigned u) { return __uint_as_float(u << 16); }
DI float bfhi(unsigned u) { return __uint_as_float(u & 0xffff0000u); }
DI float bf2f(u16 v) { return __uint_as_float(((unsigned)v) << 16); }
DI u16 f2bf(float x) { return (u16)(pk2(x, 0.f) & 0xffffu); }
DI float siluf(float x) { return x / (1.f + __expf(-x)); }
DI float sigmoidf(float x) { return 1.f / (1.f + __expf(-x)); }
DI float softplusf(float x) { return fmaxf(x, 0.f) + __logf(1.f + __expf(-fabsf(x))); }
DI int crow(int reg, int h) { return (reg & 3) + 8 * (reg >> 2) + 4 * h; }
#define MFMA32(a, b, c) __builtin_amdgcn_mfma_f32_32x32x16_bf16((a), (b), (c), 0, 0, 0)
#define MFMA16(a, b, c) __builtin_amdgcn_mfma_f32_16x16x32_bf16((a), (b), (c), 0, 0, 0)

DI s16x8 cat8(u32x2 lo, u32x2 hi) { u32x4 v = {lo.x, lo.y, hi.x, hi.y}; return __builtin_bit_cast(s16x8, v); }
DI s16x8 ldA_perm(const char* base, int row, int strideB, int kofs, int h) {
  const char* p = base + row * strideB + (kofs + 4 * h) * 2;
  u32x2 lo = *(const u32x2*)p, hi = *(const u32x2*)(p + 16);
  return cat8(lo, hi);
}
DI s16x8 ldA_nat(const char* base, int row, int strideB, int kofs, int h) {
  const char* p = base + row * strideB + (kofs + 8 * h) * 2;
  u32x2 lo = *(const u32x2*)p, hi = *(const u32x2*)(p + 8);
  return cat8(lo, hi);
}
DI s16x8 pack_step(const f32x16& x, int s) {
  u32x4 p;
  p.x = pk2(x[8 * s + 0], x[8 * s + 1]); p.y = pk2(x[8 * s + 2], x[8 * s + 3]);
  p.z = pk2(x[8 * s + 4], x[8 * s + 5]); p.w = pk2(x[8 * s + 6], x[8 * s + 7]);
  return __builtin_bit_cast(s16x8, p);
}
DI void st8(char* p, u32x4 v) { *(u32x2*)p = (u32x2){v.x, v.y}; *(u32x2*)(p + 8) = (u32x2){v.z, v.w}; }
DI u32x4 scale8(u32x4 v, float s) {
  u32x4 o;
  o.x = pk2(bflo(v.x) * s, bfhi(v.x) * s); o.y = pk2(bflo(v.y) * s, bfhi(v.y) * s);
  o.z = pk2(bflo(v.z) * s, bfhi(v.z) * s); o.w = pk2(bflo(v.w) * s, bfhi(v.w) * s);
  return o;
}
DI int opq_v(int v) { asm volatile("" : "+v"(v)); return v; }
DI int lane_id() { int r; asm volatile("v_mbcnt_lo_u32_b32 %0, -1, 0\n\tv_mbcnt_hi_u32_b32 %0, -1, %0" : "=v"(r)); return r; }
#define TIDX() (wave_s_ * 64 + lane_id())
DI float wave_sum(float v) {
#pragma unroll
  for (int o = 32; o >= 1; o >>= 1) v += __shfl_xor(v, o, 64);
  return v;
}

DI void mods_phase(char* shm, const Params& p, const int wave_s_) {
  const int bid = blockIdx.x, tid = TIDX();
  float* mods = (float*)(p.ws + OFF_MOD);
  if (bid < 192) {
    float* scond = (float*)shm;
    float* red = scond + 5 * 1024;
    for (int e = tid; e < 5 * 1024; e += 512) {
      int r = e >> 10, k = e & 1023;
      float v = (r < 4) ? p.c[r * 1024 + k] : p.c_ctx[k];
      scond[e] = siluf(v);
    }
    __syncthreads();
    const int i = bid / 96, jt = bid % 96, jl = tid & 31, ks = tid >> 5;
    const float* w = p.mod_w + (size_t)i * 1024 * 3072 + jt * 32 + jl;
    float a0 = 0, a1 = 0, a2 = 0, a3 = 0, a4 = 0;
#pragma unroll 8
    for (int kk = 0; kk < 64; ++kk) {
      int k = ks * 64 + kk;
      float wv = __builtin_nontemporal_load(w + (size_t)k * 3072);
      a0 += scond[k] * wv; a1 += scond[1024 + k] * wv; a2 += scond[2048 + k] * wv; a3 += scond[3072 + k] * wv; a4 += scond[4096 + k] * wv;
    }
    red[(ks * 5 + 0) * 32 + jl] = a0; red[(ks * 5 + 1) * 32 + jl] = a1; red[(ks * 5 + 2) * 32 + jl] = a2;
    red[(ks * 5 + 3) * 32 + jl] = a3; red[(ks * 5 + 4) * 32 + jl] = a4;
    __syncthreads();
    if (tid < 160) {
      int r = tid >> 5, j = tid & 31;
      float s = p.mod_b[i * 3072 + jt * 32 + j];
      for (int q = 0; q < 16; ++q) s += red[(q * 5 + r) * 32 + j];
      mods[(i * 5 + r) * 3072 + jt * 32 + j] = s;
    }
    __syncthreads();
  }
}

DI void wtrans_tile(char* shm, const float* src, int K, int N, u16* dst, int tile, const int wave_s_) {
  u16* t = (u16*)shm;
  const int tid = TIDX();
  const int tn = (N + 63) / 64;
  const int k0 = (tile / tn) * 64, n0 = (tile % tn) * 64;
#pragma unroll
  for (int q = 0; q < 2; ++q) {
    const int e = tid + q * 512, kk = e >> 4, nn = (e & 15) * 4;
    f32x4 v = {0.f, 0.f, 0.f, 0.f};
    if (n0 + nn < N) v = __builtin_nontemporal_load((const f32x4*)(src + (size_t)(k0 + kk) * N + n0 + nn));
    t[(nn + 0) * 72 + kk] = f2bf(v.x); t[(nn + 1) * 72 + kk] = f2bf(v.y);
    t[(nn + 2) * 72 + kk] = f2bf(v.z); t[(nn + 3) * 72 + kk] = f2bf(v.w);
  }
  __syncthreads();
  {
    const int nn = tid >> 3, kk = (tid & 7) * 8;
    if (n0 + nn < N) *(u32x4*)(dst + (size_t)(n0 + nn) * K + k0 + kk) = *(const u32x4*)(t + nn * 72 + kk);
  }
  __syncthreads();
}
template <int LAYER>
DI void wtrans_phase(char* shm, const Params& p, const int wave_s_) {
  const int t0 = 16 * 97, t1 = 32 * 16, t2 = 16 * 81, t3 = 32 * 16;
  if (LAYER == 0) {
    for (int tile = blockIdx.x; tile < t0 + t1; tile += gridDim.x) {
      if (tile < t0) wtrans_tile(shm, p.dn_w_in, 1024, 6176, (u16*)(p.ws + OFF_W0T), tile, wave_s_);
      else wtrans_tile(shm, p.dn_w_out, 2048, 1024, (u16*)(p.ws + OFF_WO0T), tile - t0, wave_s_);
    }
  } else {
    for (int tile = blockIdx.x; tile < t2 + t3; tile += gridDim.x) {
      if (tile < t2) wtrans_tile(shm, p.gla_w_in, 1024, 5152, (u16*)(p.ws + OFF_W1T), tile, wave_s_);
      else wtrans_tile(shm, p.gla_w_out, 2048, 1024, (u16*)(p.ws + OFF_WO1T), tile - t2, wave_s_);
    }
  }
}

DI void h_phase(const float* src_lat, const float* src_ctx, const float* g, const float* mods_i, u16* dst, int nrows, const int wave_s_) {
  const int tidx_ = TIDX();
  const int lane = tidx_ & 63, gw = blockIdx.x * 8 + (tidx_ >> 6), nw = gridDim.x * 8;
  for (int row0 = gw; row0 < nrows; row0 += 2 * nw) {
    const int rows[2] = {row0, row0 + nw};
    const bool ok1 = rows[1] < nrows;
    f32x4 v[2][4];
#pragma unroll
    for (int u = 0; u < 2; ++u) {
      const int row = (u == 0 || ok1) ? rows[u] : rows[0];
      const float* s = (row < RL) ? src_lat + (size_t)row * DM : src_ctx + (size_t)(row - RL) * DM;
#pragma unroll
      for (int q = 0; q < 4; ++q) v[u][q] = __builtin_nontemporal_load((const f32x4*)(s + q * 256 + lane * 4));
    }
#pragma unroll
    for (int u = 0; u < 2; ++u) {
      if (u == 1 && !ok1) break;
      const int row = rows[u];
      const int mr = (row < RL) ? (row >> 13) : 4;
      const float* sh = mods_i + mr * 3072;
      const float* sc = sh + 1024;
      float ss = 0.f;
#pragma unroll
      for (int q = 0; q < 4; ++q) ss += v[u][q].x * v[u][q].x + v[u][q].y * v[u][q].y + v[u][q].z * v[u][q].z + v[u][q].w * v[u][q].w;
      ss = wave_sum(ss);
      const float rstd = rsqrtf(ss * (1.f / 1024.f) + EPSF);
#pragma unroll
      for (int q = 0; q < 4; ++q) {
        const int col = q * 256 + lane * 4;
        f32x4 gg = *(const f32x4*)(g + col), s1 = *(const f32x4*)(sc + col), s0 = *(const f32x4*)(sh + col);
        float o0 = v[u][q].x * rstd * gg.x * (1.f + s1.x) + s0.x, o1 = v[u][q].y * rstd * gg.y * (1.f + s1.y) + s0.y;
        float o2 = v[u][q].z * rstd * gg.z * (1.f + s1.z) + s0.z, o3 = v[u][q].w * rstd * gg.w * (1.f + s1.w) + s0.w;
        *(u32x2*)(dst + (size_t)row * DM + col) = (u32x2){pk2(o0, o1), pk2(o2, o3)};
      }
    }
  }
}

DI void small_gemm(const u16* A, const u16* Wt, float* out, const int wave_s_) {
  const int tidx_ = TIDX();
  if ((blockIdx.x & 7) == 0) return;
  const int bsub = (int)blockIdx.x - 1 - ((int)blockIdx.x >> 3);
  const int lane = tidx_ & 63, gw = bsub * 8 + (tidx_ >> 6), nw = (gridDim.x - (gridDim.x >> 3)) * 8;
  const int r = lane & 31, h = lane >> 5;
  for (int wt = gw; wt < R / 32; wt += nw) {
    const u16* ap = A + (size_t)(wt * 32 + r) * 1024 + 8 * h;
    const u16* bp = Wt + (size_t)r * 1024 + 8 * h;
    f32x16 acc;
    for (int i = 0; i < 16; ++i) acc[i] = 0.f;
#pragma unroll 8
    for (int s = 0; s < 64; ++s) {
      s16x8 a = *(const s16x8*)(ap + 16 * s), b = *(const s16x8*)(bp + 16 * s);
      acc = MFMA32(a, b, acc);
    }
#pragma unroll
    for (int i = 0; i < 16; ++i) out[(size_t)(wt * 32 + crow(i, h)) * 32 + r] = acc[i];
  }
}

DI int lds_byte2(int r, int c) {
  int st = (r >> 4) * 2 + (c >> 5), ob = (r & 15) * 64 + (c & 31) * 2;
  return st * 1024 + (ob ^ (((ob >> 9) & 1) << 5));
}
DI void stage_rc2(int b, int& Rr, int& Cc) {
  int st = b >> 10, sb = b & 1023, swz = sb ^ (((sb >> 9) & 1) << 5);
  Rr = (st / 2) * 16 + swz / 64;
  Cc = (st % 2) * 32 + (swz % 64) / 2;
}

struct EpiArgs {
  int mode;
  u16* lat; u16* ctx; int ld;
  u16* b1; u16* b2;
  const float* res_lat; const float* res_ctx; const float* mods_i; float* out_lat; float* out_ctx;
};

template <int MODE>
DI void gemm_epilogue(const EpiArgs& e, f32x4 (&acc)[8][4], int row0, int pn, int wr, int wc, int fr, int fq) {
#pragma unroll
  for (int m = 0; m < 8; ++m) {
    const int row = row0 + wr * 128 + m * 16 + fr;
#pragma unroll
    for (int n = 0; n < 4; ++n) {
      const int col = pn * 256 + wc * 64 + n * 16 + fq * 4;
      const f32x4 a = acc[m][n];
      if (MODE == 0) {
        u16* pr = (row < RL) ? e.lat + (size_t)row * e.ld : e.ctx + (size_t)(row - RL) * e.ld;
        *(u32x2*)(pr + col) = (u32x2){pk2(a.x, a.y), pk2(a.z, a.w)};
      } else if (MODE == 1) {
        u32x2 v = {pk2(a.x, a.y), pk2(a.z, a.w)};
        if (pn < 4) {
          *(u32x2*)(e.lat + (size_t)row * 1024 + col) = v;
        } else {
          *(u32x2*)(e.b1 + (size_t)row * 2048 + col - 1024) = v;
          *(u32x2*)(e.b2 + (size_t)row * 2048 + col - 1024) = v;
        }
      } else {
        const int mr = (row < RL) ? (row >> 13) : 4;
        const f32x4 gt = *(const f32x4*)(e.mods_i + mr * 3072 + 2048 + col);
        const float* rp = (row < RL) ? e.res_lat + (size_t)row * DM : e.res_ctx + (size_t)(row - RL) * DM;
        float* op = (row < RL) ? e.out_lat + (size_t)row * DM : e.out_ctx + (size_t)(row - RL) * DM;
        const f32x4 rv = *(const f32x4*)(rp + col);
        f32x4 o = {rv.x + gt.x * a.x, rv.y + gt.y * a.y, rv.z + gt.z * a.z, rv.w + gt.w * a.w};
        *(f32x4*)(op + col) = o;
      }
    }
  }
}

template <int MODE>
DI void gemm_epilogue8(const EpiArgs& e, f32x4 (&acc)[2][2][4][2], int row0, int pn, int wr, int wc, int fr, int fq) {
#pragma unroll
  for (int ai = 0; ai < 2; ++ai)
#pragma unroll
    for (int m = 0; m < 4; ++m) {
      const int row = row0 + ai * 128 + wr * 64 + m * 16 + fr;
#pragma unroll
      for (int bj = 0; bj < 2; ++bj)
#pragma unroll
        for (int n = 0; n < 2; ++n) {
          const int col = pn * 256 + bj * 128 + wc * 32 + n * 16 + fq * 4;
          const f32x4 a = acc[ai][bj][m][n];
          if (MODE == 0) {
            u16* pr = (row < RL) ? e.lat + (size_t)row * e.ld : e.ctx + (size_t)(row - RL) * e.ld;
            *(u32x2*)(pr + col) = (u32x2){pk2(a.x, a.y), pk2(a.z, a.w)};
          } else if (MODE == 4) {
            const size_t dsel = (pn < 8) ? 0 : (pn < 16) ? (4 * MiB / 2) : ((OFF_ZC - OFF_X) / 2);
            *(u32x2*)(e.ctx + dsel + (size_t)(row - RL) * 2048 + (col & 2047)) = (u32x2){pk2(a.x, a.y), pk2(a.z, a.w)};
          } else if (MODE == 1) {
            u32x2 v = {pk2(a.x, a.y), pk2(a.z, a.w)};
            if (pn < 4) {
              *(u32x2*)(e.lat + (size_t)row * 1024 + col) = v;
            } else {
              *(u32x2*)(e.b1 + (size_t)row * 2048 + col - 1024) = v;
              *(u32x2*)(e.b2 + (size_t)row * 2048 + col - 1024) = v;
            }
          } else {
            const int mr = (row < RL) ? (row >> 13) : 4;
            const f32x4 gt = *(const f32x4*)(e.mods_i + mr * 3072 + 2048 + col);
            const float* rp = (row < RL) ? e.res_lat + (size_t)row * DM : e.res_ctx + (size_t)(row - RL) * DM;
            float* op = (row < RL) ? e.out_lat + (size_t)row * DM : e.out_ctx + (size_t)(row - RL) * DM;
            const f32x4 rv = __builtin_nontemporal_load((const f32x4*)(rp + col));
            f32x4 o = {rv.x + gt.x * a.x, rv.y + gt.y * a.y, rv.z + gt.z * a.z, rv.w + gt.w * a.w};
            *(f32x4*)(op + col) = o;
          }
        }
    }
}

template <int MODE>
DI void gemm_phase(char* shm_, const u16* Alat, const u16* Actx, int K, const u16* Bt, int pm0, int npm, int nN, const EpiArgs& e, const int wave_s_) {
  constexpr int BK = 64, HALF = 128, HT = HALF * BK;
  u16* shm = (u16*)shm_;
  const int tid = TIDX(), wid = tid >> 6, lane = tid & 63, wr = wid >> 2, wc = wid & 3, fr = lane & 15, fq = lane >> 4;
#define SA(b, h) (shm + ((b) * 2 + (h)) * HT)
#define SB(b, h) (shm + (4 + (b) * 2 + (h)) * HT)
#define LDSP(ptr) ((__attribute__((address_space(3))) unsigned*)(unsigned)(size_t)(ptr))
#define STAGE(P, BASE, br, kt) do { const u16* _p = (BASE) + (size_t)(br) * K + (kt) * BK + soff; \
    _Pragma("unroll") for (int _i = 0; _i < 2; ++_i) \
      __builtin_amdgcn_global_load_lds((const unsigned*)(_p + (size_t)_i * 64 * K), LDSP((char*)(P) + wid * 1024 + _i * 8192), 16, 0, 0); } while (0)
#define LDA(dst, b, h) _Pragma("unroll") for (int m = 0; m < 4; ++m) _Pragma("unroll") for (int k = 0; k < 2; ++k) \
    dst[m][k] = *(const s16x8*)((const char*)SA(b, h) + lds_byte2(wr * 64 + m * 16 + fr, k * 32 + fq * 8))
#define LDB(dst, b, h) _Pragma("unroll") for (int n = 0; n < 2; ++n) _Pragma("unroll") for (int k = 0; k < 2; ++k) \
    dst[n][k] = *(const s16x8*)((const char*)SB(b, h) + lds_byte2(wc * 32 + n * 16 + fr, k * 32 + fq * 8))
#define MMA(ai, bj, Atv, Btv) do { __builtin_amdgcn_s_setprio(1); \
    _Pragma("unroll") for (int m = 0; m < 4; ++m) _Pragma("unroll") for (int n = 0; n < 2; ++n) _Pragma("unroll") for (int k = 0; k < 2; ++k) \
      acc[ai][bj][m][n] = MFMA16(Btv[n][k], Atv[m][k], acc[ai][bj][m][n]); \
    __builtin_amdgcn_s_setprio(0); } while (0)
#define WAIT_V(n) asm volatile("s_waitcnt vmcnt(" #n ")" ::: "memory")
#define WAIT_L(n) asm volatile("s_waitcnt lgkmcnt(" #n ")" ::: "memory")
#define BAR __builtin_amdgcn_s_barrier()
#define SCHED __builtin_amdgcn_sched_barrier(0)
  int sR0, sC0;
  stage_rc2(tid * 16, sR0, sC0);
  const size_t soff = (size_t)sR0 * K + sC0;
  const int ntiles = npm * nN, nt = K / BK;
  const int xcd = blockIdx.x & 7, jj = blockIdx.x >> 3;
  const int PN = (nN % 8 == 0) ? 8 : 4, PG = 32 / PN, npg = nN / PN;
  const int ngroups = ((npm + PG - 1) / PG) * npg;
  const bool grouped = (gridDim.x == 256);
  const int nit = grouped ? (ngroups - xcd + 7) / 8 : (ntiles - (int)blockIdx.x + (int)gridDim.x - 1) / (int)gridDim.x;
  auto tile_of = [&](int it, int& pm, int& pn) -> bool {
    if (it >= nit) return false;
    if (grouped) {
      const int g = xcd + 8 * it, pmg = g / npg, png = g % npg;
      pm = pmg * PG + jj / PN; pn = png * PN + jj % PN;
      if (pm >= npm) return false;
      pm += pm0;
    } else {
      const int L = blockIdx.x + it * gridDim.x;
      pm = pm0 + L / nN; pn = L % nN;
    }
    return true;
  };
  bool prefetched = false;
  for (int it = 0; it < nit; ++it) {
    int pm, pn;
    if (!tile_of(it, pm, pn)) continue;
    const int row0 = pm * 256;
    const u16* A = (row0 < RL) ? Alat + (size_t)row0 * K : Actx + (size_t)(row0 - RL) * K;
    const u16* Bw = Bt + (size_t)pn * 256 * K;
    const int brow = 0, bcol = 0;
    f32x4 acc[2][2][4][2];
#pragma unroll
    for (int i0 = 0; i0 < 2; ++i0)
#pragma unroll
      for (int i1 = 0; i1 < 2; ++i1)
#pragma unroll
        for (int i2 = 0; i2 < 4; ++i2)
#pragma unroll
          for (int i3 = 0; i3 < 2; ++i3) acc[i0][i1][i2][i3] = (f32x4){0.f, 0.f, 0.f, 0.f};
    s16x8 At[4][2], B0[2][2], B1[2][2];
    if (!prefetched) {
      STAGE(SB(0, 0), Bw, bcol, 0); STAGE(SA(0, 0), A, brow, 0);
      STAGE(SB(0, 1), Bw, bcol + HALF, 0); STAGE(SA(0, 1), A, brow + HALF, 0);
    }
    if (wr == 1) BAR;
    WAIT_V(4); BAR;
    STAGE(SB(1, 0), Bw, bcol, 1); STAGE(SA(1, 0), A, brow, 1); STAGE(SB(1, 1), Bw, bcol + HALF, 1);
    WAIT_V(6); BAR;
    for (int t = 0; t < nt - 2; t += 2) {
      LDB(B0, 0, 0); SCHED; LDA(At, 0, 0); STAGE(SA(1, 1), A, brow + HALF, t + 1);
      WAIT_L(8); BAR; WAIT_L(0); MMA(0, 0, At, B0); BAR; SCHED;
      LDB(B1, 0, 1); STAGE(SB(0, 0), Bw, bcol, t + 2);
      BAR; WAIT_L(0); MMA(0, 1, At, B1); BAR;
      LDA(At, 0, 1); STAGE(SA(0, 0), A, brow, t + 2);
      BAR; WAIT_L(0); MMA(1, 0, At, B0); BAR; SCHED;
      STAGE(SB(0, 1), Bw, bcol + HALF, t + 2);
      WAIT_V(6); BAR; MMA(1, 1, At, B1); BAR;
      LDB(B0, 1, 0); SCHED; LDA(At, 1, 0); STAGE(SA(0, 1), A, brow + HALF, t + 2);
      WAIT_L(8); BAR; WAIT_L(0); MMA(0, 0, At, B0); BAR; SCHED;
      LDB(B1, 1, 1); STAGE(SB(1, 0), Bw, bcol, t + 3);
      BAR; WAIT_L(0); MMA(0, 1, At, B1); BAR;
      LDA(At, 1, 1); STAGE(SA(1, 0), A, brow, t + 3);
      BAR; WAIT_L(0); MMA(1, 0, At, B0); BAR; SCHED;
      STAGE(SB(1, 1), Bw, bcol + HALF, t + 3);
      WAIT_V(6); BAR; MMA(1, 1, At, B1); BAR;
    }
    { LDB(B0, 0, 0); LDA(At, 0, 0); STAGE(SA(1, 1), A, brow + HALF, nt - 1);
      BAR; WAIT_L(0); MMA(0, 0, At, B0); BAR;
      LDB(B1, 0, 1); BAR; WAIT_L(0); MMA(0, 1, At, B1); BAR;
      LDA(At, 0, 1); WAIT_V(4); BAR; WAIT_L(0); MMA(1, 0, At, B0); MMA(1, 1, At, B1); BAR; }
    { LDB(B0, 1, 0); LDA(At, 1, 0); WAIT_V(2); BAR; WAIT_L(0); MMA(0, 0, At, B0); BAR;
      LDB(B1, 1, 1); WAIT_V(0); BAR; WAIT_L(0); MMA(0, 1, At, B1); BAR;
      LDA(At, 1, 1); BAR; WAIT_L(0); MMA(1, 0, At, B0); MMA(1, 1, At, B1); BAR; }
    if (wr == 0) BAR;
    {
      int pm2, pn2;
      prefetched = tile_of(it + 1, pm2, pn2);
      if (prefetched) {
        const int r2 = pm2 * 256;
        const u16* A2 = (r2 < RL) ? Alat + (size_t)r2 * K : Actx + (size_t)(r2 - RL) * K;
        const u16* B2 = Bt + (size_t)pn2 * 256 * K;
        STAGE(SB(0, 0), B2, 0, 0); STAGE(SA(0, 0), A2, 0, 0);
        STAGE(SB(0, 1), B2, HALF, 0); STAGE(SA(0, 1), A2, HALF, 0);
      }
    }
    { const int l2 = lane_id(); gemm_epilogue8<MODE>(e, acc, row0, pn, wr, wc, l2 & 15, l2 >> 4); }
    asm volatile("s_waitcnt vmcnt(0) lgkmcnt(0)" ::: "memory");
    BAR;
  }
#undef SA
#undef SB
#undef LDSP
#undef STAGE
#undef LDA
#undef LDB
#undef MMA
#undef WAIT_V
#undef WAIT_L
#undef BAR
#undef SCHED
}

DI void conv_accum(float (&acc)[8], const u16* srow, const float* w) {
  u32x4 v = *(const u32x4*)srow;
  f32x4 w0 = *(const f32x4*)w, w1 = *(const f32x4*)(w + 4);
  acc[0] += bflo(v.x) * w0.x; acc[1] += bfhi(v.x) * w0.y; acc[2] += bflo(v.y) * w0.z; acc[3] += bfhi(v.y) * w0.w;
  acc[4] += bflo(v.z) * w1.x; acc[5] += bfhi(v.z) * w1.y; acc[6] += bflo(v.w) * w1.z; acc[7] += bfhi(v.w) * w1.w;
}
DI void fma8(float (&acc)[8], const u32x4 v, const float (&w)[8]) {
  acc[0] += bflo(v.x) * w[0]; acc[1] += bfhi(v.x) * w[1]; acc[2] += bflo(v.y) * w[2]; acc[3] += bfhi(v.y) * w[3];
  acc[4] += bflo(v.z) * w[4]; acc[5] += bfhi(v.z) * w[5]; acc[6] += bflo(v.w) * w[6]; acc[7] += bfhi(v.w) * w[7];
}
template <bool ISV>
DI void conv_store(const Params& p, float (&acc)[8], int row, int ch) {
#pragma unroll
  for (int e = 0; e < 8; ++e) acc[e] = siluf(acc[e]);
  if (!ISV) {
    u16* qk = (u16*)(p.ws + OFF_QK0);
    float ss = 0.f;
#pragma unroll
    for (int e = 0; e < 8; ++e) ss += acc[e] * acc[e];
    ss += __shfl_xor(ss, 1, 64); ss += __shfl_xor(ss, 2, 64); ss += __shfl_xor(ss, 4, 64); ss += __shfl_xor(ss, 8, 64);
    const float sc = rsqrtf(ss + EPSF) * ((ch < 1024) ? 0.08838834764831845f : 1.f);
    u32x4 o = {pk2(acc[0] * sc, acc[1] * sc), pk2(acc[2] * sc, acc[3] * sc), pk2(acc[4] * sc, acc[5] * sc), pk2(acc[6] * sc, acc[7] * sc)};
    __builtin_nontemporal_store(o, (u32x4*)(qk + (size_t)row * 2048 + ch));
  } else {
    u16* u0 = (u16*)(p.ws + OFF_U0);
    u16* u1 = (u16*)(p.ws + OFF_U1);
    const float* abt = (const float*)(p.ws + OFF_ABT);
    const int head = ch >> 8;
    const float b0 = sigmoidf(abt[(size_t)row * 32 + 16 + head]), b1 = sigmoidf(abt[(size_t)row * 32 + 24 + head]);
    u32x4 o0 = {pk2(acc[0] * b0, acc[1] * b0), pk2(acc[2] * b0, acc[3] * b0), pk2(acc[4] * b0, acc[5] * b0), pk2(acc[6] * b0, acc[7] * b0)};
    u32x4 o1 = {pk2(acc[0] * b1, acc[1] * b1), pk2(acc[2] * b1, acc[3] * b1), pk2(acc[4] * b1, acc[5] * b1), pk2(acc[6] * b1, acc[7] * b1)};
    __builtin_nontemporal_store(o0, (u32x4*)(u0 + (size_t)row * 2048 + ch));
    __builtin_nontemporal_store(o1, (u32x4*)(u1 + (size_t)row * 2048 + ch));
  }
}
template <bool ISV>
DI void conv_phase(const Params& p, const int wave_s_) {
  const u16* pre_lat = (const u16*)p.out;
  const u16* pre_ctx = (const u16*)(p.ws + OFF_X + (ISV ? 4 * MiB : 0));
  const float* cw = p.dn_conv_w + (ISV ? 2048 : 0);
  const int gt = blockIdx.x * 512 + TIDX(), nthr = gridDim.x * 512;
  const u32x4 zero4 = {0u, 0u, 0u, 0u};
  for (int idx = gt; idx < 4 * 128 * 4 * 256; idx += nthr) {
    const int cg8 = idx & 255, run = (idx >> 8) & 3, gr = (idx >> 10) & 127, b = idx >> 17, ch = cg8 * 8, c0 = run * 16;
    float w[9][8];
#pragma unroll
    for (int t = 0; t < 9; ++t) {
      const f32x4 w0 = *(const f32x4*)(cw + t * 4096 + ch), w1 = *(const f32x4*)(cw + t * 4096 + ch + 4);
      w[t][0] = w0.x; w[t][1] = w0.y; w[t][2] = w0.z; w[t][3] = w0.w; w[t][4] = w1.x; w[t][5] = w1.y; w[t][6] = w1.z; w[t][7] = w1.w;
    }
    const u16* base = pre_lat + ((size_t)(b << 13) + gr * 64) * 2048 + ch;
    const bool rok[3] = {gr > 0, true, gr < 127};
    u32x4 win[3][3];
#pragma unroll
    for (int i = 0; i < 3; ++i) {
      win[i][0] = (rok[i] && c0 > 0) ? *(const u32x4*)(base + (ptrdiff_t)((i - 1) * 64 + c0 - 1) * 2048) : zero4;
      win[i][1] = rok[i] ? *(const u32x4*)(base + (ptrdiff_t)((i - 1) * 64 + c0) * 2048) : zero4;
    }
#pragma unroll
    for (int t = 0; t < 16; ++t) {
      const int c = c0 + t;
#pragma unroll
      for (int i = 0; i < 3; ++i) win[i][2] = (rok[i] && c < 63) ? *(const u32x4*)(base + (ptrdiff_t)((i - 1) * 64 + c + 1) * 2048) : zero4;
      float acc[8];
#pragma unroll
      for (int e = 0; e < 8; ++e) acc[e] = 0.f;
#pragma unroll
      for (int i = 0; i < 3; ++i)
#pragma unroll
        for (int j = 0; j < 3; ++j) fma8(acc, win[i][j], w[i * 3 + j]);
      conv_store<ISV>(p, acc, (b << 13) + gr * 64 + c, ch);
#pragma unroll
      for (int i = 0; i < 3; ++i) { win[i][0] = win[i][1]; win[i][1] = win[i][2]; }
    }
  }
  for (int idx = gt; idx < 4 * 32 * 256; idx += nthr) {
    const int cg8 = idx & 255, run = (idx >> 8) & 31, b = idx >> 13, ch = cg8 * 8, p0 = run * 8;
    float w[3][8];
#pragma unroll
    for (int t = 0; t < 3; ++t) {
      const f32x4 w0 = *(const f32x4*)(cw + (3 + t) * 4096 + ch), w1 = *(const f32x4*)(cw + (3 + t) * 4096 + ch + 4);
      w[t][0] = w0.x; w[t][1] = w0.y; w[t][2] = w0.z; w[t][3] = w0.w; w[t][4] = w1.x; w[t][5] = w1.y; w[t][6] = w1.z; w[t][7] = w1.w;
    }
    const u16* base = pre_ctx + (size_t)(b * 256) * 2048 + ch;
    u32x4 win[3];
    win[0] = (p0 > 0) ? *(const u32x4*)(base + (size_t)(p0 - 1) * 2048) : zero4;
    win[1] = *(const u32x4*)(base + (size_t)p0 * 2048);
#pragma unroll
    for (int t = 0; t < 8; ++t) {
      const int pp = p0 + t;
      win[2] = (pp < 255) ? *(const u32x4*)(base + (size_t)(pp + 1) * 2048) : zero4;
      float acc[8];
#pragma unroll
      for (int e = 0; e < 8; ++e) acc[e] = 0.f;
#pragma unroll
      for (int j = 0; j < 3; ++j) fma8(acc, win[j], w[j]);
      conv_store<ISV>(p, acc, RL + b * 256 + pp, ch);
      win[0] = win[1]; win[1] = win[2];
    }
  }
}

constexpr int lp_off(int ip) { return ip == 0 ? 0 : (8 * ((ip - 1) / 4) * ((ip - 1) / 4 + 1) + 4 * ((ip - 1) % 4) * ((ip - 1) / 4 + 1)); }
constexpr int LP_FLOATS = 2112;
DI void dn_prep_phase(char* shm, const Params& p, const int wave_s_) {
  const int tid = TIDX(), wave = tid >> 6, lane = tid & 63, r = lane & 31, hh = lane >> 5;
  char* sQ = shm;
  char* sK = shm + 16896;
  float* sKK = (float*)(shm + 33792);
  float* sQK = (float*)(shm + 50432);
  float* sg = (float*)(shm + 67072);
  float* sbeta = sg + 128;
  float* sgc = sg + 256;
  float* sLp = (float*)(shm + 68608);
  const u16* qk = (const u16*)(p.ws + OFF_QK0);
  const float* abt = (const float*)(p.ws + OFF_ABT);
  u16* Ab_lat = (u16*)p.out;
  u16* Tb_lat = (u16*)p.out + (size_t)32 * MiB;
  u16* Ab_ctx = (u16*)(p.ws + OFF_AC);
  u16* Tb_ctx = (u16*)(p.ws + OFF_TC);
  float* Eb = (float*)(p.ws + OFF_X);
  for (int grp = blockIdx.x; grp < NCHUNK * 2; grp += gridDim.x) {
    const int ci = grp >> 1, row0 = ci * 64;
    u32x4 pq[2], pk[2];
    float pa = 0.f, pbt = 0.f;
    auto load_item = [&](int h) {
#pragma unroll
      for (int u = 0; u < 2; ++u) {
        const int chunk = tid * 2 + u, c = chunk >> 4, cc = (chunk & 15) * 8;
        const u16* src = qk + (size_t)(row0 + c) * 2048 + h * 128 + cc;
        pq[u] = *(const u32x4*)src; pk[u] = *(const u32x4*)(src + 1024);
      }
      if (tid < 128) {
        const int d = tid >> 6, c = tid & 63;
        pa = abt[(size_t)(row0 + c) * 32 + d * 8 + h]; pbt = abt[(size_t)(row0 + c) * 32 + 16 + d * 8 + h];
      }
    };
    load_item((grp & 1) * 4);
    for (int sub = 0; sub < 4; ++sub) {
      const int h = (grp & 1) * 4 + sub, item = ci * 8 + h;
#pragma unroll
      for (int u = 0; u < 2; ++u) {
        const int chunk = tid * 2 + u, c = chunk >> 4, cc = (chunk & 15) * 8;
        st8(sQ + c * 264 + cc * 2, pq[u]);
        st8(sK + c * 264 + cc * 2, pk[u]);
      }
      if (tid < 128) {
        const int d = tid >> 6, c = tid & 63;
        sg[d * 64 + c] = -__expf(p.dn_a_log[d * 8 + h]) * softplusf(pa + p.dn_dt_bias[d * 8 + h]);
        sbeta[d * 64 + c] = sigmoidf(pbt);
      }
      if (sub < 3) load_item(h + 1);
      __syncthreads();
      if (wave < 2) {
        const int c = wave ? 63 - lane : lane;
        float v = sg[wave * 64 + c];
#pragma unroll
        for (int o = 1; o < 64; o <<= 1) { const float t = __shfl_up(v, o, 64); if (lane >= o) v += t; }
        sgc[wave * 64 + c] = v;
      }
      {
        const int mat = wave >> 2, tm = (wave >> 1) & 1, tn = wave & 1;
        const char* aop = mat ? sQ : sK;
        f32x16 acc;
        for (int i = 0; i < 16; ++i) acc[i] = 0.f;
#pragma unroll
        for (int s = 0; s < 8; ++s) {
          s16x8 a = ldA_nat(aop, 32 * tm + r, 264, 16 * s, hh), b = ldA_nat(sK, 32 * tn + r, 264, 16 * s, hh);
          acc = MFMA32(a, b, acc);
        }
        float* dst = mat ? sQK : sKK;
#pragma unroll
        for (int i = 0; i < 16; ++i) dst[(32 * tm + crow(i, hh)) * 65 + 32 * tn + r] = acc[i];
      }
      __syncthreads();
      for (int e = tid; e < 8192; e += 512) {
        const int d = e >> 12, ip = (e >> 6) & 63, jp = e & 63;
        if (ip > jp) {
          const int i = d ? 63 - ip : ip, j = d ? 63 - jp : jp;
          const int q4 = (ip - 1) >> 2, r4 = (ip - 1) & 3;
          const float v = sbeta[d * 64 + i] * sKK[i * 65 + j] * __expf(fminf(sgc[d * 64 + i] - sgc[d * 64 + j], 0.f));
          sLp[(sub * 2 + d) * LP_FLOATS + 8 * q4 * (q4 + 1) + 4 * r4 * (q4 + 1) + jp] = v;
        }
      }
      for (int v = tid; v < 1024; v += 512) {
        const int d = v >> 9, i = (v >> 3) & 63, j0 = (v & 7) * 8;
        float o[8];
#pragma unroll
        for (int e = 0; e < 8; ++e) {
          const int j = j0 + e;
          const bool keep = d ? (i <= j) : (i >= j);
          o[e] = keep ? sQK[i * 65 + j] * __expf(fminf(sgc[d * 64 + i] - sgc[d * 64 + j], 0.f)) : 0.f;
        }
        u32x4 ov = {pk2(o[0], o[1]), pk2(o[2], o[3]), pk2(o[4], o[5]), pk2(o[6], o[7])};
        *(u32x4*)(((size_t)item < TA_LAT_ITEMS ? Ab_lat : Ab_ctx) + ta_off(item, d) + i * 64 + j0) = ov;
      }
      if (tid < 128) {
        const int d = tid >> 6, c = tid & 63;
        const float gl = sgc[d * 64 + (d ? 0 : 63)], gcv = sgc[d * 64 + c];
        const float e1 = __expf(gcv), be = sbeta[d * 64 + c] * e1, e2 = __expf(gl - gcv), cdv = __expf(gl);
        float* E = Eb + ((size_t)item * 2 + d) * 256;
        E[c] = e1; E[64 + c] = be; E[128 + c] = e2; E[192 + c] = cdv;
      }
      __syncthreads();
    }
    {
      const int wv = opq_v(wave), lane_l = opq_v(lane);
      const int d = wv & 1, item = ci * 8 + (grp & 1) * 4 + (wv >> 1);
      const float* Lb = sLp + wv * LP_FLOATS;
      float T[64];
#pragma unroll
      for (int ip = 0; ip < 64; ++ip) {
        f32x4 lrow[16];
#pragma unroll
        for (int j4 = 0; j4 < (ip + 3) / 4; ++j4) lrow[j4] = *(const f32x4*)(Lb + lp_off(ip) + j4 * 4);
        float a0 = (lane_l == ip) ? 1.f : 0.f, a1 = 0.f, a2 = 0.f, a3 = 0.f;
#pragma unroll
        for (int j4 = 0; j4 < (ip + 3) / 4; ++j4) {
          const f32x4 lv = lrow[j4];
          if (j4 * 4 + 0 < ip) a0 -= lv.x * T[j4 * 4 + 0];
          if (j4 * 4 + 1 < ip) a1 -= lv.y * T[j4 * 4 + 1];
          if (j4 * 4 + 2 < ip) a2 -= lv.z * T[j4 * 4 + 2];
          if (j4 * 4 + 3 < ip) a3 -= lv.w * T[j4 * 4 + 3];
        }
        T[ip] = (a0 + a1) + (a2 + a3);
        __builtin_amdgcn_sched_barrier(0);
      }
      u16* To = ((size_t)item < TA_LAT_ITEMS ? Tb_lat : Tb_ctx) + ta_off(item, d);
      const int cidx = d ? 63 - lane_l : lane_l;
#pragma unroll
      for (int ip = 0; ip < 64; ++ip) {
        const int i = d ? 63 - ip : ip;
        To[i * 64 + cidx] = f2bf(T[ip]);
      }
    }
    __syncthreads();
  }
}

constexpr int SC_QS = 272;
constexpr int SC_Q = 0, SC_K = 17408, SC_KT = 34816, SC_T = 52224, SC_A = 60928, SC_E = 69632, SC_BUF = 70656;
DI s16x8 ldA16(const char* base, int row, int strideB, int kofs, int q) {
  const char* p = base + row * strideB + (kofs + 4 * q) * 2;
  u32x2 lo = *(const u32x2*)p, hi = *(const u32x2*)(p + 32);
  return cat8(lo, hi);
}
DI s16x8 pack16(const f32x4& a, const f32x4& b) {
  u32x4 v = {pk2(a.x, a.y), pk2(a.z, a.w), pk2(b.x, b.y), pk2(b.z, b.w)};
  return __builtin_bit_cast(s16x8, v);
}

template <bool DELTA, bool DRY = false>
DI void scan_phase(char* shm, const Params& p, const int wave_s_) {
  const int bid = blockIdx.x;
  if (bid >= 256) return;
  const int tid = TIDX(), wave = tid >> 6, lane = tid & 63, n16 = lane & 15, q4 = lane >> 4;
  int cgp, d, h, b;
  if (DELTA) { cgp = (bid >> 3) & 3; const int cid = (bid & 7) + 8 * (bid >> 5); d = cid & 1; h = (cid >> 1) & 7; b = cid >> 4; }
  else { cgp = (bid >> 3) & 7; const int cid = (bid & 7) + 8 * (bid >> 6); d = cid & 1; h = (cid >> 1) & 3; b = cid >> 3; }
  const bool compute = wave < 4;
  const int col0 = (DELTA ? h * 256 : h * 512) + cgp * 64 + (wave & 3) * 16;
  u16* Ub = (u16*)(p.ws + (DELTA ? (d ? OFF_U1 : OFF_U0) : (d ? OFF_V1 : OFF_V0)));
  const u16* qk = (const u16*)(p.ws + OFF_QK0);
  const u16* Ag_lat = (const u16*)p.out;
  const u16* Tb_lat = (const u16*)p.out + (size_t)32 * MiB;
  const u16* Ag_ctx = (const u16*)(p.ws + OFF_AC);
  const u16* Tb_ctx = (const u16*)(p.ws + OFF_TC);
  const float* Eb = (const float*)(p.ws + OFF_X);
  const u16* QD = (const u16*)(p.ws + OFF_QD);
  const u16* AS = (const u16*)(p.ws + OFF_ASUM);
  const float* CD = (const float*)(p.ws + OFF_CD1);

  auto chunk_of = [&](int st) -> int {
    if (st < 4) return 512 + b * 4 + (d ? 3 - st : st);
    return b * 128 + (d ? 127 - (st - 4) : (st - 4));
  };

  auto stage_all = [&](int st, int buf) {
    const int sid = tid - 256;
    const int ci = chunk_of(st), row0 = ci * 64;
    char* sb = shm + buf * SC_BUF;
    if (DELTA) {
      const size_t it = ((size_t)ci * 8 + h) * 2 + d;
      const float* E = Eb + it * 256;
      const int c = sid >> 2, cc = (sid & 3) * 32;
      const u16* qsrc = qk + (size_t)(row0 + c) * 2048 + h * 128 + cc;
      const int c0 = (sid >> 4) * 4, dk0 = (sid & 15) * 8;
      const u16* ksrc = qk + (size_t)(row0 + c0) * 2048 + 1024 + h * 128 + dk0;
      u32x4 gq[4], gk[4], gT[2], gA[2];
#pragma unroll
      for (int u = 0; u < 4; ++u) gq[u] = *(const u32x4*)(qsrc + u * 8);
#pragma unroll
      for (int u = 0; u < 4; ++u) gk[u] = *(const u32x4*)(ksrc + (size_t)u * 2048);
#pragma unroll
      for (int u = 0; u < 2; ++u) {
        const int chunk = sid * 2 + u, tr = chunk >> 3, tc = (chunk & 7) * 8;
        const size_t itm = (size_t)ci * 8 + h;
        gT[u] = *(const u32x4*)((itm < TA_LAT_ITEMS ? Tb_lat : Tb_ctx) + ta_off(itm, d) + tr * 64 + tc);
        gA[u] = *(const u32x4*)((itm < TA_LAT_ITEMS ? Ag_lat : Ag_ctx) + ta_off(itm, d) + tr * 64 + tc);
      }
      const float e1 = E[c];
      const f32x4 bev = *(const f32x4*)(E + 64 + c0), e2v = *(const f32x4*)(E + 128 + c0);
      if (sid == 0) *(float*)(sb + SC_E) = E[192];
#pragma unroll
      for (int u = 0; u < 4; ++u) st8(sb + SC_Q + c * SC_QS + (cc + u * 8) * 2, scale8(gq[u], e1));
      const float be[4] = {bev.x, bev.y, bev.z, bev.w}, e2[4] = {e2v.x, e2v.y, e2v.z, e2v.w};
      u32x4 kt[4];
#pragma unroll
      for (int u = 0; u < 4; ++u) {
        st8(sb + SC_K + (c0 + u) * SC_QS + dk0 * 2, scale8(gk[u], -be[u]));
        kt[u] = scale8(gk[u], e2[u]);
      }
      const unsigned w[4][4] = {{kt[0].x, kt[0].y, kt[0].z, kt[0].w}, {kt[1].x, kt[1].y, kt[1].z, kt[1].w},
                                {kt[2].x, kt[2].y, kt[2].z, kt[2].w}, {kt[3].x, kt[3].y, kt[3].z, kt[3].w}};
#pragma unroll
      for (int jp = 0; jp < 4; ++jp) {
        u32x2 lo = {(w[0][jp] & 0xffffu) | (w[1][jp] << 16), (w[2][jp] & 0xffffu) | (w[3][jp] << 16)};
        u32x2 hi = {(w[0][jp] >> 16) | (w[1][jp] & 0xffff0000u), (w[2][jp] >> 16) | (w[3][jp] & 0xffff0000u)};
        *(u32x2*)(sb + SC_KT + (dk0 + 2 * jp) * 136 + c0 * 2) = lo;
        *(u32x2*)(sb + SC_KT + (dk0 + 2 * jp + 1) * 136 + c0 * 2) = hi;
      }
#pragma unroll
      for (int u = 0; u < 2; ++u) {
        const int chunk = sid * 2 + u, tr = chunk >> 3, tc = (chunk & 7) * 8;
        st8(sb + SC_T + tr * 136 + tc * 2, gT[u]);
        st8(sb + SC_A + tr * 136 + tc * 2, gA[u]);
      }
    } else {
      const size_t it = ((size_t)ci * 4 + h) * 2 + d;
      const u16* qd = QD + it * 16384;
      const int c = sid >> 2, cc = (sid & 3) * 32;
      const int kr = sid >> 1, kc = (sid & 1) * 32;
      u32x4 gq[4], gk[4], gA[2];
#pragma unroll
      for (int u = 0; u < 4; ++u) gq[u] = *(const u32x4*)(qd + c * 128 + cc + u * 8);
#pragma unroll
      for (int u = 0; u < 4; ++u) gk[u] = *(const u32x4*)(qd + 8192 + kr * 64 + kc + u * 8);
      if (d == 0) {
#pragma unroll
        for (int u = 0; u < 2; ++u) {
          const int chunk = sid * 2 + u, tr = chunk >> 3, tc = (chunk & 7) * 8;
          gA[u] = *(const u32x4*)(AS + ((size_t)ci * 4 + h) * 4096 + tr * 64 + tc);
        }
      }
      if (sid < 32) *(f32x4*)(sb + SC_E + sid * 16) = *(const f32x4*)(CD + it * 128 + sid * 4);
#pragma unroll
      for (int u = 0; u < 4; ++u) st8(sb + SC_Q + c * SC_QS + (cc + u * 8) * 2, gq[u]);
#pragma unroll
      for (int u = 0; u < 4; ++u) st8(sb + SC_KT + kr * 136 + (kc + u * 8) * 2, gk[u]);
      if (d == 0) {
#pragma unroll
        for (int u = 0; u < 2; ++u) {
          const int chunk = sid * 2 + u, tr = chunk >> 3, tc = (chunk & 7) * 8;
          st8(sb + SC_A + tr * 136 + tc * 2, gA[u]);
        }
      }
    }
  };

  f32x4 S[8];
#pragma unroll
  for (int t = 0; t < 8; ++t) S[t] = (f32x4){0.f, 0.f, 0.f, 0.f};
  u16 uraw[4][4];
  const int loff = (4 * q4) * 2048 + col0 + n16;
  auto u_issue = [&](int st) {
    const u16* up = Ub + (size_t)chunk_of(st) * (64 * 2048);
    const int lo = opq_v(loff);
#pragma unroll
    for (int mt = 0; mt < 4; ++mt)
#pragma unroll
      for (int i = 0; i < 4; ++i) uraw[mt][i] = up[lo + (16 * mt + i) * 2048];
  };

  if (compute) u_issue(0); else stage_all(0, 0);
  __syncthreads();

  for (int st = 0; st < 132; ++st) {
    const int buf = st & 1;
    const char* sb = shm + buf * SC_BUF;
    if (compute) {
      const int row0 = chunk_of(st) * 64;
      f32x4 Y[4], O[4];
#pragma unroll
      for (int mt = 0; mt < 4; ++mt) {
        Y[mt] = (f32x4){bf2f(uraw[mt][0]), bf2f(uraw[mt][1]), bf2f(uraw[mt][2]), bf2f(uraw[mt][3])};
        O[mt] = (f32x4){0.f, 0.f, 0.f, 0.f};
      }
#define SCHED_FENCE() __builtin_amdgcn_sched_barrier(0)
      s16x8 fT[8];
      if (DELTA) {
#pragma unroll
        for (int mt = 0; mt < 4; ++mt)
#pragma unroll
          for (int kc = 0; kc < 2; ++kc) fT[mt * 2 + kc] = ldA16(sb + SC_T, 16 * mt + n16, 136, 32 * kc, q4);
      }
      s16x8 fa[2][8];
#pragma unroll
      for (int mt = 0; mt < 4; ++mt) {
        if (DELTA) fa[0][mt] = ldA16(sb + SC_K, 16 * mt + n16, SC_QS, 0, q4);
        fa[0][4 + mt] = ldA16(sb + SC_Q, 16 * mt + n16, SC_QS, 0, q4);
      }
      SCHED_FENCE();
#pragma unroll
      for (int t = 0; t < 4; ++t) {
        if (t < 3) {
#pragma unroll
          for (int mt = 0; mt < 4; ++mt) {
            if (DELTA) fa[(t + 1) & 1][mt] = ldA16(sb + SC_K, 16 * mt + n16, SC_QS, 32 * (t + 1), q4);
            fa[(t + 1) & 1][4 + mt] = ldA16(sb + SC_Q, 16 * mt + n16, SC_QS, 32 * (t + 1), q4);
          }
        }
        SCHED_FENCE();
        const s16x8 Sb = pack16(S[2 * t], S[2 * t + 1]);
#pragma unroll
        for (int mt = 0; mt < 4; ++mt) {
          if (DELTA) Y[mt] = MFMA16(fa[t & 1][mt], Sb, Y[mt]);
          O[mt] = MFMA16(fa[t & 1][4 + mt], Sb, O[mt]);
        }
        SCHED_FENCE();
      }
      s16x8 fA[8];
      if (DELTA || d == 0) {
#pragma unroll
        for (int mt = 0; mt < 4; ++mt)
#pragma unroll
          for (int kc = 0; kc < 2; ++kc) fA[mt * 2 + kc] = ldA16(sb + SC_A, 16 * mt + n16, 136, 32 * kc, q4);
      }
      SCHED_FENCE();
      s16x8 vnb[2];
      if (DELTA) {
        s16x8 Yb[2];
        Yb[0] = pack16(Y[0], Y[1]); Yb[1] = pack16(Y[2], Y[3]);
        f32x4 vn[4];
#pragma unroll
        for (int mt = 0; mt < 4; ++mt) {
          vn[mt] = (f32x4){0.f, 0.f, 0.f, 0.f};
#pragma unroll
          for (int kc = 0; kc < 2; ++kc) vn[mt] = MFMA16(fT[mt * 2 + kc], Yb[kc], vn[mt]);
        }
        vnb[0] = pack16(vn[0], vn[1]); vnb[1] = pack16(vn[2], vn[3]);
      } else {
        vnb[0] = pack16(Y[0], Y[1]); vnb[1] = pack16(Y[2], Y[3]);
      }
      SCHED_FENCE();
      s16x8 fK[8];
#pragma unroll
      for (int t = 0; t < 4; ++t)
#pragma unroll
        for (int kc = 0; kc < 2; ++kc) fK[t * 2 + kc] = ldA16(sb + SC_KT, 16 * t + n16, 136, 32 * kc, q4);
      if (st + 1 < 132) u_issue(st + 1);
      SCHED_FENCE();
      if (DELTA || d == 0) {
#pragma unroll
        for (int mt = 0; mt < 4; ++mt)
#pragma unroll
          for (int kc = 0; kc < 2; ++kc) O[mt] = MFMA16(fA[mt * 2 + kc], vnb[kc], O[mt]);
      }
      if (DELTA) {
        const float cd = *(const float*)(sb + SC_E);
#pragma unroll
        for (int t = 0; t < 8; ++t) S[t] *= cd;
      } else {
#pragma unroll
        for (int t = 0; t < 8; ++t) {
          const f32x4 cv = *(const f32x4*)(sb + SC_E + (16 * t + 4 * q4) * 4);
          S[t] *= cv;
        }
      }
      SCHED_FENCE();
      s16x8 fK2[8];
#pragma unroll
      for (int t = 0; t < 4; ++t)
#pragma unroll
        for (int kc = 0; kc < 2; ++kc) fK2[t * 2 + kc] = ldA16(sb + SC_KT, 16 * (4 + t) + n16, 136, 32 * kc, q4);
      SCHED_FENCE();
#pragma unroll
      for (int t = 0; t < 4; ++t)
#pragma unroll
        for (int kc = 0; kc < 2; ++kc) S[t] = MFMA16(fK[t * 2 + kc], vnb[kc], S[t]);
      SCHED_FENCE();
#pragma unroll
      for (int t = 0; t < 4; ++t)
#pragma unroll
        for (int kc = 0; kc < 2; ++kc) S[4 + t] = MFMA16(fK2[t * 2 + kc], vnb[kc], S[4 + t]);
#undef SCHED_FENCE
      if (!DRY || p.out == nullptr)
#pragma unroll
      for (int mt = 0; mt < 4; ++mt) {
        const float ov[4] = {O[mt].x, O[mt].y, O[mt].z, O[mt].w};
        u16* op = Ub + (size_t)row0 * 2048;
        const int lo = opq_v(loff);
#pragma unroll
        for (int i = 0; i < 4; ++i) op[lo + (16 * mt + i) * 2048] = f2bf(ov[i]);
      }
    }
    else if (st + 1 < 132) stage_all(st + 1, buf ^ 1);
    asm volatile("s_waitcnt lgkmcnt(0)" ::: "memory");
    __builtin_amdgcn_s_barrier();
    asm volatile("" ::: "memory");
  }
}

DI void gla_prep_phase(char* shm, const Params& p, const int wave_s_) {
  const int tid = TIDX(), wave = tid >> 6, lane = tid & 63, r = lane & 31, hh = lane >> 5;
  char* sq = shm;
  char* sk = shm + 16896;
  char* sQa = shm + 33792;
  char* sKb = shm + 50688;
  float* sBC = (float*)(shm + 67584);
  float* sgl = (float*)(shm + 133120);
  const u16* qk1 = (const u16*)(p.ws + OFF_QK1);
  const float* gl = (const float*)(p.ws + OFF_ABT);
  u16* QD = (u16*)(p.ws + OFF_QD);
  u16* AS = (u16*)(p.ws + OFF_ASUM);
  float* CD = (float*)(p.ws + OFF_CD1);
  const float qscale = 0.08838834764831845f;
  for (int item = blockIdx.x; item < NCHUNK * 4; item += gridDim.x) {
    const int ci = item >> 2, h = item & 3, row0 = ci * 64;
#pragma unroll
    for (int u = 0; u < 2; ++u) {
      const int chunk = tid * 2 + u, c = chunk >> 4, cc = (chunk & 15) * 8;
      const u16* src = qk1 + (size_t)(row0 + c) * 1024 + h * 128 + cc;
      u32x4 vq = *(const u32x4*)src, vk = *(const u32x4*)(src + 512);
      st8(sq + c * 264 + cc * 2, vq);
      st8(sk + c * 264 + cc * 2, vk);
    }
    {
      const int rr = tid >> 3, cc = (tid & 7) * 4;
      *(f32x4*)(sgl + rr * 32 + cc) = *(const f32x4*)(gl + (size_t)(row0 + rr) * 32 + cc);
    }
    __syncthreads();
    {
      const int kk = tid & 127, d = (tid >> 7) & 1, chalf = tid >> 8;
      float w[16];
#pragma unroll
      for (int q = 0; q < 16; ++q) w[q] = p.gla_w_g2[(d * 16 + q) * 512 + h * 128 + kk];
      const float bg = p.gla_b_g[d * 512 + h * 128 + kk];
#pragma unroll 4
      for (int cc = 0; cc < 32; ++cc) {
        const int c = chalf * 32 + cc;
        const f32x4* gp = (const f32x4*)(sgl + c * 32 + d * 16);
        const f32x4 g0 = gp[0], g1 = gp[1], g2 = gp[2], g3 = gp[3];
        float z = bg;
        z += g0.x * w[0] + g0.y * w[1] + g0.z * w[2] + g0.w * w[3];
        z += g1.x * w[4] + g1.y * w[5] + g1.z * w[6] + g1.w * w[7];
        z += g2.x * w[8] + g2.y * w[9] + g2.z * w[10] + g2.w * w[11];
        z += g3.x * w[12] + g3.y * w[13] + g3.z * w[14] + g3.w * w[15];
        sBC[(d * 64 + c) * 128 + kk] = (fminf(z, 0.f) - __logf(1.f + __expf(-fabsf(z)))) * (1.f / 16.f);
      }
    }
    __syncthreads();
    if (tid < 256) {
      const int d = tid >> 7, kk = tid & 127;
      float* col = sBC + d * 64 * 128 + kk;
      float v[64];
#pragma unroll
      for (int c = 0; c < 64; ++c) v[c] = col[c * 128];
      if (d == 0) {
        float acc = 0.f;
#pragma unroll
        for (int c = 0; c < 64; ++c) { acc += v[c]; col[c * 128] = acc; }
      } else {
        float acc = 0.f;
#pragma unroll
        for (int c = 63; c >= 0; --c) { acc += v[c]; col[c * 128] = acc; }
      }
    }
    __syncthreads();
    f32x16 asum;
    for (int i = 0; i < 16; ++i) asum[i] = 0.f;
    for (int d = 0; d < 2; ++d) {
      const int cref = d ? 31 : 32, clast = d ? 0 : 63;
      const float* bcd = sBC + d * 64 * 128;
      u16* qd_o = QD + ((size_t)item * 2 + d) * 16384;
      float er[8], ern[8];
      {
        const int k0 = (tid & 15) * 8;
#pragma unroll
        for (int e = 0; e < 8; ++e) { const float rf = bcd[cref * 128 + k0 + e]; er[e] = __expf(rf); ern[e] = __expf(-rf); }
      }
      for (int v = tid; v < 1024; v += 512) {
        const int c = v >> 4, k0 = (v & 15) * 8;
        const u32x4 qv = *(const u32x4*)(sq + c * 264 + k0 * 2), kv = *(const u32x4*)(sk + c * 264 + k0 * 2);
        const unsigned qa[4] = {qv.x, qv.y, qv.z, qv.w}, ka[4] = {kv.x, kv.y, kv.z, kv.w};
        float oqa[8], okb[8], oqd[8];
#pragma unroll
        for (int e = 0; e < 8; ++e) {
          const float ebc = __expf(bcd[c * 128 + k0 + e]);
          const float qf = ((e & 1) ? bfhi(qa[e >> 1]) : bflo(qa[e >> 1])) * qscale;
          const float kf = (e & 1) ? bfhi(ka[e >> 1]) : bflo(ka[e >> 1]);
          oqd[e] = qf * ebc;
          oqa[e] = oqd[e] * ern[e];
          okb[e] = kf * er[e] * __builtin_amdgcn_rcpf(ebc);
        }
        st8(sQa + c * 264 + k0 * 2, (u32x4){pk2(oqa[0], oqa[1]), pk2(oqa[2], oqa[3]), pk2(oqa[4], oqa[5]), pk2(oqa[6], oqa[7])});
        st8(sKb + c * 264 + k0 * 2, (u32x4){pk2(okb[0], okb[1]), pk2(okb[2], okb[3]), pk2(okb[4], okb[5]), pk2(okb[6], okb[7])});
        *(u32x4*)(qd_o + c * 128 + k0) = (u32x4){pk2(oqd[0], oqd[1]), pk2(oqd[2], oqd[3]), pk2(oqd[4], oqd[5]), pk2(oqd[6], oqd[7])};
      }
      for (int v = tid; v < 1024; v += 512) {
        const int kk = v >> 3, c0 = (v & 7) * 8;
        const float last = bcd[clast * 128 + kk];
        float o[8];
#pragma unroll
        for (int e = 0; e < 8; ++e) {
          const int c = c0 + e;
          const float kf = bf2f(*(const u16*)(sk + c * 264 + kk * 2));
          o[e] = kf * __expf(last - bcd[c * 128 + kk]);
        }
        *(u32x4*)(qd_o + 8192 + kk * 64 + c0) = (u32x4){pk2(o[0], o[1]), pk2(o[2], o[3]), pk2(o[4], o[5]), pk2(o[6], o[7])};
      }
      if (tid < 128) CD[((size_t)item * 2 + d) * 128 + tid] = __expf(bcd[clast * 128 + tid]);
      __syncthreads();
      if (wave < 4) {
        const int tm = wave >> 1, tn = wave & 1;
        f32x16 acc;
        for (int i = 0; i < 16; ++i) acc[i] = 0.f;
#pragma unroll
        for (int s = 0; s < 8; ++s) {
          s16x8 a = ldA_nat(sQa, 32 * tm + r, 264, 16 * s, hh), bb = ldA_nat(sKb, 32 * tn + r, 264, 16 * s, hh);
          acc = MFMA32(a, bb, acc);
        }
#pragma unroll
        for (int i = 0; i < 16; ++i) {
          const int ii = 32 * tm + crow(i, hh), jj = 32 * tn + r;
          const bool keep = d ? (ii <= jj) : (ii >= jj);
          asum[i] += keep ? acc[i] : 0.f;
        }
      }
      __syncthreads();
    }
    if (wave < 4) {
      const int tm = wave >> 1, tn = wave & 1;
#pragma unroll
      for (int i = 0; i < 16; ++i) AS[(size_t)item * 4096 + (32 * tm + crow(i, hh)) * 64 + 32 * tn + r] = f2bf(asum[i]);
    }
  }
}

template <int GROUP>
DI void yg_phase(u16* o0, const u16* o1, const u16* z, const u16* zctx, const float* ng, int nrows, const int wave_s_) {
  const int gt = blockIdx.x * 512 + TIDX(), nthr = gridDim.x * 512;
  const int total = nrows * 256;
  for (int idx0 = gt; idx0 < total; idx0 += 2 * nthr) {
    const bool ok1 = idx0 + nthr < total;
    u32x4 a[2], bq[2], zz[2];
#pragma unroll
    for (int u = 0; u < 2; ++u) {
      const int idx = (u == 0 || ok1) ? idx0 + u * nthr : idx0;
      const size_t off = (size_t)(idx >> 8) * 2048 + (idx & 255) * 8;
      const int zrow = idx >> 8;
      const u16* zp = (zrow < RL) ? z + off : zctx + (size_t)(zrow - RL) * 2048 + (idx & 255) * 8;
      a[u] = __builtin_nontemporal_load((const u32x4*)(o0 + off)); bq[u] = __builtin_nontemporal_load((const u32x4*)(o1 + off)); zz[u] = __builtin_nontemporal_load((const u32x4*)zp);
    }
#pragma unroll
    for (int u = 0; u < 2; ++u) {
      if (u == 1 && !ok1) break;
      const int idx = idx0 + u * nthr, ch = (idx & 255) * 8;
      const size_t off = (size_t)(idx >> 8) * 2048 + ch;
      float o[8] = {bflo(a[u].x) + bflo(bq[u].x), bfhi(a[u].x) + bfhi(bq[u].x), bflo(a[u].y) + bflo(bq[u].y), bfhi(a[u].y) + bfhi(bq[u].y),
                    bflo(a[u].z) + bflo(bq[u].z), bfhi(a[u].z) + bfhi(bq[u].z), bflo(a[u].w) + bflo(bq[u].w), bfhi(a[u].w) + bfhi(bq[u].w)};
      const float zf[8] = {bflo(zz[u].x), bfhi(zz[u].x), bflo(zz[u].y), bfhi(zz[u].y), bflo(zz[u].z), bfhi(zz[u].z), bflo(zz[u].w), bfhi(zz[u].w)};
      float ss = 0.f;
#pragma unroll
      for (int e = 0; e < 8; ++e) ss += o[e] * o[e];
#pragma unroll
      for (int of = 1; of < GROUP; of <<= 1) ss += __shfl_xor(ss, of, 64);
      const float rstd = rsqrtf(ss * (1.f / (GROUP * 8)) + EPSF);
      const int gi = ch & (GROUP * 8 - 1);
      const f32x4 g0 = *(const f32x4*)(ng + gi), g1 = *(const f32x4*)(ng + gi + 4);
      const float gg[8] = {g0.x, g0.y, g0.z, g0.w, g1.x, g1.y, g1.z, g1.w};
#pragma unroll
      for (int e = 0; e < 8; ++e) o[e] = o[e] * rstd * gg[e] * siluf(zf[e]);
      *(u32x4*)(o0 + off) = (u32x4){pk2(o[0], o[1]), pk2(o[2], o[3]), pk2(o[4], o[5]), pk2(o[6], o[7])};
    }
  }
}

DI void final_phase(float* out, const float* g, const int wave_s_) {
  const int tidx_ = TIDX();
  const int lane = tidx_ & 63, gw = blockIdx.x * 8 + (tidx_ >> 6), nw = gridDim.x * 8;
  for (int row0 = gw; row0 < RL; row0 += 2 * nw) {
    const int rows[2] = {row0, row0 + nw};
    const bool ok1 = rows[1] < RL;
    f32x4 v[2][4];
#pragma unroll
    for (int u = 0; u < 2; ++u) {
      const float* s = out + (size_t)((u == 0 || ok1) ? rows[u] : rows[0]) * DM;
#pragma unroll
      for (int q = 0; q < 4; ++q) v[u][q] = __builtin_nontemporal_load((const f32x4*)(s + q * 256 + lane * 4));
    }
#pragma unroll
    for (int u = 0; u < 2; ++u) {
      if (u == 1 && !ok1) break;
      float* s = out + (size_t)rows[u] * DM;
      float ss = 0.f;
#pragma unroll
      for (int q = 0; q < 4; ++q) ss += v[u][q].x * v[u][q].x + v[u][q].y * v[u][q].y + v[u][q].z * v[u][q].z + v[u][q].w * v[u][q].w;
      ss = wave_sum(ss);
      const float rstd = rsqrtf(ss * (1.f / 1024.f) + EPSF);
#pragma unroll
      for (int q = 0; q < 4; ++q) {
        const f32x4 gg = *(const f32x4*)(g + q * 256 + lane * 4);
        f32x4 o = {v[u][q].x * rstd * gg.x, v[u][q].y * rstd * gg.y, v[u][q].z * rstd * gg.z, v[u][q].w * rstd * gg.w};
        __builtin_nontemporal_store(o, (f32x4*)(s + q * 256 + lane * 4));
      }
    }
  }
}

#define XB_XSUB(j)  (64 * (j))
#define XB_XGEN(j)  (1024 + 64 * (j))
#define XB_TOP      2048
#define XB_TOPGEN   2112
#define XCD_BAR_WORDS 2176
DI unsigned xb_ld(unsigned* p) { return __hip_atomic_load(p, __ATOMIC_RELAXED, __HIP_MEMORY_SCOPE_AGENT); }
DI unsigned xb_add(unsigned* p, unsigned v) { return __hip_atomic_fetch_add(p, v, __ATOMIC_RELAXED, __HIP_MEMORY_SCOPE_AGENT); }
DI void gbar(char* ws, const int wave_s_) {
  asm volatile("s_waitcnt vmcnt(0)" ::: "memory");
  __syncthreads();
  if (wave_s_ == 0 && lane_id() == 0) {
    unsigned* bar = (unsigned*)(ws + OFF_BAR);
    __builtin_amdgcn_s_waitcnt(0);
    const unsigned x = (unsigned)__builtin_amdgcn_s_getreg((3 << 11) | 20) & 0xFu;
    const unsigned nloc = gridDim.x >> 3, nx = 8u;
    const unsigned old = xb_add(&bar[XB_XSUB(x)], 1u);
    const unsigned gen = old / nloc;
    if (old + 1u == (gen + 1u) * nloc) {
      __builtin_amdgcn_fence(__ATOMIC_RELEASE, "agent");
      asm volatile("s_waitcnt vmcnt(0)" ::: "memory");
      const unsigned og = xb_add(&bar[XB_TOP], 1u);
      const unsigned tg = og / nx;
      if (og + 1u == (tg + 1u) * nx) xb_add(&bar[XB_TOPGEN], 1u);
      else while (xb_ld(&bar[XB_TOPGEN]) == tg) __builtin_amdgcn_s_sleep(1);
      __builtin_amdgcn_fence(__ATOMIC_ACQUIRE, "agent");
      xb_add(&bar[XB_XGEN(x)], 1u);
      asm volatile("s_waitcnt vmcnt(0)" ::: "memory");
    } else {
      while (xb_ld(&bar[XB_XGEN(x)]) == gen) __builtin_amdgcn_s_sleep(1);
      __builtin_amdgcn_fence(__ATOMIC_ACQUIRE, "agent");
      asm volatile("s_waitcnt vmcnt(0)" ::: "memory");
    }
  }
  __syncthreads();
}
#ifndef REP_GEMM
#define REP_GEMM 1
#endif
#ifndef REP_PREP
#define REP_PREP 1
#endif
#ifndef REP_GLP
#define REP_GLP 1
#endif
#ifndef REP_SCAN
#define REP_SCAN 0
#endif
#ifndef REP_SYNC
#define REP_SYNC 0
#endif
#ifndef REP_EW
#define REP_EW 1
#endif
__global__ void __launch_bounds__(512, 2) fwd_megakernel(Params p) {
  __shared__ __attribute__((aligned(1024))) char shm[141312];
  cg::grid_group grid = cg::this_grid();
  const int wave_s_ = __builtin_amdgcn_readfirstlane((int)(threadIdx.x >> 6));
  char* ws = p.ws;
  float* mods = (float*)(ws + OFF_MOD);
  u16* W0T = (u16*)(ws + OFF_W0T);
  u16* WO0T = (u16*)(ws + OFF_WO0T);
  u16* W1T = (u16*)(ws + OFF_W1T);
  u16* WO1T = (u16*)(ws + OFF_WO1T);
  u16* outb = (u16*)p.out;
  float* ctx1 = (float*)(ws + OFF_X);

  mods_phase(shm, p, wave_s_);
  wtrans_phase<0>(shm, p, wave_s_);
  if (gridDim.x == 256) gbar(ws, wave_s_); else grid.sync();
  {
    u16* H0 = (u16*)(ws + OFF_T);
    h_phase(p.x, p.ctx, p.norm_g, mods, H0, R, wave_s_);
    gbar(ws, wave_s_);
#if REP_EW > 1
    h_phase(p.x, p.ctx, p.norm_g, mods, H0, R, wave_s_);
    gbar(ws, wave_s_);
#endif
    small_gemm(H0, W0T + (size_t)6144 * 1024, (float*)(ws + OFF_ABT), wave_s_);
    EpiArgs e{};
    e.mode = 0; e.lat = outb; e.ctx = (u16*)(ws + OFF_X); e.ld = 2048;
    gemm_phase<0>(shm, H0, H0 + (size_t)RL * 1024, 1024, W0T, 0, 128, 8, e, wave_s_);
    {
      EpiArgs ec{};
      ec.mode = 4; ec.ctx = (u16*)(ws + OFF_X);
      gemm_phase<4>(shm, H0, H0 + (size_t)RL * 1024, 1024, W0T, 128, 4, 24, ec, wave_s_);
    }
    gbar(ws, wave_s_);
#if REP_GEMM > 1
    gemm_phase<0>(shm, H0, H0 + (size_t)RL * 1024, 1024, W0T, 0, 132, 8, e, wave_s_);
    gbar(ws, wave_s_);
#endif
    conv_phase<false>(p, wave_s_);
    gbar(ws, wave_s_);
#if REP_EW > 1
    conv_phase<false>(p, wave_s_);
    gbar(ws, wave_s_);
#endif
    gemm_phase<0>(shm, H0, H0 + (size_t)RL * 1024, 1024, W0T + (size_t)2048 * 1024, 0, 128, 8, e, wave_s_);
    gbar(ws, wave_s_);
#if REP_GEMM > 1
    gemm_phase<0>(shm, H0, H0 + (size_t)RL * 1024, 1024, W0T + (size_t)2048 * 1024, 0, 132, 8, e, wave_s_);
    gbar(ws, wave_s_);
#endif
    conv_phase<true>(p, wave_s_);
    gbar(ws, wave_s_);
#if REP_EW > 1
    conv_phase<true>(p, wave_s_);
    gbar(ws, wave_s_);
#endif
    for (int rep_ = 0; rep_ < REP_PREP; ++rep_) {
    dn_prep_phase(shm, p, wave_s_);
    gbar(ws, wave_s_);
    }
    for (int rep_ = 0; rep_ < REP_SCAN; ++rep_) { scan_phase<true, true>(shm, p, wave_s_); gbar(ws, wave_s_); }
    for (int rep_ = 0; rep_ < REP_SYNC; ++rep_) gbar(ws, wave_s_);
    scan_phase<true>(shm, p, wave_s_);
    gbar(ws, wave_s_);
    u16* H0b = H0;
    u16* Z = (u16*)(ws + OFF_QK0);
    EpiArgs ez{};
    ez.mode = 0; ez.lat = Z; ez.ctx = Z + (size_t)RL * 2048; ez.ld = 2048;
    gemm_phase<0>(shm, H0b, H0b + (size_t)RL * 1024, 1024, W0T + (size_t)4096 * 1024, 0, 128, 8, ez, wave_s_);
    gbar(ws, wave_s_);
#if REP_GEMM > 1
    gemm_phase<0>(shm, H0b, H0b + (size_t)RL * 1024, 1024, W0T + (size_t)4096 * 1024, 0, 132, 8, ez, wave_s_);
    gbar(ws, wave_s_);
#endif
    u16* U0 = (u16*)(ws + OFF_U0);
    yg_phase<32>(U0, (const u16*)(ws + OFF_U1), Z, (const u16*)(ws + OFF_ZC), p.dn_norm_g, R, wave_s_);
    gbar(ws, wave_s_);
    EpiArgs eo{};
    eo.mode = 2; eo.res_lat = p.x; eo.res_ctx = p.ctx; eo.mods_i = mods; eo.out_lat = p.out; eo.out_ctx = ctx1;
    gemm_phase<2>(shm, U0, U0 + (size_t)RL * 2048, 2048, WO0T, 0, 132, 4, eo, wave_s_);
    gbar(ws, wave_s_);
#if REP_GEMM > 1
    gemm_phase<2>(shm, U0, U0 + (size_t)RL * 2048, 2048, WO0T, 0, 132, 4, eo, wave_s_);
    gbar(ws, wave_s_);
#endif
  }
  {
    const float* mods1 = mods + 5 * 3072;
    u16* H1 = (u16*)(ws + OFF_QD);
    h_phase(p.out, ctx1, p.norm_g + 1024, mods1, H1, R, wave_s_);
    wtrans_phase<1>(shm, p, wave_s_);
    gbar(ws, wave_s_);
    small_gemm(H1, W1T + (size_t)5120 * 1024, (float*)(ws + OFF_ABT), wave_s_);
    EpiArgs e{};
    e.mode = 1; e.lat = (u16*)(ws + OFF_QK1); e.b1 = (u16*)(ws + OFF_V0); e.b2 = (u16*)(ws + OFF_V1);
    gemm_phase<1>(shm, H1, H1 + (size_t)RL * 1024, 1024, W1T, 0, 132, 12, e, wave_s_);
    gbar(ws, wave_s_);
    for (int rep_ = 0; rep_ < REP_GLP; ++rep_) {
    gla_prep_phase(shm, p, wave_s_);
    gbar(ws, wave_s_);
    }
    for (int rep_ = 0; rep_ < REP_SCAN; ++rep_) { scan_phase<false, true>(shm, p, wave_s_); gbar(ws, wave_s_); }
    scan_phase<false>(shm, p, wave_s_);
    gbar(ws, wave_s_);
    u16* H1b = (u16*)(ws + OFF_QK1);
    h_phase(p.out, ctx1, p.norm_g + 1024, mods1, H1b, RL, wave_s_);
    gbar(ws, wave_s_);
    u16* RB = (u16*)(ws + OFF_QD);
    EpiArgs er{};
    er.mode = 0; er.lat = RB; er.ctx = RB; er.ld = 2048;
    gemm_phase<0>(shm, H1b, H1b, 1024, W1T + (size_t)3072 * 1024, 0, 128, 8, er, wave_s_);
    gbar(ws, wave_s_);
    u16* V0 = (u16*)(ws + OFF_V0);
    yg_phase<64>(V0, (const u16*)(ws + OFF_V1), RB, RB, p.gla_norm_g, RL, wave_s_);
    gbar(ws, wave_s_);
    EpiArgs eo{};
    eo.mode = 2; eo.res_lat = p.out; eo.res_ctx = p.out; eo.mods_i = mods1; eo.out_lat = p.out; eo.out_ctx = p.out;
    gemm_phase<2>(shm, V0, V0, 2048, WO1T, 0, 128, 4, eo, wave_s_);
    gbar(ws, wave_s_);
    final_phase(p.out, p.final_g, wave_s_);
  }
}

extern "C" void kernel_launch(void* const* d_in, const int* in_sizes, int n_in, void* d_out, int out_size, void* d_ws,
                              size_t ws_size, hipStream_t stream) {
  static int grid_blocks = 0;
  if (!grid_blocks) {
    int dev = 0, cus = 0, per_cu = 0;
    hipGetDevice(&dev);
    hipDeviceGetAttribute(&cus, hipDeviceAttributeMultiprocessorCount, dev);
    hipOccupancyMaxActiveBlocksPerMultiprocessor(&per_cu, fwd_megakernel, 512, 0);
    if (per_cu < 1) per_cu = 1;
    grid_blocks = cus;
    if (grid_blocks > 256) grid_blocks = 256;
  }
  Params p{};
  p.x = (const float*)d_in[0]; p.c = (const float*)d_in[1]; p.ctx = (const float*)d_in[2]; p.c_ctx = (const float*)d_in[3];
  p.mod_w = (const float*)d_in[4]; p.mod_b = (const float*)d_in[5]; p.norm_g = (const float*)d_in[6];
  p.dn_w_in = (const float*)d_in[7]; p.dn_conv_w = (const float*)d_in[8]; p.dn_a_log = (const float*)d_in[9];
  p.dn_dt_bias = (const float*)d_in[10]; p.dn_norm_g = (const float*)d_in[11]; p.dn_w_out = (const float*)d_in[12];
  p.gla_w_in = (const float*)d_in[13]; p.gla_w_g2 = (const float*)d_in[14]; p.gla_b_g = (const float*)d_in[15];
  p.gla_norm_g = (const float*)d_in[16]; p.gla_w_out = (const float*)d_in[17]; p.final_g = (const float*)d_in[18];
  p.out = (float*)d_out;
  p.ws = (char*)d_ws;
  (void)hipMemsetAsync((char*)d_ws + OFF_BAR, 0, XCD_BAR_WORDS * sizeof(unsigned), stream);
  void* args[] = {&p};
  hipError_t e = hipLaunchCooperativeKernel((void*)fwd_megakernel, dim3(grid_blocks), dim3(512), args, 0, stream);
  if (e != hipSuccess) fprintf(stderr, "cooperative launch failed: %s (grid %d)\n", hipGetErrorString(e), grid_blocks);
}
```

```cpp
#include <hip/hip_runtime.h>
#include <hip/hip_cooperative_groups.h>
#include <cstdio>
namespace cg = cooperative_groups;

#define DI __device__ __forceinline__
typedef unsigned short u16;
typedef short s16x8 __attribute__((ext_vector_type(8)));
typedef short s16x4 __attribute__((ext_vector_type(4)));
typedef float f32x2 __attribute__((ext_vector_type(2)));
typedef float f32x4 __attribute__((ext_vector_type(4)));
typedef float f32x16 __attribute__((ext_vector_type(16)));
typedef int i32x4 __attribute__((ext_vector_type(4)));
typedef unsigned u32x2 __attribute__((ext_vector_type(2)));
typedef unsigned u32x4 __attribute__((ext_vector_type(4)));
typedef __bf16 bf2_t __attribute__((ext_vector_type(2)));

constexpr int RL = 32768;
constexpr int RC = 1024;
constexpr int R = RL + RC;
constexpr int DM = 1024;
constexpr int NCHUNK = R / 64;
constexpr float EPSF = 1e-6f;
constexpr size_t MiB = 1u << 20;

constexpr size_t OFF_QK0 = 0;
constexpr size_t OFF_U0 = 132 * MiB;
constexpr size_t OFF_U1 = 264 * MiB;
constexpr size_t OFF_T = 396 * MiB;
constexpr size_t OFF_W1T = 462 * MiB;
constexpr size_t OFF_WO1T = OFF_W1T + 10 * MiB + 256 * 1024;
constexpr size_t OFF_MOD = OFF_WO1T + 4 * MiB;
constexpr size_t OFF_X = OFF_MOD + 256 * 1024;
constexpr size_t OFF_ABT = OFF_X + 8 * MiB + 256 * 1024;
constexpr size_t OFF_W0T = OFF_ABT + 4 * MiB + 256 * 1024;
constexpr size_t OFF_WO0T = OFF_W0T + 12 * MiB + 256 * 1024;
constexpr size_t OFF_V0 = 0;
constexpr size_t OFF_V1 = 132 * MiB;
constexpr size_t OFF_QK1 = 264 * MiB;
constexpr size_t OFF_QD = 330 * MiB;
constexpr size_t OFF_CD1 = OFF_X + 4 * MiB;
constexpr size_t OFF_ASUM = OFF_W0T;
constexpr size_t OFF_BAR = 506 * MiB;
constexpr size_t OFF_ZC = 507 * MiB;

constexpr size_t TA_LAT_ITEMS = 4096;
constexpr size_t OFF_TC = 462 * MiB;
constexpr size_t OFF_AC = 464 * MiB;
DI size_t ta_off(size_t item, int d) { return ((item < TA_LAT_ITEMS ? item : item - TA_LAT_ITEMS) * 2 + d) * 4096; }
struct Params {
  const float *x, *c, *ctx, *c_ctx, *mod_w, *mod_b, *norm_g, *dn_w_in, *dn_conv_w, *dn_a_log, *dn_dt_bias, *dn_norm_g,
      *dn_w_out, *gla_w_in, *gla_w_g2, *gla_b_g, *gla_norm_g, *gla_w_out, *final_g;
  float* out;
  char* ws;
};

DI unsigned pk2(float lo, float hi) { f32x2 v = {lo, hi}; return __builtin_bit_cast(unsigned, __builtin_convertvector(v, bf2_t)); }
DI float bflo(unsigned u) { return __uint_as_float(u << 16); }
DI float bfhi(unsigned u) { return __uint_as_float(u & 0xffff0000u); }
DI float bf2f(u16 v) { return __uint_as_float(((unsigned)v) << 16); }
DI u16 f2bf(float x) { return (u16)(pk2(x, 0.f) & 0xffffu); }
DI float siluf(float x) { return x / (1.f + __expf(-x)); }
DI float sigmoidf(float x) { return 1.f / (1.f + __expf(-x)); }
DI float softplusf(float x) { return fmaxf(x, 0.f) + __logf(1.f + __expf(-fabsf(x))); }
DI int crow(int reg, int h) { return (reg & 3) + 8 * (reg >> 2) + 4 * h; }
#define MFMA32(a, b, c) __builtin_amdgcn_mfma_f32_32x32x16_bf16((a), (b), (c), 0, 0, 0)
#define MFMA16(a, b, c) __builtin_amdgcn_mfma_f32_16x16x32_bf16((a), (b), (c), 0, 0, 0)

DI s16x8 cat8(u32x2 lo, u32x2 hi) { u32x4 v = {lo.x, lo.y, hi.x, hi.y}; return __builtin_bit_cast(s16x8, v); }
DI s16x8 ldA_perm(const char* base, int row, int strideB, int kofs, int h) {
  const char* p = base + row * strideB + (kofs + 4 * h) * 2;
  u32x2 lo = *(const u32x2*)p, hi = *(const u32x2*)(p + 16);
  return cat8(lo, hi);
}
DI s16x8 ldA_nat(const char* base, int row, int strideB, int kofs, int h) {
  const char* p = base + row * strideB + (kofs + 8 * h) * 2;
  u32x2 lo = *(const u32x2*)p, hi = *(const u32x2*)(p + 8);
  return cat8(lo, hi);
}
DI s16x8 pack_step(const f32x16& x, int s) {
  u32x4 p;
  p.x = pk2(x[8 * s + 0], x[8 * s + 1]); p.y = pk2(x[8 * s + 2], x[8 * s + 3]);
  p.z = pk2(x[8 * s + 4], x[8 * s + 5]); p.w = pk2(x[8 * s + 6], x[8 * s + 7]);
  return __builtin_bit_cast(s16x8, p);
}
DI void st8(char* p, u32x4 v) { *(u32x2*)p = (u32x2){v.x, v.y}; *(u32x2*)(p + 8) = (u32x2){v.z, v.w}; }
DI u32x4 scale8(u32x4 v, float s) {
  u32x4 o;
  o.x = pk2(bflo(v.x) * s, bfhi(v.x) * s); o.y = pk2(bflo(v.y) * s, bfhi(v.y) * s);
  o.z = pk2(bflo(v.z) * s, bfhi(v.z) * s); o.w = pk2(bflo(v.w) * s, bfhi(v.w) * s);
  return o;
}
DI int opq_v(int v) { asm volatile("" : "+v"(v)); return v; }
DI int lane_id() { int r; asm volatile("v_mbcnt_lo_u32_b32 %0, -1, 0\n\tv_mbcnt_hi_u32_b32 %0, -1, %0" : "=v"(r)); return r; }
#define TIDX() (wave_s_ * 64 + lane_id())
DI float wave_sum(float v) {
#pragma unroll
  for (int o = 32; o >= 1; o >>= 1) v += __shfl_xor(v, o, 64);
  return v;
}

DI void mods_phase(char* shm, const Params& p, const int wave_s_) {
  const int bid = blockIdx.x, tid = TIDX();
  float* mods = (float*)(p.ws + OFF_MOD);
  if (bid < 192) {
    float* scond = (float*)shm;
    float* red = scond + 5 * 1024;
    for (int e = tid; e < 5 * 1024; e += 512) {
      int r = e >> 10, k = e & 1023;
      float v = (r < 4) ? p.c[r * 1024 + k] : p.c_ctx[k];
      scond[e] = siluf(v);
    }
    __syncthreads();
    const int i = bid / 96, jt = bid % 96, jl = tid & 31, ks = tid >> 5;
    const float* w = p.mod_w + (size_t)i * 1024 * 3072 + jt * 32 + jl;
    float a0 = 0, a1 = 0, a2 = 0, a3 = 0, a4 = 0;
#pragma unroll 8
    for (int kk = 0; kk < 64; ++kk) {
      int k = ks * 64 + kk;
      float wv = __builtin_nontemporal_load(w + (size_t)k * 3072);
      a0 += scond[k] * wv; a1 += scond[1024 + k] * wv; a2 += scond[2048 + k] * wv; a3 += scond[3072 + k] * wv; a4 += scond[4096 + k] * wv;
    }
    red[(ks * 5 + 0) * 32 + jl] = a0; red[(ks * 5 + 1) * 32 + jl] = a1; red[(ks * 5 + 2) * 32 + jl] = a2;
    red[(ks * 5 + 3) * 32 + jl] = a3; red[(ks * 5 + 4) * 32 + jl] = a4;
    __syncthreads();
    if (tid < 160) {
      int r = tid >> 5, j = tid & 31;
      float s = p.mod_b[i * 3072 + jt * 32 + j];
      for (int q = 0; q < 16; ++q) s += red[(q * 5 + r) * 32 + j];
      mods[(i * 5 + r) * 3072 + jt * 32 + j] = s;
    }
    __syncthreads();
  }
}

DI void wtrans_tile(char* shm, const float* src, int K, int N, u16* dst, int tile, const int wave_s_) {
  u16* t = (u16*)shm;
  const int tid = TIDX();
  const int tn = (N + 63) / 64;
  const int k0 = (tile / tn) * 64, n0 = (tile % tn) * 64;
#pragma unroll
  for (int q = 0; q < 2; ++q) {
    const int e = tid + q * 512, kk = e >> 4, nn = (e & 15) * 4;
    f32x4 v = {0.f, 0.f, 0.f, 0.f};
    if (n0 + nn < N) v = __builtin_nontemporal_load((const f32x4*)(src + (size_t)(k0 + kk) * N + n0 + nn));
    t[(nn + 0) * 72 + kk] = f2bf(v.x); t[(nn + 1) * 72 + kk] = f2bf(v.y);
    t[(nn + 2) * 72 + kk] = f2bf(v.z); t[(nn + 3) * 72 + kk] = f2bf(v.w);
  }
  __syncthreads();
  {
    const int nn = tid >> 3, kk = (tid & 7) * 8;
    if (n0 + nn < N) *(u32x4*)(dst + (size_t)(n0 + nn) * K + k0 + kk) = *(const u32x4*)(t + nn * 72 + kk);
  }
  __syncthreads();
}
template <int LAYER>
DI void wtrans_phase(char* shm, const Params& p, const int wave_s_) {
  const int t0 = 16 * 97, t1 = 32 * 16, t2 = 16 * 81, t3 = 32 * 16;
  if (LAYER == 0) {
    for (int tile = blockIdx.x; tile < t0 + t1; tile += gridDim.x) {
      if (tile < t0) wtrans_tile(shm, p.dn_w_in, 1024, 6176, (u16*)(p.ws + OFF_W0T), tile, wave_s_);
      else wtrans_tile(shm, p.dn_w_out, 2048, 1024, (u16*)(p.ws + OFF_WO0T), tile - t0, wave_s_);
    }
  } else {
    for (int tile = blockIdx.x; tile < t2 + t3; tile += gridDim.x) {
      if (tile < t2) wtrans_tile(shm, p.gla_w_in, 1024, 5152, (u16*)(p.ws + OFF_W1T), tile, wave_s_);
      else wtrans_tile(shm, p.gla_w_out, 2048, 1024, (u16*)(p.ws + OFF_WO1T), tile - t2, wave_s_);
    }
  }
}

DI void h_phase(const float* src_lat, const float* src_ctx, const float* g, const float* mods_i, u16* dst, int nrows, const int wave_s_) {
  const int tidx_ = TIDX();
  const int lane = tidx_ & 63, gw = blockIdx.x * 8 + (tidx_ >> 6), nw = gridDim.x * 8;
  for (int row0 = gw; row0 < nrows; row0 += 2 * nw) {
    const int rows[2] = {row0, row0 + nw};
    const bool ok1 = rows[1] < nrows;
    f32x4 v[2][4];
#pragma unroll
    for (int u = 0; u < 2; ++u) {
      const int row = (u == 0 || ok1) ? rows[u] : rows[0];
      const float* s = (row < RL) ? src_lat + (size_t)row * DM : src_ctx + (size_t)(row - RL) * DM;
#pragma unroll
      for (int q = 0; q < 4; ++q) v[u][q] = __builtin_nontemporal_load((const f32x4*)(s + q * 256 + lane * 4));
    }
#pragma unroll
    for (int u = 0; u < 2; ++u) {
      if (u == 1 && !ok1) break;
      const int row = rows[u];
      const int mr = (row < RL) ? (row >> 13) : 4;
      const float* sh = mods_i + mr * 3072;
      const float* sc = sh + 1024;
      float ss = 0.f;
#pragma unroll
      for (int q = 0; q < 4; ++q) ss += v[u][q].x * v[u][q].x + v[u][q].y * v[u][q].y + v[u][q].z * v[u][q].z + v[u][q].w * v[u][q].w;
      ss = wave_sum(ss);
      const float rstd = rsqrtf(ss * (1.f / 1024.f) + EPSF);
#pragma unroll
      for (int q = 0; q < 4; ++q) {
        const int col = q * 256 + lane * 4;
        f32x4 gg = *(const f32x4*)(g + col), s1 = *(const f32x4*)(sc + col), s0 = *(const f32x4*)(sh + col);
        float o0 = v[u][q].x * rstd * gg.x * (1.f + s1.x) + s0.x, o1 = v[u][q].y * rstd * gg.y * (1.f + s1.y) + s0.y;
        float o2 = v[u][q].z * rstd * gg.z * (1.f + s1.z) + s0.z, o3 = v[u][q].w * rstd * gg.w * (1.f + s1.w) + s0.w;
        *(u32x2*)(dst + (size_t)row * DM + col) = (u32x2){pk2(o0, o1), pk2(o2, o3)};
      }
    }
  }
}

DI void small_gemm(const u16* A, const u16* Wt, float* out, const int wave_s_) {
  const int tidx_ = TIDX();
  if ((blockIdx.x & 7) == 0) return;
  const int bsub = (int)blockIdx.x - 1 - ((int)blockIdx.x >> 3);
  const int lane = tidx_ & 63, gw = bsub * 8 + (tidx_ >> 6), nw = (gridDim.x - (gridDim.x >> 3)) * 8;
  const int r = lane & 31, h = lane >> 5;
  for (int wt = gw; wt < R / 32; wt += nw) {
    const u16* ap = A + (size_t)(wt * 32 + r) * 1024 + 8 * h;
    const u16* bp = Wt + (size_t)r * 1024 + 8 * h;
    f32x16 acc;
    for (int i = 0; i < 16; ++i) acc[i] = 0.f;
#pragma unroll 8
    for (int s = 0; s < 64; ++s) {
      s16x8 a = *(const s16x8*)(ap + 16 * s), b = *(const s16x8*)(bp + 16 * s);
      acc = MFMA32(a, b, acc);
    }
#pragma unroll
    for (int i = 0; i < 16; ++i) out[(size_t)(wt * 32 + crow(i, h)) * 32 + r] = acc[i];
  }
}

DI int lds_byte2(int r, int c) {
  int st = (r >> 4) * 2 + (c >> 5), ob = (r & 15) * 64 + (c & 31) * 2;
  return st * 1024 + (ob ^ (((ob >> 9) & 1) << 5));
}
DI void stage_rc2(int b, int& Rr, int& Cc) {
  int st = b >> 10, sb = b & 1023, swz = sb ^ (((sb >> 9) & 1) << 5);
  Rr = (st / 2) * 16 + swz / 64;
  Cc = (st % 2) * 32 + (swz % 64) / 2;
}

struct EpiArgs {
  int mode;
  u16* lat; u16* ctx; int ld;
  u16* b1; u16* b2;
  const float* res_lat; const float* res_ctx; const float* mods_i; float* out_lat; float* out_ctx;
};

template <int MODE>
DI void gemm_epilogue(const EpiArgs& e, f32x4 (&acc)[8][4], int row0, int pn, int wr, int wc, int fr, int fq) {
#pragma unroll
  for (int m = 0; m < 8; ++m) {
    const int row = row0 + wr * 128 + m * 16 + fr;
#pragma unroll
    for (int n = 0; n < 4; ++n) {
      const int col = pn * 256 + wc * 64 + n * 16 + fq * 4;
      const f32x4 a = acc[m][n];
      if (MODE == 0) {
        u16* pr = (row < RL) ? e.lat + (size_t)row * e.ld : e.ctx + (size_t)(row - RL) * e.ld;
        *(u32x2*)(pr + col) = (u32x2){pk2(a.x, a.y), pk2(a.z, a.w)};
      } else if (MODE == 1) {
        u32x2 v = {pk2(a.x, a.y), pk2(a.z, a.w)};
        if (pn < 4) {
          *(u32x2*)(e.lat + (size_t)row * 1024 + col) = v;
        } else {
          *(u32x2*)(e.b1 + (size_t)row * 2048 + col - 1024) = v;
          *(u32x2*)(e.b2 + (size_t)row * 2048 + col - 1024) = v;
        }
      } else {
        const int mr = (row < RL) ? (row >> 13) : 4;
        const f32x4 gt = *(const f32x4*)(e.mods_i + mr * 3072 + 2048 + col);
        const float* rp = (row < RL) ? e.res_lat + (size_t)row * DM : e.res_ctx + (size_t)(row - RL) * DM;
        float* op = (row < RL) ? e.out_lat + (size_t)row * DM : e.out_ctx + (size_t)(row - RL) * DM;
        const f32x4 rv = *(const f32x4*)(rp + col);
        f32x4 o = {rv.x + gt.x * a.x, rv.y + gt.y * a.y, rv.z + gt.z * a.z, rv.w + gt.w * a.w};
        *(f32x4*)(op + col) = o;
      }
    }
  }
}

template <int MODE>
DI void gemm_epilogue8(const EpiArgs& e, f32x4 (&acc)[2][2][4][2], int row0, int pn, int wr, int wc, int fr, int fq) {
#pragma unroll
  for (int ai = 0; ai < 2; ++ai)
#pragma unroll
    for (int m = 0; m < 4; ++m) {
      const int row = row0 + ai * 128 + wr * 64 + m * 16 + fr;
#pragma unroll
      for (int bj = 0; bj < 2; ++bj)
#pragma unroll
        for (int n = 0; n < 2; ++n) {
          const int col = pn * 256 + bj * 128 + wc * 32 + n * 16 + fq * 4;
          const f32x4 a = acc[ai][bj][m][n];
          if (MODE == 0) {
            u16* pr = (row < RL) ? e.lat + (size_t)row * e.ld : e.ctx + (size_t)(row - RL) * e.ld;
            *(u32x2*)(pr + col) = (u32x2){pk2(a.x, a.y), pk2(a.z, a.w)};
          } else if (MODE == 4) {
            const size_t dsel = (pn < 8) ? 0 : (pn < 16) ? (4 * MiB / 2) : ((OFF_ZC - OFF_X) / 2);
            *(u32x2*)(e.ctx + dsel + (size_t)(row - RL) * 2048 + (col & 2047)) = (u32x2){pk2(a.x, a.y), pk2(a.z, a.w)};
          } else if (MODE == 1) {
            u32x2 v = {pk2(a.x, a.y), pk2(a.z, a.w)};
            if (pn < 4) {
              *(u32x2*)(e.lat + (size_t)row * 1024 + col) = v;
            } else {
              *(u32x2*)(e.b1 + (size_t)row * 2048 + col - 1024) = v;
              *(u32x2*)(e.b2 + (size_t)row * 2048 + col - 1024) = v;
            }
          } else {
            const int mr = (row < RL) ? (row >> 13) : 4;
            const f32x4 gt = *(const f32x4*)(e.mods_i + mr * 3072 + 2048 + col);
            const float* rp = (row < RL) ? e.res_lat + (size_t)row * DM : e.res_ctx + (size_t)(row - RL) * DM;
            float* op = (row < RL) ? e.out_lat + (size_t)row * DM : e.out_ctx + (size_t)(row - RL) * DM;
            const f32x4 rv = __builtin_nontemporal_load((const f32x4*)(rp + col));
            f32x4 o = {rv.x + gt.x * a.x, rv.y + gt.y * a.y, rv.z + gt.z * a.z, rv.w + gt.w * a.w};
            *(f32x4*)(op + col) = o;
          }
        }
    }
}

template <int MODE>
DI void gemm_phase(char* shm_, const u16* Alat, const u16* Actx, int K, const u16* Bt, int pm0, int npm, int nN, const EpiArgs& e, const int wave_s_) {
  constexpr int BK = 64, HALF = 128, HT = HALF * BK;
  u16* shm = (u16*)shm_;
  const int tid = TIDX(), wid = tid >> 6, lane = tid & 63, wr = wid >> 2, wc = wid & 3, fr = lane & 15, fq = lane >> 4;
#define SA(b, h) (shm + ((b) * 2 + (h)) * HT)
#define SB(b, h) (shm + (4 + (b) * 2 + (h)) * HT)
#define LDSP(ptr) ((__attribute__((address_space(3))) unsigned*)(unsigned)(size_t)(ptr))
#define STAGE(P, BASE, br, kt) do { const u16* _p = (BASE) + (size_t)(br) * K + (kt) * BK + soff; \
    _Pragma("unroll") for (int _i = 0; _i < 2; ++_i) \
      __builtin_amdgcn_global_load_lds((const unsigned*)(_p + (size_t)_i * 64 * K), LDSP((char*)(P) + wid * 1024 + _i * 8192), 16, 0, 0); } while (0)
#define LDA(dst, b, h) _Pragma("unroll") for (int m = 0; m < 4; ++m) _Pragma("unroll") for (int k = 0; k < 2; ++k) \
    dst[m][k] = *(const s16x8*)((const char*)SA(b, h) + lds_byte2(wr * 64 + m * 16 + fr, k * 32 + fq * 8))
#define LDB(dst, b, h) _Pragma("unroll") for (int n = 0; n < 2; ++n) _Pragma("unroll") for (int k = 0; k < 2; ++k) \
    dst[n][k] = *(const s16x8*)((const char*)SB(b, h) + lds_byte2(wc * 32 + n * 16 + fr, k * 32 + fq * 8))
#define MMA(ai, bj, Atv, Btv) do { __builtin_amdgcn_s_setprio(1); \
    _Pragma("unroll") for (int m = 0; m < 4; ++m) _Pragma("unroll") for (int n = 0; n < 2; ++n) _Pragma("unroll") for (int k = 0; k < 2; ++k) \
      acc[ai][bj][m][n] = MFMA16(Btv[n][k], Atv[m][k], acc[ai][bj][m][n]); \
    __builtin_amdgcn_s_setprio(0); } while (0)
#define WAIT_V(n) asm volatile("s_waitcnt vmcnt(" #n ")" ::: "memory")
#define WAIT_L(n) asm volatile("s_waitcnt lgkmcnt(" #n ")" ::: "memory")
#define BAR __builtin_amdgcn_s_barrier()
#define SCHED __builtin_amdgcn_sched_barrier(0)
  int sR0, sC0;
  stage_rc2(tid * 16, sR0, sC0);
  const size_t soff = (size_t)sR0 * K + sC0;
  const int ntiles = npm * nN, nt = K / BK;
  const int xcd = blockIdx.x & 7, jj = blockIdx.x >> 3;
  const int PN = (nN % 8 == 0) ? 8 : 4, PG = 32 / PN, npg = nN / PN;
  const int ngroups = ((npm + PG - 1) / PG) * npg;
  const bool grouped = (gridDim.x == 256);
  const int nit = grouped ? (ngroups - xcd + 7) / 8 : (ntiles - (int)blockIdx.x + (int)gridDim.x - 1) / (int)gridDim.x;
  auto tile_of = [&](int it, int& pm, int& pn) -> bool {
    if (it >= nit) return false;
    if (grouped) {
      const int g = xcd + 8 * it, pmg = g / npg, png = g % npg;
      pm = pmg * PG + jj / PN; pn = png * PN + jj % PN;
      if (pm >= npm) return false;
      pm += pm0;
    } else {
      const int L = blockIdx.x + it * gridDim.x;
      pm = pm0 + L / nN; pn = L % nN;
    }
    return true;
  };
  bool prefetched = false;
  for (int it = 0; it < nit; ++it) {
    int pm, pn;
    if (!tile_of(it, pm, pn)) continue;
    const int row0 = pm * 256;
    const u16* A = (row0 < RL) ? Alat + (size_t)row0 * K : Actx + (size_t)(row0 - RL) * K;
    const u16* Bw = Bt + (size_t)pn * 256 * K;
    const int brow = 0, bcol = 0;
    f32x4 acc[2][2][4][2];
#pragma unroll
    for (int i0 = 0; i0 < 2; ++i0)
#pragma unroll
      for (int i1 = 0; i1 < 2; ++i1)
#pragma unroll
        for (int i2 = 0; i2 < 4; ++i2)
#pragma unroll
          for (int i3 = 0; i3 < 2; ++i3) acc[i0][i1][i2][i3] = (f32x4){0.f, 0.f, 0.f, 0.f};
    s16x8 At[4][2], B0[2][2], B1[2][2];
    if (!prefetched) {
      STAGE(SB(0, 0), Bw, bcol, 0); STAGE(SA(0, 0), A, brow, 0);
      STAGE(SB(0, 1), Bw, bcol + HALF, 0); STAGE(SA(0, 1), A, brow + HALF, 0);
    }
    if (wr == 1) BAR;
    WAIT_V(4); BAR;
    STAGE(SB(1, 0), Bw, bcol, 1); STAGE(SA(1, 0), A, brow, 1); STAGE(SB(1, 1), Bw, bcol + HALF, 1);
    WAIT_V(6); BAR;
    for (int t = 0; t < nt - 2; t += 2) {
      LDB(B0, 0, 0); SCHED; LDA(At, 0, 0); STAGE(SA(1, 1), A, brow + HALF, t + 1);
      WAIT_L(8); BAR; WAIT_L(0); MMA(0, 0, At, B0); BAR; SCHED;
      LDB(B1, 0, 1); STAGE(SB(0, 0), Bw, bcol, t + 2);
      BAR; WAIT_L(0); MMA(0, 1, At, B1); BAR;
      LDA(At, 0, 1); STAGE(SA(0, 0), A, brow, t + 2);
      BAR; WAIT_L(0); MMA(1, 0, At, B0); BAR; SCHED;
      STAGE(SB(0, 1), Bw, bcol + HALF, t + 2);
      WAIT_V(6); BAR; MMA(1, 1, At, B1); BAR;
      LDB(B0, 1, 0); SCHED; LDA(At, 1, 0); STAGE(SA(0, 1), A, brow + HALF, t + 2);
      WAIT_L(8); BAR; WAIT_L(0); MMA(0, 0, At, B0); BAR; SCHED;
      LDB(B1, 1, 1); STAGE(SB(1, 0), Bw, bcol, t + 3);
      BAR; WAIT_L(0); MMA(0, 1, At, B1); BAR;
      LDA(At, 1, 1); STAGE(SA(1, 0), A, brow, t + 3);
      BAR; WAIT_L(0); MMA(1, 0, At, B0); BAR; SCHED;
      STAGE(SB(1, 1), Bw, bcol + HALF, t + 3);
      WAIT_V(6); BAR; MMA(1, 1, At, B1); BAR;
    }
    { LDB(B0, 0, 0); LDA(At, 0, 0); STAGE(SA(1, 1), A, brow + HALF, nt - 1);
      BAR; WAIT_L(0); MMA(0, 0, At, B0); BAR;
      LDB(B1, 0, 1); BAR; WAIT_L(0); MMA(0, 1, At, B1); BAR;
      LDA(At, 0, 1); WAIT_V(4); BAR; WAIT_L(0); MMA(1, 0, At, B0); MMA(1, 1, At, B1); BAR; }
    { LDB(B0, 1, 0); LDA(At, 1, 0); WAIT_V(2); BAR; WAIT_L(0); MMA(0, 0, At, B0); BAR;
      LDB(B1, 1, 1); WAIT_V(0); BAR; WAIT_L(0); MMA(0, 1, At, B1); BAR;
      LDA(At, 1, 1); BAR; WAIT_L(0); MMA(1, 0, At, B0); MMA(1, 1, At, B1); BAR; }
    if (wr == 0) BAR;
    {
      int pm2, pn2;
      prefetched = tile_of(it + 1, pm2, pn2);
      if (prefetched) {
        const int r2 = pm2 * 256;
        const u16* A2 = (r2 < RL) ? Alat + (size_t)r2 * K : Actx + (size_t)(r2 - RL) * K;
        const u16* B2 = Bt + (size_t)pn2 * 256 * K;
        STAGE(SB(0, 0), B2, 0, 0); STAGE(SA(0, 0), A2, 0, 0);
        STAGE(SB(0, 1), B2, HALF, 0); STAGE(SA(0, 1), A2, HALF, 0);
      }
    }
    { const int l2 = lane_id(); gemm_epilogue8<MODE>(e, acc, row0, pn, wr, wc, l2 & 15, l2 >> 4); }
    asm volatile("s_waitcnt vmcnt(0) lgkmcnt(0)" ::: "memory");
    BAR;
  }
#undef SA
#undef SB
#undef LDSP
#undef STAGE
#undef LDA
#undef LDB
#undef MMA
#undef WAIT_V
#undef WAIT_L
#undef BAR
#undef SCHED
}

DI void conv_accum(float (&acc)[8], const u16* srow, const float* w) {
  u32x4 v = *(const u32x4*)srow;
  f32x4 w0 = *(const f32x4*)w, w1 = *(const f32x4*)(w + 4);
  acc[0] += bflo(v.x) * w0.x; acc[1] += bfhi(v.x) * w0.y; acc[2] += bflo(v.y) * w0.z; acc[3] += bfhi(v.y) * w0.w;
  acc[4] += bflo(v.z) * w1.x; acc[5] += bfhi(v.z) * w1.y; acc[6] += bflo(v.w) * w1.z; acc[7] += bfhi(v.w) * w1.w;
}
DI void fma8(float (&acc)[8], const u32x4 v, const float (&w)[8]) {
  acc[0] += bflo(v.x) * w[0]; acc[1] += bfhi(v.x) * w[1]; acc[2] += bflo(v.y) * w[2]; acc[3] += bfhi(v.y) * w[3];
  acc[4] += bflo(v.z) * w[4]; acc[5] += bfhi(v.z) * w[5]; acc[6] += bflo(v.w) * w[6]; acc[7] += bfhi(v.w) * w[7];
}
template <bool ISV>
DI void conv_store(const Params& p, float (&acc)[8], int row, int ch) {
#pragma unroll
  for (int e = 0; e < 8; ++e) acc[e] = siluf(acc[e]);
  if (!ISV) {
    u16* qk = (u16*)(p.ws + OFF_QK0);
    float ss = 0.f;
#pragma unroll
    for (int e = 0; e < 8; ++e) ss += acc[e] * acc[e];
    ss += __shfl_xor(ss, 1, 64); ss += __shfl_xor(ss, 2, 64); ss += __shfl_xor(ss, 4, 64); ss += __shfl_xor(ss, 8, 64);
    const float sc = rsqrtf(ss + EPSF) * ((ch < 1024) ? 0.08838834764831845f : 1.f);
    u32x4 o = {pk2(acc[0] * sc, acc[1] * sc), pk2(acc[2] * sc, acc[3] * sc), pk2(acc[4] * sc, acc[5] * sc), pk2(acc[6] * sc, acc[7] * sc)};
    __builtin_nontemporal_store(o, (u32x4*)(qk + (size_t)row * 2048 + ch));
  } else {
    u16* u0 = (u16*)(p.ws + OFF_U0);
    u16* u1 = (u16*)(p.ws + OFF_U1);
    const float* abt = (const float*)(p.ws + OFF_ABT);
    const int head = ch >> 8;
    const float b0 = sigmoidf(abt[(size_t)row * 32 + 16 + head]), b1 = sigmoidf(abt[(size_t)row * 32 + 24 + head]);
    u32x4 o0 = {pk2(acc[0] * b0, acc[1] * b0), pk2(acc[2] * b0, acc[3] * b0), pk2(acc[4] * b0, acc[5] * b0), pk2(acc[6] * b0, acc[7] * b0)};
    u32x4 o1 = {pk2(acc[0] * b1, acc[1] * b1), pk2(acc[2] * b1, acc[3] * b1), pk2(acc[4] * b1, acc[5] * b1), pk2(acc[6] * b1, acc[7] * b1)};
    __builtin_nontemporal_store(o0, (u32x4*)(u0 + (size_t)row * 2048 + ch));
    __builtin_nontemporal_store(o1, (u32x4*)(u1 + (size_t)row * 2048 + ch));
  }
}
template <bool ISV>
DI void conv_phase(const Params& p, const int wave_s_) {
  const u16* pre_lat = (const u16*)p.out;
  const u16* pre_ctx = (const u16*)(p.ws + OFF_X + (ISV ? 4 * MiB : 0));
  const float* cw = p.dn_conv_w + (ISV ? 2048 : 0);
  const int gt = blockIdx.x * 512 + TIDX(), nthr = gridDim.x * 512;
  const u32x4 zero4 = {0u, 0u, 0u, 0u};
  for (int idx = gt; idx < 4 * 128 * 4 * 256; idx += nthr) {
    const int cg8 = idx & 255, run = (idx >> 8) & 3, gr = (idx >> 10) & 127, b = idx >> 17, ch = cg8 * 8, c0 = run * 16;
    float w[9][8];
#pragma unroll
    for (int t = 0; t < 9; ++t) {
      const f32x4 w0 = *(const f32x4*)(cw + t * 4096 + ch), w1 = *(const f32x4*)(cw + t * 4096 + ch + 4);
      w[t][0] = w0.x; w[t][1] = w0.y; w[t][2] = w0.z; w[t][3] = w0.w; w[t][4] = w1.x; w[t][5] = w1.y; w[t][6] = w1.z; w[t][7] = w1.w;
    }
    const u16* base = pre_lat + ((size_t)(b << 13) + gr * 64) * 2048 + ch;
    const bool rok[3] = {gr > 0, true, gr < 127};
    u32x4 win[3][3];
#pragma unroll
    for (int i = 0; i < 3; ++i) {
      win[i][0] = (rok[i] && c0 > 0) ? *(const u32x4*)(base + (ptrdiff_t)((i - 1) * 64 + c0 - 1) * 2048) : zero4;
      win[i][1] = rok[i] ? *(const u32x4*)(base + (ptrdiff_t)((i - 1) * 64 + c0) * 2048) : zero4;
    }
#pragma unroll
    for (int t = 0; t < 16; ++t) {
      const int c = c0 + t;
#pragma unroll
      for (int i = 0; i < 3; ++i) win[i][2] = (rok[i] && c < 63) ? *(const u32x4*)(base + (ptrdiff_t)((i - 1) * 64 + c + 1) * 2048) : zero4;
      float acc[8];
#pragma unroll
      for (int e = 0; e < 8; ++e) acc[e] = 0.f;
#pragma unroll
      for (int i = 0; i < 3; ++i)
#pragma unroll
        for (int j = 0; j < 3; ++j) fma8(acc, win[i][j], w[i * 3 + j]);
      conv_store<ISV>(p, acc, (b << 13) + gr * 64 + c, ch);
#pragma unroll
      for (int i = 0; i < 3; ++i) { win[i][0] = win[i][1]; win[i][1] = win[i][2]; }
    }
  }
  for (int idx = gt; idx < 4 * 32 * 256; idx += nthr) {
    const int cg8 = idx & 255, run = (idx >> 8) & 31, b = idx >> 13, ch = cg8 * 8, p0 = run * 8;
    float w[3][8];
#pragma unroll
    for (int t = 0; t < 3; ++t) {
      const f32x4 w0 = *(const f32x4*)(cw + (3 + t) * 4096 + ch), w1 = *(const f32x4*)(cw + (3 + t) * 4096 + ch + 4);
      w[t][0] = w0.x; w[t][1] = w0.y; w[t][2] = w0.z; w[t][3] = w0.w; w[t][4] = w1.x; w[t][5] = w1.y; w[t][6] = w1.z; w[t][7] = w1.w;
    }
    const u16* base = pre_ctx + (size_t)(b * 256) * 2048 + ch;
    u32x4 win[3];
    win[0] = (p0 > 0) ? *(const u32x4*)(base + (size_t)(p0 - 1) * 2048) : zero4;
    win[1] = *(const u32x4*)(base + (size_t)p0 * 2048);
#pragma unroll
    for (int t = 0; t < 8; ++t) {
      const int pp = p0 + t;
      win[2] = (pp < 255) ? *(const u32x4*)(base + (size_t)(pp + 1) * 2048) : zero4;
      float acc[8];
#pragma unroll
      for (int e = 0; e < 8; ++e) acc[e] = 0.f;
#pragma unroll
      for (int j = 0; j < 3; ++j) fma8(acc, win[j], w[j]);
      conv_store<ISV>(p, acc, RL + b * 256 + pp, ch);
      win[0] = win[1]; win[1] = win[2];
    }
  }
}

constexpr int lp_off(int ip) { return ip == 0 ? 0 : (8 * ((ip - 1) / 4) * ((ip - 1) / 4 + 1) + 4 * ((ip - 1) % 4) * ((ip - 1) / 4 + 1)); }
constexpr int LP_FLOATS = 2112;
DI void dn_prep_phase(char* shm, const Params& p, const int wave_s_) {
  const int tid = TIDX(), wave = tid >> 6, lane = tid & 63, r = lane & 31, hh = lane >> 5;
  char* sQ = shm;
  char* sK = shm + 16896;
  float* sKK = (float*)(shm + 33792);
  float* sQK = (float*)(shm + 50432);
  float* sg = (float*)(shm + 67072);
  float* sbeta = sg + 128;
  float* sgc = sg + 256;
  float* sLp = (float*)(shm + 68608);
  const u16* qk = (const u16*)(p.ws + OFF_QK0);
  const float* abt = (const float*)(p.ws + OFF_ABT);
  u16* Ab_lat = (u16*)p.out;
  u16* Tb_lat = (u16*)p.out + (size_t)32 * MiB;
  u16* Ab_ctx = (u16*)(p.ws + OFF_AC);
  u16* Tb_ctx = (u16*)(p.ws + OFF_TC);
  float* Eb = (float*)(p.ws + OFF_X);
  for (int grp = blockIdx.x; grp < NCHUNK * 2; grp += gridDim.x) {
    const int ci = grp >> 1, row0 = ci * 64;
    u32x4 pq[2], pk[2];
    float pa = 0.f, pbt = 0.f;
    auto load_item = [&](int h) {
#pragma unroll
      for (int u = 0; u < 2; ++u) {
        const int chunk = tid * 2 + u, c = chunk >> 4, cc = (chunk & 15) * 8;
        const u16* src = qk + (size_t)(row0 + c) * 2048 + h * 128 + cc;
        pq[u] = *(const u32x4*)src; pk[u] = *(const u32x4*)(src + 1024);
      }
      if (tid < 128) {
        const int d = tid >> 6, c = tid & 63;
        pa = abt[(size_t)(row0 + c) * 32 + d * 8 + h]; pbt = abt[(size_t)(row0 + c) * 32 + 16 + d * 8 + h];
      }
    };
    load_item((grp & 1) * 4);
    for (int sub = 0; sub < 4; ++sub) {
      const int h = (grp & 1) * 4 + sub, item = ci * 8 + h;
#pragma unroll
      for (int u = 0; u < 2; ++u) {
        const int chunk = tid * 2 + u, c = chunk >> 4, cc = (chunk & 15) * 8;
        st8(sQ + c * 264 + cc * 2, pq[u]);
        st8(sK + c * 264 + cc * 2, pk[u]);
      }
      if (tid < 128) {
        const int d = tid >> 6, c = tid & 63;
        sg[d * 64 + c] = -__expf(p.dn_a_log[d * 8 + h]) * softplusf(pa + p.dn_dt_bias[d * 8 + h]);
        sbeta[d * 64 + c] = sigmoidf(pbt);
      }
      if (sub < 3) load_item(h + 1);
      __syncthreads();
      if (wave < 2) {
        const int c = wave ? 63 - lane : lane;
        float v = sg[wave * 64 + c];
#pragma unroll
        for (int o = 1; o < 64; o <<= 1) { const float t = __shfl_up(v, o, 64); if (lane >= o) v += t; }
        sgc[wave * 64 + c] = v;
      }
      {
        const int mat = wave >> 2, tm = (wave >> 1) & 1, tn = wave & 1;
        const char* aop = mat ? sQ : sK;
        f32x16 acc;
        for (int i = 0; i < 16; ++i) acc[i] = 0.f;
#pragma unroll
        for (int s = 0; s < 8; ++s) {
          s16x8 a = ldA_nat(aop, 32 * tm + r, 264, 16 * s, hh), b = ldA_nat(sK, 32 * tn + r, 264, 16 * s, hh);
          acc = MFMA32(a, b, acc);
        }
        float* dst = mat ? sQK : sKK;
#pragma unroll
        for (int i = 0; i < 16; ++i) dst[(32 * tm + crow(i, hh)) * 65 + 32 * tn + r] = acc[i];
      }
      __syncthreads();
      for (int e = tid; e < 8192; e += 512) {
        const int d = e >> 12, ip = (e >> 6) & 63, jp = e & 63;
        if (ip > jp) {
          const int i = d ? 63 - ip : ip, j = d ? 63 - jp : jp;
          const int q4 = (ip - 1) >> 2, r4 = (ip - 1) & 3;
          const float v = sbeta[d * 64 + i] * sKK[i * 65 + j] * __expf(fminf(sgc[d * 64 + i] - sgc[d * 64 + j], 0.f));
          sLp[(sub * 2 + d) * LP_FLOATS + 8 * q4 * (q4 + 1) + 4 * r4 * (q4 + 1) + jp] = v;
        }
      }
      for (int v = tid; v < 1024; v += 512) {
        const int d = v >> 9, i = (v >> 3) & 63, j0 = (v & 7) * 8;
        float o[8];
#pragma unroll
        for (int e = 0; e < 8; ++e) {
          const int j = j0 + e;
          const bool keep = d ? (i <= j) : (i >= j);
          o[e] = keep ? sQK[i * 65 + j] * __expf(fminf(sgc[d * 64 + i] - sgc[d * 64 + j], 0.f)) : 0.f;
        }
        u32x4 ov = {pk2(o[0], o[1]), pk2(o[2], o[3]), pk2(o[4], o[5]), pk2(o[6], o[7])};
        *(u32x4*)(((size_t)item < TA_LAT_ITEMS ? Ab_lat : Ab_ctx) + ta_off(item, d) + i * 64 + j0) = ov;
      }
      if (tid < 128) {
        const int d = tid >> 6, c = tid & 63;
        const float gl = sgc[d * 64 + (d ? 0 : 63)], gcv = sgc[d * 64 + c];
        const float e1 = __expf(gcv), be = sbeta[d * 64 + c] * e1, e2 = __expf(gl - gcv), cdv = __expf(gl);
        float* E = Eb + ((size_t)item * 2 + d) * 256;
        E[c] = e1; E[64 + c] = be; E[128 + c] = e2; E[192 + c] = cdv;
      }
      __syncthreads();
    }
    {
      const int wv = opq_v(wave), lane_l = opq_v(lane);
      const int d = wv & 1, item = ci * 8 + (grp & 1) * 4 + (wv >> 1);
      const float* Lb = sLp + wv * LP_FLOATS;
      float T[64];
#pragma unroll
      for (int ip = 0; ip < 64; ++ip) {
        f32x4 lrow[16];
#pragma unroll
        for (int j4 = 0; j4 < (ip + 3) / 4; ++j4) lrow[j4] = *(const f32x4*)(Lb + lp_off(ip) + j4 * 4);
        float a0 = (lane_l == ip) ? 1.f : 0.f, a1 = 0.f, a2 = 0.f, a3 = 0.f;
#pragma unroll
        for (int j4 = 0; j4 < (ip + 3) / 4; ++j4) {
          const f32x4 lv = lrow[j4];
          if (j4 * 4 + 0 < ip) a0 -= lv.x * T[j4 * 4 + 0];
          if (j4 * 4 + 1 < ip) a1 -= lv.y * T[j4 * 4 + 1];
          if (j4 * 4 + 2 < ip) a2 -= lv.z * T[j4 * 4 + 2];
          if (j4 * 4 + 3 < ip) a3 -= lv.w * T[j4 * 4 + 3];
        }
        T[ip] = (a0 + a1) + (a2 + a3);
        __builtin_amdgcn_sched_barrier(0);
      }
      u16* To = ((size_t)item < TA_LAT_ITEMS ? Tb_lat : Tb_ctx) + ta_off(item, d);
      const int cidx = d ? 63 - lane_l : lane_l;
#pragma unroll
      for (int ip = 0; ip < 64; ++ip) {
        const int i = d ? 63 - ip : ip;
        To[i * 64 + cidx] = f2bf(T[ip]);
      }
    }
    __syncthreads();
  }
}

constexpr int SC_QS = 272;
constexpr int SC_Q = 0, SC_K = 17408, SC_KT = 34816, SC_T = 52224, SC_A = 60928, SC_E = 69632, SC_BUF = 70656;
DI s16x8 ldA16(const char* base, int row, int strideB, int kofs, int q) {
  const char* p = base + row * strideB + (kofs + 4 * q) * 2;
  u32x2 lo = *(const u32x2*)p, hi = *(const u32x2*)(p + 32);
  return cat8(lo, hi);
}
DI s16x8 pack16(const f32x4& a, const f32x4& b) {
  u32x4 v = {pk2(a.x, a.y), pk2(a.z, a.w), pk2(b.x, b.y), pk2(b.z, b.w)};
  return __builtin_bit_cast(s16x8, v);
}

template <bool DELTA, bool DRY = false>
DI void scan_phase(char* shm, const Params& p, const int wave_s_) {
  const int bid = blockIdx.x;
  if (bid >= 256) return;
  const int tid = TIDX(), wave = tid >> 6, lane = tid & 63, n16 = lane & 15, q4 = lane >> 4;
  int cgp, d, h, b;
  if (DELTA) { cgp = (bid >> 3) & 3; const int cid = (bid & 7) + 8 * (bid >> 5); d = cid & 1; h = (cid >> 1) & 7; b = cid >> 4; }
  else { cgp = (bid >> 3) & 7; const int cid = (bid & 7) + 8 * (bid >> 6); d = cid & 1; h = (cid >> 1) & 3; b = cid >> 3; }
  const bool compute = wave < 4;
  const int col0 = (DELTA ? h * 256 : h * 512) + cgp * 64 + (wave & 3) * 16;
  u16* Ub = (u16*)(p.ws + (DELTA ? (d ? OFF_U1 : OFF_U0) : (d ? OFF_V1 : OFF_V0)));
  const u16* qk = (const u16*)(p.ws + OFF_QK0);
  const u16* Ag_lat = (const u16*)p.out;
  const u16* Tb_lat = (const u16*)p.out + (size_t)32 * MiB;
  const u16* Ag_ctx = (const u16*)(p.ws + OFF_AC);
  const u16* Tb_ctx = (const u16*)(p.ws + OFF_TC);
  const float* Eb = (const float*)(p.ws + OFF_X);
  const u16* QD = (const u16*)(p.ws + OFF_QD);
  const u16* AS = (const u16*)(p.ws + OFF_ASUM);
  const float* CD = (const float*)(p.ws + OFF_CD1);

  auto chunk_of = [&](int st) -> int {
    if (st < 4) return 512 + b * 4 + (d ? 3 - st : st);
    return b * 128 + (d ? 127 - (st - 4) : (st - 4));
  };

  auto stage_all = [&](int st, int buf) {
    const int sid = tid - 256;
    const int ci = chunk_of(st), row0 = ci * 64;
    char* sb = shm + buf * SC_BUF;
    if (DELTA) {
      const size_t it = ((size_t)ci * 8 + h) * 2 + d;
      const float* E = Eb + it * 256;
      const int c = sid >> 2, cc = (sid & 3) * 32;
      const u16* qsrc = qk + (size_t)(row0 + c) * 2048 + h * 128 + cc;
      const int c0 = (sid >> 4) * 4, dk0 = (sid & 15) * 8;
      const u16* ksrc = qk + (size_t)(row0 + c0) * 2048 + 1024 + h * 128 + dk0;
      u32x4 gq[4], gk[4], gT[2], gA[2];
#pragma unroll
      for (int u = 0; u < 4; ++u) gq[u] = *(const u32x4*)(qsrc + u * 8);
#pragma unroll
      for (int u = 0; u < 4; ++u) gk[u] = *(const u32x4*)(ksrc + (size_t)u * 2048);
#pragma unroll
      for (int u = 0; u < 2; ++u) {
        const int chunk = sid * 2 + u, tr = chunk >> 3, tc = (chunk & 7) * 8;
        const size_t itm = (size_t)ci * 8 + h;
        gT[u] = *(const u32x4*)((itm < TA_LAT_ITEMS ? Tb_lat : Tb_ctx) + ta_off(itm, d) + tr * 64 + tc);
        gA[u] = *(const u32x4*)((itm < TA_LAT_ITEMS ? Ag_lat : Ag_ctx) + ta_off(itm, d) + tr * 64 + tc);
      }
      const float e1 = E[c];
      const f32x4 bev = *(const f32x4*)(E + 64 + c0), e2v = *(const f32x4*)(E + 128 + c0);
      if (sid == 0) *(float*)(sb + SC_E) = E[192];
#pragma unroll
      for (int u = 0; u < 4; ++u) st8(sb + SC_Q + c * SC_QS + (cc + u * 8) * 2, scale8(gq[u], e1));
      const float be[4] = {bev.x, bev.y, bev.z, bev.w}, e2[4] = {e2v.x, e2v.y, e2v.z, e2v.w};
      u32x4 kt[4];
#pragma unroll
      for (int u = 0; u < 4; ++u) {
        st8(sb + SC_K + (c0 + u) * SC_QS + dk0 * 2, scale8(gk[u], -be[u]));
        kt[u] = scale8(gk[u], e2[u]);
      }
      const unsigned w[4][4] = {{kt[0].x, kt[0].y, kt[0].z, kt[0].w}, {kt[1].x, kt[1].y, kt[1].z, kt[1].w},
                                {kt[2].x, kt[2].y, kt[2].z, kt[2].w}, {kt[3].x, kt[3].y, kt[3].z, kt[3].w}};
#pragma unroll
      for (int jp = 0; jp < 4; ++jp) {
        u32x2 lo = {(w[0][jp] & 0xffffu) | (w[1][jp] << 16), (w[2][jp] & 0xffffu) | (w[3][jp] << 16)};
        u32x2 hi = {(w[0][jp] >> 16) | (w[1][jp] & 0xffff0000u), (w[2][jp] >> 16) | (w[3][jp] & 0xffff0000u)};
        *(u32x2*)(sb + SC_KT + (dk0 + 2 * jp) * 136 + c0 * 2) = lo;
        *(u32x2*)(sb + SC_KT + (dk0 + 2 * jp + 1) * 136 + c0 * 2) = hi;
      }
#pragma unroll
      for (int u = 0; u < 2; ++u) {
        const int chunk = sid * 2 + u, tr = chunk >> 3, tc = (chunk & 7) * 8;
        st8(sb + SC_T + tr * 136 + tc * 2, gT[u]);
        st8(sb + SC_A + tr * 136 + tc * 2, gA[u]);
      }
    } else {
      const size_t it = ((size_t)ci * 4 + h) * 2 + d;
      const u16* qd = QD + it * 16384;
      const int c = sid >> 2, cc = (sid & 3) * 32;
      const int kr = sid >> 1, kc = (sid & 1) * 32;
      u32x4 gq[4], gk[4], gA[2];
#pragma unroll
      for (int u = 0; u < 4; ++u) gq[u] = *(const u32x4*)(qd + c * 128 + cc + u * 8);
#pragma unroll
      for (int u = 0; u < 4; ++u) gk[u] = *(const u32x4*)(qd + 8192 + kr * 64 + kc + u * 8);
      if (d == 0) {
#pragma unroll
        for (int u = 0; u < 2; ++u) {
          const int chunk = sid * 2 + u, tr = chunk >> 3, tc = (chunk & 7) * 8;
          gA[u] = *(const u32x4*)(AS + ((size_t)ci * 4 + h) * 4096 + tr * 64 + tc);
        }
      }
      if (sid < 32) *(f32x4*)(sb + SC_E + sid * 16) = *(const f32x4*)(CD + it * 128 + sid * 4);
#pragma unroll
      for (int u = 0; u < 4; ++u) st8(sb + SC_Q + c * SC_QS + (cc + u * 8) * 2, gq[u]);
#pragma unroll
      for (int u = 0; u < 4; ++u) st8(sb + SC_KT + kr * 136 + (kc + u * 8) * 2, gk[u]);
      if (d == 0) {
#pragma unroll
        for (int u = 0; u < 2; ++u) {
          const int chunk = sid * 2 + u, tr = chunk >> 3, tc = (chunk & 7) * 8;
          st8(sb + SC_A + tr * 136 + tc * 2, gA[u]);
        }
      }
    }
  };

  f32x4 S[8];
#pragma unroll
  for (int t = 0; t < 8; ++t) S[t] = (f32x4){0.f, 0.f, 0.f, 0.f};
  u16 uraw[4][4];
  const int loff = (4 * q4) * 2048 + col0 + n16;
  auto u_issue = [&](int st) {
    const u16* up = Ub + (size_t)chunk_of(st) * (64 * 2048);
    const int lo = opq_v(loff);
#pragma unroll
    for (int mt = 0; mt < 4; ++mt)
#pragma unroll
      for (int i = 0; i < 4; ++i) uraw[mt][i] = up[lo + (16 * mt + i) * 2048];
  };

  if (compute) u_issue(0); else stage_all(0, 0);
  __syncthreads();

  for (int st = 0; st < 132; ++st) {
    const int buf = st & 1;
    const char* sb = shm + buf * SC_BUF;
    if (compute) {
      const int row0 = chunk_of(st) * 64;
      f32x4 Y[4], O[4];
#pragma unroll
      for (int mt = 0; mt < 4; ++mt) {
        Y[mt] = (f32x4){bf2f(uraw[mt][0]), bf2f(uraw[mt][1]), bf2f(uraw[mt][2]), bf2f(uraw[mt][3])};
        O[mt] = (f32x4){0.f, 0.f, 0.f, 0.f};
      }
#define SCHED_FENCE() __builtin_amdgcn_sched_barrier(0)
      s16x8 fT[8];
      if (DELTA) {
#pragma unroll
        for (int mt = 0; mt < 4; ++mt)
#pragma unroll
          for (int kc = 0; kc < 2; ++kc) fT[mt * 2 + kc] = ldA16(sb + SC_T, 16 * mt + n16, 136, 32 * kc, q4);
      }
      s16x8 fa[2][8];
#pragma unroll
      for (int mt = 0; mt < 4; ++mt) {
        if (DELTA) fa[0][mt] = ldA16(sb + SC_K, 16 * mt + n16, SC_QS, 0, q4);
        fa[0][4 + mt] = ldA16(sb + SC_Q, 16 * mt + n16, SC_QS, 0, q4);
      }
      SCHED_FENCE();
#pragma unroll
      for (int t = 0; t < 4; ++t) {
        if (t < 3) {
#pragma unroll
          for (int mt = 0; mt < 4; ++mt) {
            if (DELTA) fa[(t + 1) & 1][mt] = ldA16(sb + SC_K, 16 * mt + n16, SC_QS, 32 * (t + 1), q4);
            fa[(t + 1) & 1][4 + mt] = ldA16(sb + SC_Q, 16 * mt + n16, SC_QS, 32 * (t + 1), q4);
          }
        }
        SCHED_FENCE();
        const s16x8 Sb = pack16(S[2 * t], S[2 * t + 1]);
#pragma unroll
        for (int mt = 0; mt < 4; ++mt) {
          if (DELTA) Y[mt] = MFMA16(fa[t & 1][mt], Sb, Y[mt]);
          O[mt] = MFMA16(fa[t & 1][4 + mt], Sb, O[mt]);
        }
        SCHED_FENCE();
      }
      s16x8 fA[8];
      if (DELTA || d == 0) {
#pragma unroll
        for (int mt = 0; mt < 4; ++mt)
#pragma unroll
          for (int kc = 0; kc < 2; ++kc) fA[mt * 2 + kc] = ldA16(sb + SC_A, 16 * mt + n16, 136, 32 * kc, q4);
      }
      SCHED_FENCE();
      s16x8 vnb[2];
      if (DELTA) {
        s16x8 Yb[2];
        Yb[0] = pack16(Y[0], Y[1]); Yb[1] = pack16(Y[2], Y[3]);
        f32x4 vn[4];
#pragma unroll
        for (int mt = 0; mt < 4; ++mt) {
          vn[mt] = (f32x4){0.f, 0.f, 0.f, 0.f};
#pragma unroll
          for (int kc = 0; kc < 2; ++kc) vn[mt] = MFMA16(fT[mt * 2 + kc], Yb[kc], vn[mt]);
        }
        vnb[0] = pack16(vn[0], vn[1]); vnb[1] = pack16(vn[2], vn[3]);
      } else {
        vnb[0] = pack16(Y[0], Y[1]); vnb[1] = pack16(Y[2], Y[3]);
      }
      SCHED_FENCE();
      s16x8 fK[8];
#pragma unroll
      for (int t = 0; t < 4; ++t)
#pragma unroll
        for (int kc = 0; kc < 2; ++kc) fK[t * 2 + kc] = ldA16(sb + SC_KT, 16 * t + n16, 136, 32 * kc, q4);
      if (st + 1 < 132) u_issue(st + 1);
      SCHED_FENCE();
      if (DELTA || d == 0) {
#pragma unroll
        for (int mt = 0; mt < 4; ++mt)
#pragma unroll
          for (int kc = 0; kc < 2; ++kc) O[mt] = MFMA16(fA[mt * 2 + kc], vnb[kc], O[mt]);
      }
      if (DELTA) {
        const float cd = *(const float*)(sb + SC_E);
#pragma unroll
        for (int t = 0; t < 8; ++t) S[t] *= cd;
      } else {
#pragma unroll
        for (int t = 0; t < 8; ++t) {
          const f32x4 cv = *(const f32x4*)(sb + SC_E + (16 * t + 4 * q4) * 4);
          S[t] *= cv;
        }
      }
      SCHED_FENCE();
      s16x8 fK2[8];
#pragma unroll
      for (int t = 0; t < 4; ++t)
#pragma unroll
        for (int kc = 0; kc < 2; ++kc) fK2[t * 2 + kc] = ldA16(sb + SC_KT, 16 * (4 + t) + n16, 136, 32 * kc, q4);
      SCHED_FENCE();
#pragma unroll
      for (int t = 0; t < 4; ++t)
#pragma unroll
        for (int kc = 0; kc < 2; ++kc) S[t] = MFMA16(fK[t * 2 + kc], vnb[kc], S[t]);
      SCHED_FENCE();
#pragma unroll
      for (int t = 0; t < 4; ++t)
#pragma unroll
        for (int kc = 0; kc < 2; ++kc) S[4 + t] = MFMA16(fK2[t * 2 + kc], vnb[kc], S[4 + t]);
#undef SCHED_FENCE
      if (!DRY || p.out == nullptr)
#pragma unroll
      for (int mt = 0; mt < 4; ++mt) {
        const float ov[4] = {O[mt].x, O[mt].y, O[mt].z, O[mt].w};
        u16* op = Ub + (size_t)row0 * 2048;
        const int lo = opq_v(loff);
#pragma unroll
        for (int i = 0; i < 4; ++i) op[lo + (16 * mt + i) * 2048] = f2bf(ov[i]);
      }
    }
    else if (st + 1 < 132) stage_all(st + 1, buf ^ 1);
    asm volatile("s_waitcnt lgkmcnt(0)" ::: "memory");
    __builtin_amdgcn_s_barrier();
    asm volatile("" ::: "memory");
  }
}

DI void gla_prep_phase(char* shm, const Params& p, const int wave_s_) {
  const int tid = TIDX(), wave = tid >> 6, lane = tid & 63, r = lane & 31, hh = lane >> 5;
  char* sq = shm;
  char* sk = shm + 16896;
  char* sQa = shm + 33792;
  char* sKb = shm + 50688;
  float* sBC = (float*)(shm + 67584);
  float* sgl = (float*)(shm + 133120);
  const u16* qk1 = (const u16*)(p.ws + OFF_QK1);
  const float* gl = (const float*)(p.ws + OFF_ABT);
  u16* QD = (u16*)(p.ws + OFF_QD);
  u16* AS = (u16*)(p.ws + OFF_ASUM);
  float* CD = (float*)(p.ws + OFF_CD1);
  const float qscale = 0.08838834764831845f;
  for (int item = blockIdx.x; item < NCHUNK * 4; item += gridDim.x) {
    const int ci = item >> 2, h = item & 3, row0 = ci * 64;
#pragma unroll
    for (int u = 0; u < 2; ++u) {
      const int chunk = tid * 2 + u, c = chunk >> 4, cc = (chunk & 15) * 8;
      const u16* src = qk1 + (size_t)(row0 + c) * 1024 + h * 128 + cc;
      u32x4 vq = *(const u32x4*)src, vk = *(const u32x4*)(src + 512);
      st8(sq + c * 264 + cc * 2, vq);
      st8(sk + c * 264 + cc * 2, vk);
    }
    {
      const int rr = tid >> 3, cc = (tid & 7) * 4;
      *(f32x4*)(sgl + rr * 32 + cc) = *(const f32x4*)(gl + (size_t)(row0 + rr) * 32 + cc);
    }
    __syncthreads();
    {
      const int kk = tid & 127, d = (tid >> 7) & 1, chalf = tid >> 8;
      float w[16];
#pragma unroll
      for (int q = 0; q < 16; ++q) w[q] = p.gla_w_g2[(d * 16 + q) * 512 + h * 128 + kk];
      const float bg = p.gla_b_g[d * 512 + h * 128 + kk];
#pragma unroll 4
      for (int cc = 0; cc < 32; ++cc) {
        const int c = chalf * 32 + cc;
        const f32x4* gp = (const f32x4*)(sgl + c * 32 + d * 16);
        const f32x4 g0 = gp[0], g1 = gp[1], g2 = gp[2], g3 = gp[3];
        float z = bg;
        z += g0.x * w[0] + g0.y * w[1] + g0.z * w[2] + g0.w * w[3];
        z += g1.x * w[4] + g1.y * w[5] + g1.z * w[6] + g1.w * w[7];
        z += g2.x * w[8] + g2.y * w[9] + g2.z * w[10] + g2.w * w[11];
        z += g3.x * w[12] + g3.y * w[13] + g3.z * w[14] + g3.w * w[15];
        sBC[(d * 64 + c) * 128 + kk] = (fminf(z, 0.f) - __logf(1.f + __expf(-fabsf(z)))) * (1.f / 16.f);
      }
    }
    __syncthreads();
    if (tid < 256) {
      const int d = tid >> 7, kk = tid & 127;
      float* col = sBC + d * 64 * 128 + kk;
      float v[64];
#pragma unroll
      for (int c = 0; c < 64; ++c) v[c] = col[c * 128];
      if (d == 0) {
        float acc = 0.f;
#pragma unroll
        for (int c = 0; c < 64; ++c) { acc += v[c]; col[c * 128] = acc; }
      } else {
        float acc = 0.f;
#pragma unroll
        for (int c = 63; c >= 0; --c) { acc += v[c]; col[c * 128] = acc; }
      }
    }
    __syncthreads();
    f32x16 asum;
    for (int i = 0; i < 16; ++i) asum[i] = 0.f;
    for (int d = 0; d < 2; ++d) {
      const int cref = d ? 31 : 32, clast = d ? 0 : 63;
      const float* bcd = sBC + d * 64 * 128;
      u16* qd_o = QD + ((size_t)item * 2 + d) * 16384;
      float er[8], ern[8];
      {
        const int k0 = (tid & 15) * 8;
#pragma unroll
        for (int e = 0; e < 8; ++e) { const float rf = bcd[cref * 128 + k0 + e]; er[e] = __expf(rf); ern[e] = __expf(-rf); }
      }
      for (int v = tid; v < 1024; v += 512) {
        const int c = v >> 4, k0 = (v & 15) * 8;
        const u32x4 qv = *(const u32x4*)(sq + c * 264 + k0 * 2), kv = *(const u32x4*)(sk + c * 264 + k0 * 2);
        const unsigned qa[4] = {qv.x, qv.y, qv.z, qv.w}, ka[4] = {kv.x, kv.y, kv.z, kv.w};
        float oqa[8], okb[8], oqd[8];
#pragma unroll
        for (int e = 0; e < 8; ++e) {
          const float ebc = __expf(bcd[c * 128 + k0 + e]);
          const float qf = ((e & 1) ? bfhi(qa[e >> 1]) : bflo(qa[e >> 1])) * qscale;
          const float kf = (e & 1) ? bfhi(ka[e >> 1]) : bflo(ka[e >> 1]);
          oqd[e] = qf * ebc;
          oqa[e] = oqd[e] * ern[e];
          okb[e] = kf * er[e] * __builtin_amdgcn_rcpf(ebc);
        }
        st8(sQa + c * 264 + k0 * 2, (u32x4){pk2(oqa[0], oqa[1]), pk2(oqa[2], oqa[3]), pk2(oqa[4], oqa[5]), pk2(oqa[6], oqa[7])});
        st8(sKb + c * 264 + k0 * 2, (u32x4){pk2(okb[0], okb[1]), pk2(okb[2], okb[3]), pk2(okb[4], okb[5]), pk2(okb[6], okb[7])});
        *(u32x4*)(qd_o + c * 128 + k0) = (u32x4){pk2(oqd[0], oqd[1]), pk2(oqd[2], oqd[3]), pk2(oqd[4], oqd[5]), pk2(oqd[6], oqd[7])};
      }
      for (int v = tid; v < 1024; v += 512) {
        const int kk = v >> 3, c0 = (v & 7) * 8;
        const float last = bcd[clast * 128 + kk];
        float o[8];
#pragma unroll
        for (int e = 0; e < 8; ++e) {
          const int c = c0 + e;
          const float kf = bf2f(*(const u16*)(sk + c * 264 + kk * 2));
          o[e] = kf * __expf(last - bcd[c * 128 + kk]);
        }
        *(u32x4*)(qd_o + 8192 + kk * 64 + c0) = (u32x4){pk2(o[0], o[1]), pk2(o[2], o[3]), pk2(o[4], o[5]), pk2(o[6], o[7])};
      }
      if (tid < 128) CD[((size_t)item * 2 + d) * 128 + tid] = __expf(bcd[clast * 128 + tid]);
      __syncthreads();
      if (wave < 4) {
        const int tm = wave >> 1, tn = wave & 1;
        f32x16 acc;
        for (int i = 0; i < 16; ++i) acc[i] = 0.f;
#pragma unroll
        for (int s = 0; s < 8; ++s) {
          s16x8 a = ldA_nat(sQa, 32 * tm + r, 264, 16 * s, hh), bb = ldA_nat(sKb, 32 * tn + r, 264, 16 * s, hh);
          acc = MFMA32(a, bb, acc);
        }
#pragma unroll
        for (int i = 0; i < 16; ++i) {
          const int ii = 32 * tm + crow(i, hh), jj = 32 * tn + r;
          const bool keep = d ? (ii <= jj) : (ii >= jj);
          asum[i] += keep ? acc[i] : 0.f;
        }
      }
      __syncthreads();
    }
    if (wave < 4) {
      const int tm = wave >> 1, tn = wave & 1;
#pragma unroll
      for (int i = 0; i < 16; ++i) AS[(size_t)item * 4096 + (32 * tm + crow(i, hh)) * 64 + 32 * tn + r] = f2bf(asum[i]);
    }
  }
}

template <int GROUP>
DI void yg_phase(u16* o0, const u16* o1, const u16* z, const u16* zctx, const float* ng, int nrows, const int wave_s_) {
  const int gt = blockIdx.x * 512 + TIDX(), nthr = gridDim.x * 512;
  const int total = nrows * 256;
  for (int idx0 = gt; idx0 < total; idx0 += 2 * nthr) {
    const bool ok1 = idx0 + nthr < total;
    u32x4 a[2], bq[2], zz[2];
#pragma unroll
    for (int u = 0; u < 2; ++u) {
      const int idx = (u == 0 || ok1) ? idx0 + u * nthr : idx0;
      const size_t off = (size_t)(idx >> 8) * 2048 + (idx & 255) * 8;
      const int zrow = idx >> 8;
      const u16* zp = (zrow < RL) ? z + off : zctx + (size_t)(zrow - RL) * 2048 + (idx & 255) * 8;
      a[u] = __builtin_nontemporal_load((const u32x4*)(o0 + off)); bq[u] = __builtin_nontemporal_load((const u32x4*)(o1 + off)); zz[u] = __builtin_nontemporal_load((const u32x4*)zp);
    }
#pragma unroll
    for (int u = 0; u < 2; ++u) {
      if (u == 1 && !ok1) break;
      const int idx = idx0 + u * nthr, ch = (idx & 255) * 8;
      const size_t off = (size_t)(idx >> 8) * 2048 + ch;
      float o[8] = {bflo(a[u].x) + bflo(bq[u].x), bfhi(a[u].x) + bfhi(bq[u].x), bflo(a[u].y) + bflo(bq[u].y), bfhi(a[u].y) + bfhi(bq[u].y),
                    bflo(a[u].z) + bflo(bq[u].z), bfhi(a[u].z) + bfhi(bq[u].z), bflo(a[u].w) + bflo(bq[u].w), bfhi(a[u].w) + bfhi(bq[u].w)};
      const float zf[8] = {bflo(zz[u].x), bfhi(zz[u].x), bflo(zz[u].y), bfhi(zz[u].y), bflo(zz[u].z), bfhi(zz[u].z), bflo(zz[u].w), bfhi(zz[u].w)};
      float ss = 0.f;
#pragma unroll
      for (int e = 0; e < 8; ++e) ss += o[e] * o[e];
#pragma unroll
      for (int of = 1; of < GROUP; of <<= 1) ss += __shfl_xor(ss, of, 64);
      const float rstd = rsqrtf(ss * (1.f / (GROUP * 8)) + EPSF);
      const int gi = ch & (GROUP * 8 - 1);
      const f32x4 g0 = *(const f32x4*)(ng + gi), g1 = *(const f32x4*)(ng + gi + 4);
      const float gg[8] = {g0.x, g0.y, g0.z, g0.w, g1.x, g1.y, g1.z, g1.w};
#pragma unroll
      for (int e = 0; e < 8; ++e) o[e] = o[e] * rstd * gg[e] * siluf(zf[e]);
      *(u32x4*)(o0 + off) = (u32x4){pk2(o[0], o[1]), pk2(o[2], o[3]), pk2(o[4], o[5]), pk2(o[6], o[7])};
    }
  }
}

DI void final_phase(float* out, const float* g, const int wave_s_) {
  const int tidx_ = TIDX();
  const int lane = tidx_ & 63, gw = blockIdx.x * 8 + (tidx_ >> 6), nw = gridDim.x * 8;
  for (int row0 = gw; row0 < RL; row0 += 2 * nw) {
    const int rows[2] = {row0, row0 + nw};
    const bool ok1 = rows[1] < RL;
    f32x4 v[2][4];
#pragma unroll
    for (int u = 0; u < 2; ++u) {
      const float* s = out + (size_t)((u == 0 || ok1) ? rows[u] : rows[0]) * DM;
#pragma unroll
      for (int q = 0; q < 4; ++q) v[u][q] = __builtin_nontemporal_load((const f32x4*)(s + q * 256 + lane * 4));
    }
#pragma unroll
    for (int u = 0; u < 2; ++u) {
      if (u == 1 && !ok1) break;
      float* s = out + (size_t)rows[u] * DM;
      float ss = 0.f;
#pragma unroll
      for (int q = 0; q < 4; ++q) ss += v[u][q].x * v[u][q].x + v[u][q].y * v[u][q].y + v[u][q].z * v[u][q].z + v[u][q].w * v[u][q].w;
      ss = wave_sum(ss);
      const float rstd = rsqrtf(ss * (1.f / 1024.f) + EPSF);
#pragma unroll
      for (int q = 0; q < 4; ++q) {
        const f32x4 gg = *(const f32x4*)(g + q * 256 + lane * 4);
        f32x4 o = {v[u][q].x * rstd * gg.x, v[u][q].y * rstd * gg.y, v[u][q].z * rstd * gg.z, v[u][q].w * rstd * gg.w};
        __builtin_nontemporal_store(o, (f32x4*)(s + q * 256 + lane * 4));
      }
    }
  }
}

#define XB_XSUB(j)  (64 * (j))
#define XB_XGEN(j)  (1024 + 64 * (j))
#define XB_TOP      2048
#define XB_TOPGEN   2112
#define XCD_BAR_WORDS 2176
DI unsigned xb_ld(unsigned* p) { return __hip_atomic_load(p, __ATOMIC_RELAXED, __HIP_MEMORY_SCOPE_AGENT); }
DI unsigned xb_add(unsigned* p, unsigned v) { return __hip_atomic_fetch_add(p, v, __ATOMIC_RELAXED, __HIP_MEMORY_SCOPE_AGENT); }
DI void gbar(char* ws, const int wave_s_) {
  asm volatile("s_waitcnt vmcnt(0)" ::: "memory");
  __syncthreads();
  if (wave_s_ == 0 && lane_id() == 0) {
    unsigned* bar = (unsigned*)(ws + OFF_BAR);
    __builtin_amdgcn_s_waitcnt(0);
    const unsigned x = (unsigned)__builtin_amdgcn_s_getreg((3 << 11) | 20) & 0xFu;
    const unsigned nloc = gridDim.x >> 3, nx = 8u;
    const unsigned old = xb_add(&bar[XB_XSUB(x)], 1u);
    const unsigned gen = old / nloc;
    if (old + 1u == (gen + 1u) * nloc) {
      __builtin_amdgcn_fence(__ATOMIC_RELEASE, "agent");
      asm volatile("s_waitcnt vmcnt(0)" ::: "memory");
      const unsigned og = xb_add(&bar[XB_TOP], 1u);
      const unsigned tg = og / nx;
      if (og + 1u == (tg + 1u) * nx) xb_add(&bar[XB_TOPGEN], 1u);
      else while (xb_ld(&bar[XB_TOPGEN]) == tg) __builtin_amdgcn_s_sleep(1);
      __builtin_amdgcn_fence(__ATOMIC_ACQUIRE, "agent");
      xb_add(&bar[XB_XGEN(x)], 1u);
      asm volatile("s_waitcnt vmcnt(0)" ::: "memory");
    } else {
      while (xb_ld(&bar[XB_XGEN(x)]) == gen) __builtin_amdgcn_s_sleep(1);
      __builtin_amdgcn_fence(__ATOMIC_ACQUIRE, "agent");
      asm volatile("s_waitcnt vmcnt(0)" ::: "memory");
    }
  }
  __syncthreads();
}
#ifndef REP_GEMM
#define REP_GEMM 1
#endif
#ifndef REP_PREP
#define REP_PREP 1
#endif
#ifndef REP_GLP
#define REP_GLP 1
#endif
#ifndef REP_SCAN
#define REP_SCAN 0
#endif
#ifndef REP_SYNC
#define REP_SYNC 0
#endif
#ifndef REP_EW
#define REP_EW 1
#endif
__global__ void __launch_bounds__(512, 2) fwd_megakernel(Params p) {
  __shared__ __attribute__((aligned(1024))) char shm[141312];
  cg::grid_group grid = cg::this_grid();
  const int wave_s_ = __builtin_amdgcn_readfirstlane((int)(threadIdx.x >> 6));
  char* ws = p.ws;
  float* mods = (float*)(ws + OFF_MOD);
  u16* W0T = (u16*)(ws + OFF_W0T);
  u16* WO0T = (u16*)(ws + OFF_WO0T);
  u16* W1T = (u16*)(ws + OFF_W1T);
  u16* WO1T = (u16*)(ws + OFF_WO1T);
  u16* outb = (u16*)p.out;
  float* ctx1 = (float*)(ws + OFF_X);

  mods_phase(shm, p, wave_s_);
  wtrans_phase<0>(shm, p, wave_s_);
  if (gridDim.x == 256) gbar(ws, wave_s_); else grid.sync();
  {
    u16* H0 = (u16*)(ws + OFF_T);
    h_phase(p.x, p.ctx, p.norm_g, mods, H0, R, wave_s_);
    gbar(ws, wave_s_);
#if REP_EW > 1
    h_phase(p.x, p.ctx, p.norm_g, mods, H0, R, wave_s_);
    gbar(ws, wave_s_);
#endif
    small_gemm(H0, W0T + (size_t)6144 * 1024, (float*)(ws + OFF_ABT), wave_s_);
    EpiArgs e{};
    e.mode = 0; e.lat = outb; e.ctx = (u16*)(ws + OFF_X); e.ld = 2048;
    gemm_phase<0>(shm, H0, H0 + (size_t)RL * 1024, 1024, W0T, 0, 128, 8, e, wave_s_);
    {
      EpiArgs ec{};
      ec.mode = 4; ec.ctx = (u16*)(ws + OFF_X);
      gemm_phase<4>(shm, H0, H0 + (size_t)RL * 1024, 1024, W0T, 128, 4, 24, ec, wave_s_);
    }
    gbar(ws, wave_s_);
#if REP_GEMM > 1
    gemm_phase<0>(shm, H0, H0 + (size_t)RL * 1024, 1024, W0T, 0, 132, 8, e, wave_s_);
    gbar(ws, wave_s_);
#endif
    conv_phase<false>(p, wave_s_);
    gbar(ws, wave_s_);
#if REP_EW > 1
    conv_phase<false>(p, wave_s_);
    gbar(ws, wave_s_);
#endif
    gemm_phase<0>(shm, H0, H0 + (size_t)RL * 1024, 1024, W0T + (size_t)2048 * 1024, 0, 128, 8, e, wave_s_);
    gbar(ws, wave_s_);
#if REP_GEMM > 1
    gemm_phase<0>(shm, H0, H0 + (size_t)RL * 1024, 1024, W0T + (size_t)2048 * 1024, 0, 132, 8, e, wave_s_);
    gbar(ws, wave_s_);
#endif
    conv_phase<true>(p, wave_s_);
    gbar(ws, wave_s_);
#if REP_EW > 1
    conv_phase<true>(p, wave_s_);
    gbar(ws, wave_s_);
#endif
    for (int rep_ = 0; rep_ < REP_PREP; ++rep_) {
    dn_prep_phase(shm, p, wave_s_);
    gbar(ws, wave_s_);
    }
    for (int rep_ = 0; rep_ < REP_SCAN; ++rep_) { scan_phase<true, true>(shm, p, wave_s_); gbar(ws, wave_s_); }
    for (int rep_ = 0; rep_ < REP_SYNC; ++rep_) gbar(ws, wave_s_);
    scan_phase<true>(shm, p, wave_s_);
    gbar(ws, wave_s_);
    u16* H0b = H0;
    u16* Z = (u16*)(ws + OFF_QK0);
    EpiArgs ez{};
    ez.mode = 0; ez.lat = Z; ez.ctx = Z + (size_t)RL * 2048; ez.ld = 2048;
    gemm_phase<0>(shm, H0b, H0b + (size_t)RL * 1024, 1024, W0T + (size_t)4096 * 1024, 0, 128, 8, ez, wave_s_);
    gbar(ws, wave_s_);
#if REP_GEMM > 1
    gemm_phase<0>(shm, H0b, H0b + (size_t)RL * 1024, 1024, W0T + (size_t)4096 * 1024, 0, 132, 8, ez, wave_s_);
    gbar(ws, wave_s_);
#endif
    u16* U0 = (u16*)(ws + OFF_U0);
    yg_phase<32>(U0, (const u16*)(ws + OFF_U1), Z, (const u16*)(ws + OFF_ZC), p.dn_norm_g, R, wave_s_);
    gbar(ws, wave_s_);
    EpiArgs eo{};
    eo.mode = 2; eo.res_lat = p.x; eo.res_ctx = p.ctx; eo.mods_i = mods; eo.out_lat = p.out; eo.out_ctx = ctx1;
    gemm_phase<2>(shm, U0, U0 + (size_t)RL * 2048, 2048, WO0T, 0, 132, 4, eo, wave_s_);
    gbar(ws, wave_s_);
#if REP_GEMM > 1
    gemm_phase<2>(shm, U0, U0 + (size_t)RL * 2048, 2048, WO0T, 0, 132, 4, eo, wave_s_);
    gbar(ws, wave_s_);
#endif
  }
  {
    const float* mods1 = mods + 5 * 3072;
    u16* H1 = (u16*)(ws + OFF_QD);
    h_phase(p.out, ctx1, p.norm_g + 1024, mods1, H1, R, wave_s_);
    wtrans_phase<1>(shm, p, wave_s_);
    gbar(ws, wave_s_);
    small_gemm(H1, W1T + (size_t)5120 * 1024, (float*)(ws + OFF_ABT), wave_s_);
    EpiArgs e{};
    e.mode = 1; e.lat = (u16*)(ws + OFF_QK1); e.b1 = (u16*)(ws + OFF_V0); e.b2 = (u16*)(ws + OFF_V1);
    gemm_phase<1>(shm, H1, H1 + (size_t)RL * 1024, 1024, W1T, 0, 132, 12, e, wave_s_);
    gbar(ws, wave_s_);
    for (int rep_ = 0; rep_ < REP_GLP; ++rep_) {
    gla_prep_phase(shm, p, wave_s_);
    gbar(ws, wave_s_);
    }
    for (int rep_ = 0; rep_ < REP_SCAN; ++rep_) { scan_phase<false, true>(shm, p, wave_s_); gbar(ws, wave_s_); }
    scan_phase<false>(shm, p, wave_s_);
    u16* H1b = (u16*)(ws + OFF_QK1);
    h_phase(p.out, ctx1, p.norm_g + 1024, mods1, H1b, RL, wave_s_);
    gbar(ws, wave_s_);
    u16* RB = (u16*)(ws + OFF_QD);
    EpiArgs er{};
    er.mode = 0; er.lat = RB; er.ctx = RB; er.ld = 2048;
    gemm_phase<0>(shm, H1b, H1b, 1024, W1T + (size_t)3072 * 1024, 0, 128, 8, er, wave_s_);
    gbar(ws, wave_s_);
    u16* V0 = (u16*)(ws + OFF_V0);
    yg_phase<64>(V0, (const u16*)(ws + OFF_V1), RB, RB, p.gla_norm_g, RL, wave_s_);
    gbar(ws, wave_s_);
    EpiArgs eo{};
    eo.mode = 2; eo.res_lat = p.out; eo.res_ctx = p.out; eo.mods_i = mods1; eo.out_lat = p.out; eo.out_ctx = p.out;
    gemm_phase<2>(shm, V0, V0, 2048, WO1T, 0, 128, 4, eo, wave_s_);
    gbar(ws, wave_s_);
    final_phase(p.out, p.final_g, wave_s_);
  }
}

extern "C" void kernel_launch(void* const* d_in, const int* in_sizes, int n_in, void* d_out, int out_size, void* d_ws,
                              size_t ws_size, hipStream_t stream) {
  static int grid_blocks = 0;
  if (!grid_blocks) {
    int dev = 0, cus = 0, per_cu = 0;
    hipGetDevice(&dev);
    hipDeviceGetAttribute(&cus, hipDeviceAttributeMultiprocessorCount, dev);
    hipOccupancyMaxActiveBlocksPerMultiprocessor(&per_cu, fwd_megakernel, 512, 0);
    if (per_cu < 1) per_cu = 1;
    grid_blocks = cus;
    if (grid_blocks > 256) grid_blocks = 256;
  }
  Params p{};
  p.x = (const float*)d_in[0]; p.c = (const float*)d_in[1]; p.ctx = (const float*)d_in[2]; p.c_ctx = (const float*)d_in[3];
  p.mod_w = (const float*)d_in[4]; p.mod_b = (const float*)d_in[5]; p.norm_g = (const float*)d_in[6];
  p.dn_w_in = (const float*)d_in[7]; p.dn_conv_w = (const float*)d_in[8]; p.dn_a_log = (const float*)d_in[9];
  p.dn_dt_bias = (const float*)d_in[10]; p.dn_norm_g = (const float*)d_in[11]; p.dn_w_out = (const float*)d_in[12];
  p.gla_w_in = (const float*)d_in[13]; p.gla_w_g2 = (const float*)d_in[14]; p.gla_b_g = (const float*)d_in[15];
  p.gla_norm_g = (const float*)d_in[16]; p.gla_w_out = (const float*)d_in[17]; p.final_g = (const float*)d_in[18];
  p.out = (float*)d_out;
  p.ws = (char*)d_ws;
  (void)hipMemsetAsync((char*)d_ws + OFF_BAR, 0, XCD_BAR_WORDS * sizeof(unsigned), stream);
  void* args[] = {&p};
  hipError_t e = hipLaunchCooperativeKernel((void*)fwd_megakernel, dim3(grid_blocks), dim3(512), args, 0, stream);
  if (e != hipSuccess) fprintf(stderr, "cooperative launch failed: %s (grid %d)\n", hipGetErrorString(e), grid_blocks);
}
```

```cpp
#include <hip/hip_runtime.h>
#include <hip/hip_cooperative_groups.h>
#include <cstdio>
namespace cg = cooperative_groups;

#define DI __device__ __forceinline__
typedef unsigned short u16;
typedef short s16x8 __attribute__((ext_vector_type(8)));
typedef short s16x4 __attribute__((ext_vector_type(4)));
typedef float f32x2 __attribute__((ext_vector_type(2)));
typedef float f32x4 __attribute__((ext_vector_type(4)));
typedef float f32x16 __attribute__((ext_vector_type(16)));
typedef int i32x4 __attribute__((ext_vector_type(4)));
typedef unsigned u32x2 __attribute__((ext_vector_type(2)));
typedef unsigned u32x4 __attribute__((ext_vector_type(4)));
typedef __bf16 bf2_t __attribute__((ext_vector_type(2)));

constexpr int RL = 32768;
constexpr int RC = 1024;
constexpr int R = RL + RC;
constexpr int DM = 1024;
constexpr int NCHUNK = R / 64;
constexpr float EPSF = 1e-6f;
constexpr size_t MiB = 1u << 20;

constexpr size_t OFF_QK0 = 0;
constexpr size_t OFF_U0 = 132 * MiB;
constexpr size_t OFF_U1 = 264 * MiB;
constexpr size_t OFF_T = 396 * MiB;
constexpr size_t OFF_W1T = 462 * MiB;
constexpr size_t OFF_WO1T = OFF_W1T + 10 * MiB + 256 * 1024;
constexpr size_t OFF_MOD = OFF_WO1T + 4 * MiB;
constexpr size_t OFF_X = OFF_MOD + 256 * 1024;
constexpr size_t OFF_ABT = OFF_X + 8 * MiB + 256 * 1024;
constexpr size_t OFF_W0T = OFF_ABT + 4 * MiB + 256 * 1024;
constexpr size_t OFF_WO0T = OFF_W0T + 12 * MiB + 256 * 1024;
constexpr size_t OFF_V0 = 0;
constexpr size_t OFF_V1 = 132 * MiB;
constexpr size_t OFF_QK1 = 264 * MiB;
constexpr size_t OFF_QD = 330 * MiB;
constexpr size_t OFF_CD1 = OFF_X + 4 * MiB;
constexpr size_t OFF_ASUM = OFF_W0T;
constexpr size_t OFF_BAR = 506 * MiB;
constexpr size_t OFF_ZC = 507 * MiB;

constexpr size_t TA_LAT_ITEMS = 4096;
constexpr size_t OFF_TC = 462 * MiB;
constexpr size_t OFF_AC = 464 * MiB;
DI size_t ta_off(size_t item, int d) { return ((item < TA_LAT_ITEMS ? item : item - TA_LAT_ITEMS) * 2 + d) * 4096; }
struct Params {
  const float *x, *c, *ctx, *c_ctx, *mod_w, *mod_b, *norm_g, *dn_w_in, *dn_conv_w, *dn_a_log, *dn_dt_bias, *dn_norm_g,
      *dn_w_out, *gla_w_in, *gla_w_g2, *gla_b_g, *gla_norm_g, *gla_w_out, *final_g;
  float* out;
  char* ws;
};

DI unsigned pk2(float lo, float hi) { f32x2 v = {lo, hi}; return __builtin_bit_cast(unsigned, __builtin_convertvector(v, bf2_t)); }
DI float bflo(unsigned u) { return __uint_as_float(u << 16); }
DI float bfhi(unsigned u) { return __uint_as_float(u & 0xffff0000u); }
DI float bf2f(u16 v) { return __uint_as_float(((unsigned)v) << 16); }
DI u16 f2bf(float x) { return (u16)(pk2(x, 0.f) & 0xffffu); }
DI float siluf(float x) { return x / (1.f + __expf(-x)); }
DI float sigmoidf(float x) { return 1.f / (1.f + __expf(-x)); }
DI float softplusf(float x) { return fmaxf(x, 0.f) + __logf(1.f + __expf(-fabsf(x))); }
DI int crow(int reg, int h) { return (reg & 3) + 8 * (reg >> 2) + 4 * h; }
#define MFMA32(a, b, c) __builtin_amdgcn_mfma_f32_32x32x16_bf16((a), (b), (c), 0, 0, 0)
#define MFMA16(a, b, c) __builtin_amdgcn_mfma_f32_16x16x32_bf16((a), (b), (c), 0, 0, 0)

DI s16x8 cat8(u32x2 lo, u32x2 hi) { u32x4 v = {lo.x, lo.y, hi.x, hi.y}; return __builtin_bit_cast(s16x8, v); }
DI s16x8 ldA_perm(const char* base, int row, int strideB, int kofs, int h) {
  const char* p = base + row * strideB + (kofs + 4 * h) * 2;
  u32x2 lo = *(const u32x2*)p, hi = *(const u32x2*)(p + 16);
  return cat8(lo, hi);
}
DI s16x8 ldA_nat(const char* base, int row, int strideB, int kofs, int h) {
  const char* p = base + row * strideB + (kofs + 8 * h) * 2;
  u32x2 lo = *(const u32x2*)p, hi = *(const u32x2*)(p + 8);
  return cat8(lo, hi);
}
DI s16x8 pack_step(const f32x16& x, int s) {
  u32x4 p;
  p.x = pk2(x[8 * s + 0], x[8 * s + 1]); p.y = pk2(x[8 * s + 2], x[8 * s + 3]);
  p.z = pk2(x[8 * s + 4], x[8 * s + 5]); p.w = pk2(x[8 * s + 6], x[8 * s + 7]);
  return __builtin_bit_cast(s16x8, p);
}
DI void st8(char* p, u32x4 v) { *(u32x2*)p = (u32x2){v.x, v.y}; *(u32x2*)(p + 8) = (u32x2){v.z, v.w}; }
DI u32x4 scale8(u32x4 v, float s) {
  u32x4 o;
  o.x = pk2(bflo(v.x) * s, bfhi(v.x) * s); o.y = pk2(bflo(v.y) * s, bfhi(v.y) * s);
  o.z = pk2(bflo(v.z) * s, bfhi(v.z) * s); o.w = pk2(bflo(v.w) * s, bfhi(v.w) * s);
  return o;
}
DI int opq_v(int v) { asm volatile("" : "+v"(v)); return v; }
DI int lane_id() { int r; asm volatile("v_mbcnt_lo_u32_b32 %0, -1, 0\n\tv_mbcnt_hi_u32_b32 %0, -1, %0" : "=v"(r)); return r; }
#define TIDX() (wave_s_ * 64 + lane_id())
DI float wave_sum(float v) {
#pragma unroll
  for (int o = 32; o >= 1; o >>= 1) v += __shfl_xor(v, o, 64);
  return v;
}

DI void mods_phase(char* shm, const Params& p, const int wave_s_) {
  const int bid = blockIdx.x, tid = TIDX();
  float* mods = (float*)(p.ws + OFF_MOD);
  if (bid < 192) {
    float* scond = (float*)shm;
    float* red = scond + 5 * 1024;
    for (int e = tid; e < 5 * 1024; e += 512) {
      int r = e >> 10, k = e & 1023;
      float v = (r < 4) ? p.c[r * 1024 + k] : p.c_ctx[k];
      scond[e] = siluf(v);
    }
    __syncthreads();
    const int i = bid / 96, jt = bid % 96, jl = tid & 31, ks = tid >> 5;
    const float* w = p.mod_w + (size_t)i * 1024 * 3072 + jt * 32 + jl;
    float a0 = 0, a1 = 0, a2 = 0, a3 = 0, a4 = 0;
#pragma unroll 8
    for (int kk = 0; kk < 64; ++kk) {
      int k = ks * 64 + kk;
      float wv = __builtin_nontemporal_load(w + (size_t)k * 3072);
      a0 += scond[k] * wv; a1 += scond[1024 + k] * wv; a2 += scond[2048 + k] * wv; a3 += scond[3072 + k] * wv; a4 += scond[4096 + k] * wv;
    }
    red[(ks * 5 + 0) * 32 + jl] = a0; red[(ks * 5 + 1) * 32 + jl] = a1; red[(ks * 5 + 2) * 32 + jl] = a2;
    red[(ks * 5 + 3) * 32 + jl] = a3; red[(ks * 5 + 4) * 32 + jl] = a4;
    __syncthreads();
    if (tid < 160) {
      int r = tid >> 5, j = tid & 31;
      float s = p.mod_b[i * 3072 + jt * 32 + j];
      for (int q = 0; q < 16; ++q) s += red[(q * 5 + r) * 32 + j];
      mods[(i * 5 + r) * 3072 + jt * 32 + j] = s;
    }
    __syncthreads();
  }
}

DI void wtrans_tile(char* shm, const float* src, int K, int N, u16* dst, int tile, const int wave_s_) {
  u16* t = (u16*)shm;
  const int tid = TIDX();
  const int tn = (N + 63) / 64;
  const int k0 = (tile / tn) * 64, n0 = (tile % tn) * 64;
#pragma unroll
  for (int q = 0; q < 2; ++q) {
    const int e = tid + q * 512, kk = e >> 4, nn = (e & 15) * 4;
    f32x4 v = {0.f, 0.f, 0.f, 0.f};
    if (n0 + nn < N) v = __builtin_nontemporal_load((const f32x4*)(src + (size_t)(k0 + kk) * N + n0 + nn));
    t[(nn + 0) * 72 + kk] = f2bf(v.x); t[(nn + 1) * 72 + kk] = f2bf(v.y);
    t[(nn + 2) * 72 + kk] = f2bf(v.z); t[(nn + 3) * 72 + kk] = f2bf(v.w);
  }
  __syncthreads();
  {
    const int nn = tid >> 3, kk = (tid & 7) * 8;
    if (n0 + nn < N) *(u32x4*)(dst + (size_t)(n0 + nn) * K + k0 + kk) = *(const u32x4*)(t + nn * 72 + kk);
  }
  __syncthreads();
}
template <int LAYER>
DI void wtrans_phase(char* shm, const Params& p, const int wave_s_, const bool skip_xcd0 = false) {
  const int t0 = 16 * 97, t1 = 32 * 16, t2 = 16 * 81, t3 = 32 * 16;
  int b = blockIdx.x, nb = gridDim.x;
  if (skip_xcd0) { if ((b & 7) == 0) return; b = b - 1 - (b >> 3); nb = nb - (nb >> 3); }
  if (LAYER == 0) {
    for (int tile = b; tile < t0 + t1; tile += nb) {
      if (tile < t0) wtrans_tile(shm, p.dn_w_in, 1024, 6176, (u16*)(p.ws + OFF_W0T), tile, wave_s_);
      else wtrans_tile(shm, p.dn_w_out, 2048, 1024, (u16*)(p.ws + OFF_WO0T), tile - t0, wave_s_);
    }
  } else {
    for (int tile = b; tile < t2 + t3; tile += nb) {
      if (tile < t2) wtrans_tile(shm, p.gla_w_in, 1024, 5152, (u16*)(p.ws + OFF_W1T), tile, wave_s_);
      else wtrans_tile(shm, p.gla_w_out, 2048, 1024, (u16*)(p.ws + OFF_WO1T), tile - t2, wave_s_);
    }
  }
}

DI void h_phase(const float* src_lat, const float* src_ctx, const float* g, const float* mods_i, u16* dst, int nrows, const int wave_s_) {
  const int tidx_ = TIDX();
  const int lane = tidx_ & 63, gw = blockIdx.x * 8 + (tidx_ >> 6), nw = gridDim.x * 8;
  for (int row0 = gw; row0 < nrows; row0 += 2 * nw) {
    const int rows[2] = {row0, row0 + nw};
    const bool ok1 = rows[1] < nrows;
    f32x4 v[2][4];
#pragma unroll
    for (int u = 0; u < 2; ++u) {
      const int row = (u == 0 || ok1) ? rows[u] : rows[0];
      const float* s = (row < RL) ? src_lat + (size_t)row * DM : src_ctx + (size_t)(row - RL) * DM;
#pragma unroll
      for (int q = 0; q < 4; ++q) v[u][q] = __builtin_nontemporal_load((const f32x4*)(s + q * 256 + lane * 4));
    }
#pragma unroll
    for (int u = 0; u < 2; ++u) {
      if (u == 1 && !ok1) break;
      const int row = rows[u];
      const int mr = (row < RL) ? (row >> 13) : 4;
      const float* sh = mods_i + mr * 3072;
      const float* sc = sh + 1024;
      float ss = 0.f;
#pragma unroll
      for (int q = 0; q < 4; ++q) ss += v[u][q].x * v[u][q].x + v[u][q].y * v[u][q].y + v[u][q].z * v[u][q].z + v[u][q].w * v[u][q].w;
      ss = wave_sum(ss);
      const float rstd = rsqrtf(ss * (1.f / 1024.f) + EPSF);
#pragma unroll
      for (int q = 0; q < 4; ++q) {
        const int col = q * 256 + lane * 4;
        f32x4 gg = *(const f32x4*)(g + col), s1 = *(const f32x4*)(sc + col), s0 = *(const f32x4*)(sh + col);
        float o0 = v[u][q].x * rstd * gg.x * (1.f + s1.x) + s0.x, o1 = v[u][q].y * rstd * gg.y * (1.f + s1.y) + s0.y;
        float o2 = v[u][q].z * rstd * gg.z * (1.f + s1.z) + s0.z, o3 = v[u][q].w * rstd * gg.w * (1.f + s1.w) + s0.w;
        *(u32x2*)(dst + (size_t)row * DM + col) = (u32x2){pk2(o0, o1), pk2(o2, o3)};
      }
    }
  }
}

DI void small_gemm(const u16* A, const u16* Wt, float* out, const int wave_s_) {
  const int tidx_ = TIDX();
  if ((blockIdx.x & 7) == 0) return;
  const int bsub = (int)blockIdx.x - 1 - ((int)blockIdx.x >> 3);
  const int lane = tidx_ & 63, gw = bsub * 8 + (tidx_ >> 6), nw = (gridDim.x - (gridDim.x >> 3)) * 8;
  const int r = lane & 31, h = lane >> 5;
  for (int wt = gw; wt < R / 32; wt += nw) {
    const u16* ap = A + (size_t)(wt * 32 + r) * 1024 + 8 * h;
    const u16* bp = Wt + (size_t)r * 1024 + 8 * h;
    f32x16 acc;
    for (int i = 0; i < 16; ++i) acc[i] = 0.f;
#pragma unroll 8
    for (int s = 0; s < 64; ++s) {
      s16x8 a = *(const s16x8*)(ap + 16 * s), b = *(const s16x8*)(bp + 16 * s);
      acc = MFMA32(a, b, acc);
    }
#pragma unroll
    for (int i = 0; i < 16; ++i) out[(size_t)(wt * 32 + crow(i, h)) * 32 + r] = acc[i];
  }
}

DI int lds_byte2(int r, int c) {
  int st = (r >> 4) * 2 + (c >> 5), ob = (r & 15) * 64 + (c & 31) * 2;
  return st * 1024 + (ob ^ (((ob >> 9) & 1) << 5));
}
DI void stage_rc2(int b, int& Rr, int& Cc) {
  int st = b >> 10, sb = b & 1023, swz = sb ^ (((sb >> 9) & 1) << 5);
  Rr = (st / 2) * 16 + swz / 64;
  Cc = (st % 2) * 32 + (swz % 64) / 2;
}

struct EpiArgs {
  int mode;
  u16* lat; u16* ctx; int ld;
  u16* b1; u16* b2;
  const float* res_lat; const float* res_ctx; const float* mods_i; float* out_lat; float* out_ctx;
};

template <int MODE>
DI void gemm_epilogue(const EpiArgs& e, f32x4 (&acc)[8][4], int row0, int pn, int wr, int wc, int fr, int fq) {
#pragma unroll
  for (int m = 0; m < 8; ++m) {
    const int row = row0 + wr * 128 + m * 16 + fr;
#pragma unroll
    for (int n = 0; n < 4; ++n) {
      const int col = pn * 256 + wc * 64 + n * 16 + fq * 4;
      const f32x4 a = acc[m][n];
      if (MODE == 0) {
        u16* pr = (row < RL) ? e.lat + (size_t)row * e.ld : e.ctx + (size_t)(row - RL) * e.ld;
        *(u32x2*)(pr + col) = (u32x2){pk2(a.x, a.y), pk2(a.z, a.w)};
      } else if (MODE == 1) {
        u32x2 v = {pk2(a.x, a.y), pk2(a.z, a.w)};
        if (pn < 4) {
          *(u32x2*)(e.lat + (size_t)row * 1024 + col) = v;
        } else {
          *(u32x2*)(e.b1 + (size_t)row * 2048 + col - 1024) = v;
          *(u32x2*)(e.b2 + (size_t)row * 2048 + col - 1024) = v;
        }
      } else {
        const int mr = (row < RL) ? (row >> 13) : 4;
        const f32x4 gt = *(const f32x4*)(e.mods_i + mr * 3072 + 2048 + col);
        const float* rp = (row < RL) ? e.res_lat + (size_t)row * DM : e.res_ctx + (size_t)(row - RL) * DM;
        float* op = (row < RL) ? e.out_lat + (size_t)row * DM : e.out_ctx + (size_t)(row - RL) * DM;
        const f32x4 rv = *(const f32x4*)(rp + col);
        f32x4 o = {rv.x + gt.x * a.x, rv.y + gt.y * a.y, rv.z + gt.z * a.z, rv.w + gt.w * a.w};
        *(f32x4*)(op + col) = o;
      }
    }
  }
}

template <int MODE>
DI void gemm_epilogue8(const EpiArgs& e, f32x4 (&acc)[2][2][4][2], int row0, int pn, int wr, int wc, int fr, int fq) {
#pragma unroll
  for (int ai = 0; ai < 2; ++ai)
#pragma unroll
    for (int m = 0; m < 4; ++m) {
      const int row = row0 + ai * 128 + wr * 64 + m * 16 + fr;
#pragma unroll
      for (int bj = 0; bj < 2; ++bj)
#pragma unroll
        for (int n = 0; n < 2; ++n) {
          const int col = pn * 256 + bj * 128 + wc * 32 + n * 16 + fq * 4;
          const f32x4 a = acc[ai][bj][m][n];
          if (MODE == 0) {
            u16* pr = (row < RL) ? e.lat + (size_t)row * e.ld : e.ctx + (size_t)(row - RL) * e.ld;
            *(u32x2*)(pr + col) = (u32x2){pk2(a.x, a.y), pk2(a.z, a.w)};
          } else if (MODE == 4) {
            const size_t dsel = (pn < 8) ? 0 : (pn < 16) ? (4 * MiB / 2) : ((OFF_ZC - OFF_X) / 2);
            *(u32x2*)(e.ctx + dsel + (size_t)(row - RL) * 2048 + (col & 2047)) = (u32x2){pk2(a.x, a.y), pk2(a.z, a.w)};
          } else if (MODE == 1) {
            u32x2 v = {pk2(a.x, a.y), pk2(a.z, a.w)};
            if (pn < 4) {
              *(u32x2*)(e.lat + (size_t)row * 1024 + col) = v;
            } else {
              *(u32x2*)(e.b1 + (size_t)row * 2048 + col - 1024) = v;
              *(u32x2*)(e.b2 + (size_t)row * 2048 + col - 1024) = v;
            }
          } else {
            const int mr = (row < RL) ? (row >> 13) : 4;
            const f32x4 gt = *(const f32x4*)(e.mods_i + mr * 3072 + 2048 + col);
            const float* rp = (row < RL) ? e.res_lat + (size_t)row * DM : e.res_ctx + (size_t)(row - RL) * DM;
            float* op = (row < RL) ? e.out_lat + (size_t)row * DM : e.out_ctx + (size_t)(row - RL) * DM;
            const f32x4 rv = __builtin_nontemporal_load((const f32x4*)(rp + col));
            f32x4 o = {rv.x + gt.x * a.x, rv.y + gt.y * a.y, rv.z + gt.z * a.z, rv.w + gt.w * a.w};
            *(f32x4*)(op + col) = o;
          }
        }
    }
}

template <int MODE>
DI void gemm_phase(char* shm_, const u16* Alat, const u16* Actx, int K, const u16* Bt, int pm0, int npm, int nN, const EpiArgs& e, const int wave_s_) {
  constexpr int BK = 64, HALF = 128, HT = HALF * BK;
  u16* shm = (u16*)shm_;
  const int tid = TIDX(), wid = tid >> 6, lane = tid & 63, wr = wid >> 2, wc = wid & 3, fr = lane & 15, fq = lane >> 4;
#define SA(b, h) (shm + ((b) * 2 + (h)) * HT)
#define SB(b, h) (shm + (4 + (b) * 2 + (h)) * HT)
#define LDSP(ptr) ((__attribute__((address_space(3))) unsigned*)(unsigned)(size_t)(ptr))
#define STAGE(P, BASE, br, kt) do { const u16* _p = (BASE) + (size_t)(br) * K + (kt) * BK + soff; \
    _Pragma("unroll") for (int _i = 0; _i < 2; ++_i) \
      __builtin_amdgcn_global_load_lds((const unsigned*)(_p + (size_t)_i * 64 * K), LDSP((char*)(P) + wid * 1024 + _i * 8192), 16, 0, 0); } while (0)
#define LDA(dst, b, h) _Pragma("unroll") for (int m = 0; m < 4; ++m) _Pragma("unroll") for (int k = 0; k < 2; ++k) \
    dst[m][k] = *(const s16x8*)((const char*)SA(b, h) + lds_byte2(wr * 64 + m * 16 + fr, k * 32 + fq * 8))
#define LDB(dst, b, h) _Pragma("unroll") for (int n = 0; n < 2; ++n) _Pragma("unroll") for (int k = 0; k < 2; ++k) \
    dst[n][k] = *(const s16x8*)((const char*)SB(b, h) + lds_byte2(wc * 32 + n * 16 + fr, k * 32 + fq * 8))
#define MMA(ai, bj, Atv, Btv) do { __builtin_amdgcn_s_setprio(1); \
    _Pragma("unroll") for (int m = 0; m < 4; ++m) _Pragma("unroll") for (int n = 0; n < 2; ++n) _Pragma("unroll") for (int k = 0; k < 2; ++k) \
      acc[ai][bj][m][n] = MFMA16(Btv[n][k], Atv[m][k], acc[ai][bj][m][n]); \
    __builtin_amdgcn_s_setprio(0); } while (0)
#define WAIT_V(n) asm volatile("s_waitcnt vmcnt(" #n ")" ::: "memory")
#define WAIT_L(n) asm volatile("s_waitcnt lgkmcnt(" #n ")" ::: "memory")
#define BAR __builtin_amdgcn_s_barrier()
#define SCHED __builtin_amdgcn_sched_barrier(0)
  int sR0, sC0;
  stage_rc2(tid * 16, sR0, sC0);
  const size_t soff = (size_t)sR0 * K + sC0;
  const int ntiles = npm * nN, nt = K / BK;
  const int xcd = blockIdx.x & 7, jj = blockIdx.x >> 3;
  const int PN = (nN % 8 == 0) ? 8 : 4, PG = 32 / PN, npg = nN / PN;
  const int ngroups = ((npm + PG - 1) / PG) * npg;
  const bool grouped = (gridDim.x == 256);
  const int nit = grouped ? (ngroups - xcd + 7) / 8 : (ntiles - (int)blockIdx.x + (int)gridDim.x - 1) / (int)gridDim.x;
  auto tile_of = [&](int it, int& pm, int& pn) -> bool {
    if (it >= nit) return false;
    if (grouped) {
      const int g = xcd + 8 * it, pmg = g / npg, png = g % npg;
      pm = pmg * PG + jj / PN; pn = png * PN + jj % PN;
      if (pm >= npm) return false;
      pm += pm0;
    } else {
      const int L = blockIdx.x + it * gridDim.x;
      pm = pm0 + L / nN; pn = L % nN;
    }
    return true;
  };
  bool prefetched = false;
  for (int it = 0; it < nit; ++it) {
    int pm, pn;
    if (!tile_of(it, pm, pn)) continue;
    const int row0 = pm * 256;
    const u16* A = (row0 < RL) ? Alat + (size_t)row0 * K : Actx + (size_t)(row0 - RL) * K;
    const u16* Bw = Bt + (size_t)pn * 256 * K;
    const int brow = 0, bcol = 0;
    f32x4 acc[2][2][4][2];
#pragma unroll
    for (int i0 = 0; i0 < 2; ++i0)
#pragma unroll
      for (int i1 = 0; i1 < 2; ++i1)
#pragma unroll
        for (int i2 = 0; i2 < 4; ++i2)
#pragma unroll
          for (int i3 = 0; i3 < 2; ++i3) acc[i0][i1][i2][i3] = (f32x4){0.f, 0.f, 0.f, 0.f};
    s16x8 At[4][2], B0[2][2], B1[2][2];
    if (!prefetched) {
      STAGE(SB(0, 0), Bw, bcol, 0); STAGE(SA(0, 0), A, brow, 0);
      STAGE(SB(0, 1), Bw, bcol + HALF, 0); STAGE(SA(0, 1), A, brow + HALF, 0);
    }
    if (wr == 1) BAR;
    WAIT_V(4); BAR;
    STAGE(SB(1, 0), Bw, bcol, 1); STAGE(SA(1, 0), A, brow, 1); STAGE(SB(1, 1), Bw, bcol + HALF, 1);
    WAIT_V(6); BAR;
    for (int t = 0; t < nt - 2; t += 2) {
      LDB(B0, 0, 0); SCHED; LDA(At, 0, 0); STAGE(SA(1, 1), A, brow + HALF, t + 1);
      WAIT_L(8); BAR; WAIT_L(0); MMA(0, 0, At, B0); BAR; SCHED;
      LDB(B1, 0, 1); STAGE(SB(0, 0), Bw, bcol, t + 2);
      BAR; WAIT_L(0); MMA(0, 1, At, B1); BAR;
      LDA(At, 0, 1); STAGE(SA(0, 0), A, brow, t + 2);
      BAR; WAIT_L(0); MMA(1, 0, At, B0); BAR; SCHED;
      STAGE(SB(0, 1), Bw, bcol + HALF, t + 2);
      WAIT_V(6); BAR; MMA(1, 1, At, B1); BAR;
      LDB(B0, 1, 0); SCHED; LDA(At, 1, 0); STAGE(SA(0, 1), A, brow + HALF, t + 2);
      WAIT_L(8); BAR; WAIT_L(0); MMA(0, 0, At, B0); BAR; SCHED;
      LDB(B1, 1, 1); STAGE(SB(1, 0), Bw, bcol, t + 3);
      BAR; WAIT_L(0); MMA(0, 1, At, B1); BAR;
      LDA(At, 1, 1); STAGE(SA(1, 0), A, brow, t + 3);
      BAR; WAIT_L(0); MMA(1, 0, At, B0); BAR; SCHED;
      STAGE(SB(1, 1), Bw, bcol + HALF, t + 3);
      WAIT_V(6); BAR; MMA(1, 1, At, B1); BAR;
    }
    { LDB(B0, 0, 0); LDA(At, 0, 0); STAGE(SA(1, 1), A, brow + HALF, nt - 1);
      BAR; WAIT_L(0); MMA(0, 0, At, B0); BAR;
      LDB(B1, 0, 1); BAR; WAIT_L(0); MMA(0, 1, At, B1); BAR;
      LDA(At, 0, 1); WAIT_V(4); BAR; WAIT_L(0); MMA(1, 0, At, B0); MMA(1, 1, At, B1); BAR; }
    { LDB(B0, 1, 0); LDA(At, 1, 0); WAIT_V(2); BAR; WAIT_L(0); MMA(0, 0, At, B0); BAR;
      LDB(B1, 1, 1); WAIT_V(0); BAR; WAIT_L(0); MMA(0, 1, At, B1); BAR;
      LDA(At, 1, 1); BAR; WAIT_L(0); MMA(1, 0, At, B0); MMA(1, 1, At, B1); BAR; }
    if (wr == 0) BAR;
    {
      int pm2, pn2;
      prefetched = tile_of(it + 1, pm2, pn2);
      if (prefetched) {
        const int r2 = pm2 * 256;
        const u16* A2 = (r2 < RL) ? Alat + (size_t)r2 * K : Actx + (size_t)(r2 - RL) * K;
        const u16* B2 = Bt + (size_t)pn2 * 256 * K;
        STAGE(SB(0, 0), B2, 0, 0); STAGE(SA(0, 0), A2, 0, 0);
        STAGE(SB(0, 1), B2, HALF, 0); STAGE(SA(0, 1), A2, HALF, 0);
      }
    }
    { const int l2 = lane_id(); gemm_epilogue8<MODE>(e, acc, row0, pn, wr, wc, l2 & 15, l2 >> 4); }
    asm volatile("s_waitcnt vmcnt(0) lgkmcnt(0)" ::: "memory");
    BAR;
  }
#undef SA
#undef SB
#undef LDSP
#undef STAGE
#undef LDA
#undef LDB
#undef MMA
#undef WAIT_V
#undef WAIT_L
#undef BAR
#undef SCHED
}

DI void conv_accum(float (&acc)[8], const u16* srow, const float* w) {
  u32x4 v = *(const u32x4*)srow;
  f32x4 w0 = *(const f32x4*)w, w1 = *(const f32x4*)(w + 4);
  acc[0] += bflo(v.x) * w0.x; acc[1] += bfhi(v.x) * w0.y; acc[2] += bflo(v.y) * w0.z; acc[3] += bfhi(v.y) * w0.w;
  acc[4] += bflo(v.z) * w1.x; acc[5] += bfhi(v.z) * w1.y; acc[6] += bflo(v.w) * w1.z; acc[7] += bfhi(v.w) * w1.w;
}
DI void fma8(float (&acc)[8], const u32x4 v, const float (&w)[8]) {
  acc[0] += bflo(v.x) * w[0]; acc[1] += bfhi(v.x) * w[1]; acc[2] += bflo(v.y) * w[2]; acc[3] += bfhi(v.y) * w[3];
  acc[4] += bflo(v.z) * w[4]; acc[5] += bfhi(v.z) * w[5]; acc[6] += bflo(v.w) * w[6]; acc[7] += bfhi(v.w) * w[7];
}
template <bool ISV>
DI void conv_store(const Params& p, float (&acc)[8], int row, int ch) {
#pragma unroll
  for (int e = 0; e < 8; ++e) acc[e] = siluf(acc[e]);
  if (!ISV) {
    u16* qk = (u16*)(p.ws + OFF_QK0);
    float ss = 0.f;
#pragma unroll
    for (int e = 0; e < 8; ++e) ss += acc[e] * acc[e];
    ss += __shfl_xor(ss, 1, 64); ss += __shfl_xor(ss, 2, 64); ss += __shfl_xor(ss, 4, 64); ss += __shfl_xor(ss, 8, 64);
    const float sc = rsqrtf(ss + EPSF) * ((ch < 1024) ? 0.08838834764831845f : 1.f);
    u32x4 o = {pk2(acc[0] * sc, acc[1] * sc), pk2(acc[2] * sc, acc[3] * sc), pk2(acc[4] * sc, acc[5] * sc), pk2(acc[6] * sc, acc[7] * sc)};
    __builtin_nontemporal_store(o, (u32x4*)(qk + (size_t)row * 2048 + ch));
  } else {
    u16* u0 = (u16*)(p.ws + OFF_U0);
    u16* u1 = (u16*)(p.ws + OFF_U1);
    const float* abt = (const float*)(p.ws + OFF_ABT);
    const int head = ch >> 8;
    const float b0 = sigmoidf(abt[(size_t)row * 32 + 16 + head]), b1 = sigmoidf(abt[(size_t)row * 32 + 24 + head]);
    u32x4 o0 = {pk2(acc[0] * b0, acc[1] * b0), pk2(acc[2] * b0, acc[3] * b0), pk2(acc[4] * b0, acc[5] * b0), pk2(acc[6] * b0, acc[7] * b0)};
    u32x4 o1 = {pk2(acc[0] * b1, acc[1] * b1), pk2(acc[2] * b1, acc[3] * b1), pk2(acc[4] * b1, acc[5] * b1), pk2(acc[6] * b1, acc[7] * b1)};
    __builtin_nontemporal_store(o0, (u32x4*)(u0 + (size_t)row * 2048 + ch));
    __builtin_nontemporal_store(o1, (u32x4*)(u1 + (size_t)row * 2048 + ch));
  }
}
template <bool ISV>
DI void conv_phase(const Params& p, const int wave_s_) {
  const u16* pre_lat = (const u16*)p.out;
  const u16* pre_ctx = (const u16*)(p.ws + OFF_X + (ISV ? 4 * MiB : 0));
  const float* cw = p.dn_conv_w + (ISV ? 2048 : 0);
  const int gt = blockIdx.x * 512 + TIDX(), nthr = gridDim.x * 512;
  const u32x4 zero4 = {0u, 0u, 0u, 0u};
  for (int idx = gt; idx < 4 * 128 * 4 * 256; idx += nthr) {
    const int cg8 = idx & 255, run = (idx >> 8) & 3, gr = (idx >> 10) & 127, b = idx >> 17, ch = cg8 * 8, c0 = run * 16;
    float w[9][8];
#pragma unroll
    for (int t = 0; t < 9; ++t) {
      const f32x4 w0 = *(const f32x4*)(cw + t * 4096 + ch), w1 = *(const f32x4*)(cw + t * 4096 + ch + 4);
      w[t][0] = w0.x; w[t][1] = w0.y; w[t][2] = w0.z; w[t][3] = w0.w; w[t][4] = w1.x; w[t][5] = w1.y; w[t][6] = w1.z; w[t][7] = w1.w;
    }
    const u16* base = pre_lat + ((size_t)(b << 13) + gr * 64) * 2048 + ch;
    const bool rok[3] = {gr > 0, true, gr < 127};
    u32x4 win[3][3];
#pragma unroll
    for (int i = 0; i < 3; ++i) {
      win[i][0] = (rok[i] && c0 > 0) ? *(const u32x4*)(base + (ptrdiff_t)((i - 1) * 64 + c0 - 1) * 2048) : zero4;
      win[i][1] = rok[i] ? *(const u32x4*)(base + (ptrdiff_t)((i - 1) * 64 + c0) * 2048) : zero4;
    }
#pragma unroll
    for (int t = 0; t < 16; ++t) {
      const int c = c0 + t;
#pragma unroll
      for (int i = 0; i < 3; ++i) win[i][2] = (rok[i] && c < 63) ? *(const u32x4*)(base + (ptrdiff_t)((i - 1) * 64 + c + 1) * 2048) : zero4;
      float acc[8];
#pragma unroll
      for (int e = 0; e < 8; ++e) acc[e] = 0.f;
#pragma unroll
      for (int i = 0; i < 3; ++i)
#pragma unroll
        for (int j = 0; j < 3; ++j) fma8(acc, win[i][j], w[i * 3 + j]);
      conv_store<ISV>(p, acc, (b << 13) + gr * 64 + c, ch);
#pragma unroll
      for (int i = 0; i < 3; ++i) { win[i][0] = win[i][1]; win[i][1] = win[i][2]; }
    }
  }
  for (int idx = gt; idx < 4 * 32 * 256; idx += nthr) {
    const int cg8 = idx & 255, run = (idx >> 8) & 31, b = idx >> 13, ch = cg8 * 8, p0 = run * 8;
    float w[3][8];
#pragma unroll
    for (int t = 0; t < 3; ++t) {
      const f32x4 w0 = *(const f32x4*)(cw + (3 + t) * 4096 + ch), w1 = *(const f32x4*)(cw + (3 + t) * 4096 + ch + 4);
      w[t][0] = w0.x; w[t][1] = w0.y; w[t][2] = w0.z; w[t][3] = w0.w; w[t][4] = w1.x; w[t][5] = w1.y; w[t][6] = w1.z; w[t][7] = w1.w;
    }
    const u16* base = pre_ctx + (size_t)(b * 256) * 2048 + ch;
    u32x4 win[3];
    win[0] = (p0 > 0) ? *(const u32x4*)(base + (size_t)(p0 - 1) * 2048) : zero4;
    win[1] = *(const u32x4*)(base + (size_t)p0 * 2048);
#pragma unroll
    for (int t = 0; t < 8; ++t) {
      const int pp = p0 + t;
      win[2] = (pp < 255) ? *(const u32x4*)(base + (size_t)(pp + 1) * 2048) : zero4;
      float acc[8];
#pragma unroll
      for (int e = 0; e < 8; ++e) acc[e] = 0.f;
#pragma unroll
      for (int j = 0; j < 3; ++j) fma8(acc, win[j], w[j]);
      conv_store<ISV>(p, acc, RL + b * 256 + pp, ch);
      win[0] = win[1]; win[1] = win[2];
    }
  }
}

constexpr int lp_off(int ip) { return ip == 0 ? 0 : (8 * ((ip - 1) / 4) * ((ip - 1) / 4 + 1) + 4 * ((ip - 1) % 4) * ((ip - 1) / 4 + 1)); }
constexpr int LP_FLOATS = 2112;
DI void dn_prep_phase(char* shm, const Params& p, const int wave_s_) {
  const int tid = TIDX(), wave = tid >> 6, lane = tid & 63, r = lane & 31, hh = lane >> 5;
  char* sQ = shm;
  char* sK = shm + 16896;
  float* sKK = (float*)(shm + 33792);
  float* sQK = (float*)(shm + 50432);
  float* sg = (float*)(shm + 67072);
  float* sbeta = sg + 128;
  float* sgc = sg + 256;
  float* sLp = (float*)(shm + 68608);
  const u16* qk = (const u16*)(p.ws + OFF_QK0);
  const float* abt = (const float*)(p.ws + OFF_ABT);
  u16* Ab_lat = (u16*)p.out;
  u16* Tb_lat = (u16*)p.out + (size_t)32 * MiB;
  u16* Ab_ctx = (u16*)(p.ws + OFF_AC);
  u16* Tb_ctx = (u16*)(p.ws + OFF_TC);
  float* Eb = (float*)(p.ws + OFF_X);
  for (int grp = blockIdx.x; grp < NCHUNK * 2; grp += gridDim.x) {
    const int ci = grp >> 1, row0 = ci * 64;
    u32x4 pq[2], pk[2];
    float pa = 0.f, pbt = 0.f;
    auto load_item = [&](int h) {
#pragma unroll
      for (int u = 0; u < 2; ++u) {
        const int chunk = tid * 2 + u, c = chunk >> 4, cc = (chunk & 15) * 8;
        const u16* src = qk + (size_t)(row0 + c) * 2048 + h * 128 + cc;
        pq[u] = *(const u32x4*)src; pk[u] = *(const u32x4*)(src + 1024);
      }
      if (tid < 128) {
        const int d = tid >> 6, c = tid & 63;
        pa = abt[(size_t)(row0 + c) * 32 + d * 8 + h]; pbt = abt[(size_t)(row0 + c) * 32 + 16 + d * 8 + h];
      }
    };
    load_item((grp & 1) * 4);
    for (int sub = 0; sub < 4; ++sub) {
      const int h = (grp & 1) * 4 + sub, item = ci * 8 + h;
#pragma unroll
      for (int u = 0; u < 2; ++u) {
        const int chunk = tid * 2 + u, c = chunk >> 4, cc = (chunk & 15) * 8;
        st8(sQ + c * 264 + cc * 2, pq[u]);
        st8(sK + c * 264 + cc * 2, pk[u]);
      }
      if (tid < 128) {
        const int d = tid >> 6, c = tid & 63;
        sg[d * 64 + c] = -__expf(p.dn_a_log[d * 8 + h]) * softplusf(pa + p.dn_dt_bias[d * 8 + h]);
        sbeta[d * 64 + c] = sigmoidf(pbt);
      }
      if (sub < 3) load_item(h + 1);
      __syncthreads();
      if (wave < 2) {
        const int c = wave ? 63 - lane : lane;
        float v = sg[wave * 64 + c];
#pragma unroll
        for (int o = 1; o < 64; o <<= 1) { const float t = __shfl_up(v, o, 64); if (lane >= o) v += t; }
        sgc[wave * 64 + c] = v;
      }
      {
        const int mat = wave >> 2, tm = (wave >> 1) & 1, tn = wave & 1;
        const char* aop = mat ? sQ : sK;
        f32x16 acc;
        for (int i = 0; i < 16; ++i) acc[i] = 0.f;
#pragma unroll
        for (int s = 0; s < 8; ++s) {
          s16x8 a = ldA_nat(aop, 32 * tm + r, 264, 16 * s, hh), b = ldA_nat(sK, 32 * tn + r, 264, 16 * s, hh);
          acc = MFMA32(a, b, acc);
        }
        float* dst = mat ? sQK : sKK;
#pragma unroll
        for (int i = 0; i < 16; ++i) dst[(32 * tm + crow(i, hh)) * 65 + 32 * tn + r] = acc[i];
      }
      __syncthreads();
      for (int e = tid; e < 8192; e += 512) {
        const int d = e >> 12, ip = (e >> 6) & 63, jp = e & 63;
        if (ip > jp) {
          const int i = d ? 63 - ip : ip, j = d ? 63 - jp : jp;
          const int q4 = (ip - 1) >> 2, r4 = (ip - 1) & 3;
          const float v = sbeta[d * 64 + i] * sKK[i * 65 + j] * __expf(fminf(sgc[d * 64 + i] - sgc[d * 64 + j], 0.f));
          sLp[(sub * 2 + d) * LP_FLOATS + 8 * q4 * (q4 + 1) + 4 * r4 * (q4 + 1) + jp] = v;
        }
      }
      for (int v = tid; v < 1024; v += 512) {
        const int d = v >> 9, i = (v >> 3) & 63, j0 = (v & 7) * 8;
        float o[8];
#pragma unroll
        for (int e = 0; e < 8; ++e) {
          const int j = j0 + e;
          const bool keep = d ? (i <= j) : (i >= j);
          o[e] = keep ? sQK[i * 65 + j] * __expf(fminf(sgc[d * 64 + i] - sgc[d * 64 + j], 0.f)) : 0.f;
        }
        u32x4 ov = {pk2(o[0], o[1]), pk2(o[2], o[3]), pk2(o[4], o[5]), pk2(o[6], o[7])};
        *(u32x4*)(((size_t)item < TA_LAT_ITEMS ? Ab_lat : Ab_ctx) + ta_off(item, d) + i * 64 + j0) = ov;
      }
      if (tid < 128) {
        const int d = tid >> 6, c = tid & 63;
        const float gl = sgc[d * 64 + (d ? 0 : 63)], gcv = sgc[d * 64 + c];
        const float e1 = __expf(gcv), be = sbeta[d * 64 + c] * e1, e2 = __expf(gl - gcv), cdv = __expf(gl);
        float* E = Eb + ((size_t)item * 2 + d) * 256;
        E[c] = e1; E[64 + c] = be; E[128 + c] = e2; E[192 + c] = cdv;
      }
      __syncthreads();
    }
    {
      const int wv = opq_v(wave), lane_l = opq_v(lane);
      const int d = wv & 1, item = ci * 8 + (grp & 1) * 4 + (wv >> 1);
      const float* Lb = sLp + wv * LP_FLOATS;
      float T[64];
#pragma unroll
      for (int ip = 0; ip < 64; ++ip) {
        f32x4 lrow[16];
#pragma unroll
        for (int j4 = 0; j4 < (ip + 3) / 4; ++j4) lrow[j4] = *(const f32x4*)(Lb + lp_off(ip) + j4 * 4);
        float a0 = (lane_l == ip) ? 1.f : 0.f, a1 = 0.f, a2 = 0.f, a3 = 0.f;
#pragma unroll
        for (int j4 = 0; j4 < (ip + 3) / 4; ++j4) {
          const f32x4 lv = lrow[j4];
          if (j4 * 4 + 0 < ip) a0 -= lv.x * T[j4 * 4 + 0];
          if (j4 * 4 + 1 < ip) a1 -= lv.y * T[j4 * 4 + 1];
          if (j4 * 4 + 2 < ip) a2 -= lv.z * T[j4 * 4 + 2];
          if (j4 * 4 + 3 < ip) a3 -= lv.w * T[j4 * 4 + 3];
        }
        T[ip] = (a0 + a1) + (a2 + a3);
        __builtin_amdgcn_sched_barrier(0);
      }
      u16* To = ((size_t)item < TA_LAT_ITEMS ? Tb_lat : Tb_ctx) + ta_off(item, d);
      const int cidx = d ? 63 - lane_l : lane_l;
#pragma unroll
      for (int ip = 0; ip < 64; ++ip) {
        const int i = d ? 63 - ip : ip;
        To[i * 64 + cidx] = f2bf(T[ip]);
      }
    }
    __syncthreads();
  }
}

constexpr int SC_QS = 272;
constexpr int SC_Q = 0, SC_K = 17408, SC_KT = 34816, SC_T = 52224, SC_A = 60928, SC_E = 69632, SC_BUF = 70656;
DI s16x8 ldA16(const char* base, int row, int strideB, int kofs, int q) {
  const char* p = base + row * strideB + (kofs + 4 * q) * 2;
  u32x2 lo = *(const u32x2*)p, hi = *(const u32x2*)(p + 32);
  return cat8(lo, hi);
}
DI s16x8 pack16(const f32x4& a, const f32x4& b) {
  u32x4 v = {pk2(a.x, a.y), pk2(a.z, a.w), pk2(b.x, b.y), pk2(b.z, b.w)};
  return __builtin_bit_cast(s16x8, v);
}

template <bool DELTA, bool DRY = false>
DI void scan_phase(char* shm, const Params& p, const int wave_s_) {
  const int bid = blockIdx.x;
  if (bid >= 256) return;
  const int tid = TIDX(), wave = tid >> 6, lane = tid & 63, n16 = lane & 15, q4 = lane >> 4;
  int cgp, d, h, b;
  if (DELTA) { cgp = (bid >> 3) & 3; const int cid = (bid & 7) + 8 * (bid >> 5); d = cid & 1; h = (cid >> 1) & 7; b = cid >> 4; }
  else { cgp = (bid >> 3) & 7; const int cid = (bid & 7) + 8 * (bid >> 6); d = cid & 1; h = (cid >> 1) & 3; b = cid >> 3; }
  const bool compute = wave < 4;
  const int col0 = (DELTA ? h * 256 : h * 512) + cgp * 64 + (wave & 3) * 16;
  u16* Ub = (u16*)(p.ws + (DELTA ? (d ? OFF_U1 : OFF_U0) : (d ? OFF_V1 : OFF_V0)));
  const u16* qk = (const u16*)(p.ws + OFF_QK0);
  const u16* Ag_lat = (const u16*)p.out;
  const u16* Tb_lat = (const u16*)p.out + (size_t)32 * MiB;
  const u16* Ag_ctx = (const u16*)(p.ws + OFF_AC);
  const u16* Tb_ctx = (const u16*)(p.ws + OFF_TC);
  const float* Eb = (const float*)(p.ws + OFF_X);
  const u16* QD = (const u16*)(p.ws + OFF_QD);
  const u16* AS = (const u16*)(p.ws + OFF_ASUM);
  const float* CD = (const float*)(p.ws + OFF_CD1);

  auto chunk_of = [&](int st) -> int {
    if (st < 4) return 512 + b * 4 + (d ? 3 - st : st);
    return b * 128 + (d ? 127 - (st - 4) : (st - 4));
  };

  auto stage_all = [&](int st, int buf) {
    const int sid = tid - 256;
    const int ci = chunk_of(st), row0 = ci * 64;
    char* sb = shm + buf * SC_BUF;
    if (DELTA) {
      const size_t it = ((size_t)ci * 8 + h) * 2 + d;
      const float* E = Eb + it * 256;
      const int c = sid >> 2, cc = (sid & 3) * 32;
      const u16* qsrc = qk + (size_t)(row0 + c) * 2048 + h * 128 + cc;
      const int c0 = (sid >> 4) * 4, dk0 = (sid & 15) * 8;
      const u16* ksrc = qk + (size_t)(row0 + c0) * 2048 + 1024 + h * 128 + dk0;
      u32x4 gq[4], gk[4], gT[2], gA[2];
#pragma unroll
      for (int u = 0; u < 4; ++u) gq[u] = *(const u32x4*)(qsrc + u * 8);
#pragma unroll
      for (int u = 0; u < 4; ++u) gk[u] = *(const u32x4*)(ksrc + (size_t)u * 2048);
#pragma unroll
      for (int u = 0; u < 2; ++u) {
        const int chunk = sid * 2 + u, tr = chunk >> 3, tc = (chunk & 7) * 8;
        const size_t itm = (size_t)ci * 8 + h;
        gT[u] = *(const u32x4*)((itm < TA_LAT_ITEMS ? Tb_lat : Tb_ctx) + ta_off(itm, d) + tr * 64 + tc);
        gA[u] = *(const u32x4*)((itm < TA_LAT_ITEMS ? Ag_lat : Ag_ctx) + ta_off(itm, d) + tr * 64 + tc);
      }
      const float e1 = E[c];
      const f32x4 bev = *(const f32x4*)(E + 64 + c0), e2v = *(const f32x4*)(E + 128 + c0);
      if (sid == 0) *(float*)(sb + SC_E) = E[192];
#pragma unroll
      for (int u = 0; u < 4; ++u) st8(sb + SC_Q + c * SC_QS + (cc + u * 8) * 2, scale8(gq[u], e1));
      const float be[4] = {bev.x, bev.y, bev.z, bev.w}, e2[4] = {e2v.x, e2v.y, e2v.z, e2v.w};
      u32x4 kt[4];
#pragma unroll
      for (int u = 0; u < 4; ++u) {
        st8(sb + SC_K + (c0 + u) * SC_QS + dk0 * 2, scale8(gk[u], -be[u]));
        kt[u] = scale8(gk[u], e2[u]);
      }
      const unsigned w[4][4] = {{kt[0].x, kt[0].y, kt[0].z, kt[0].w}, {kt[1].x, kt[1].y, kt[1].z, kt[1].w},
                                {kt[2].x, kt[2].y, kt[2].z, kt[2].w}, {kt[3].x, kt[3].y, kt[3].z, kt[3].w}};
#pragma unroll
      for (int jp = 0; jp < 4; ++jp) {
        u32x2 lo = {(w[0][jp] & 0xffffu) | (w[1][jp] << 16), (w[2][jp] & 0xffffu) | (w[3][jp] << 16)};
        u32x2 hi = {(w[0][jp] >> 16) | (w[1][jp] & 0xffff0000u), (w[2][jp] >> 16) | (w[3][jp] & 0xffff0000u)};
        *(u32x2*)(sb + SC_KT + (dk0 + 2 * jp) * 136 + c0 * 2) = lo;
        *(u32x2*)(sb + SC_KT + (dk0 + 2 * jp + 1) * 136 + c0 * 2) = hi;
      }
#pragma unroll
      for (int u = 0; u < 2; ++u) {
        const int chunk = sid * 2 + u, tr = chunk >> 3, tc = (chunk & 7) * 8;
        st8(sb + SC_T + tr * 136 + tc * 2, gT[u]);
        st8(sb + SC_A + tr * 136 + tc * 2, gA[u]);
      }
    } else {
      const size_t it = ((size_t)ci * 4 + h) * 2 + d;
      const u16* qd = QD + it * 16384;
      const int c = sid >> 2, cc = (sid & 3) * 32;
      const int kr = sid >> 1, kc = (sid & 1) * 32;
      u32x4 gq[4], gk[4], gA[2];
#pragma unroll
      for (int u = 0; u < 4; ++u) gq[u] = *(const u32x4*)(qd + c * 128 + cc + u * 8);
#pragma unroll
      for (int u = 0; u < 4; ++u) gk[u] = *(const u32x4*)(qd + 8192 + kr * 64 + kc + u * 8);
      if (d == 0) {
#pragma unroll
        for (int u = 0; u < 2; ++u) {
          const int chunk = sid * 2 + u, tr = chunk >> 3, tc = (chunk & 7) * 8;
          gA[u] = *(const u32x4*)(AS + ((size_t)ci * 4 + h) * 4096 + tr * 64 + tc);
        }
      }
      if (sid < 32) *(f32x4*)(sb + SC_E + sid * 16) = *(const f32x4*)(CD + it * 128 + sid * 4);
#pragma unroll
      for (int u = 0; u < 4; ++u) st8(sb + SC_Q + c * SC_QS + (cc + u * 8) * 2, gq[u]);
#pragma unroll
      for (int u = 0; u < 4; ++u) st8(sb + SC_KT + kr * 136 + (kc + u * 8) * 2, gk[u]);
      if (d == 0) {
#pragma unroll
        for (int u = 0; u < 2; ++u) {
          const int chunk = sid * 2 + u, tr = chunk >> 3, tc = (chunk & 7) * 8;
          st8(sb + SC_A + tr * 136 + tc * 2, gA[u]);
        }
      }
    }
  };

  f32x4 S[8];
#pragma unroll
  for (int t = 0; t < 8; ++t) S[t] = (f32x4){0.f, 0.f, 0.f, 0.f};
  u16 uraw[4][4];
  const int loff = (4 * q4) * 2048 + col0 + n16;
  auto u_issue = [&](int st) {
    const u16* up = Ub + (size_t)chunk_of(st) * (64 * 2048);
    const int lo = opq_v(loff);
#pragma unroll
    for (int mt = 0; mt < 4; ++mt)
#pragma unroll
      for (int i = 0; i < 4; ++i) uraw[mt][i] = up[lo + (16 * mt + i) * 2048];
  };

  if (compute) u_issue(0); else stage_all(0, 0);
  __syncthreads();

  for (int st = 0; st < 132; ++st) {
    const int buf = st & 1;
    const char* sb = shm + buf * SC_BUF;
    if (compute) {
      const int row0 = chunk_of(st) * 64;
      f32x4 Y[4], O[4];
#pragma unroll
      for (int mt = 0; mt < 4; ++mt) {
        Y[mt] = (f32x4){bf2f(uraw[mt][0]), bf2f(uraw[mt][1]), bf2f(uraw[mt][2]), bf2f(uraw[mt][3])};
        O[mt] = (f32x4){0.f, 0.f, 0.f, 0.f};
      }
#define SCHED_FENCE() __builtin_amdgcn_sched_barrier(0)
      s16x8 fT[8];
      if (DELTA) {
#pragma unroll
        for (int mt = 0; mt < 4; ++mt)
#pragma unroll
          for (int kc = 0; kc < 2; ++kc) fT[mt * 2 + kc] = ldA16(sb + SC_T, 16 * mt + n16, 136, 32 * kc, q4);
      }
      s16x8 fa[2][8];
#pragma unroll
      for (int mt = 0; mt < 4; ++mt) {
        if (DELTA) fa[0][mt] = ldA16(sb + SC_K, 16 * mt + n16, SC_QS, 0, q4);
        fa[0][4 + mt] = ldA16(sb + SC_Q, 16 * mt + n16, SC_QS, 0, q4);
      }
      SCHED_FENCE();
#pragma unroll
      for (int t = 0; t < 4; ++t) {
        if (t < 3) {
#pragma unroll
          for (int mt = 0; mt < 4; ++mt) {
            if (DELTA) fa[(t + 1) & 1][mt] = ldA16(sb + SC_K, 16 * mt + n16, SC_QS, 32 * (t + 1), q4);
            fa[(t + 1) & 1][4 + mt] = ldA16(sb + SC_Q, 16 * mt + n16, SC_QS, 32 * (t + 1), q4);
          }
        }
        SCHED_FENCE();
        const s16x8 Sb = pack16(S[2 * t], S[2 * t + 1]);
#pragma unroll
        for (int mt = 0; mt < 4; ++mt) {
          if (DELTA) Y[mt] = MFMA16(fa[t & 1][mt], Sb, Y[mt]);
          O[mt] = MFMA16(fa[t & 1][4 + mt], Sb, O[mt]);
        }
        SCHED_FENCE();
      }
      s16x8 fA[8];
      if (DELTA || d == 0) {
#pragma unroll
        for (int mt = 0; mt < 4; ++mt)
#pragma unroll
          for (int kc = 0; kc < 2; ++kc) fA[mt * 2 + kc] = ldA16(sb + SC_A, 16 * mt + n16, 136, 32 * kc, q4);
      }
      SCHED_FENCE();
      s16x8 vnb[2];
      if (DELTA) {
        s16x8 Yb[2];
        Yb[0] = pack16(Y[0], Y[1]); Yb[1] = pack16(Y[2], Y[3]);
        f32x4 vn[4];
#pragma unroll
        for (int mt = 0; mt < 4; ++mt) {
          vn[mt] = (f32x4){0.f, 0.f, 0.f, 0.f};
#pragma unroll
          for (int kc = 0; kc < 2; ++kc) vn[mt] = MFMA16(fT[mt * 2 + kc], Yb[kc], vn[mt]);
        }
        vnb[0] = pack16(vn[0], vn[1]); vnb[1] = pack16(vn[2], vn[3]);
      } else {
        vnb[0] = pack16(Y[0], Y[1]); vnb[1] = pack16(Y[2], Y[3]);
      }
      SCHED_FENCE();
      s16x8 fK[8];
#pragma unroll
      for (int t = 0; t < 4; ++t)
#pragma unroll
        for (int kc = 0; kc < 2; ++kc) fK[t * 2 + kc] = ldA16(sb + SC_KT, 16 * t + n16, 136, 32 * kc, q4);
      if (st + 1 < 132) u_issue(st + 1);
      SCHED_FENCE();
      if (DELTA || d == 0) {
#pragma unroll
        for (int mt = 0; mt < 4; ++mt)
#pragma unroll
          for (int kc = 0; kc < 2; ++kc) O[mt] = MFMA16(fA[mt * 2 + kc], vnb[kc], O[mt]);
      }
      if (DELTA) {
        const float cd = *(const float*)(sb + SC_E);
#pragma unroll
        for (int t = 0; t < 8; ++t) S[t] *= cd;
      } else {
#pragma unroll
        for (int t = 0; t < 8; ++t) {
          const f32x4 cv = *(const f32x4*)(sb + SC_E + (16 * t + 4 * q4) * 4);
          S[t] *= cv;
        }
      }
      SCHED_FENCE();
      s16x8 fK2[8];
#pragma unroll
      for (int t = 0; t < 4; ++t)
#pragma unroll
        for (int kc = 0; kc < 2; ++kc) fK2[t * 2 + kc] = ldA16(sb + SC_KT, 16 * (4 + t) + n16, 136, 32 * kc, q4);
      SCHED_FENCE();
#pragma unroll
      for (int t = 0; t < 4; ++t)
#pragma unroll
        for (int kc = 0; kc < 2; ++kc) S[t] = MFMA16(fK[t * 2 + kc], vnb[kc], S[t]);
      SCHED_FENCE();
#pragma unroll
      for (int t = 0; t < 4; ++t)
#pragma unroll
        for (int kc = 0; kc < 2; ++kc) S[4 + t] = MFMA16(fK2[t * 2 + kc], vnb[kc], S[4 + t]);
#undef SCHED_FENCE
      if (!DRY || p.out == nullptr)
#pragma unroll
      for (int mt = 0; mt < 4; ++mt) {
        const float ov[4] = {O[mt].x, O[mt].y, O[mt].z, O[mt].w};
        u16* op = Ub + (size_t)row0 * 2048;
        const int lo = opq_v(loff);
#pragma unroll
        for (int i = 0; i < 4; ++i) op[lo + (16 * mt + i) * 2048] = f2bf(ov[i]);
      }
    }
    else if (st + 1 < 132) stage_all(st + 1, buf ^ 1);
    asm volatile("s_waitcnt lgkmcnt(0)" ::: "memory");
    __builtin_amdgcn_s_barrier();
    asm volatile("" ::: "memory");
  }
}

DI void gla_prep_phase(char* shm, const Params& p, const int wave_s_) {
  const int tid = TIDX(), wave = tid >> 6, lane = tid & 63, r = lane & 31, hh = lane >> 5;
  char* sq = shm;
  char* sk = shm + 16896;
  char* sQa = shm + 33792;
  char* sKb = shm + 50688;
  float* sBC = (float*)(shm + 67584);
  float* sgl = (float*)(shm + 133120);
  const u16* qk1 = (const u16*)(p.ws + OFF_QK1);
  const float* gl = (const float*)(p.ws + OFF_ABT);
  u16* QD = (u16*)(p.ws + OFF_QD);
  u16* AS = (u16*)(p.ws + OFF_ASUM);
  float* CD = (float*)(p.ws + OFF_CD1);
  const float qscale = 0.08838834764831845f;
  for (int item = blockIdx.x; item < NCHUNK * 4; item += gridDim.x) {
    const int ci = item >> 2, h = item & 3, row0 = ci * 64;
#pragma unroll
    for (int u = 0; u < 2; ++u) {
      const int chunk = tid * 2 + u, c = chunk >> 4, cc = (chunk & 15) * 8;
      const u16* src = qk1 + (size_t)(row0 + c) * 1024 + h * 128 + cc;
      u32x4 vq = *(const u32x4*)src, vk = *(const u32x4*)(src + 512);
      st8(sq + c * 264 + cc * 2, vq);
      st8(sk + c * 264 + cc * 2, vk);
    }
    {
      const int rr = tid >> 3, cc = (tid & 7) * 4;
      *(f32x4*)(sgl + rr * 32 + cc) = *(const f32x4*)(gl + (size_t)(row0 + rr) * 32 + cc);
    }
    __syncthreads();
    {
      const int kk = tid & 127, d = (tid >> 7) & 1, chalf = tid >> 8;
      float w[16];
#pragma unroll
      for (int q = 0; q < 16; ++q) w[q] = p.gla_w_g2[(d * 16 + q) * 512 + h * 128 + kk];
      const float bg = p.gla_b_g[d * 512 + h * 128 + kk];
#pragma unroll 4
      for (int cc = 0; cc < 32; ++cc) {
        const int c = chalf * 32 + cc;
        const f32x4* gp = (const f32x4*)(sgl + c * 32 + d * 16);
        const f32x4 g0 = gp[0], g1 = gp[1], g2 = gp[2], g3 = gp[3];
        float z = bg;
        z += g0.x * w[0] + g0.y * w[1] + g0.z * w[2] + g0.w * w[3];
        z += g1.x * w[4] + g1.y * w[5] + g1.z * w[6] + g1.w * w[7];
        z += g2.x * w[8] + g2.y * w[9] + g2.z * w[10] + g2.w * w[11];
        z += g3.x * w[12] + g3.y * w[13] + g3.z * w[14] + g3.w * w[15];
        sBC[(d * 64 + c) * 128 + kk] = (fminf(z, 0.f) - __logf(1.f + __expf(-fabsf(z)))) * (1.f / 16.f);
      }
    }
    __syncthreads();
    if (tid < 256) {
      const int d = tid >> 7, kk = tid & 127;
      float* col = sBC + d * 64 * 128 + kk;
      float v[64];
#pragma unroll
      for (int c = 0; c < 64; ++c) v[c] = col[c * 128];
      if (d == 0) {
        float acc = 0.f;
#pragma unroll
        for (int c = 0; c < 64; ++c) { acc += v[c]; col[c * 128] = acc; }
      } else {
        float acc = 0.f;
#pragma unroll
        for (int c = 63; c >= 0; --c) { acc += v[c]; col[c * 128] = acc; }
      }
    }
    __syncthreads();
    f32x16 asum;
    for (int i = 0; i < 16; ++i) asum[i] = 0.f;
    for (int d = 0; d < 2; ++d) {
      const int cref = d ? 31 : 32, clast = d ? 0 : 63;
      const float* bcd = sBC + d * 64 * 128;
      u16* qd_o = QD + ((size_t)item * 2 + d) * 16384;
      float er[8], ern[8];
      {
        const int k0 = (tid & 15) * 8;
#pragma unroll
        for (int e = 0; e < 8; ++e) { const float rf = bcd[cref * 128 + k0 + e]; er[e] = __expf(rf); ern[e] = __expf(-rf); }
      }
      for (int v = tid; v < 1024; v += 512) {
        const int c = v >> 4, k0 = (v & 15) * 8;
        const u32x4 qv = *(const u32x4*)(sq + c * 264 + k0 * 2), kv = *(const u32x4*)(sk + c * 264 + k0 * 2);
        const unsigned qa[4] = {qv.x, qv.y, qv.z, qv.w}, ka[4] = {kv.x, kv.y, kv.z, kv.w};
        float oqa[8], okb[8], oqd[8];
#pragma unroll
        for (int e = 0; e < 8; ++e) {
          const float ebc = __expf(bcd[c * 128 + k0 + e]);
          const float qf = ((e & 1) ? bfhi(qa[e >> 1]) : bflo(qa[e >> 1])) * qscale;
          const float kf = (e & 1) ? bfhi(ka[e >> 1]) : bflo(ka[e >> 1]);
          oqd[e] = qf * ebc;
          oqa[e] = oqd[e] * ern[e];
          okb[e] = kf * er[e] * __builtin_amdgcn_rcpf(ebc);
        }
        st8(sQa + c * 264 + k0 * 2, (u32x4){pk2(oqa[0], oqa[1]), pk2(oqa[2], oqa[3]), pk2(oqa[4], oqa[5]), pk2(oqa[6], oqa[7])});
        st8(sKb + c * 264 + k0 * 2, (u32x4){pk2(okb[0], okb[1]), pk2(okb[2], okb[3]), pk2(okb[4], okb[5]), pk2(okb[6], okb[7])});
        *(u32x4*)(qd_o + c * 128 + k0) = (u32x4){pk2(oqd[0], oqd[1]), pk2(oqd[2], oqd[3]), pk2(oqd[4], oqd[5]), pk2(oqd[6], oqd[7])};
      }
      for (int v = tid; v < 1024; v += 512) {
        const int kk = v >> 3, c0 = (v & 7) * 8;
        const float last = bcd[clast * 128 + kk];
        float o[8];
#pragma unroll
        for (int e = 0; e < 8; ++e) {
          const int c = c0 + e;
          const float kf = bf2f(*(const u16*)(sk + c * 264 + kk * 2));
          o[e] = kf * __expf(last - bcd[c * 128 + kk]);
        }
        *(u32x4*)(qd_o + 8192 + kk * 64 + c0) = (u32x4){pk2(o[0], o[1]), pk2(o[2], o[3]), pk2(o[4], o[5]), pk2(o[6], o[7])};
      }
      if (tid < 128) CD[((size_t)item * 2 + d) * 128 + tid] = __expf(bcd[clast * 128 + tid]);
      __syncthreads();
      if (wave < 4) {
        const int tm = wave >> 1, tn = wave & 1;
        f32x16 acc;
        for (int i = 0; i < 16; ++i) acc[i] = 0.f;
#pragma unroll
        for (int s = 0; s < 8; ++s) {
          s16x8 a = ldA_nat(sQa, 32 * tm + r, 264, 16 * s, hh), bb = ldA_nat(sKb, 32 * tn + r, 264, 16 * s, hh);
          acc = MFMA32(a, bb, acc);
        }
#pragma unroll
        for (int i = 0; i < 16; ++i) {
          const int ii = 32 * tm + crow(i, hh), jj = 32 * tn + r;
          const bool keep = d ? (ii <= jj) : (ii >= jj);
          asum[i] += keep ? acc[i] : 0.f;
        }
      }
      __syncthreads();
    }
    if (wave < 4) {
      const int tm = wave >> 1, tn = wave & 1;
#pragma unroll
      for (int i = 0; i < 16; ++i) AS[(size_t)item * 4096 + (32 * tm + crow(i, hh)) * 64 + 32 * tn + r] = f2bf(asum[i]);
    }
  }
}

template <int GROUP>
DI void yg_phase(u16* o0, const u16* o1, const u16* z, const u16* zctx, const float* ng, int nrows, const int wave_s_) {
  const int gt = blockIdx.x * 512 + TIDX(), nthr = gridDim.x * 512;
  const int total = nrows * 256;
  for (int idx0 = gt; idx0 < total; idx0 += 2 * nthr) {
    const bool ok1 = idx0 + nthr < total;
    u32x4 a[2], bq[2], zz[2];
#pragma unroll
    for (int u = 0; u < 2; ++u) {
      const int idx = (u == 0 || ok1) ? idx0 + u * nthr : idx0;
      const size_t off = (size_t)(idx >> 8) * 2048 + (idx & 255) * 8;
      const int zrow = idx >> 8;
      const u16* zp = (zrow < RL) ? z + off : zctx + (size_t)(zrow - RL) * 2048 + (idx & 255) * 8;
      a[u] = __builtin_nontemporal_load((const u32x4*)(o0 + off)); bq[u] = __builtin_nontemporal_load((const u32x4*)(o1 + off)); zz[u] = __builtin_nontemporal_load((const u32x4*)zp);
    }
#pragma unroll
    for (int u = 0; u < 2; ++u) {
      if (u == 1 && !ok1) break;
      const int idx = idx0 + u * nthr, ch = (idx & 255) * 8;
      const size_t off = (size_t)(idx >> 8) * 2048 + ch;
      float o[8] = {bflo(a[u].x) + bflo(bq[u].x), bfhi(a[u].x) + bfhi(bq[u].x), bflo(a[u].y) + bflo(bq[u].y), bfhi(a[u].y) + bfhi(bq[u].y),
                    bflo(a[u].z) + bflo(bq[u].z), bfhi(a[u].z) + bfhi(bq[u].z), bflo(a[u].w) + bflo(bq[u].w), bfhi(a[u].w) + bfhi(bq[u].w)};
      const float zf[8] = {bflo(zz[u].x), bfhi(zz[u].x), bflo(zz[u].y), bfhi(zz[u].y), bflo(zz[u].z), bfhi(zz[u].z), bflo(zz[u].w), bfhi(zz[u].w)};
      float ss = 0.f;
#pragma unroll
      for (int e = 0; e < 8; ++e) ss += o[e] * o[e];
#pragma unroll
      for (int of = 1; of < GROUP; of <<= 1) ss += __shfl_xor(ss, of, 64);
      const float rstd = rsqrtf(ss * (1.f / (GROUP * 8)) + EPSF);
      const int gi = ch & (GROUP * 8 - 1);
      const f32x4 g0 = *(const f32x4*)(ng + gi), g1 = *(const f32x4*)(ng + gi + 4);
      const float gg[8] = {g0.x, g0.y, g0.z, g0.w, g1.x, g1.y, g1.z, g1.w};
#pragma unroll
      for (int e = 0; e < 8; ++e) o[e] = o[e] * rstd * gg[e] * siluf(zf[e]);
      *(u32x4*)(o0 + off) = (u32x4){pk2(o[0], o[1]), pk2(o[2], o[3]), pk2(o[4], o[5]), pk2(o[6], o[7])};
    }
  }
}

DI void final_phase(float* out, const float* g, const int wave_s_) {
  const int tidx_ = TIDX();
  const int lane = tidx_ & 63, gw = blockIdx.x * 8 + (tidx_ >> 6), nw = gridDim.x * 8;
  for (int row0 = gw; row0 < RL; row0 += 2 * nw) {
    const int rows[2] = {row0, row0 + nw};
    const bool ok1 = rows[1] < RL;
    f32x4 v[2][4];
#pragma unroll
    for (int u = 0; u < 2; ++u) {
      const float* s = out + (size_t)((u == 0 || ok1) ? rows[u] : rows[0]) * DM;
#pragma unroll
      for (int q = 0; q < 4; ++q) v[u][q] = __builtin_nontemporal_load((const f32x4*)(s + q * 256 + lane * 4));
    }
#pragma unroll
    for (int u = 0; u < 2; ++u) {
      if (u == 1 && !ok1) break;
      float* s = out + (size_t)rows[u] * DM;
      float ss = 0.f;
#pragma unroll
      for (int q = 0; q < 4; ++q) ss += v[u][q].x * v[u][q].x + v[u][q].y * v[u][q].y + v[u][q].z * v[u][q].z + v[u][q].w * v[u][q].w;
      ss = wave_sum(ss);
      const float rstd = rsqrtf(ss * (1.f / 1024.f) + EPSF);
#pragma unroll
      for (int q = 0; q < 4; ++q) {
        const f32x4 gg = *(const f32x4*)(g + q * 256 + lane * 4);
        f32x4 o = {v[u][q].x * rstd * gg.x, v[u][q].y * rstd * gg.y, v[u][q].z * rstd * gg.z, v[u][q].w * rstd * gg.w};
        __builtin_nontemporal_store(o, (f32x4*)(s + q * 256 + lane * 4));
      }
    }
  }
}

#define XB_XSUB(j)  (64 * (j))
#define XB_XGEN(j)  (1024 + 64 * (j))
#define XB_TOP      2048
#define XB_TOPGEN   2112
#define XCD_BAR_WORDS 2176
DI unsigned xb_ld(unsigned* p) { return __hip_atomic_load(p, __ATOMIC_RELAXED, __HIP_MEMORY_SCOPE_AGENT); }
DI unsigned xb_add(unsigned* p, unsigned v) { return __hip_atomic_fetch_add(p, v, __ATOMIC_RELAXED, __HIP_MEMORY_SCOPE_AGENT); }
DI void gbar(char* ws, const int wave_s_) {
  asm volatile("s_waitcnt vmcnt(0)" ::: "memory");
  __syncthreads();
  if (wave_s_ == 0 && lane_id() == 0) {
    unsigned* bar = (unsigned*)(ws + OFF_BAR);
    __builtin_amdgcn_s_waitcnt(0);
    const unsigned x = (unsigned)__builtin_amdgcn_s_getreg((3 << 11) | 20) & 0xFu;
    const unsigned nloc = gridDim.x >> 3, nx = 8u;
    const unsigned old = xb_add(&bar[XB_XSUB(x)], 1u);
    const unsigned gen = old / nloc;
    if (old + 1u == (gen + 1u) * nloc) {
      __builtin_amdgcn_fence(__ATOMIC_RELEASE, "agent");
      asm volatile("s_waitcnt vmcnt(0)" ::: "memory");
      const unsigned og = xb_add(&bar[XB_TOP], 1u);
      const unsigned tg = og / nx;
      if (og + 1u == (tg + 1u) * nx) xb_add(&bar[XB_TOPGEN], 1u);
      else while (xb_ld(&bar[XB_TOPGEN]) == tg) __builtin_amdgcn_s_sleep(1);
      __builtin_amdgcn_fence(__ATOMIC_ACQUIRE, "agent");
      xb_add(&bar[XB_XGEN(x)], 1u);
      asm volatile("s_waitcnt vmcnt(0)" ::: "memory");
    } else {
      while (xb_ld(&bar[XB_XGEN(x)]) == gen) __builtin_amdgcn_s_sleep(1);
      __builtin_amdgcn_fence(__ATOMIC_ACQUIRE, "agent");
      asm volatile("s_waitcnt vmcnt(0)" ::: "memory");
    }
  }
  __syncthreads();
}
#ifndef REP_GEMM
#define REP_GEMM 1
#endif
#ifndef REP_PREP
#define REP_PREP 1
#endif
#ifndef REP_GLP
#define REP_GLP 1
#endif
#ifndef REP_SCAN
#define REP_SCAN 0
#endif
#ifndef REP_SYNC
#define REP_SYNC 0
#endif
#ifndef REP_EW
#define REP_EW 1
#endif
__global__ void __launch_bounds__(512, 2) fwd_megakernel(Params p) {
  __shared__ __attribute__((aligned(1024))) char shm[141312];
  cg::grid_group grid = cg::this_grid();
  const int wave_s_ = __builtin_amdgcn_readfirstlane((int)(threadIdx.x >> 6));
  char* ws = p.ws;
  float* mods = (float*)(ws + OFF_MOD);
  u16* W0T = (u16*)(ws + OFF_W0T);
  u16* WO0T = (u16*)(ws + OFF_WO0T);
  u16* W1T = (u16*)(ws + OFF_W1T);
  u16* WO1T = (u16*)(ws + OFF_WO1T);
  u16* outb = (u16*)p.out;
  float* ctx1 = (float*)(ws + OFF_X);

  mods_phase(shm, p, wave_s_);
  wtrans_phase<0>(shm, p, wave_s_);
  if (gridDim.x == 256) gbar(ws, wave_s_); else grid.sync();
  {
    u16* H0 = (u16*)(ws + OFF_T);
    h_phase(p.x, p.ctx, p.norm_g, mods, H0, R, wave_s_);
    gbar(ws, wave_s_);
#if REP_EW > 1
    h_phase(p.x, p.ctx, p.norm_g, mods, H0, R, wave_s_);
    gbar(ws, wave_s_);
#endif
    small_gemm(H0, W0T + (size_t)6144 * 1024, (float*)(ws + OFF_ABT), wave_s_);
    EpiArgs e{};
    e.mode = 0; e.lat = outb; e.ctx = (u16*)(ws + OFF_X); e.ld = 2048;
    gemm_phase<0>(shm, H0, H0 + (size_t)RL * 1024, 1024, W0T, 0, 128, 8, e, wave_s_);
    {
      EpiArgs ec{};
      ec.mode = 4; ec.ctx = (u16*)(ws + OFF_X);
      gemm_phase<4>(shm, H0, H0 + (size_t)RL * 1024, 1024, W0T, 128, 4, 24, ec, wave_s_);
    }
    gbar(ws, wave_s_);
#if REP_GEMM > 1
    gemm_phase<0>(shm, H0, H0 + (size_t)RL * 1024, 1024, W0T, 0, 132, 8, e, wave_s_);
    gbar(ws, wave_s_);
#endif
    conv_phase<false>(p, wave_s_);
    gbar(ws, wave_s_);
#if REP_EW > 1
    conv_phase<false>(p, wave_s_);
    gbar(ws, wave_s_);
#endif
    gemm_phase<0>(shm, H0, H0 + (size_t)RL * 1024, 1024, W0T + (size_t)2048 * 1024, 0, 128, 8, e, wave_s_);
    gbar(ws, wave_s_);
#if REP_GEMM > 1
    gemm_phase<0>(shm, H0, H0 + (size_t)RL * 1024, 1024, W0T + (size_t)2048 * 1024, 0, 132, 8, e, wave_s_);
    gbar(ws, wave_s_);
#endif
    conv_phase<true>(p, wave_s_);
    gbar(ws, wave_s_);
#if REP_EW > 1
    conv_phase<true>(p, wave_s_);
    gbar(ws, wave_s_);
#endif
    for (int rep_ = 0; rep_ < REP_PREP; ++rep_) {
    dn_prep_phase(shm, p, wave_s_);
    gbar(ws, wave_s_);
    }
    for (int rep_ = 0; rep_ < REP_SCAN; ++rep_) { scan_phase<true, true>(shm, p, wave_s_); gbar(ws, wave_s_); }
    for (int rep_ = 0; rep_ < REP_SYNC; ++rep_) gbar(ws, wave_s_);
    scan_phase<true>(shm, p, wave_s_);
    gbar(ws, wave_s_);
    u16* H0b = H0;
    u16* Z = (u16*)(ws + OFF_QK0);
    EpiArgs ez{};
    ez.mode = 0; ez.lat = Z; ez.ctx = Z + (size_t)RL * 2048; ez.ld = 2048;
    gemm_phase<0>(shm, H0b, H0b + (size_t)RL * 1024, 1024, W0T + (size_t)4096 * 1024, 0, 128, 8, ez, wave_s_);
    gbar(ws, wave_s_);
#if REP_GEMM > 1
    gemm_phase<0>(shm, H0b, H0b + (size_t)RL * 1024, 1024, W0T + (size_t)4096 * 1024, 0, 132, 8, ez, wave_s_);
    gbar(ws, wave_s_);
#endif
    u16* U0 = (u16*)(ws + OFF_U0);
    yg_phase<32>(U0, (const u16*)(ws + OFF_U1), Z, (const u16*)(ws + OFF_ZC), p.dn_norm_g, R, wave_s_);
    gbar(ws, wave_s_);
    EpiArgs eo{};
    eo.mode = 2; eo.res_lat = p.x; eo.res_ctx = p.ctx; eo.mods_i = mods; eo.out_lat = p.out; eo.out_ctx = ctx1;
    wtrans_phase<1>(shm, p, wave_s_, true);
    gemm_phase<2>(shm, U0, U0 + (size_t)RL * 2048, 2048, WO0T, 0, 132, 4, eo, wave_s_);
    gbar(ws, wave_s_);
#if REP_GEMM > 1
    gemm_phase<2>(shm, U0, U0 + (size_t)RL * 2048, 2048, WO0T, 0, 132, 4, eo, wave_s_);
    gbar(ws, wave_s_);
#endif
  }
  {
    const float* mods1 = mods + 5 * 3072;
    u16* H1 = (u16*)(ws + OFF_QD);
    h_phase(p.out, ctx1, p.norm_g + 1024, mods1, H1, R, wave_s_);
    gbar(ws, wave_s_);
    small_gemm(H1, W1T + (size_t)5120 * 1024, (float*)(ws + OFF_ABT), wave_s_);
    EpiArgs e{};
    e.mode = 1; e.lat = (u16*)(ws + OFF_QK1); e.b1 = (u16*)(ws + OFF_V0); e.b2 = (u16*)(ws + OFF_V1);
    gemm_phase<1>(shm, H1, H1 + (size_t)RL * 1024, 1024, W1T, 0, 132, 12, e, wave_s_);
    gbar(ws, wave_s_);
    for (int rep_ = 0; rep_ < REP_GLP; ++rep_) {
    gla_prep_phase(shm, p, wave_s_);
    gbar(ws, wave_s_);
    }
    for (int rep_ = 0; rep_ < REP_SCAN; ++rep_) { scan_phase<false, true>(shm, p, wave_s_); gbar(ws, wave_s_); }
    scan_phase<false>(shm, p, wave_s_);
    u16* H1b = (u16*)(ws + OFF_QK1);
    h_phase(p.out, ctx1, p.norm_g + 1024, mods1, H1b, RL, wave_s_);
    gbar(ws, wave_s_);
    u16* RB = (u16*)(ws + OFF_QD);
    EpiArgs er{};
    er.mode = 0; er.lat = RB; er.ctx = RB; er.ld = 2048;
    gemm_phase<0>(shm, H1b, H1b, 1024, W1T + (size_t)3072 * 1024, 0, 128, 8, er, wave_s_);
    gbar(ws, wave_s_);
    u16* V0 = (u16*)(ws + OFF_V0);
    yg_phase<64>(V0, (const u16*)(ws + OFF_V1), RB, RB, p.gla_norm_g, RL, wave_s_);
    gbar(ws, wave_s_);
    EpiArgs eo{};
    eo.mode = 2; eo.res_lat = p.out; eo.res_ctx = p.out; eo.mods_i = mods1; eo.out_lat = p.out; eo.out_ctx = p.out;
    gemm_phase<2>(shm, V0, V0, 2048, WO1T, 0, 128, 4, eo, wave_s_);
    gbar(ws, wave_s_);
    final_phase(p.out, p.final_g, wave_s_);
  }
}

extern "C" void kernel_launch(void* const* d_in, const int* in_sizes, int n_in, void* d_out, int out_size, void* d_ws,
                              size_t ws_size, hipStream_t stream) {
  static int grid_blocks = 0;
  if (!grid_blocks) {
    int dev = 0, cus = 0, per_cu = 0;
    hipGetDevice(&dev);
    hipDeviceGetAttribute(&cus, hipDeviceAttributeMultiprocessorCount, dev);
    hipOccupancyMaxActiveBlocksPerMultiprocessor(&per_cu, fwd_megakernel, 512, 0);
    if (per_cu < 1) per_cu = 1;
    grid_blocks = cus;
    if (grid_blocks > 256) grid_blocks = 256;
  }
  Params p{};
  p.x = (const float*)d_in[0]; p.c = (const float*)d_in[1]; p.ctx = (const float*)d_in[2]; p.c_ctx = (const float*)d_in[3];
  p.mod_w = (const float*)d_in[4]; p.mod_b = (const float*)d_in[5]; p.norm_g = (const float*)d_in[6];
  p.dn_w_in = (const float*)d_in[7]; p.dn_conv_w = (const float*)d_in[8]; p.dn_a_log = (const float*)d_in[9];
  p.dn_dt_bias = (const float*)d_in[10]; p.dn_norm_g = (const float*)d_in[11]; p.dn_w_out = (const float*)d_in[12];
  p.gla_w_in = (const float*)d_in[13]; p.gla_w_g2 = (const float*)d_in[14]; p.gla_b_g = (const float*)d_in[15];
  p.gla_norm_g = (const float*)d_in[16]; p.gla_w_out = (const float*)d_in[17]; p.final_g = (const float*)d_in[18];
  p.out = (float*)d_out;
  p.ws = (char*)d_ws;
  (void)hipMemsetAsync((char*)d_ws + OFF_BAR, 0, XCD_BAR_WORDS * sizeof(unsigned), stream);
  void* args[] = {&p};
  hipError_t e = hipLaunchCooperativeKernel((void*)fwd_megakernel, dim3(grid_blocks), dim3(512), args, 0, stream);
  if (e != hipSuccess) fprintf(stderr, "cooperative launch failed: %s (grid %d)\n", hipGetErrorString(e), grid_blocks);
}
```

```cpp
#include <hip/hip_runtime.h>
#include <hip/hip_cooperative_groups.h>
#include <cstdio>
namespace cg = cooperative_groups;

#define DI __device__ __forceinline__
typedef unsigned short u16;
typedef short s16x8 __attribute__((ext_vector_type(8)));
typedef short s16x4 __attribute__((ext_vector_type(4)));
typedef float f32x2 __attribute__((ext_vector_type(2)));
typedef float f32x4 __attribute__((ext_vector_type(4)));
typedef float f32x16 __attribute__((ext_vector_type(16)));
typedef int i32x4 __attribute__((ext_vector_type(4)));
typedef unsigned u32x2 __attribute__((ext_vector_type(2)));
typedef unsigned u32x4 __attribute__((ext_vector_type(4)));
typedef __bf16 bf2_t __attribute__((ext_vector_type(2)));

constexpr int RL = 32768;
constexpr int RC = 1024;
constexpr int R = RL + RC;
constexpr int DM = 1024;
constexpr int NCHUNK = R / 64;
constexpr float EPSF = 1e-6f;
constexpr size_t MiB = 1u << 20;

constexpr size_t OFF_QK0 = 0;
constexpr size_t OFF_U0 = 132 * MiB;
constexpr size_t OFF_U1 = 264 * MiB;
constexpr size_t OFF_T = 396 * MiB;
constexpr size_t OFF_W1T = 462 * MiB;
constexpr size_t OFF_WO1T = OFF_W1T + 10 * MiB + 256 * 1024;
constexpr size_t OFF_MOD = OFF_WO1T + 4 * MiB;
constexpr size_t OFF_X = OFF_MOD + 256 * 1024;
constexpr size_t OFF_ABT = OFF_X + 8 * MiB + 256 * 1024;
constexpr size_t OFF_W0T = OFF_ABT + 4 * MiB + 256 * 1024;
constexpr size_t OFF_WO0T = OFF_W0T + 12 * MiB + 256 * 1024;
constexpr size_t OFF_V0 = 0;
constexpr size_t OFF_V1 = 132 * MiB;
constexpr size_t OFF_QK1 = 264 * MiB;
constexpr size_t OFF_QD = 330 * MiB;
constexpr size_t OFF_CD1 = OFF_X + 4 * MiB;
constexpr size_t OFF_ASUM = OFF_W0T;
constexpr size_t OFF_BAR = 506 * MiB;
constexpr size_t OFF_ZC = 507 * MiB;

constexpr size_t TA_LAT_ITEMS = 4096;
constexpr size_t OFF_TC = 462 * MiB;
constexpr size_t OFF_AC = 464 * MiB;
DI size_t ta_off(size_t item, int d) { return ((item < TA_LAT_ITEMS ? item : item - TA_LAT_ITEMS) * 2 + d) * 4096; }
struct Params {
  const float *x, *c, *ctx, *c_ctx, *mod_w, *mod_b, *norm_g, *dn_w_in, *dn_conv_w, *dn_a_log, *dn_dt_bias, *dn_norm_g,
      *dn_w_out, *gla_w_in, *gla_w_g2, *gla_b_g, *gla_norm_g, *gla_w_out, *final_g;
  float* out;
  char* ws;
};

DI unsigned pk2(float lo, float hi) { f32x2 v = {lo, hi}; return __builtin_bit_cast(unsigned, __builtin_convertvector(v, bf2_t)); }
DI float bflo(unsigned u) { return __uint_as_float(u << 16); }
DI float bfhi(unsigned u) { return __uint_as_float(u & 0xffff0000u); }
DI float bf2f(u16 v) { return __uint_as_float(((unsigned)v) << 16); }
DI u16 f2bf(float x) { return (u16)(pk2(x, 0.f) & 0xffffu); }
DI float siluf(float x) { return x / (1.f + __expf(-x)); }
DI float sigmoidf(float x) { return 1.f / (1.f + __expf(-x)); }
DI float softplusf(float x) { return fmaxf(x, 0.f) + __logf(1.f + __expf(-fabsf(x))); }
DI int crow(int reg, int h) { return (reg & 3) + 8 * (reg >> 2) + 4 * h; }
#define MFMA32(a, b, c) __builtin_amdgcn_mfma_f32_32x32x16_bf16((a), (b), (c), 0, 0, 0)
#define MFMA16(a, b, c) __builtin_amdgcn_mfma_f32_16x16x32_bf16((a), (b), (c), 0, 0, 0)

DI s16x8 cat8(u32x2 lo, u32x2 hi) { u32x4 v = {lo.x, lo.y, hi.x, hi.y}; return __builtin_bit_cast(s16x8, v); }
DI s16x8 ldA_perm(const char* base, int row, int strideB, int kofs, int h) {
  const char* p = base + row * strideB + (kofs + 4 * h) * 2;
  u32x2 lo = *(const u32x2*)p, hi = *(const u32x2*)(p + 16);
  return cat8(lo, hi);
}
DI s16x8 ldA_nat(const char* base, int row, int strideB, int kofs, int h) {
  const char* p = base + row * strideB + (kofs + 8 * h) * 2;
  u32x2 lo = *(const u32x2*)p, hi = *(const u32x2*)(p + 8);
  return cat8(lo, hi);
}
DI s16x8 pack_step(const f32x16& x, int s) {
  u32x4 p;
  p.x = pk2(x[8 * s + 0], x[8 * s + 1]); p.y = pk2(x[8 * s + 2], x[8 * s + 3]);
  p.z = pk2(x[8 * s + 4], x[8 * s + 5]); p.w = pk2(x[8 * s + 6], x[8 * s + 7]);
  return __builtin_bit_cast(s16x8, p);
}
DI void st8(char* p, u32x4 v) { *(u32x2*)p = (u32x2){v.x, v.y}; *(u32x2*)(p + 8) = (u32x2){v.z, v.w}; }
DI u32x4 scale8(u32x4 v, float s) {
  u32x4 o;
  o.x = pk2(bflo(v.x) * s, bfhi(v.x) * s); o.y = pk2(bflo(v.y) * s, bfhi(v.y) * s);
  o.z = pk2(bflo(v.z) * s, bfhi(v.z) * s); o.w = pk2(bflo(v.w) * s, bfhi(v.w) * s);
  return o;
}
DI int opq_v(int v) { asm volatile("" : "+v"(v)); return v; }
DI int lane_id() { int r; asm volatile("v_mbcnt_lo_u32_b32 %0, -1, 0\n\tv_mbcnt_hi_u32_b32 %0, -1, %0" : "=v"(r)); return r; }
#define TIDX() (wave_s_ * 64 + lane_id())
DI float wave_sum(float v) {
#pragma unroll
  for (int o = 32; o >= 1; o >>= 1) v += __shfl_xor(v, o, 64);
  return v;
}

DI void mods_phase(char* shm, const Params& p, const int wave_s_) {
  const int bid = blockIdx.x, tid = TIDX();
  float* mods = (float*)(p.ws + OFF_MOD);
  if (bid < 192) {
    float* scond = (float*)shm;
    float* red = scond + 5 * 1024;
    for (int e = tid; e < 5 * 1024; e += 512) {
      int r = e >> 10, k = e & 1023;
      float v = (r < 4) ? p.c[r * 1024 + k] : p.c_ctx[k];
      scond[e] = siluf(v);
    }
    __syncthreads();
    const int i = bid / 96, jt = bid % 96, jl = tid & 31, ks = tid >> 5;
    const float* w = p.mod_w + (size_t)i * 1024 * 3072 + jt * 32 + jl;
    float a0 = 0, a1 = 0, a2 = 0, a3 = 0, a4 = 0;
#pragma unroll 8
    for (int kk = 0; kk < 64; ++kk) {
      int k = ks * 64 + kk;
      float wv = __builtin_nontemporal_load(w + (size_t)k * 3072);
      a0 += scond[k] * wv; a1 += scond[1024 + k] * wv; a2 += scond[2048 + k] * wv; a3 += scond[3072 + k] * wv; a4 += scond[4096 + k] * wv;
    }
    red[(ks * 5 + 0) * 32 + jl] = a0; red[(ks * 5 + 1) * 32 + jl] = a1; red[(ks * 5 + 2) * 32 + jl] = a2;
    red[(ks * 5 + 3) * 32 + jl] = a3; red[(ks * 5 + 4) * 32 + jl] = a4;
    __syncthreads();
    if (tid < 160) {
      int r = tid >> 5, j = tid & 31;
      float s = p.mod_b[i * 3072 + jt * 32 + j];
      for (int q = 0; q < 16; ++q) s += red[(q * 5 + r) * 32 + j];
      mods[(i * 5 + r) * 3072 + jt * 32 + j] = s;
    }
    __syncthreads();
  }
}

DI void wtrans_tile(char* shm, const float* src, int K, int N, u16* dst, int tile, const int wave_s_) {
  u16* t = (u16*)shm;
  const int tid = TIDX();
  const int tn = (N + 63) / 64;
  const int k0 = (tile / tn) * 64, n0 = (tile % tn) * 64;
#pragma unroll
  for (int q = 0; q < 2; ++q) {
    const int e = tid + q * 512, kk = e >> 4, nn = (e & 15) * 4;
    f32x4 v = {0.f, 0.f, 0.f, 0.f};
    if (n0 + nn < N) v = __builtin_nontemporal_load((const f32x4*)(src + (size_t)(k0 + kk) * N + n0 + nn));
    t[(nn + 0) * 72 + kk] = f2bf(v.x); t[(nn + 1) * 72 + kk] = f2bf(v.y);
    t[(nn + 2) * 72 + kk] = f2bf(v.z); t[(nn + 3) * 72 + kk] = f2bf(v.w);
  }
  __syncthreads();
  {
    const int nn = tid >> 3, kk = (tid & 7) * 8;
    if (n0 + nn < N) *(u32x4*)(dst + (size_t)(n0 + nn) * K + k0 + kk) = *(const u32x4*)(t + nn * 72 + kk);
  }
  __syncthreads();
}
template <int LAYER>
DI void wtrans_phase(char* shm, const Params& p, const int wave_s_, const bool skip_xcd0 = false) {
  const int t0 = 16 * 97, t1 = 32 * 16, t2 = 16 * 81, t3 = 32 * 16;
  int b = blockIdx.x, nb = gridDim.x;
  if (skip_xcd0) { if ((b & 7) == 0) return; b = b - 1 - (b >> 3); nb = nb - (nb >> 3); }
  if (LAYER == 0) {
    for (int tile = b; tile < t0 + t1; tile += nb) {
      if (tile < t0) wtrans_tile(shm, p.dn_w_in, 1024, 6176, (u16*)(p.ws + OFF_W0T), tile, wave_s_);
      else wtrans_tile(shm, p.dn_w_out, 2048, 1024, (u16*)(p.ws + OFF_WO0T), tile - t0, wave_s_);
    }
  } else {
    for (int tile = b; tile < t2 + t3; tile += nb) {
      if (tile < t2) wtrans_tile(shm, p.gla_w_in, 1024, 5152, (u16*)(p.ws + OFF_W1T), tile, wave_s_);
      else wtrans_tile(shm, p.gla_w_out, 2048, 1024, (u16*)(p.ws + OFF_WO1T), tile - t2, wave_s_);
    }
  }
}

DI void h_phase(const float* src_lat, const float* src_ctx, const float* g, const float* mods_i, u16* dst, int nrows, const int wave_s_) {
  const int tidx_ = TIDX();
  const int lane = tidx_ & 63, gw = blockIdx.x * 8 + (tidx_ >> 6), nw = gridDim.x * 8;
  for (int row0 = gw; row0 < nrows; row0 += 2 * nw) {
    const int rows[2] = {row0, row0 + nw};
    const bool ok1 = rows[1] < nrows;
    f32x4 v[2][4];
#pragma unroll
    for (int u = 0; u < 2; ++u) {
      const int row = (u == 0 || ok1) ? rows[u] : rows[0];
      const float* s = (row < RL) ? src_lat + (size_t)row * DM : src_ctx + (size_t)(row - RL) * DM;
#pragma unroll
      for (int q = 0; q < 4; ++q) v[u][q] = __builtin_nontemporal_load((const f32x4*)(s + q * 256 + lane * 4));
    }
#pragma unroll
    for (int u = 0; u < 2; ++u) {
      if (u == 1 && !ok1) break;
      const int row = rows[u];
      const int mr = (row < RL) ? (row >> 13) : 4;
      const float* sh = mods_i + mr * 3072;
      const float* sc = sh + 1024;
      float ss = 0.f;
#pragma unroll
      for (int q = 0; q < 4; ++q) ss += v[u][q].x * v[u][q].x + v[u][q].y * v[u][q].y + v[u][q].z * v[u][q].z + v[u][q].w * v[u][q].w;
      ss = wave_sum(ss);
      const float rstd = rsqrtf(ss * (1.f / 1024.f) + EPSF);
#pragma unroll
      for (int q = 0; q < 4; ++q) {
        const int col = q * 256 + lane * 4;
        f32x4 gg = *(const f32x4*)(g + col), s1 = *(const f32x4*)(sc + col), s0 = *(const f32x4*)(sh + col);
        float o0 = v[u][q].x * rstd * gg.x * (1.f + s1.x) + s0.x, o1 = v[u][q].y * rstd * gg.y * (1.f + s1.y) + s0.y;
        float o2 = v[u][q].z * rstd * gg.z * (1.f + s1.z) + s0.z, o3 = v[u][q].w * rstd * gg.w * (1.f + s1.w) + s0.w;
        *(u32x2*)(dst + (size_t)row * DM + col) = (u32x2){pk2(o0, o1), pk2(o2, o3)};
      }
    }
  }
}

DI void small_gemm(const u16* A, const u16* Wt, float* out, const int wave_s_) {
  const int tidx_ = TIDX();
  if ((blockIdx.x & 7) < 3) return;
  const int bsub = ((int)blockIdx.x >> 3) * 5 + ((int)(blockIdx.x & 7) - 3);
  const int lane = tidx_ & 63, gw = bsub * 8 + (tidx_ >> 6), nw = ((int)gridDim.x >> 3) * 5 * 8;
  const int r = lane & 31, h = lane >> 5;
  for (int wt = gw; wt < R / 32; wt += nw) {
    const u16* ap = A + (size_t)(wt * 32 + r) * 1024 + 8 * h;
    const u16* bp = Wt + (size_t)r * 1024 + 8 * h;
    f32x16 acc;
    for (int i = 0; i < 16; ++i) acc[i] = 0.f;
#pragma unroll 8
    for (int s = 0; s < 64; ++s) {
      s16x8 a = *(const s16x8*)(ap + 16 * s), b = *(const s16x8*)(bp + 16 * s);
      acc = MFMA32(a, b, acc);
    }
#pragma unroll
    for (int i = 0; i < 16; ++i) out[(size_t)(wt * 32 + crow(i, h)) * 32 + r] = acc[i];
  }
}

DI int lds_byte2(int r, int c) {
  int st = (r >> 4) * 2 + (c >> 5), ob = (r & 15) * 64 + (c & 31) * 2;
  return st * 1024 + (ob ^ (((ob >> 9) & 1) << 5));
}
DI void stage_rc2(int b, int& Rr, int& Cc) {
  int st = b >> 10, sb = b & 1023, swz = sb ^ (((sb >> 9) & 1) << 5);
  Rr = (st / 2) * 16 + swz / 64;
  Cc = (st % 2) * 32 + (swz % 64) / 2;
}

struct EpiArgs {
  int mode;
  u16* lat; u16* ctx; int ld;
  u16* b1; u16* b2;
  const float* res_lat; const float* res_ctx; const float* mods_i; float* out_lat; float* out_ctx;
};

template <int MODE>
DI void gemm_epilogue(const EpiArgs& e, f32x4 (&acc)[8][4], int row0, int pn, int wr, int wc, int fr, int fq) {
#pragma unroll
  for (int m = 0; m < 8; ++m) {
    const int row = row0 + wr * 128 + m * 16 + fr;
#pragma unroll
    for (int n = 0; n < 4; ++n) {
      const int col = pn * 256 + wc * 64 + n * 16 + fq * 4;
      const f32x4 a = acc[m][n];
      if (MODE == 0) {
        u16* pr = (row < RL) ? e.lat + (size_t)row * e.ld : e.ctx + (size_t)(row - RL) * e.ld;
        *(u32x2*)(pr + col) = (u32x2){pk2(a.x, a.y), pk2(a.z, a.w)};
      } else if (MODE == 1) {
        u32x2 v = {pk2(a.x, a.y), pk2(a.z, a.w)};
        if (pn < 4) {
          *(u32x2*)(e.lat + (size_t)row * 1024 + col) = v;
        } else {
          *(u32x2*)(e.b1 + (size_t)row * 2048 + col - 1024) = v;
          *(u32x2*)(e.b2 + (size_t)row * 2048 + col - 1024) = v;
        }
      } else {
        const int mr = (row < RL) ? (row >> 13) : 4;
        const f32x4 gt = *(const f32x4*)(e.mods_i + mr * 3072 + 2048 + col);
        const float* rp = (row < RL) ? e.res_lat + (size_t)row * DM : e.res_ctx + (size_t)(row - RL) * DM;
        float* op = (row < RL) ? e.out_lat + (size_t)row * DM : e.out_ctx + (size_t)(row - RL) * DM;
        const f32x4 rv = *(const f32x4*)(rp + col);
        f32x4 o = {rv.x + gt.x * a.x, rv.y + gt.y * a.y, rv.z + gt.z * a.z, rv.w + gt.w * a.w};
        *(f32x4*)(op + col) = o;
      }
    }
  }
}

template <int MODE>
DI void gemm_epilogue8(const EpiArgs& e, f32x4 (&acc)[2][2][4][2], int row0, int pn, int wr, int wc, int fr, int fq) {
#pragma unroll
  for (int ai = 0; ai < 2; ++ai)
#pragma unroll
    for (int m = 0; m < 4; ++m) {
      const int row = row0 + ai * 128 + wr * 64 + m * 16 + fr;
#pragma unroll
      for (int bj = 0; bj < 2; ++bj)
#pragma unroll
        for (int n = 0; n < 2; ++n) {
          const int col = pn * 256 + bj * 128 + wc * 32 + n * 16 + fq * 4;
          const f32x4 a = acc[ai][bj][m][n];
          if (MODE == 0) {
            u16* pr = (row < RL) ? e.lat + (size_t)row * e.ld : e.ctx + (size_t)(row - RL) * e.ld;
            *(u32x2*)(pr + col) = (u32x2){pk2(a.x, a.y), pk2(a.z, a.w)};
          } else if (MODE == 4) {
            const size_t dsel = (pn < 8) ? 0 : (pn < 16) ? (4 * MiB / 2) : ((OFF_ZC - OFF_X) / 2);
            *(u32x2*)(e.ctx + dsel + (size_t)(row - RL) * 2048 + (col & 2047)) = (u32x2){pk2(a.x, a.y), pk2(a.z, a.w)};
          } else if (MODE == 1) {
            u32x2 v = {pk2(a.x, a.y), pk2(a.z, a.w)};
            if (pn < 4) {
              *(u32x2*)(e.lat + (size_t)row * 1024 + col) = v;
            } else {
              *(u32x2*)(e.b1 + (size_t)row * 2048 + col - 1024) = v;
              *(u32x2*)(e.b2 + (size_t)row * 2048 + col - 1024) = v;
            }
          } else {
            const int mr = (row < RL) ? (row >> 13) : 4;
            const f32x4 gt = *(const f32x4*)(e.mods_i + mr * 3072 + 2048 + col);
            const float* rp = (row < RL) ? e.res_lat + (size_t)row * DM : e.res_ctx + (size_t)(row - RL) * DM;
            float* op = (row < RL) ? e.out_lat + (size_t)row * DM : e.out_ctx + (size_t)(row - RL) * DM;
            const f32x4 rv = __builtin_nontemporal_load((const f32x4*)(rp + col));
            f32x4 o = {rv.x + gt.x * a.x, rv.y + gt.y * a.y, rv.z + gt.z * a.z, rv.w + gt.w * a.w};
            *(f32x4*)(op + col) = o;
          }
        }
    }
}

template <int MODE>
DI void gemm_phase(char* shm_, const u16* Alat, const u16* Actx, int K, const u16* Bt, int pm0, int npm, int nN, const EpiArgs& e, const int wave_s_) {
  constexpr int BK = 64, HALF = 128, HT = HALF * BK;
  u16* shm = (u16*)shm_;
  const int tid = TIDX(), wid = tid >> 6, lane = tid & 63, wr = wid >> 2, wc = wid & 3, fr = lane & 15, fq = lane >> 4;
#define SA(b, h) (shm + ((b) * 2 + (h)) * HT)
#define SB(b, h) (shm + (4 + (b) * 2 + (h)) * HT)
#define LDSP(ptr) ((__attribute__((address_space(3))) unsigned*)(unsigned)(size_t)(ptr))
#define STAGE(P, BASE, br, kt) do { const u16* _p = (BASE) + (size_t)(br) * K + (kt) * BK + soff; \
    _Pragma("unroll") for (int _i = 0; _i < 2; ++_i) \
      __builtin_amdgcn_global_load_lds((const unsigned*)(_p + (size_t)_i * 64 * K), LDSP((char*)(P) + wid * 1024 + _i * 8192), 16, 0, 0); } while (0)
#define LDA(dst, b, h) _Pragma("unroll") for (int m = 0; m < 4; ++m) _Pragma("unroll") for (int k = 0; k < 2; ++k) \
    dst[m][k] = *(const s16x8*)((const char*)SA(b, h) + lds_byte2(wr * 64 + m * 16 + fr, k * 32 + fq * 8))
#define LDB(dst, b, h) _Pragma("unroll") for (int n = 0; n < 2; ++n) _Pragma("unroll") for (int k = 0; k < 2; ++k) \
    dst[n][k] = *(const s16x8*)((const char*)SB(b, h) + lds_byte2(wc * 32 + n * 16 + fr, k * 32 + fq * 8))
#define MMA(ai, bj, Atv, Btv) do { __builtin_amdgcn_s_setprio(1); \
    _Pragma("unroll") for (int m = 0; m < 4; ++m) _Pragma("unroll") for (int n = 0; n < 2; ++n) _Pragma("unroll") for (int k = 0; k < 2; ++k) \
      acc[ai][bj][m][n] = MFMA16(Btv[n][k], Atv[m][k], acc[ai][bj][m][n]); \
    __builtin_amdgcn_s_setprio(0); } while (0)
#define WAIT_V(n) asm volatile("s_waitcnt vmcnt(" #n ")" ::: "memory")
#define WAIT_L(n) asm volatile("s_waitcnt lgkmcnt(" #n ")" ::: "memory")
#define BAR __builtin_amdgcn_s_barrier()
#define SCHED __builtin_amdgcn_sched_barrier(0)
  int sR0, sC0;
  stage_rc2(tid * 16, sR0, sC0);
  const size_t soff = (size_t)sR0 * K + sC0;
  const int ntiles = npm * nN, nt = K / BK;
  const int xcd = blockIdx.x & 7, jj = blockIdx.x >> 3;
  const int PN = (nN % 8 == 0) ? 8 : 4, PG = 32 / PN, npg = nN / PN;
  const int ngroups = ((npm + PG - 1) / PG) * npg;
  const bool grouped = (gridDim.x == 256);
  const int nit = grouped ? (ngroups - xcd + 7) / 8 : (ntiles - (int)blockIdx.x + (int)gridDim.x - 1) / (int)gridDim.x;
  auto tile_of = [&](int it, int& pm, int& pn) -> bool {
    if (it >= nit) return false;
    if (grouped) {
      const int g = xcd + 8 * it, pmg = g / npg, png = g % npg;
      pm = pmg * PG + jj / PN; pn = png * PN + jj % PN;
      if (pm >= npm) return false;
      pm += pm0;
    } else {
      const int L = blockIdx.x + it * gridDim.x;
      pm = pm0 + L / nN; pn = L % nN;
    }
    return true;
  };
  bool prefetched = false;
  for (int it = 0; it < nit; ++it) {
    int pm, pn;
    if (!tile_of(it, pm, pn)) continue;
    const int row0 = pm * 256;
    const u16* A = (row0 < RL) ? Alat + (size_t)row0 * K : Actx + (size_t)(row0 - RL) * K;
    const u16* Bw = Bt + (size_t)pn * 256 * K;
    const int brow = 0, bcol = 0;
    f32x4 acc[2][2][4][2];
#pragma unroll
    for (int i0 = 0; i0 < 2; ++i0)
#pragma unroll
      for (int i1 = 0; i1 < 2; ++i1)
#pragma unroll
        for (int i2 = 0; i2 < 4; ++i2)
#pragma unroll
          for (int i3 = 0; i3 < 2; ++i3) acc[i0][i1][i2][i3] = (f32x4){0.f, 0.f, 0.f, 0.f};
    s16x8 At[4][2], B0[2][2], B1[2][2];
    if (!prefetched) {
      STAGE(SB(0, 0), Bw, bcol, 0); STAGE(SA(0, 0), A, brow, 0);
      STAGE(SB(0, 1), Bw, bcol + HALF, 0); STAGE(SA(0, 1), A, brow + HALF, 0);
    }
    if (wr == 1) BAR;
    WAIT_V(4); BAR;
    STAGE(SB(1, 0), Bw, bcol, 1); STAGE(SA(1, 0), A, brow, 1); STAGE(SB(1, 1), Bw, bcol + HALF, 1);
    WAIT_V(6); BAR;
    for (int t = 0; t < nt - 2; t += 2) {
      LDB(B0, 0, 0); SCHED; LDA(At, 0, 0); STAGE(SA(1, 1), A, brow + HALF, t + 1);
      WAIT_L(8); BAR; WAIT_L(0); MMA(0, 0, At, B0); BAR; SCHED;
      LDB(B1, 0, 1); STAGE(SB(0, 0), Bw, bcol, t + 2);
      BAR; WAIT_L(0); MMA(0, 1, At, B1); BAR;
      LDA(At, 0, 1); STAGE(SA(0, 0), A, brow, t + 2);
      BAR; WAIT_L(0); MMA(1, 0, At, B0); BAR; SCHED;
      STAGE(SB(0, 1), Bw, bcol + HALF, t + 2);
      WAIT_V(6); BAR; MMA(1, 1, At, B1); BAR;
      LDB(B0, 1, 0); SCHED; LDA(At, 1, 0); STAGE(SA(0, 1), A, brow + HALF, t + 2);
      WAIT_L(8); BAR; WAIT_L(0); MMA(0, 0, At, B0); BAR; SCHED;
      LDB(B1, 1, 1); STAGE(SB(1, 0), Bw, bcol, t + 3);
      BAR; WAIT_L(0); MMA(0, 1, At, B1); BAR;
      LDA(At, 1, 1); STAGE(SA(1, 0), A, brow, t + 3);
      BAR; WAIT_L(0); MMA(1, 0, At, B0); BAR; SCHED;
      STAGE(SB(1, 1), Bw, bcol + HALF, t + 3);
      WAIT_V(6); BAR; MMA(1, 1, At, B1); BAR;
    }
    { LDB(B0, 0, 0); LDA(At, 0, 0); STAGE(SA(1, 1), A, brow + HALF, nt - 1);
      BAR; WAIT_L(0); MMA(0, 0, At, B0); BAR;
      LDB(B1, 0, 1); BAR; WAIT_L(0); MMA(0, 1, At, B1); BAR;
      LDA(At, 0, 1); WAIT_V(4); BAR; WAIT_L(0); MMA(1, 0, At, B0); MMA(1, 1, At, B1); BAR; }
    { LDB(B0, 1, 0); LDA(At, 1, 0); WAIT_V(2); BAR; WAIT_L(0); MMA(0, 0, At, B0); BAR;
      LDB(B1, 1, 1); WAIT_V(0); BAR; WAIT_L(0); MMA(0, 1, At, B1); BAR;
      LDA(At, 1, 1); BAR; WAIT_L(0); MMA(1, 0, At, B0); MMA(1, 1, At, B1); BAR; }
    if (wr == 0) BAR;
    {
      int pm2, pn2;
      prefetched = tile_of(it + 1, pm2, pn2);
      if (prefetched) {
        const int r2 = pm2 * 256;
        const u16* A2 = (r2 < RL) ? Alat + (size_t)r2 * K : Actx + (size_t)(r2 - RL) * K;
        const u16* B2 = Bt + (size_t)pn2 * 256 * K;
        STAGE(SB(0, 0), B2, 0, 0); STAGE(SA(0, 0), A2, 0, 0);
        STAGE(SB(0, 1), B2, HALF, 0); STAGE(SA(0, 1), A2, HALF, 0);
      }
    }
    { const int l2 = lane_id(); gemm_epilogue8<MODE>(e, acc, row0, pn, wr, wc, l2 & 15, l2 >> 4); }
    asm volatile("s_waitcnt vmcnt(0) lgkmcnt(0)" ::: "memory");
    BAR;
  }
#undef SA
#undef SB
#undef LDSP
#undef STAGE
#undef LDA
#undef LDB
#undef MMA
#undef WAIT_V
#undef WAIT_L
#undef BAR
#undef SCHED
}

DI void conv_accum(float (&acc)[8], const u16* srow, const float* w) {
  u32x4 v = *(const u32x4*)srow;
  f32x4 w0 = *(const f32x4*)w, w1 = *(const f32x4*)(w + 4);
  acc[0] += bflo(v.x) * w0.x; acc[1] += bfhi(v.x) * w0.y; acc[2] += bflo(v.y) * w0.z; acc[3] += bfhi(v.y) * w0.w;
  acc[4] += bflo(v.z) * w1.x; acc[5] += bfhi(v.z) * w1.y; acc[6] += bflo(v.w) * w1.z; acc[7] += bfhi(v.w) * w1.w;
}
DI void fma8(float (&acc)[8], const u32x4 v, const float (&w)[8]) {
  acc[0] += bflo(v.x) * w[0]; acc[1] += bfhi(v.x) * w[1]; acc[2] += bflo(v.y) * w[2]; acc[3] += bfhi(v.y) * w[3];
  acc[4] += bflo(v.z) * w[4]; acc[5] += bfhi(v.z) * w[5]; acc[6] += bflo(v.w) * w[6]; acc[7] += bfhi(v.w) * w[7];
}
template <bool ISV>
DI void conv_store(const Params& p, float (&acc)[8], int row, int ch) {
#pragma unroll
  for (int e = 0; e < 8; ++e) acc[e] = siluf(acc[e]);
  if (!ISV) {
    u16* qk = (u16*)(p.ws + OFF_QK0);
    float ss = 0.f;
#pragma unroll
    for (int e = 0; e < 8; ++e) ss += acc[e] * acc[e];
    ss += __shfl_xor(ss, 1, 64); ss += __shfl_xor(ss, 2, 64); ss += __shfl_xor(ss, 4, 64); ss += __shfl_xor(ss, 8, 64);
    const float sc = rsqrtf(ss + EPSF) * ((ch < 1024) ? 0.08838834764831845f : 1.f);
    u32x4 o = {pk2(acc[0] * sc, acc[1] * sc), pk2(acc[2] * sc, acc[3] * sc), pk2(acc[4] * sc, acc[5] * sc), pk2(acc[6] * sc, acc[7] * sc)};
    __builtin_nontemporal_store(o, (u32x4*)(qk + (size_t)row * 2048 + ch));
  } else {
    u16* u0 = (u16*)(p.ws + OFF_U0);
    u16* u1 = (u16*)(p.ws + OFF_U1);
    const float* abt = (const float*)(p.ws + OFF_ABT);
    const int head = ch >> 8;
    const float b0 = sigmoidf(abt[(size_t)row * 32 + 16 + head]), b1 = sigmoidf(abt[(size_t)row * 32 + 24 + head]);
    u32x4 o0 = {pk2(acc[0] * b0, acc[1] * b0), pk2(acc[2] * b0, acc[3] * b0), pk2(acc[4] * b0, acc[5] * b0), pk2(acc[6] * b0, acc[7] * b0)};
    u32x4 o1 = {pk2(acc[0] * b1, acc[1] * b1), pk2(acc[2] * b1, acc[3] * b1), pk2(acc[4] * b1, acc[5] * b1), pk2(acc[6] * b1, acc[7] * b1)};
    __builtin_nontemporal_store(o0, (u32x4*)(u0 + (size_t)row * 2048 + ch));
    __builtin_nontemporal_store(o1, (u32x4*)(u1 + (size_t)row * 2048 + ch));
  }
}
template <bool ISV>
DI void conv_phase(const Params& p, const int wave_s_) {
  const u16* pre_lat = (const u16*)p.out;
  const u16* pre_ctx = (const u16*)(p.ws + OFF_X + (ISV ? 4 * MiB : 0));
  const float* cw = p.dn_conv_w + (ISV ? 2048 : 0);
  const int gt = blockIdx.x * 512 + TIDX(), nthr = gridDim.x * 512;
  const u32x4 zero4 = {0u, 0u, 0u, 0u};
  for (int idx = gt; idx < 4 * 128 * 4 * 256; idx += nthr) {
    const int cg8 = idx & 255, run = (idx >> 8) & 3, gr = (idx >> 10) & 127, b = idx >> 17, ch = cg8 * 8, c0 = run * 16;
    float w[9][8];
#pragma unroll
    for (int t = 0; t < 9; ++t) {
      const f32x4 w0 = *(const f32x4*)(cw + t * 4096 + ch), w1 = *(const f32x4*)(cw + t * 4096 + ch + 4);
      w[t][0] = w0.x; w[t][1] = w0.y; w[t][2] = w0.z; w[t][3] = w0.w; w[t][4] = w1.x; w[t][5] = w1.y; w[t][6] = w1.z; w[t][7] = w1.w;
    }
    const u16* base = pre_lat + ((size_t)(b << 13) + gr * 64) * 2048 + ch;
    const bool rok[3] = {gr > 0, true, gr < 127};
    u32x4 win[3][3];
#pragma unroll
    for (int i = 0; i < 3; ++i) {
      win[i][0] = (rok[i] && c0 > 0) ? *(const u32x4*)(base + (ptrdiff_t)((i - 1) * 64 + c0 - 1) * 2048) : zero4;
      win[i][1] = rok[i] ? *(const u32x4*)(base + (ptrdiff_t)((i - 1) * 64 + c0) * 2048) : zero4;
    }
#pragma unroll
    for (int t = 0; t < 16; ++t) {
      const int c = c0 + t;
#pragma unroll
      for (int i = 0; i < 3; ++i) win[i][2] = (rok[i] && c < 63) ? *(const u32x4*)(base + (ptrdiff_t)((i - 1) * 64 + c + 1) * 2048) : zero4;
      float acc[8];
#pragma unroll
      for (int e = 0; e < 8; ++e) acc[e] = 0.f;
#pragma unroll
      for (int i = 0; i < 3; ++i)
#pragma unroll
        for (int j = 0; j < 3; ++j) fma8(acc, win[i][j], w[i * 3 + j]);
      conv_store<ISV>(p, acc, (b << 13) + gr * 64 + c, ch);
#pragma unroll
      for (int i = 0; i < 3; ++i) { win[i][0] = win[i][1]; win[i][1] = win[i][2]; }
    }
  }
  for (int idx = gt; idx < 4 * 32 * 256; idx += nthr) {
    const int cg8 = idx & 255, run = (idx >> 8) & 31, b = idx >> 13, ch = cg8 * 8, p0 = run * 8;
    float w[3][8];
#pragma unroll
    for (int t = 0; t < 3; ++t) {
      const f32x4 w0 = *(const f32x4*)(cw + (3 + t) * 4096 + ch), w1 = *(const f32x4*)(cw + (3 + t) * 4096 + ch + 4);
      w[t][0] = w0.x; w[t][1] = w0.y; w[t][2] = w0.z; w[t][3] = w0.w; w[t][4] = w1.x; w[t][5] = w1.y; w[t][6] = w1.z; w[t][7] = w1.w;
    }
    const u16* base = pre_ctx + (size_t)(b * 256) * 2048 + ch;
    u32x4 win[3];
    win[0] = (p0 > 0) ? *(const u32x4*)(base + (size_t)(p0 - 1) * 2048) : zero4;
    win[1] = *(const u32x4*)(base + (size_t)p0 * 2048);
#pragma unroll
    for (int t = 0; t < 8; ++t) {
      const int pp = p0 + t;
      win[2] = (pp < 255) ? *(const u32x4*)(base + (size_t)(pp + 1) * 2048) : zero4;
      float acc[8];
#pragma unroll
      for (int e = 0; e < 8; ++e) acc[e] = 0.f;
#pragma unroll
      for (int j = 0; j < 3; ++j) fma8(acc, win[j], w[j]);
      conv_store<ISV>(p, acc, RL + b * 256 + pp, ch);
      win[0] = win[1]; win[1] = win[2];
    }
  }
}

constexpr int lp_off(int ip) { return ip == 0 ? 0 : (8 * ((ip - 1) / 4) * ((ip - 1) / 4 + 1) + 4 * ((ip - 1) % 4) * ((ip - 1) / 4 + 1)); }
constexpr int LP_FLOATS = 2112;
DI void dn_prep_phase(char* shm, const Params& p, const int wave_s_) {
  const int tid = TIDX(), wave = tid >> 6, lane = tid & 63, r = lane & 31, hh = lane >> 5;
  char* sQ = shm;
  char* sK = shm + 16896;
  float* sKK = (float*)(shm + 33792);
  float* sQK = (float*)(shm + 50432);
  float* sg = (float*)(shm + 67072);
  float* sbeta = sg + 128;
  float* sgc = sg + 256;
  float* sLp = (float*)(shm + 68608);
  const u16* qk = (const u16*)(p.ws + OFF_QK0);
  const float* abt = (const float*)(p.ws + OFF_ABT);
  u16* Ab_lat = (u16*)p.out;
  u16* Tb_lat = (u16*)p.out + (size_t)32 * MiB;
  u16* Ab_ctx = (u16*)(p.ws + OFF_AC);
  u16* Tb_ctx = (u16*)(p.ws + OFF_TC);
  float* Eb = (float*)(p.ws + OFF_X);
  for (int grp = blockIdx.x; grp < NCHUNK * 2; grp += gridDim.x) {
    const int ci = grp >> 1, row0 = ci * 64;
    u32x4 pq[2], pk[2];
    float pa = 0.f, pbt = 0.f;
    auto load_item = [&](int h) {
#pragma unroll
      for (int u = 0; u < 2; ++u) {
        const int chunk = tid * 2 + u, c = chunk >> 4, cc = (chunk & 15) * 8;
        const u16* src = qk + (size_t)(row0 + c) * 2048 + h * 128 + cc;
        pq[u] = *(const u32x4*)src; pk[u] = *(const u32x4*)(src + 1024);
      }
      if (tid < 128) {
        const int d = tid >> 6, c = tid & 63;
        pa = abt[(size_t)(row0 + c) * 32 + d * 8 + h]; pbt = abt[(size_t)(row0 + c) * 32 + 16 + d * 8 + h];
      }
    };
    load_item((grp & 1) * 4);
    for (int sub = 0; sub < 4; ++sub) {
      const int h = (grp & 1) * 4 + sub, item = ci * 8 + h;
#pragma unroll
      for (int u = 0; u < 2; ++u) {
        const int chunk = tid * 2 + u, c = chunk >> 4, cc = (chunk & 15) * 8;
        st8(sQ + c * 264 + cc * 2, pq[u]);
        st8(sK + c * 264 + cc * 2, pk[u]);
      }
      if (tid < 128) {
        const int d = tid >> 6, c = tid & 63;
        sg[d * 64 + c] = -__expf(p.dn_a_log[d * 8 + h]) * softplusf(pa + p.dn_dt_bias[d * 8 + h]);
        sbeta[d * 64 + c] = sigmoidf(pbt);
      }
      if (sub < 3) load_item(h + 1);
      __syncthreads();
      if (wave < 2) {
        const int c = wave ? 63 - lane : lane;
        float v = sg[wave * 64 + c];
#pragma unroll
        for (int o = 1; o < 64; o <<= 1) { const float t = __shfl_up(v, o, 64); if (lane >= o) v += t; }
        sgc[wave * 64 + c] = v;
      }
      {
        const int mat = wave >> 2, tm = (wave >> 1) & 1, tn = wave & 1;
        const char* aop = mat ? sQ : sK;
        f32x16 acc;
        for (int i = 0; i < 16; ++i) acc[i] = 0.f;
#pragma unroll
        for (int s = 0; s < 8; ++s) {
          s16x8 a = ldA_nat(aop, 32 * tm + r, 264, 16 * s, hh), b = ldA_nat(sK, 32 * tn + r, 264, 16 * s, hh);
          acc = MFMA32(a, b, acc);
        }
        float* dst = mat ? sQK : sKK;
#pragma unroll
        for (int i = 0; i < 16; ++i) dst[(32 * tm + crow(i, hh)) * 65 + 32 * tn + r] = acc[i];
      }
      __syncthreads();
      for (int e = tid; e < 8192; e += 512) {
        const int d = e >> 12, ip = (e >> 6) & 63, jp = e & 63;
        if (ip > jp) {
          const int i = d ? 63 - ip : ip, j = d ? 63 - jp : jp;
          const int q4 = (ip - 1) >> 2, r4 = (ip - 1) & 3;
          const float v = sbeta[d * 64 + i] * sKK[i * 65 + j] * __expf(fminf(sgc[d * 64 + i] - sgc[d * 64 + j], 0.f));
          sLp[(sub * 2 + d) * LP_FLOATS + 8 * q4 * (q4 + 1) + 4 * r4 * (q4 + 1) + jp] = v;
        }
      }
      for (int v = tid; v < 1024; v += 512) {
        const int d = v >> 9, i = (v >> 3) & 63, j0 = (v & 7) * 8;
        float o[8];
#pragma unroll
        for (int e = 0; e < 8; ++e) {
          const int j = j0 + e;
          const bool keep = d ? (i <= j) : (i >= j);
          o[e] = keep ? sQK[i * 65 + j] * __expf(fminf(sgc[d * 64 + i] - sgc[d * 64 + j], 0.f)) : 0.f;
        }
        u32x4 ov = {pk2(o[0], o[1]), pk2(o[2], o[3]), pk2(o[4], o[5]), pk2(o[6], o[7])};
        *(u32x4*)(((size_t)item < TA_LAT_ITEMS ? Ab_lat : Ab_ctx) + ta_off(item, d) + i * 64 + j0) = ov;
      }
      if (tid < 128) {
        const int d = tid >> 6, c = tid & 63;
        const float gl = sgc[d * 64 + (d ? 0 : 63)], gcv = sgc[d * 64 + c];
        const float e1 = __expf(gcv), be = sbeta[d * 64 + c] * e1, e2 = __expf(gl - gcv), cdv = __expf(gl);
        float* E = Eb + ((size_t)item * 2 + d) * 256;
        E[c] = e1; E[64 + c] = be; E[128 + c] = e2; E[192 + c] = cdv;
      }
      __syncthreads();
    }
    {
      const int wv = opq_v(wave), lane_l = opq_v(lane);
      const int d = wv & 1, item = ci * 8 + (grp & 1) * 4 + (wv >> 1);
      const float* Lb = sLp + wv * LP_FLOATS;
      float T[64];
#pragma unroll
      for (int ip = 0; ip < 64; ++ip) {
        f32x4 lrow[16];
#pragma unroll
        for (int j4 = 0; j4 < (ip + 3) / 4; ++j4) lrow[j4] = *(const f32x4*)(Lb + lp_off(ip) + j4 * 4);
        float a0 = (lane_l == ip) ? 1.f : 0.f, a1 = 0.f, a2 = 0.f, a3 = 0.f;
#pragma unroll
        for (int j4 = 0; j4 < (ip + 3) / 4; ++j4) {
          const f32x4 lv = lrow[j4];
          if (j4 * 4 + 0 < ip) a0 -= lv.x * T[j4 * 4 + 0];
          if (j4 * 4 + 1 < ip) a1 -= lv.y * T[j4 * 4 + 1];
          if (j4 * 4 + 2 < ip) a2 -= lv.z * T[j4 * 4 + 2];
          if (j4 * 4 + 3 < ip) a3 -= lv.w * T[j4 * 4 + 3];
        }
        T[ip] = (a0 + a1) + (a2 + a3);
        __builtin_amdgcn_sched_barrier(0);
      }
      u16* To = ((size_t)item < TA_LAT_ITEMS ? Tb_lat : Tb_ctx) + ta_off(item, d);
      const int cidx = d ? 63 - lane_l : lane_l;
#pragma unroll
      for (int ip = 0; ip < 64; ++ip) {
        const int i = d ? 63 - ip : ip;
        To[i * 64 + cidx] = f2bf(T[ip]);
      }
    }
    __syncthreads();
  }
}

constexpr int SC_QS = 272;
constexpr int SC_Q = 0, SC_K = 17408, SC_KT = 34816, SC_T = 52224, SC_A = 60928, SC_E = 69632, SC_BUF = 70656;
DI s16x8 ldA16(const char* base, int row, int strideB, int kofs, int q) {
  const char* p = base + row * strideB + (kofs + 4 * q) * 2;
  u32x2 lo = *(const u32x2*)p, hi = *(const u32x2*)(p + 32);
  return cat8(lo, hi);
}
DI s16x8 pack16(const f32x4& a, const f32x4& b) {
  u32x4 v = {pk2(a.x, a.y), pk2(a.z, a.w), pk2(b.x, b.y), pk2(b.z, b.w)};
  return __builtin_bit_cast(s16x8, v);
}

template <bool DELTA, bool DRY = false>
DI void scan_phase(char* shm, const Params& p, const int wave_s_) {
  const int bid = blockIdx.x;
  if (bid >= 256) return;
  const int tid = TIDX(), wave = tid >> 6, lane = tid & 63, n16 = lane & 15, q4 = lane >> 4;
  int cgp, d, h, b;
  if (DELTA) { cgp = (bid >> 3) & 3; const int cid = (bid & 7) + 8 * (bid >> 5); d = cid & 1; h = (cid >> 1) & 7; b = cid >> 4; }
  else { cgp = (bid >> 3) & 7; const int cid = (bid & 7) + 8 * (bid >> 6); d = cid & 1; h = (cid >> 1) & 3; b = cid >> 3; }
  const bool compute = wave < 4;
  const int col0 = (DELTA ? h * 256 : h * 512) + cgp * 64 + (wave & 3) * 16;
  u16* Ub = (u16*)(p.ws + (DELTA ? (d ? OFF_U1 : OFF_U0) : (d ? OFF_V1 : OFF_V0)));
  const u16* qk = (const u16*)(p.ws + OFF_QK0);
  const u16* Ag_lat = (const u16*)p.out;
  const u16* Tb_lat = (const u16*)p.out + (size_t)32 * MiB;
  const u16* Ag_ctx = (const u16*)(p.ws + OFF_AC);
  const u16* Tb_ctx = (const u16*)(p.ws + OFF_TC);
  const float* Eb = (const float*)(p.ws + OFF_X);
  const u16* QD = (const u16*)(p.ws + OFF_QD);
  const u16* AS = (const u16*)(p.ws + OFF_ASUM);
  const float* CD = (const float*)(p.ws + OFF_CD1);

  auto chunk_of = [&](int st) -> int {
    if (st < 4) return 512 + b * 4 + (d ? 3 - st : st);
    return b * 128 + (d ? 127 - (st - 4) : (st - 4));
  };

  auto stage_all = [&](int st, int buf) {
    const int sid = tid - 256;
    const int ci = chunk_of(st), row0 = ci * 64;
    char* sb = shm + buf * SC_BUF;
    if (DELTA) {
      const size_t it = ((size_t)ci * 8 + h) * 2 + d;
      const float* E = Eb + it * 256;
      const int c = sid >> 2, cc = (sid & 3) * 32;
      const u16* qsrc = qk + (size_t)(row0 + c) * 2048 + h * 128 + cc;
      const int c0 = (sid >> 4) * 4, dk0 = (sid & 15) * 8;
      const u16* ksrc = qk + (size_t)(row0 + c0) * 2048 + 1024 + h * 128 + dk0;
      u32x4 gq[4], gk[4], gT[2], gA[2];
#pragma unroll
      for (int u = 0; u < 4; ++u) gq[u] = *(const u32x4*)(qsrc + u * 8);
#pragma unroll
      for (int u = 0; u < 4; ++u) gk[u] = *(const u32x4*)(ksrc + (size_t)u * 2048);
#pragma unroll
      for (int u = 0; u < 2; ++u) {
        const int chunk = sid * 2 + u, tr = chunk >> 3, tc = (chunk & 7) * 8;
        const size_t itm = (size_t)ci * 8 + h;
        gT[u] = *(const u32x4*)((itm < TA_LAT_ITEMS ? Tb_lat : Tb_ctx) + ta_off(itm, d) + tr * 64 + tc);
        gA[u] = *(const u32x4*)((itm < TA_LAT_ITEMS ? Ag_lat : Ag_ctx) + ta_off(itm, d) + tr * 64 + tc);
      }
      const float e1 = E[c];
      const f32x4 bev = *(const f32x4*)(E + 64 + c0), e2v = *(const f32x4*)(E + 128 + c0);
      if (sid == 0) *(float*)(sb + SC_E) = E[192];
#pragma unroll
      for (int u = 0; u < 4; ++u) st8(sb + SC_Q + c * SC_QS + (cc + u * 8) * 2, scale8(gq[u], e1));
      const float be[4] = {bev.x, bev.y, bev.z, bev.w}, e2[4] = {e2v.x, e2v.y, e2v.z, e2v.w};
      u32x4 kt[4];
#pragma unroll
      for (int u = 0; u < 4; ++u) {
        st8(sb + SC_K + (c0 + u) * SC_QS + dk0 * 2, scale8(gk[u], -be[u]));
        kt[u] = scale8(gk[u], e2[u]);
      }
      const unsigned w[4][4] = {{kt[0].x, kt[0].y, kt[0].z, kt[0].w}, {kt[1].x, kt[1].y, kt[1].z, kt[1].w},
                                {kt[2].x, kt[2].y, kt[2].z, kt[2].w}, {kt[3].x, kt[3].y, kt[3].z, kt[3].w}};
#pragma unroll
      for (int jp = 0; jp < 4; ++jp) {
        u32x2 lo = {(w[0][jp] & 0xffffu) | (w[1][jp] << 16), (w[2][jp] & 0xffffu) | (w[3][jp] << 16)};
        u32x2 hi = {(w[0][jp] >> 16) | (w[1][jp] & 0xffff0000u), (w[2][jp] >> 16) | (w[3][jp] & 0xffff0000u)};
        *(u32x2*)(sb + SC_KT + (dk0 + 2 * jp) * 136 + c0 * 2) = lo;
        *(u32x2*)(sb + SC_KT + (dk0 + 2 * jp + 1) * 136 + c0 * 2) = hi;
      }
#pragma unroll
      for (int u = 0; u < 2; ++u) {
        const int chunk = sid * 2 + u, tr = chunk >> 3, tc = (chunk & 7) * 8;
        st8(sb + SC_T + tr * 136 + tc * 2, gT[u]);
        st8(sb + SC_A + tr * 136 + tc * 2, gA[u]);
      }
    } else {
      const size_t it = ((size_t)ci * 4 + h) * 2 + d;
      const u16* qd = QD + it * 16384;
      const int c = sid >> 2, cc = (sid & 3) * 32;
      const int kr = sid >> 1, kc = (sid & 1) * 32;
      u32x4 gq[4], gk[4], gA[2];
#pragma unroll
      for (int u = 0; u < 4; ++u) gq[u] = *(const u32x4*)(qd + c * 128 + cc + u * 8);
#pragma unroll
      for (int u = 0; u < 4; ++u) gk[u] = *(const u32x4*)(qd + 8192 + kr * 64 + kc + u * 8);
      if (d == 0) {
#pragma unroll
        for (int u = 0; u < 2; ++u) {
          const int chunk = sid * 2 + u, tr = chunk >> 3, tc = (chunk & 7) * 8;
          gA[u] = *(const u32x4*)(AS + ((size_t)ci * 4 + h) * 4096 + tr * 64 + tc);
        }
      }
      if (sid < 32) *(f32x4*)(sb + SC_E + sid * 16) = *(const f32x4*)(CD + it * 128 + sid * 4);
#pragma unroll
      for (int u = 0; u < 4; ++u) st8(sb + SC_Q + c * SC_QS + (cc + u * 8) * 2, gq[u]);
#pragma unroll
      for (int u = 0; u < 4; ++u) st8(sb + SC_KT + kr * 136 + (kc + u * 8) * 2, gk[u]);
      if (d == 0) {
#pragma unroll
        for (int u = 0; u < 2; ++u) {
          const int chunk = sid * 2 + u, tr = chunk >> 3, tc = (chunk & 7) * 8;
          st8(sb + SC_A + tr * 136 + tc * 2, gA[u]);
        }
      }
    }
  };

  f32x4 S[8];
#pragma unroll
  for (int t = 0; t < 8; ++t) S[t] = (f32x4){0.f, 0.f, 0.f, 0.f};
  u16 uraw[4][4];
  const int loff = (4 * q4) * 2048 + col0 + n16;
  auto u_issue = [&](int st) {
    const u16* up = Ub + (size_t)chunk_of(st) * (64 * 2048);
    const int lo = opq_v(loff);
#pragma unroll
    for (int mt = 0; mt < 4; ++mt)
#pragma unroll
      for (int i = 0; i < 4; ++i) uraw[mt][i] = up[lo + (16 * mt + i) * 2048];
  };

  if (compute) u_issue(0); else stage_all(0, 0);
  __syncthreads();

  for (int st = 0; st < 132; ++st) {
    const int buf = st & 1;
    const char* sb = shm + buf * SC_BUF;
    if (compute) {
      const int row0 = chunk_of(st) * 64;
      f32x4 Y[4], O[4];
#pragma unroll
      for (int mt = 0; mt < 4; ++mt) {
        Y[mt] = (f32x4){bf2f(uraw[mt][0]), bf2f(uraw[mt][1]), bf2f(uraw[mt][2]), bf2f(uraw[mt][3])};
        O[mt] = (f32x4){0.f, 0.f, 0.f, 0.f};
      }
#define SCHED_FENCE() __builtin_amdgcn_sched_barrier(0)
      s16x8 fT[8];
      if (DELTA) {
#pragma unroll
        for (int mt = 0; mt < 4; ++mt)
#pragma unroll
          for (int kc = 0; kc < 2; ++kc) fT[mt * 2 + kc] = ldA16(sb + SC_T, 16 * mt + n16, 136, 32 * kc, q4);
      }
      s16x8 fa[2][8];
#pragma unroll
      for (int mt = 0; mt < 4; ++mt) {
        if (DELTA) fa[0][mt] = ldA16(sb + SC_K, 16 * mt + n16, SC_QS, 0, q4);
        fa[0][4 + mt] = ldA16(sb + SC_Q, 16 * mt + n16, SC_QS, 0, q4);
      }
      SCHED_FENCE();
#pragma unroll
      for (int t = 0; t < 4; ++t) {
        if (t < 3) {
#pragma unroll
          for (int mt = 0; mt < 4; ++mt) {
            if (DELTA) fa[(t + 1) & 1][mt] = ldA16(sb + SC_K, 16 * mt + n16, SC_QS, 32 * (t + 1), q4);
            fa[(t + 1) & 1][4 + mt] = ldA16(sb + SC_Q, 16 * mt + n16, SC_QS, 32 * (t + 1), q4);
          }
        }
        SCHED_FENCE();
        const s16x8 Sb = pack16(S[2 * t], S[2 * t + 1]);
#pragma unroll
        for (int mt = 0; mt < 4; ++mt) {
          if (DELTA) Y[mt] = MFMA16(fa[t & 1][mt], Sb, Y[mt]);
          O[mt] = MFMA16(fa[t & 1][4 + mt], Sb, O[mt]);
        }
        SCHED_FENCE();
      }
      s16x8 fA[8];
      if (DELTA || d == 0) {
#pragma unroll
        for (int mt = 0; mt < 4; ++mt)
#pragma unroll
          for (int kc = 0; kc < 2; ++kc) fA[mt * 2 + kc] = ldA16(sb + SC_A, 16 * mt + n16, 136, 32 * kc, q4);
      }
      SCHED_FENCE();
      s16x8 vnb[2];
      if (DELTA) {
        s16x8 Yb[2];
        Yb[0] = pack16(Y[0], Y[1]); Yb[1] = pack16(Y[2], Y[3]);
        f32x4 vn[4];
#pragma unroll
        for (int mt = 0; mt < 4; ++mt) {
          vn[mt] = (f32x4){0.f, 0.f, 0.f, 0.f};
#pragma unroll
          for (int kc = 0; kc < 2; ++kc) vn[mt] = MFMA16(fT[mt * 2 + kc], Yb[kc], vn[mt]);
        }
        vnb[0] = pack16(vn[0], vn[1]); vnb[1] = pack16(vn[2], vn[3]);
      } else {
        vnb[0] = pack16(Y[0], Y[1]); vnb[1] = pack16(Y[2], Y[3]);
      }
      SCHED_FENCE();
      s16x8 fK[8];
#pragma unroll
      for (int t = 0; t < 4; ++t)
#pragma unroll
        for (int kc = 0; kc < 2; ++kc) fK[t * 2 + kc] = ldA16(sb + SC_KT, 16 * t + n16, 136, 32 * kc, q4);
      if (st + 1 < 132) u_issue(st + 1);
      SCHED_FENCE();
      if (DELTA || d == 0) {
#pragma unroll
        for (int mt = 0; mt < 4; ++mt)
#pragma unroll
          for (int kc = 0; kc < 2; ++kc) O[mt] = MFMA16(fA[mt * 2 + kc], vnb[kc], O[mt]);
      }
      if (DELTA) {
        const float cd = *(const float*)(sb + SC_E);
#pragma unroll
        for (int t = 0; t < 8; ++t) S[t] *= cd;
      } else {
#pragma unroll
        for (int t = 0; t < 8; ++t) {
          const f32x4 cv = *(const f32x4*)(sb + SC_E + (16 * t + 4 * q4) * 4);
          S[t] *= cv;
        }
      }
      SCHED_FENCE();
      s16x8 fK2[8];
#pragma unroll
      for (int t = 0; t < 4; ++t)
#pragma unroll
        for (int kc = 0; kc < 2; ++kc) fK2[t * 2 + kc] = ldA16(sb + SC_KT, 16 * (4 + t) + n16, 136, 32 * kc, q4);
      SCHED_FENCE();
#pragma unroll
      for (int t = 0; t < 4; ++t)
#pragma unroll
        for (int kc = 0; kc < 2; ++kc) S[t] = MFMA16(fK[t * 2 + kc], vnb[kc], S[t]);
      SCHED_FENCE();
#pragma unroll
      for (int t = 0; t < 4; ++t)
#pragma unroll
        for (int kc = 0; kc < 2; ++kc) S[4 + t] = MFMA16(fK2[t * 2 + kc], vnb[kc], S[4 + t]);
#undef SCHED_FENCE
      if (!DRY || p.out == nullptr)
#pragma unroll
      for (int mt = 0; mt < 4; ++mt) {
        const float ov[4] = {O[mt].x, O[mt].y, O[mt].z, O[mt].w};
        u16* op = Ub + (size_t)row0 * 2048;
        const int lo = opq_v(loff);
#pragma unroll
        for (int i = 0; i < 4; ++i) op[lo + (16 * mt + i) * 2048] = f2bf(ov[i]);
      }
    }
    else if (st + 1 < 132) stage_all(st + 1, buf ^ 1);
    asm volatile("s_waitcnt lgkmcnt(0)" ::: "memory");
    __builtin_amdgcn_s_barrier();
    asm volatile("" ::: "memory");
  }
}

DI void gla_prep_phase(char* shm, const Params& p, const int wave_s_) {
  const int tid = TIDX(), wave = tid >> 6, lane = tid & 63, r = lane & 31, hh = lane >> 5;
  char* sq = shm;
  char* sk = shm + 16896;
  char* sQa = shm + 33792;
  char* sKb = shm + 50688;
  float* sBC = (float*)(shm + 67584);
  float* sgl = (float*)(shm + 133120);
  const u16* qk1 = (const u16*)(p.ws + OFF_QK1);
  const float* gl = (const float*)(p.ws + OFF_ABT);
  u16* QD = (u16*)(p.ws + OFF_QD);
  u16* AS = (u16*)(p.ws + OFF_ASUM);
  float* CD = (float*)(p.ws + OFF_CD1);
  const float qscale = 0.08838834764831845f;
  for (int item = blockIdx.x; item < NCHUNK * 4; item += gridDim.x) {
    const int ci = item >> 2, h = item & 3, row0 = ci * 64;
#pragma unroll
    for (int u = 0; u < 2; ++u) {
      const int chunk = tid * 2 + u, c = chunk >> 4, cc = (chunk & 15) * 8;
      const u16* src = qk1 + (size_t)(row0 + c) * 1024 + h * 128 + cc;
      u32x4 vq = *(const u32x4*)src, vk = *(const u32x4*)(src + 512);
      st8(sq + c * 264 + cc * 2, vq);
      st8(sk + c * 264 + cc * 2, vk);
    }
    {
      const int rr = tid >> 3, cc = (tid & 7) * 4;
      *(f32x4*)(sgl + rr * 32 + cc) = *(const f32x4*)(gl + (size_t)(row0 + rr) * 32 + cc);
    }
    __syncthreads();
    {
      const int kk = tid & 127, d = (tid >> 7) & 1, chalf = tid >> 8;
      float w[16];
#pragma unroll
      for (int q = 0; q < 16; ++q) w[q] = p.gla_w_g2[(d * 16 + q) * 512 + h * 128 + kk];
      const float bg = p.gla_b_g[d * 512 + h * 128 + kk];
#pragma unroll 4
      for (int cc = 0; cc < 32; ++cc) {
        const int c = chalf * 32 + cc;
        const f32x4* gp = (const f32x4*)(sgl + c * 32 + d * 16);
        const f32x4 g0 = gp[0], g1 = gp[1], g2 = gp[2], g3 = gp[3];
        float z = bg;
        z += g0.x * w[0] + g0.y * w[1] + g0.z * w[2] + g0.w * w[3];
        z += g1.x * w[4] + g1.y * w[5] + g1.z * w[6] + g1.w * w[7];
        z += g2.x * w[8] + g2.y * w[9] + g2.z * w[10] + g2.w * w[11];
        z += g3.x * w[12] + g3.y * w[13] + g3.z * w[14] + g3.w * w[15];
        sBC[(d * 64 + c) * 128 + kk] = (fminf(z, 0.f) - __logf(1.f + __expf(-fabsf(z)))) * (1.f / 16.f);
      }
    }
    __syncthreads();
    if (tid < 256) {
      const int d = tid >> 7, kk = tid & 127;
      float* col = sBC + d * 64 * 128 + kk;
      float v[64];
#pragma unroll
      for (int c = 0; c < 64; ++c) v[c] = col[c * 128];
      if (d == 0) {
        float acc = 0.f;
#pragma unroll
        for (int c = 0; c < 64; ++c) { acc += v[c]; col[c * 128] = acc; }
      } else {
        float acc = 0.f;
#pragma unroll
        for (int c = 63; c >= 0; --c) { acc += v[c]; col[c * 128] = acc; }
      }
    }
    __syncthreads();
    f32x16 asum;
    for (int i = 0; i < 16; ++i) asum[i] = 0.f;
    for (int d = 0; d < 2; ++d) {
      const int cref = d ? 31 : 32, clast = d ? 0 : 63;
      const float* bcd = sBC + d * 64 * 128;
      u16* qd_o = QD + ((size_t)item * 2 + d) * 16384;
      float er[8], ern[8];
      {
        const int k0 = (tid & 15) * 8;
#pragma unroll
        for (int e = 0; e < 8; ++e) { const float rf = bcd[cref * 128 + k0 + e]; er[e] = __expf(rf); ern[e] = __expf(-rf); }
      }
      for (int v = tid; v < 1024; v += 512) {
        const int c = v >> 4, k0 = (v & 15) * 8;
        const u32x4 qv = *(const u32x4*)(sq + c * 264 + k0 * 2), kv = *(const u32x4*)(sk + c * 264 + k0 * 2);
        const unsigned qa[4] = {qv.x, qv.y, qv.z, qv.w}, ka[4] = {kv.x, kv.y, kv.z, kv.w};
        float oqa[8], okb[8], oqd[8];
#pragma unroll
        for (int e = 0; e < 8; ++e) {
          const float ebc = __expf(bcd[c * 128 + k0 + e]);
          const float qf = ((e & 1) ? bfhi(qa[e >> 1]) : bflo(qa[e >> 1])) * qscale;
          const float kf = (e & 1) ? bfhi(ka[e >> 1]) : bflo(ka[e >> 1]);
          oqd[e] = qf * ebc;
          oqa[e] = oqd[e] * ern[e];
          okb[e] = kf * er[e] * __builtin_amdgcn_rcpf(ebc);
        }
        st8(sQa + c * 264 + k0 * 2, (u32x4){pk2(oqa[0], oqa[1]), pk2(oqa[2], oqa[3]), pk2(oqa[4], oqa[5]), pk2(oqa[6], oqa[7])});
        st8(sKb + c * 264 + k0 * 2, (u32x4){pk2(okb[0], okb[1]), pk2(okb[2], okb[3]), pk2(okb[4], okb[5]), pk2(okb[6], okb[7])});
        *(u32x4*)(qd_o + c * 128 + k0) = (u32x4){pk2(oqd[0], oqd[1]), pk2(oqd[2], oqd[3]), pk2(oqd[4], oqd[5]), pk2(oqd[6], oqd[7])};
      }
      for (int v = tid; v < 1024; v += 512) {
        const int kk = v >> 3, c0 = (v & 7) * 8;
        const float last = bcd[clast * 128 + kk];
        float o[8];
#pragma unroll
        for (int e = 0; e < 8; ++e) {
          const int c = c0 + e;
          const float kf = bf2f(*(const u16*)(sk + c * 264 + kk * 2));
          o[e] = kf * __expf(last - bcd[c * 128 + kk]);
        }
        *(u32x4*)(qd_o + 8192 + kk * 64 + c0) = (u32x4){pk2(o[0], o[1]), pk2(o[2], o[3]), pk2(o[4], o[5]), pk2(o[6], o[7])};
      }
      if (tid < 128) CD[((size_t)item * 2 + d) * 128 + tid] = __expf(bcd[clast * 128 + tid]);
      __syncthreads();
      if (wave < 4) {
        const int tm = wave >> 1, tn = wave & 1;
        f32x16 acc;
        for (int i = 0; i < 16; ++i) acc[i] = 0.f;
#pragma unroll
        for (int s = 0; s < 8; ++s) {
          s16x8 a = ldA_nat(sQa, 32 * tm + r, 264, 16 * s, hh), bb = ldA_nat(sKb, 32 * tn + r, 264, 16 * s, hh);
          acc = MFMA32(a, bb, acc);
        }
#pragma unroll
        for (int i = 0; i < 16; ++i) {
          const int ii = 32 * tm + crow(i, hh), jj = 32 * tn + r;
          const bool keep = d ? (ii <= jj) : (ii >= jj);
          asum[i] += keep ? acc[i] : 0.f;
        }
      }
      __syncthreads();
    }
    if (wave < 4) {
      const int tm = wave >> 1, tn = wave & 1;
#pragma unroll
      for (int i = 0; i < 16; ++i) AS[(size_t)item * 4096 + (32 * tm + crow(i, hh)) * 64 + 32 * tn + r] = f2bf(asum[i]);
    }
  }
}

template <int GROUP>
DI void yg_phase(u16* o0, const u16* o1, const u16* z, const u16* zctx, const float* ng, int nrows, const int wave_s_) {
  const int gt = blockIdx.x * 512 + TIDX(), nthr = gridDim.x * 512;
  const int total = nrows * 256;
  for (int idx0 = gt; idx0 < total; idx0 += 2 * nthr) {
    const bool ok1 = idx0 + nthr < total;
    u32x4 a[2], bq[2], zz[2];
#pragma unroll
    for (int u = 0; u < 2; ++u) {
      const int idx = (u == 0 || ok1) ? idx0 + u * nthr : idx0;
      const size_t off = (size_t)(idx >> 8) * 2048 + (idx & 255) * 8;
      const int zrow = idx >> 8;
      const u16* zp = (zrow < RL) ? z + off : zctx + (size_t)(zrow - RL) * 2048 + (idx & 255) * 8;
      a[u] = __builtin_nontemporal_load((const u32x4*)(o0 + off)); bq[u] = __builtin_nontemporal_load((const u32x4*)(o1 + off)); zz[u] = __builtin_nontemporal_load((const u32x4*)zp);
    }
#pragma unroll
    for (int u = 0; u < 2; ++u) {
      if (u == 1 && !ok1) break;
      const int idx = idx0 + u * nthr, ch = (idx & 255) * 8;
      const size_t off = (size_t)(idx >> 8) * 2048 + ch;
      float o[8] = {bflo(a[u].x) + bflo(bq[u].x), bfhi(a[u].x) + bfhi(bq[u].x), bflo(a[u].y) + bflo(bq[u].y), bfhi(a[u].y) + bfhi(bq[u].y),
                    bflo(a[u].z) + bflo(bq[u].z), bfhi(a[u].z) + bfhi(bq[u].z), bflo(a[u].w) + bflo(bq[u].w), bfhi(a[u].w) + bfhi(bq[u].w)};
      const float zf[8] = {bflo(zz[u].x), bfhi(zz[u].x), bflo(zz[u].y), bfhi(zz[u].y), bflo(zz[u].z), bfhi(zz[u].z), bflo(zz[u].w), bfhi(zz[u].w)};
      float ss = 0.f;
#pragma unroll
      for (int e = 0; e < 8; ++e) ss += o[e] * o[e];
#pragma unroll
      for (int of = 1; of < GROUP; of <<= 1) ss += __shfl_xor(ss, of, 64);
      const float rstd = rsqrtf(ss * (1.f / (GROUP * 8)) + EPSF);
      const int gi = ch & (GROUP * 8 - 1);
      const f32x4 g0 = *(const f32x4*)(ng + gi), g1 = *(const f32x4*)(ng + gi + 4);
      const float gg[8] = {g0.x, g0.y, g0.z, g0.w, g1.x, g1.y, g1.z, g1.w};
#pragma unroll
      for (int e = 0; e < 8; ++e) o[e] = o[e] * rstd * gg[e] * siluf(zf[e]);
      *(u32x4*)(o0 + off) = (u32x4){pk2(o[0], o[1]), pk2(o[2], o[3]), pk2(o[4], o[5]), pk2(o[6], o[7])};
    }
  }
}

DI void final_phase(float* out, const float* g, const int wave_s_) {
  const int tidx_ = TIDX();
  const int lane = tidx_ & 63, gw = blockIdx.x * 8 + (tidx_ >> 6), nw = gridDim.x * 8;
  for (int row0 = gw; row0 < RL; row0 += 2 * nw) {
    const int rows[2] = {row0, row0 + nw};
    const bool ok1 = rows[1] < RL;
    f32x4 v[2][4];
#pragma unroll
    for (int u = 0; u < 2; ++u) {
      const float* s = out + (size_t)((u == 0 || ok1) ? rows[u] : rows[0]) * DM;
#pragma unroll
      for (int q = 0; q < 4; ++q) v[u][q] = __builtin_nontemporal_load((const f32x4*)(s + q * 256 + lane * 4));
    }
#pragma unroll
    for (int u = 0; u < 2; ++u) {
      if (u == 1 && !ok1) break;
      float* s = out + (size_t)rows[u] * DM;
      float ss = 0.f;
#pragma unroll
      for (int q = 0; q < 4; ++q) ss += v[u][q].x * v[u][q].x + v[u][q].y * v[u][q].y + v[u][q].z * v[u][q].z + v[u][q].w * v[u][q].w;
      ss = wave_sum(ss);
      const float rstd = rsqrtf(ss * (1.f / 1024.f) + EPSF);
#pragma unroll
      for (int q = 0; q < 4; ++q) {
        const f32x4 gg = *(const f32x4*)(g + q * 256 + lane * 4);
        f32x4 o = {v[u][q].x * rstd * gg.x, v[u][q].y * rstd * gg.y, v[u][q].z * rstd * gg.z, v[u][q].w * rstd * gg.w};
        __builtin_nontemporal_store(o, (f32x4*)(s + q * 256 + lane * 4));
      }
    }
  }
}

#define XB_XSUB(j)  (64 * (j))
#define XB_XGEN(j)  (1024 + 64 * (j))
#define XB_TOP      2048
#define XB_TOPGEN   2112
#define XCD_BAR_WORDS 2176
DI unsigned xb_ld(unsigned* p) { return __hip_atomic_load(p, __ATOMIC_RELAXED, __HIP_MEMORY_SCOPE_AGENT); }
DI unsigned xb_add(unsigned* p, unsigned v) { return __hip_atomic_fetch_add(p, v, __ATOMIC_RELAXED, __HIP_MEMORY_SCOPE_AGENT); }
DI void gbar(char* ws, const int wave_s_) {
  asm volatile("s_waitcnt vmcnt(0)" ::: "memory");
  __syncthreads();
  if (wave_s_ == 0 && lane_id() == 0) {
    unsigned* bar = (unsigned*)(ws + OFF_BAR);
    __builtin_amdgcn_s_waitcnt(0);
    const unsigned x = (unsigned)__builtin_amdgcn_s_getreg((3 << 11) | 20) & 0xFu;
    const unsigned nloc = gridDim.x >> 3, nx = 8u;
    const unsigned old = xb_add(&bar[XB_XSUB(x)], 1u);
    const unsigned gen = old / nloc;
    if (old + 1u == (gen + 1u) * nloc) {
      __builtin_amdgcn_fence(__ATOMIC_RELEASE, "agent");
      asm volatile("s_waitcnt vmcnt(0)" ::: "memory");
      const unsigned og = xb_add(&bar[XB_TOP], 1u);
      const unsigned tg = og / nx;
      if (og + 1u == (tg + 1u) * nx) xb_add(&bar[XB_TOPGEN], 1u);
      else while (xb_ld(&bar[XB_TOPGEN]) == tg) __builtin_amdgcn_s_sleep(1);
      __builtin_amdgcn_fence(__ATOMIC_ACQUIRE, "agent");
      xb_add(&bar[XB_XGEN(x)], 1u);
      asm volatile("s_waitcnt vmcnt(0)" ::: "memory");
    } else {
      while (xb_ld(&bar[XB_XGEN(x)]) == gen) __builtin_amdgcn_s_sleep(1);
      __builtin_amdgcn_fence(__ATOMIC_ACQUIRE, "agent");
      asm volatile("s_waitcnt vmcnt(0)" ::: "memory");
    }
  }
  __syncthreads();
}
#ifndef REP_GEMM
#define REP_GEMM 1
#endif
#ifndef REP_PREP
#define REP_PREP 1
#endif
#ifndef REP_GLP
#define REP_GLP 1
#endif
#ifndef REP_SCAN
#define REP_SCAN 0
#endif
#ifndef REP_SYNC
#define REP_SYNC 0
#endif
#ifndef REP_EW
#define REP_EW 1
#endif
__global__ void __launch_bounds__(512, 2) fwd_megakernel(Params p) {
  __shared__ __attribute__((aligned(1024))) char shm[141312];
  cg::grid_group grid = cg::this_grid();
  const int wave_s_ = __builtin_amdgcn_readfirstlane((int)(threadIdx.x >> 6));
  char* ws = p.ws;
  float* mods = (float*)(ws + OFF_MOD);
  u16* W0T = (u16*)(ws + OFF_W0T);
  u16* WO0T = (u16*)(ws + OFF_WO0T);
  u16* W1T = (u16*)(ws + OFF_W1T);
  u16* WO1T = (u16*)(ws + OFF_WO1T);
  u16* outb = (u16*)p.out;
  float* ctx1 = (float*)(ws + OFF_X);

  mods_phase(shm, p, wave_s_);
  wtrans_phase<0>(shm, p, wave_s_);
  if (gridDim.x == 256) gbar(ws, wave_s_); else grid.sync();
  {
    u16* H0 = (u16*)(ws + OFF_T);
    h_phase(p.x, p.ctx, p.norm_g, mods, H0, R, wave_s_);
    gbar(ws, wave_s_);
#if REP_EW > 1
    h_phase(p.x, p.ctx, p.norm_g, mods, H0, R, wave_s_);
    gbar(ws, wave_s_);
#endif
    small_gemm(H0, W0T + (size_t)6144 * 1024, (float*)(ws + OFF_ABT), wave_s_);
    EpiArgs e{};
    e.mode = 0; e.lat = outb; e.ctx = (u16*)(ws + OFF_X); e.ld = 2048;
    gemm_phase<0>(shm, H0, H0 + (size_t)RL * 1024, 1024, W0T, 0, 128, 8, e, wave_s_);
    {
      EpiArgs ec{};
      ec.mode = 4; ec.ctx = (u16*)(ws + OFF_X);
      gemm_phase<4>(shm, H0, H0 + (size_t)RL * 1024, 1024, W0T, 128, 4, 24, ec, wave_s_);
    }
    gbar(ws, wave_s_);
#if REP_GEMM > 1
    gemm_phase<0>(shm, H0, H0 + (size_t)RL * 1024, 1024, W0T, 0, 132, 8, e, wave_s_);
    gbar(ws, wave_s_);
#endif
    conv_phase<false>(p, wave_s_);
    gbar(ws, wave_s_);
#if REP_EW > 1
    conv_phase<false>(p, wave_s_);
    gbar(ws, wave_s_);
#endif
    gemm_phase<0>(shm, H0, H0 + (size_t)RL * 1024, 1024, W0T + (size_t)2048 * 1024, 0, 128, 8, e, wave_s_);
    gbar(ws, wave_s_);
#if REP_GEMM > 1
    gemm_phase<0>(shm, H0, H0 + (size_t)RL * 1024, 1024, W0T + (size_t)2048 * 1024, 0, 132, 8, e, wave_s_);
    gbar(ws, wave_s_);
#endif
    conv_phase<true>(p, wave_s_);
    gbar(ws, wave_s_);
#if REP_EW > 1
    conv_phase<true>(p, wave_s_);
    gbar(ws, wave_s_);
#endif
    for (int rep_ = 0; rep_ < REP_PREP; ++rep_) {
    dn_prep_phase(shm, p, wave_s_);
    gbar(ws, wave_s_);
    }
    for (int rep_ = 0; rep_ < REP_SCAN; ++rep_) { scan_phase<true, true>(shm, p, wave_s_); gbar(ws, wave_s_); }
    for (int rep_ = 0; rep_ < REP_SYNC; ++rep_) gbar(ws, wave_s_);
    scan_phase<true>(shm, p, wave_s_);
    gbar(ws, wave_s_);
    u16* H0b = H0;
    u16* Z = (u16*)(ws + OFF_QK0);
    EpiArgs ez{};
    ez.mode = 0; ez.lat = Z; ez.ctx = Z + (size_t)RL * 2048; ez.ld = 2048;
    gemm_phase<0>(shm, H0b, H0b + (size_t)RL * 1024, 1024, W0T + (size_t)4096 * 1024, 0, 128, 8, ez, wave_s_);
    gbar(ws, wave_s_);
#if REP_GEMM > 1
    gemm_phase<0>(shm, H0b, H0b + (size_t)RL * 1024, 1024, W0T + (size_t)4096 * 1024, 0, 132, 8, ez, wave_s_);
    gbar(ws, wave_s_);
#endif
    u16* U0 = (u16*)(ws + OFF_U0);
    yg_phase<32>(U0, (const u16*)(ws + OFF_U1), Z, (const u16*)(ws + OFF_ZC), p.dn_norm_g, R, wave_s_);
    gbar(ws, wave_s_);
    EpiArgs eo{};
    eo.mode = 2; eo.res_lat = p.x; eo.res_ctx = p.ctx; eo.mods_i = mods; eo.out_lat = p.out; eo.out_ctx = ctx1;
    wtrans_phase<1>(shm, p, wave_s_, true);
    gemm_phase<2>(shm, U0, U0 + (size_t)RL * 2048, 2048, WO0T, 0, 132, 4, eo, wave_s_);
    gbar(ws, wave_s_);
#if REP_GEMM > 1
    gemm_phase<2>(shm, U0, U0 + (size_t)RL * 2048, 2048, WO0T, 0, 132, 4, eo, wave_s_);
    gbar(ws, wave_s_);
#endif
  }
  {
    const float* mods1 = mods + 5 * 3072;
    u16* H1 = (u16*)(ws + OFF_QD);
    h_phase(p.out, ctx1, p.norm_g + 1024, mods1, H1, R, wave_s_);
    gbar(ws, wave_s_);
    small_gemm(H1, W1T + (size_t)5120 * 1024, (float*)(ws + OFF_ABT), wave_s_);
    EpiArgs e{};
    e.mode = 1; e.lat = (u16*)(ws + OFF_QK1); e.b1 = (u16*)(ws + OFF_V0); e.b2 = (u16*)(ws + OFF_V1);
    gemm_phase<1>(shm, H1, H1 + (size_t)RL * 1024, 1024, W1T, 0, 132, 12, e, wave_s_);
    gbar(ws, wave_s_);
    for (int rep_ = 0; rep_ < REP_GLP; ++rep_) {
    gla_prep_phase(shm, p, wave_s_);
    gbar(ws, wave_s_);
    }
    for (int rep_ = 0; rep_ < REP_SCAN; ++rep_) { scan_phase<false, true>(shm, p, wave_s_); gbar(ws, wave_s_); }
    scan_phase<false>(shm, p, wave_s_);
    u16* H1b = (u16*)(ws + OFF_QK1);
    h_phase(p.out, ctx1, p.norm_g + 1024, mods1, H1b, RL, wave_s_);
    gbar(ws, wave_s_);
    u16* RB = (u16*)(ws + OFF_QD);
    EpiArgs er{};
    er.mode = 0; er.lat = RB; er.ctx = RB; er.ld = 2048;
    gemm_phase<0>(shm, H1b, H1b, 1024, W1T + (size_t)3072 * 1024, 0, 128, 8, er, wave_s_);
    gbar(ws, wave_s_);
    u16* V0 = (u16*)(ws + OFF_V0);
    yg_phase<64>(V0, (const u16*)(ws + OFF_V1), RB, RB, p.gla_norm_g, RL, wave_s_);
    gbar(ws, wave_s_);
    EpiArgs eo{};
    eo.mode = 2; eo.res_lat = p.out; eo.res_ctx = p.out; eo.mods_i = mods1; eo.out_lat = p.out; eo.out_ctx = p.out;
    gemm_phase<2>(shm, V0, V0, 2048, WO1T, 0, 128, 4, eo, wave_s_);
    gbar(ws, wave_s_);
    final_phase(p.out, p.final_g, wave_s_);
  }
}

extern "C" void kernel_launch(void* const* d_in, const int* in_sizes, int n_in, void* d_out, int out_size, void* d_ws,
                              size_t ws_size, hipStream_t stream) {
  static int grid_blocks = 0;
  if (!grid_blocks) {
    int dev = 0, cus = 0, per_cu = 0;
    hipGetDevice(&dev);
    hipDeviceGetAttribute(&cus, hipDeviceAttributeMultiprocessorCount, dev);
    hipOccupancyMaxActiveBlocksPerMultiprocessor(&per_cu, fwd_megakernel, 512, 0);
    if (per_cu < 1) per_cu = 1;
    grid_blocks = cus;
    if (grid_blocks > 256) grid_blocks = 256;
  }
  Params p{};
  p.x = (const float*)d_in[0]; p.c = (const float*)d_in[1]; p.ctx = (const float*)d_in[2]; p.c_ctx = (const float*)d_in[3];
  p.mod_w = (const float*)d_in[4]; p.mod_b = (const float*)d_in[5]; p.norm_g = (const float*)d_in[6];
  p.dn_w_in = (const float*)d_in[7]; p.dn_conv_w = (const float*)d_in[8]; p.dn_a_log = (const float*)d_in[9];
  p.dn_dt_bias = (const float*)d_in[10]; p.dn_norm_g = (const float*)d_in[11]; p.dn_w_out = (const float*)d_in[12];
  p.gla_w_in = (const float*)d_in[13]; p.gla_w_g2 = (const float*)d_in[14]; p.gla_b_g = (const float*)d_in[15];
  p.gla_norm_g = (const float*)d_in[16]; p.gla_w_out = (const float*)d_in[17]; p.final_g = (const float*)d_in[18];
  p.out = (float*)d_out;
  p.ws = (char*)d_ws;
  (void)hipMemsetAsync((char*)d_ws + OFF_BAR, 0, XCD_BAR_WORDS * sizeof(unsigned), stream);
  void* args[] = {&p};
  hipError_t e = hipLaunchCooperativeKernel((void*)fwd_megakernel, dim3(grid_blocks), dim3(512), args, 0, stream);
  if (e != hipSuccess) fprintf(stderr, "cooperative launch failed: %s (grid %d)\n", hipGetErrorString(e), grid_blocks);
}
```

```cpp
#include <hip/hip_runtime.h>
#include <hip/hip_cooperative_groups.h>
#include <cstdio>
namespace cg = cooperative_groups;

#define DI __device__ __forceinline__
typedef unsigned short u16;
typedef short s16x8 __attribute__((ext_vector_type(8)));
typedef short s16x4 __attribute__((ext_vector_type(4)));
typedef float f32x2 __attribute__((ext_vector_type(2)));
typedef float f32x4 __attribute__((ext_vector_type(4)));
typedef float f32x16 __attribute__((ext_vector_type(16)));
typedef int i32x4 __attribute__((ext_vector_type(4)));
typedef unsigned u32x2 __attribute__((ext_vector_type(2)));
typedef unsigned u32x4 __attribute__((ext_vector_type(4)));
typedef __bf16 bf2_t __attribute__((ext_vector_type(2)));

constexpr int RL = 32768;
constexpr int RC = 1024;
constexpr int R = RL + RC;
constexpr int DM = 1024;
constexpr int NCHUNK = R / 64;
constexpr float EPSF = 1e-6f;
constexpr size_t MiB = 1u << 20;

constexpr size_t OFF_QK0 = 0;
constexpr size_t OFF_U0 = 132 * MiB;
constexpr size_t OFF_U1 = 264 * MiB;
constexpr size_t OFF_T = 396 * MiB;
constexpr size_t OFF_W1T = 462 * MiB;
constexpr size_t OFF_WO1T = OFF_W1T + 10 * MiB + 256 * 1024;
constexpr size_t OFF_MOD = OFF_WO1T + 4 * MiB;
constexpr size_t OFF_X = OFF_MOD + 256 * 1024;
constexpr size_t OFF_ABT = OFF_X + 8 * MiB + 256 * 1024;
constexpr size_t OFF_W0T = OFF_ABT + 4 * MiB + 256 * 1024;
constexpr size_t OFF_WO0T = OFF_W0T + 12 * MiB + 256 * 1024;
constexpr size_t OFF_V0 = 0;
constexpr size_t OFF_V1 = 132 * MiB;
constexpr size_t OFF_QK1 = 264 * MiB;
constexpr size_t OFF_QD = 330 * MiB;
constexpr size_t OFF_CD1 = OFF_X + 4 * MiB;
constexpr size_t OFF_ASUM = OFF_W0T;
constexpr size_t OFF_BAR = 506 * MiB;
constexpr size_t OFF_ZC = 507 * MiB;

constexpr size_t TA_LAT_ITEMS = 4096;
constexpr size_t OFF_TC = 462 * MiB;
constexpr size_t OFF_AC = 464 * MiB;
DI size_t ta_off(size_t item, int d) { return ((item < TA_LAT_ITEMS ? item : item - TA_LAT_ITEMS) * 2 + d) * 4096; }
struct Params {
  const float *x, *c, *ctx, *c_ctx, *mod_w, *mod_b, *norm_g, *dn_w_in, *dn_conv_w, *dn_a_log, *dn_dt_bias, *dn_norm_g,
      *dn_w_out, *gla_w_in, *gla_w_g2, *gla_b_g, *gla_norm_g, *gla_w_out, *final_g;
  float* out;
  char* ws;
};

DI unsigned pk2(float lo, float hi) { f32x2 v = {lo, hi}; return __builtin_bit_cast(unsigned, __builtin_convertvector(v, bf2_t)); }
DI float bflo(unsigned u) { return __uint_as_float(u << 16); }
DI float bfhi(unsigned u) { return __uint_as_float(u & 0xffff0000u); }
DI float bf2f(u16 v) { return __uint_as_float(((unsigned)v) << 16); }
DI u16 f2bf(float x) { return (u16)(pk2(x, 0.f) & 0xffffu); }
DI float siluf(float x) { return x / (1.f + __expf(-x)); }
DI float sigmoidf(float x) { return 1.f / (1.f + __expf(-x)); }
DI float softplusf(float x) { return fmaxf(x, 0.f) + __logf(1.f + __expf(-fabsf(x))); }
DI int crow(int reg, int h) { return (reg & 3) + 8 * (reg >> 2) + 4 * h; }
#define MFMA32(a, b, c) __builtin_amdgcn_mfma_f32_32x32x16_bf16((a), (b), (c), 0, 0, 0)
#define MFMA16(a, b, c) __builtin_amdgcn_mfma_f32_16x16x32_bf16((a), (b), (c), 0, 0, 0)

DI s16x8 cat8(u32x2 lo, u32x2 hi) { u32x4 v = {lo.x, lo.y, hi.x, hi.y}; return __builtin_bit_cast(s16x8, v); }
DI s16x8 ldA_perm(const char* base, int row, int strideB, int kofs, int h) {
  const char* p = base + row * strideB + (kofs + 4 * h) * 2;
  u32x2 lo = *(const u32x2*)p, hi = *(const u32x2*)(p + 16);
  return cat8(lo, hi);
}
DI s16x8 ldA_nat(const char* base, int row, int strideB, int kofs, int h) {
  const char* p = base + row * strideB + (kofs + 8 * h) * 2;
  u32x2 lo = *(const u32x2*)p, hi = *(const u32x2*)(p + 8);
  return cat8(lo, hi);
}
DI s16x8 pack_step(const f32x16& x, int s) {
  u32x4 p;
  p.x = pk2(x[8 * s + 0], x[8 * s + 1]); p.y = pk2(x[8 * s + 2], x[8 * s + 3]);
  p.z = pk2(x[8 * s + 4], x[8 * s + 5]); p.w = pk2(x[8 * s + 6], x[8 * s + 7]);
  return __builtin_bit_cast(s16x8, p);
}
DI void st8(char* p, u32x4 v) { *(u32x2*)p = (u32x2){v.x, v.y}; *(u32x2*)(p + 8) = (u32x2){v.z, v.w}; }
DI u32x4 scale8(u32x4 v, float s) {
  u32x4 o;
  o.x = pk2(bflo(v.x) * s, bfhi(v.x) * s); o.y = pk2(bflo(v.y) * s, bfhi(v.y) * s);
  o.z = pk2(bflo(v.z) * s, bfhi(v.z) * s); o.w = pk2(bflo(v.w) * s, bfhi(v.w) * s);
  return o;
}
DI int opq_v(int v) { asm volatile("" : "+v"(v)); return v; }
DI int lane_id() { int r; asm volatile("v_mbcnt_lo_u32_b32 %0, -1, 0\n\tv_mbcnt_hi_u32_b32 %0, -1, %0" : "=v"(r)); return r; }
#define TIDX() (wave_s_ * 64 + lane_id())
DI float wave_sum(float v) {
#pragma unroll
  for (int o = 32; o >= 1; o >>= 1) v += __shfl_xor(v, o, 64);
  return v;
}

DI void mods_phase(char* shm, const Params& p, const int wave_s_) {
  const int bid = blockIdx.x, tid = TIDX();
  float* mods = (float*)(p.ws + OFF_MOD);
  if (bid < 192) {
    float* scond = (float*)shm;
    float* red = scond + 5 * 1024;
    for (int e = tid; e < 5 * 1024; e += 512) {
      int r = e >> 10, k = e & 1023;
      float v = (r < 4) ? p.c[r * 1024 + k] : p.c_ctx[k];
      scond[e] = siluf(v);
    }
    __syncthreads();
    const int i = bid / 96, jt = bid % 96, jl = tid & 31, ks = tid >> 5;
    const float* w = p.mod_w + (size_t)i * 1024 * 3072 + jt * 32 + jl;
    float a0 = 0, a1 = 0, a2 = 0, a3 = 0, a4 = 0;
#pragma unroll 8
    for (int kk = 0; kk < 64; ++kk) {
      int k = ks * 64 + kk;
      float wv = __builtin_nontemporal_load(w + (size_t)k * 3072);
      a0 += scond[k] * wv; a1 += scond[1024 + k] * wv; a2 += scond[2048 + k] * wv; a3 += scond[3072 + k] * wv; a4 += scond[4096 + k] * wv;
    }
    red[(ks * 5 + 0) * 32 + jl] = a0; red[(ks * 5 + 1) * 32 + jl] = a1; red[(ks * 5 + 2) * 32 + jl] = a2;
    red[(ks * 5 + 3) * 32 + jl] = a3; red[(ks * 5 + 4) * 32 + jl] = a4;
    __syncthreads();
    if (tid < 160) {
      int r = tid >> 5, j = tid & 31;
      float s = p.mod_b[i * 3072 + jt * 32 + j];
      for (int q = 0; q < 16; ++q) s += red[(q * 5 + r) * 32 + j];
      mods[(i * 5 + r) * 3072 + jt * 32 + j] = s;
    }
    __syncthreads();
  }
}

DI void wtrans_tile(char* shm, const float* src, int K, int N, u16* dst, int tile, const int wave_s_) {
  u16* t = (u16*)shm;
  const int tid = TIDX();
  const int tn = (N + 63) / 64;
  const int k0 = (tile / tn) * 64, n0 = (tile % tn) * 64;
#pragma unroll
  for (int q = 0; q < 2; ++q) {
    const int e = tid + q * 512, kk = e >> 4, nn = (e & 15) * 4;
    f32x4 v = {0.f, 0.f, 0.f, 0.f};
    if (n0 + nn < N) v = __builtin_nontemporal_load((const f32x4*)(src + (size_t)(k0 + kk) * N + n0 + nn));
    t[(nn + 0) * 72 + kk] = f2bf(v.x); t[(nn + 1) * 72 + kk] = f2bf(v.y);
    t[(nn + 2) * 72 + kk] = f2bf(v.z); t[(nn + 3) * 72 + kk] = f2bf(v.w);
  }
  __syncthreads();
  {
    const int nn = tid >> 3, kk = (tid & 7) * 8;
    if (n0 + nn < N) *(u32x4*)(dst + (size_t)(n0 + nn) * K + k0 + kk) = *(const u32x4*)(t + nn * 72 + kk);
  }
  __syncthreads();
}
template <int LAYER>
DI void wtrans_phase(char* shm, const Params& p, const int wave_s_, const int xmin = 0) {
  const int t0 = 16 * 97, t1 = 32 * 16, t2 = 16 * 81, t3 = 32 * 16;
  int b = blockIdx.x, nb = gridDim.x;
  if (xmin > 0) { if ((b & 7) < xmin) return; b = (b >> 3) * (8 - xmin) + (b & 7) - xmin; nb = (nb >> 3) * (8 - xmin); }
  if (LAYER == 0) {
    for (int tile = b; tile < t0; tile += nb) wtrans_tile(shm, p.dn_w_in, 1024, 6176, (u16*)(p.ws + OFF_W0T), tile, wave_s_);
  } else if (LAYER == 2) {
    for (int tile = b; tile < t1; tile += nb) wtrans_tile(shm, p.dn_w_out, 2048, 1024, (u16*)(p.ws + OFF_WO0T), tile, wave_s_);
  } else {
    for (int tile = b; tile < t2 + t3; tile += nb) {
      if (tile < t2) wtrans_tile(shm, p.gla_w_in, 1024, 5152, (u16*)(p.ws + OFF_W1T), tile, wave_s_);
      else wtrans_tile(shm, p.gla_w_out, 2048, 1024, (u16*)(p.ws + OFF_WO1T), tile - t2, wave_s_);
    }
  }
}

DI void h_phase(const float* src_lat, const float* src_ctx, const float* g, const float* mods_i, u16* dst, int nrows, const int wave_s_) {
  const int tidx_ = TIDX();
  const int lane = tidx_ & 63, gw = blockIdx.x * 8 + (tidx_ >> 6), nw = gridDim.x * 8;
  for (int row0 = gw; row0 < nrows; row0 += 2 * nw) {
    const int rows[2] = {row0, row0 + nw};
    const bool ok1 = rows[1] < nrows;
    f32x4 v[2][4];
#pragma unroll
    for (int u = 0; u < 2; ++u) {
      const int row = (u == 0 || ok1) ? rows[u] : rows[0];
      const float* s = (row < RL) ? src_lat + (size_t)row * DM : src_ctx + (size_t)(row - RL) * DM;
#pragma unroll
      for (int q = 0; q < 4; ++q) v[u][q] = __builtin_nontemporal_load((const f32x4*)(s + q * 256 + lane * 4));
    }
#pragma unroll
    for (int u = 0; u < 2; ++u) {
      if (u == 1 && !ok1) break;
      const int row = rows[u];
      const int mr = (row < RL) ? (row >> 13) : 4;
      const float* sh = mods_i + mr * 3072;
      const float* sc = sh + 1024;
      float ss = 0.f;
#pragma unroll
      for (int q = 0; q < 4; ++q) ss += v[u][q].x * v[u][q].x + v[u][q].y * v[u][q].y + v[u][q].z * v[u][q].z + v[u][q].w * v[u][q].w;
      ss = wave_sum(ss);
      const float rstd = rsqrtf(ss * (1.f / 1024.f) + EPSF);
#pragma unroll
      for (int q = 0; q < 4; ++q) {
        const int col = q * 256 + lane * 4;
        f32x4 gg = *(const f32x4*)(g + col), s1 = *(const f32x4*)(sc + col), s0 = *(const f32x4*)(sh + col);
        float o0 = v[u][q].x * rstd * gg.x * (1.f + s1.x) + s0.x, o1 = v[u][q].y * rstd * gg.y * (1.f + s1.y) + s0.y;
        float o2 = v[u][q].z * rstd * gg.z * (1.f + s1.z) + s0.z, o3 = v[u][q].w * rstd * gg.w * (1.f + s1.w) + s0.w;
        *(u32x2*)(dst + (size_t)row * DM + col) = (u32x2){pk2(o0, o1), pk2(o2, o3)};
      }
    }
  }
}

DI void small_gemm(const u16* A, const u16* Wt, float* out, const int wave_s_) {
  const int tidx_ = TIDX();
  if ((blockIdx.x & 7) < 3) return;
  const int bsub = ((int)blockIdx.x >> 3) * 5 + ((int)(blockIdx.x & 7) - 3);
  const int lane = tidx_ & 63, gw = bsub * 8 + (tidx_ >> 6), nw = ((int)gridDim.x >> 3) * 5 * 8;
  const int r = lane & 31, h = lane >> 5;
  for (int wt = gw; wt < R / 32; wt += nw) {
    const u16* ap = A + (size_t)(wt * 32 + r) * 1024 + 8 * h;
    const u16* bp = Wt + (size_t)r * 1024 + 8 * h;
    f32x16 acc;
    for (int i = 0; i < 16; ++i) acc[i] = 0.f;
#pragma unroll 8
    for (int s = 0; s < 64; ++s) {
      s16x8 a = *(const s16x8*)(ap + 16 * s), b = *(const s16x8*)(bp + 16 * s);
      acc = MFMA32(a, b, acc);
    }
#pragma unroll
    for (int i = 0; i < 16; ++i) out[(size_t)(wt * 32 + crow(i, h)) * 32 + r] = acc[i];
  }
}

DI int lds_byte2(int r, int c) {
  int st = (r >> 4) * 2 + (c >> 5), ob = (r & 15) * 64 + (c & 31) * 2;
  return st * 1024 + (ob ^ (((ob >> 9) & 1) << 5));
}
DI void stage_rc2(int b, int& Rr, int& Cc) {
  int st = b >> 10, sb = b & 1023, swz = sb ^ (((sb >> 9) & 1) << 5);
  Rr = (st / 2) * 16 + swz / 64;
  Cc = (st % 2) * 32 + (swz % 64) / 2;
}

struct EpiArgs {
  int mode;
  u16* lat; u16* ctx; int ld;
  u16* b1; u16* b2;
  const float* res_lat; const float* res_ctx; const float* mods_i; float* out_lat; float* out_ctx;
};

template <int MODE>
DI void gemm_epilogue(const EpiArgs& e, f32x4 (&acc)[8][4], int row0, int pn, int wr, int wc, int fr, int fq) {
#pragma unroll
  for (int m = 0; m < 8; ++m) {
    const int row = row0 + wr * 128 + m * 16 + fr;
#pragma unroll
    for (int n = 0; n < 4; ++n) {
      const int col = pn * 256 + wc * 64 + n * 16 + fq * 4;
      const f32x4 a = acc[m][n];
      if (MODE == 0) {
        u16* pr = (row < RL) ? e.lat + (size_t)row * e.ld : e.ctx + (size_t)(row - RL) * e.ld;
        *(u32x2*)(pr + col) = (u32x2){pk2(a.x, a.y), pk2(a.z, a.w)};
      } else if (MODE == 1) {
        u32x2 v = {pk2(a.x, a.y), pk2(a.z, a.w)};
        if (pn < 4) {
          *(u32x2*)(e.lat + (size_t)row * 1024 + col) = v;
        } else {
          *(u32x2*)(e.b1 + (size_t)row * 2048 + col - 1024) = v;
          *(u32x2*)(e.b2 + (size_t)row * 2048 + col - 1024) = v;
        }
      } else {
        const int mr = (row < RL) ? (row >> 13) : 4;
        const f32x4 gt = *(const f32x4*)(e.mods_i + mr * 3072 + 2048 + col);
        const float* rp = (row < RL) ? e.res_lat + (size_t)row * DM : e.res_ctx + (size_t)(row - RL) * DM;
        float* op = (row < RL) ? e.out_lat + (size_t)row * DM : e.out_ctx + (size_t)(row - RL) * DM;
        const f32x4 rv = *(const f32x4*)(rp + col);
        f32x4 o = {rv.x + gt.x * a.x, rv.y + gt.y * a.y, rv.z + gt.z * a.z, rv.w + gt.w * a.w};
        *(f32x4*)(op + col) = o;
      }
    }
  }
}

template <int MODE>
DI void gemm_epilogue8(const EpiArgs& e, f32x4 (&acc)[2][2][4][2], int row0, int pn, int wr, int wc, int fr, int fq) {
#pragma unroll
  for (int ai = 0; ai < 2; ++ai)
#pragma unroll
    for (int m = 0; m < 4; ++m) {
      const int row = row0 + ai * 128 + wr * 64 + m * 16 + fr;
#pragma unroll
      for (int bj = 0; bj < 2; ++bj)
#pragma unroll
        for (int n = 0; n < 2; ++n) {
          const int col = pn * 256 + bj * 128 + wc * 32 + n * 16 + fq * 4;
          const f32x4 a = acc[ai][bj][m][n];
          if (MODE == 0) {
            u16* pr = (row < RL) ? e.lat + (size_t)row * e.ld : e.ctx + (size_t)(row - RL) * e.ld;
            *(u32x2*)(pr + col) = (u32x2){pk2(a.x, a.y), pk2(a.z, a.w)};
          } else if (MODE == 4) {
            const size_t dsel = (pn < 8) ? 0 : (pn < 16) ? (4 * MiB / 2) : ((OFF_ZC - OFF_X) / 2);
            *(u32x2*)(e.ctx + dsel + (size_t)(row - RL) * 2048 + (col & 2047)) = (u32x2){pk2(a.x, a.y), pk2(a.z, a.w)};
          } else if (MODE == 1) {
            u32x2 v = {pk2(a.x, a.y), pk2(a.z, a.w)};
            if (pn < 4) {
              *(u32x2*)(e.lat + (size_t)row * 1024 + col) = v;
            } else {
              *(u32x2*)(e.b1 + (size_t)row * 2048 + col - 1024) = v;
              *(u32x2*)(e.b2 + (size_t)row * 2048 + col - 1024) = v;
            }
          } else {
            const int mr = (row < RL) ? (row >> 13) : 4;
            const f32x4 gt = *(const f32x4*)(e.mods_i + mr * 3072 + 2048 + col);
            const float* rp = (row < RL) ? e.res_lat + (size_t)row * DM : e.res_ctx + (size_t)(row - RL) * DM;
            float* op = (row < RL) ? e.out_lat + (size_t)row * DM : e.out_ctx + (size_t)(row - RL) * DM;
            const f32x4 rv = __builtin_nontemporal_load((const f32x4*)(rp + col));
            f32x4 o = {rv.x + gt.x * a.x, rv.y + gt.y * a.y, rv.z + gt.z * a.z, rv.w + gt.w * a.w};
            *(f32x4*)(op + col) = o;
          }
        }
    }
}

template <int MODE>
DI void gemm_phase(char* shm_, const u16* Alat, const u16* Actx, int K, const u16* Bt, int pm0, int npm, int nN, const EpiArgs& e, const int wave_s_) {
  constexpr int BK = 64, HALF = 128, HT = HALF * BK;
  u16* shm = (u16*)shm_;
  const int tid = TIDX(), wid = tid >> 6, lane = tid & 63, wr = wid >> 2, wc = wid & 3, fr = lane & 15, fq = lane >> 4;
#define SA(b, h) (shm + ((b) * 2 + (h)) * HT)
#define SB(b, h) (shm + (4 + (b) * 2 + (h)) * HT)
#define LDSP(ptr) ((__attribute__((address_space(3))) unsigned*)(unsigned)(size_t)(ptr))
#define STAGE(P, BASE, br, kt) do { const u16* _p = (BASE) + (size_t)(br) * K + (kt) * BK + soff; \
    _Pragma("unroll") for (int _i = 0; _i < 2; ++_i) \
      __builtin_amdgcn_global_load_lds((const unsigned*)(_p + (size_t)_i * 64 * K), LDSP((char*)(P) + wid * 1024 + _i * 8192), 16, 0, 0); } while (0)
#define LDA(dst, b, h) _Pragma("unroll") for (int m = 0; m < 4; ++m) _Pragma("unroll") for (int k = 0; k < 2; ++k) \
    dst[m][k] = *(const s16x8*)((const char*)SA(b, h) + lds_byte2(wr * 64 + m * 16 + fr, k * 32 + fq * 8))
#define LDB(dst, b, h) _Pragma("unroll") for (int n = 0; n < 2; ++n) _Pragma("unroll") for (int k = 0; k < 2; ++k) \
    dst[n][k] = *(const s16x8*)((const char*)SB(b, h) + lds_byte2(wc * 32 + n * 16 + fr, k * 32 + fq * 8))
#define MMA(ai, bj, Atv, Btv) do { __builtin_amdgcn_s_setprio(1); \
    _Pragma("unroll") for (int m = 0; m < 4; ++m) _Pragma("unroll") for (int n = 0; n < 2; ++n) _Pragma("unroll") for (int k = 0; k < 2; ++k) \
      acc[ai][bj][m][n] = MFMA16(Btv[n][k], Atv[m][k], acc[ai][bj][m][n]); \
    __builtin_amdgcn_s_setprio(0); } while (0)
#define WAIT_V(n) asm volatile("s_waitcnt vmcnt(" #n ")" ::: "memory")
#define WAIT_L(n) asm volatile("s_waitcnt lgkmcnt(" #n ")" ::: "memory")
#define BAR __builtin_amdgcn_s_barrier()
#define SCHED __builtin_amdgcn_sched_barrier(0)
  int sR0, sC0;
  stage_rc2(tid * 16, sR0, sC0);
  const size_t soff = (size_t)sR0 * K + sC0;
  const int ntiles = npm * nN, nt = K / BK;
  const int xcd = blockIdx.x & 7, jj = blockIdx.x >> 3;
  const int PN = (nN % 8 == 0) ? 8 : 4, PG = 32 / PN, npg = nN / PN;
  const int ngroups = ((npm + PG - 1) / PG) * npg;
  const bool grouped = (gridDim.x == 256);
  const int nit = grouped ? (ngroups - xcd + 7) / 8 : (ntiles - (int)blockIdx.x + (int)gridDim.x - 1) / (int)gridDim.x;
  auto tile_of = [&](int it, int& pm, int& pn) -> bool {
    if (it >= nit) return false;
    if (grouped) {
      const int g = xcd + 8 * it, pmg = g / npg, png = g % npg;
      pm = pmg * PG + jj / PN; pn = png * PN + jj % PN;
      if (pm >= npm) return false;
      pm += pm0;
    } else {
      const int L = blockIdx.x + it * gridDim.x;
      pm = pm0 + L / nN; pn = L % nN;
    }
    return true;
  };
  bool prefetched = false;
  for (int it = 0; it < nit; ++it) {
    int pm, pn;
    if (!tile_of(it, pm, pn)) continue;
    const int row0 = pm * 256;
    const u16* A = (row0 < RL) ? Alat + (size_t)row0 * K : Actx + (size_t)(row0 - RL) * K;
    const u16* Bw = Bt + (size_t)pn * 256 * K;
    const int brow = 0, bcol = 0;
    f32x4 acc[2][2][4][2];
#pragma unroll
    for (int i0 = 0; i0 < 2; ++i0)
#pragma unroll
      for (int i1 = 0; i1 < 2; ++i1)
#pragma unroll
        for (int i2 = 0; i2 < 4; ++i2)
#pragma unroll
          for (int i3 = 0; i3 < 2; ++i3) acc[i0][i1][i2][i3] = (f32x4){0.f, 0.f, 0.f, 0.f};
    s16x8 At[4][2], B0[2][2], B1[2][2];
    if (!prefetched) {
      STAGE(SB(0, 0), Bw, bcol, 0); STAGE(SA(0, 0), A, brow, 0);
      STAGE(SB(0, 1), Bw, bcol + HALF, 0); STAGE(SA(0, 1), A, brow + HALF, 0);
    }
    if (wr == 1) BAR;
    WAIT_V(4); BAR;
    STAGE(SB(1, 0), Bw, bcol, 1); STAGE(SA(1, 0), A, brow, 1); STAGE(SB(1, 1), Bw, bcol + HALF, 1);
    WAIT_V(6); BAR;
    for (int t = 0; t < nt - 2; t += 2) {
      LDB(B0, 0, 0); SCHED; LDA(At, 0, 0); STAGE(SA(1, 1), A, brow + HALF, t + 1);
      WAIT_L(8); BAR; WAIT_L(0); MMA(0, 0, At, B0); BAR; SCHED;
      LDB(B1, 0, 1); STAGE(SB(0, 0), Bw, bcol, t + 2);
      BAR; WAIT_L(0); MMA(0, 1, At, B1); BAR;
      LDA(At, 0, 1); STAGE(SA(0, 0), A, brow, t + 2);
      BAR; WAIT_L(0); MMA(1, 0, At, B0); BAR; SCHED;
      STAGE(SB(0, 1), Bw, bcol + HALF, t + 2);
      WAIT_V(6); BAR; MMA(1, 1, At, B1); BAR;
      LDB(B0, 1, 0); SCHED; LDA(At, 1, 0); STAGE(SA(0, 1), A, brow + HALF, t + 2);
      WAIT_L(8); BAR; WAIT_L(0); MMA(0, 0, At, B0); BAR; SCHED;
      LDB(B1, 1, 1); STAGE(SB(1, 0), Bw, bcol, t + 3);
      BAR; WAIT_L(0); MMA(0, 1, At, B1); BAR;
      LDA(At, 1, 1); STAGE(SA(1, 0), A, brow, t + 3);
      BAR; WAIT_L(0); MMA(1, 0, At, B0); BAR; SCHED;
      STAGE(SB(1, 1), Bw, bcol + HALF, t + 3);
      WAIT_V(6); BAR; MMA(1, 1, At, B1); BAR;
    }
    { LDB(B0, 0, 0); LDA(At, 0, 0); STAGE(SA(1, 1), A, brow + HALF, nt - 1);
      BAR; WAIT_L(0); MMA(0, 0, At, B0); BAR;
      LDB(B1, 0, 1); BAR; WAIT_L(0); MMA(0, 1, At, B1); BAR;
      LDA(At, 0, 1); WAIT_V(4); BAR; WAIT_L(0); MMA(1, 0, At, B0); MMA(1, 1, At, B1); BAR; }
    { LDB(B0, 1, 0); LDA(At, 1, 0); WAIT_V(2); BAR; WAIT_L(0); MMA(0, 0, At, B0); BAR;
      LDB(B1, 1, 1); WAIT_V(0); BAR; WAIT_L(0); MMA(0, 1, At, B1); BAR;
      LDA(At, 1, 1); BAR; WAIT_L(0); MMA(1, 0, At, B0); MMA(1, 1, At, B1); BAR; }
    if (wr == 0) BAR;
    {
      int pm2, pn2;
      prefetched = tile_of(it + 1, pm2, pn2);
      if (prefetched) {
        const int r2 = pm2 * 256;
        const u16* A2 = (r2 < RL) ? Alat + (size_t)r2 * K : Actx + (size_t)(r2 - RL) * K;
        const u16* B2 = Bt + (size_t)pn2 * 256 * K;
        STAGE(SB(0, 0), B2, 0, 0); STAGE(SA(0, 0), A2, 0, 0);
        STAGE(SB(0, 1), B2, HALF, 0); STAGE(SA(0, 1), A2, HALF, 0);
      }
    }
    { const int l2 = lane_id(); gemm_epilogue8<MODE>(e, acc, row0, pn, wr, wc, l2 & 15, l2 >> 4); }
    asm volatile("s_waitcnt vmcnt(0) lgkmcnt(0)" ::: "memory");
    BAR;
  }
#undef SA
#undef SB
#undef LDSP
#undef STAGE
#undef LDA
#undef LDB
#undef MMA
#undef WAIT_V
#undef WAIT_L
#undef BAR
#undef SCHED
}

DI void conv_accum(float (&acc)[8], const u16* srow, const float* w) {
  u32x4 v = *(const u32x4*)srow;
  f32x4 w0 = *(const f32x4*)w, w1 = *(const f32x4*)(w + 4);
  acc[0] += bflo(v.x) * w0.x; acc[1] += bfhi(v.x) * w0.y; acc[2] += bflo(v.y) * w0.z; acc[3] += bfhi(v.y) * w0.w;
  acc[4] += bflo(v.z) * w1.x; acc[5] += bfhi(v.z) * w1.y; acc[6] += bflo(v.w) * w1.z; acc[7] += bfhi(v.w) * w1.w;
}
DI void fma8(float (&acc)[8], const u32x4 v, const float (&w)[8]) {
  acc[0] += bflo(v.x) * w[0]; acc[1] += bfhi(v.x) * w[1]; acc[2] += bflo(v.y) * w[2]; acc[3] += bfhi(v.y) * w[3];
  acc[4] += bflo(v.z) * w[4]; acc[5] += bfhi(v.z) * w[5]; acc[6] += bflo(v.w) * w[6]; acc[7] += bfhi(v.w) * w[7];
}
template <bool ISV>
DI void conv_store(const Params& p, float (&acc)[8], int row, int ch) {
#pragma unroll
  for (int e = 0; e < 8; ++e) acc[e] = siluf(acc[e]);
  if (!ISV) {
    u16* qk = (u16*)(p.ws + OFF_QK0);
    float ss = 0.f;
#pragma unroll
    for (int e = 0; e < 8; ++e) ss += acc[e] * acc[e];
    ss += __shfl_xor(ss, 1, 64); ss += __shfl_xor(ss, 2, 64); ss += __shfl_xor(ss, 4, 64); ss += __shfl_xor(ss, 8, 64);
    const float sc = rsqrtf(ss + EPSF) * ((ch < 1024) ? 0.08838834764831845f : 1.f);
    u32x4 o = {pk2(acc[0] * sc, acc[1] * sc), pk2(acc[2] * sc, acc[3] * sc), pk2(acc[4] * sc, acc[5] * sc), pk2(acc[6] * sc, acc[7] * sc)};
    __builtin_nontemporal_store(o, (u32x4*)(qk + (size_t)row * 2048 + ch));
  } else {
    u16* u0 = (u16*)(p.ws + OFF_U0);
    u16* u1 = (u16*)(p.ws + OFF_U1);
    const float* abt = (const float*)(p.ws + OFF_ABT);
    const int head = ch >> 8;
    const float b0 = sigmoidf(abt[(size_t)row * 32 + 16 + head]), b1 = sigmoidf(abt[(size_t)row * 32 + 24 + head]);
    u32x4 o0 = {pk2(acc[0] * b0, acc[1] * b0), pk2(acc[2] * b0, acc[3] * b0), pk2(acc[4] * b0, acc[5] * b0), pk2(acc[6] * b0, acc[7] * b0)};
    u32x4 o1 = {pk2(acc[0] * b1, acc[1] * b1), pk2(acc[2] * b1, acc[3] * b1), pk2(acc[4] * b1, acc[5] * b1), pk2(acc[6] * b1, acc[7] * b1)};
    __builtin_nontemporal_store(o0, (u32x4*)(u0 + (size_t)row * 2048 + ch));
    __builtin_nontemporal_store(o1, (u32x4*)(u1 + (size_t)row * 2048 + ch));
  }
}
template <bool ISV>
DI void conv_phase(const Params& p, const int wave_s_) {
  const u16* pre_lat = (const u16*)p.out;
  const u16* pre_ctx = (const u16*)(p.ws + OFF_X + (ISV ? 4 * MiB : 0));
  const float* cw = p.dn_conv_w + (ISV ? 2048 : 0);
  const int gt = blockIdx.x * 512 + TIDX(), nthr = gridDim.x * 512;
  const u32x4 zero4 = {0u, 0u, 0u, 0u};
  for (int idx = gt; idx < 4 * 128 * 4 * 256; idx += nthr) {
    const int cg8 = idx & 255, run = (idx >> 8) & 3, gr = (idx >> 10) & 127, b = idx >> 17, ch = cg8 * 8, c0 = run * 16;
    float w[9][8];
#pragma unroll
    for (int t = 0; t < 9; ++t) {
      const f32x4 w0 = *(const f32x4*)(cw + t * 4096 + ch), w1 = *(const f32x4*)(cw + t * 4096 + ch + 4);
      w[t][0] = w0.x; w[t][1] = w0.y; w[t][2] = w0.z; w[t][3] = w0.w; w[t][4] = w1.x; w[t][5] = w1.y; w[t][6] = w1.z; w[t][7] = w1.w;
    }
    const u16* base = pre_lat + ((size_t)(b << 13) + gr * 64) * 2048 + ch;
    const bool rok[3] = {gr > 0, true, gr < 127};
    u32x4 win[3][3];
#pragma unroll
    for (int i = 0; i < 3; ++i) {
      win[i][0] = (rok[i] && c0 > 0) ? *(const u32x4*)(base + (ptrdiff_t)((i - 1) * 64 + c0 - 1) * 2048) : zero4;
      win[i][1] = rok[i] ? *(const u32x4*)(base + (ptrdiff_t)((i - 1) * 64 + c0) * 2048) : zero4;
    }
#pragma unroll
    for (int t = 0; t < 16; ++t) {
      const int c = c0 + t;
#pragma unroll
      for (int i = 0; i < 3; ++i) win[i][2] = (rok[i] && c < 63) ? *(const u32x4*)(base + (ptrdiff_t)((i - 1) * 64 + c + 1) * 2048) : zero4;
      float acc[8];
#pragma unroll
      for (int e = 0; e < 8; ++e) acc[e] = 0.f;
#pragma unroll
      for (int i = 0; i < 3; ++i)
#pragma unroll
        for (int j = 0; j < 3; ++j) fma8(acc, win[i][j], w[i * 3 + j]);
      conv_store<ISV>(p, acc, (b << 13) + gr * 64 + c, ch);
#pragma unroll
      for (int i = 0; i < 3; ++i) { win[i][0] = win[i][1]; win[i][1] = win[i][2]; }
    }
  }
  for (int idx = gt; idx < 4 * 32 * 256; idx += nthr) {
    const int cg8 = idx & 255, run = (idx >> 8) & 31, b = idx >> 13, ch = cg8 * 8, p0 = run * 8;
    float w[3][8];
#pragma unroll
    for (int t = 0; t < 3; ++t) {
      const f32x4 w0 = *(const f32x4*)(cw + (3 + t) * 4096 + ch), w1 = *(const f32x4*)(cw + (3 + t) * 4096 + ch + 4);
      w[t][0] = w0.x; w[t][1] = w0.y; w[t][2] = w0.z; w[t][3] = w0.w; w[t][4] = w1.x; w[t][5] = w1.y; w[t][6] = w1.z; w[t][7] = w1.w;
    }
    const u16* base = pre_ctx + (size_t)(b * 256) * 2048 + ch;
    u32x4 win[3];
    win[0] = (p0 > 0) ? *(const u32x4*)(base + (size_t)(p0 - 1) * 2048) : zero4;
    win[1] = *(const u32x4*)(base + (size_t)p0 * 2048);
#pragma unroll
    for (int t = 0; t < 8; ++t) {
      const int pp = p0 + t;
      win[2] = (pp < 255) ? *(const u32x4*)(base + (size_t)(pp + 1) * 2048) : zero4;
      float acc[8];
#pragma unroll
      for (int e = 0; e < 8; ++e) acc[e] = 0.f;
#pragma unroll
      for (int j = 0; j < 3; ++j) fma8(acc, win[j], w[j]);
      conv_store<ISV>(p, acc, RL + b * 256 + pp, ch);
      win[0] = win[1]; win[1] = win[2];
    }
  }
}

constexpr int lp_off(int ip) { return ip == 0 ? 0 : (8 * ((ip - 1) / 4) * ((ip - 1) / 4 + 1) + 4 * ((ip - 1) % 4) * ((ip - 1) / 4 + 1)); }
constexpr int LP_FLOATS = 2112;
DI void dn_prep_phase(char* shm, const Params& p, const int wave_s_) {
  const int tid = TIDX(), wave = tid >> 6, lane = tid & 63, r = lane & 31, hh = lane >> 5;
  char* sQ = shm;
  char* sK = shm + 16896;
  float* sKK = (float*)(shm + 33792);
  float* sQK = (float*)(shm + 50432);
  float* sg = (float*)(shm + 67072);
  float* sbeta = sg + 128;
  float* sgc = sg + 256;
  float* sLp = (float*)(shm + 68608);
  const u16* qk = (const u16*)(p.ws + OFF_QK0);
  const float* abt = (const float*)(p.ws + OFF_ABT);
  u16* Ab_lat = (u16*)p.out;
  u16* Tb_lat = (u16*)p.out + (size_t)32 * MiB;
  u16* Ab_ctx = (u16*)(p.ws + OFF_AC);
  u16* Tb_ctx = (u16*)(p.ws + OFF_TC);
  float* Eb = (float*)(p.ws + OFF_X);
  for (int grp = blockIdx.x; grp < NCHUNK * 2; grp += gridDim.x) {
    const int ci = grp >> 1, row0 = ci * 64;
    u32x4 pq[2], pk[2];
    float pa = 0.f, pbt = 0.f;
    auto load_item = [&](int h) {
#pragma unroll
      for (int u = 0; u < 2; ++u) {
        const int chunk = tid * 2 + u, c = chunk >> 4, cc = (chunk & 15) * 8;
        const u16* src = qk + (size_t)(row0 + c) * 2048 + h * 128 + cc;
        pq[u] = *(const u32x4*)src; pk[u] = *(const u32x4*)(src + 1024);
      }
      if (tid < 128) {
        const int d = tid >> 6, c = tid & 63;
        pa = abt[(size_t)(row0 + c) * 32 + d * 8 + h]; pbt = abt[(size_t)(row0 + c) * 32 + 16 + d * 8 + h];
      }
    };
    load_item((grp & 1) * 4);
    for (int sub = 0; sub < 4; ++sub) {
      const int h = (grp & 1) * 4 + sub, item = ci * 8 + h;
#pragma unroll
      for (int u = 0; u < 2; ++u) {
        const int chunk = tid * 2 + u, c = chunk >> 4, cc = (chunk & 15) * 8;
        st8(sQ + c * 264 + cc * 2, pq[u]);
        st8(sK + c * 264 + cc * 2, pk[u]);
      }
      if (tid < 128) {
        const int d = tid >> 6, c = tid & 63;
        sg[d * 64 + c] = -__expf(p.dn_a_log[d * 8 + h]) * softplusf(pa + p.dn_dt_bias[d * 8 + h]);
        sbeta[d * 64 + c] = sigmoidf(pbt);
      }
      if (sub < 3) load_item(h + 1);
      __syncthreads();
      if (wave < 2) {
        const int c = wave ? 63 - lane : lane;
        float v = sg[wave * 64 + c];
#pragma unroll
        for (int o = 1; o < 64; o <<= 1) { const float t = __shfl_up(v, o, 64); if (lane >= o) v += t; }
        sgc[wave * 64 + c] = v;
      }
      {
        const int mat = wave >> 2, tm = (wave >> 1) & 1, tn = wave & 1;
        const char* aop = mat ? sQ : sK;
        f32x16 acc;
        for (int i = 0; i < 16; ++i) acc[i] = 0.f;
#pragma unroll
        for (int s = 0; s < 8; ++s) {
          s16x8 a = ldA_nat(aop, 32 * tm + r, 264, 16 * s, hh), b = ldA_nat(sK, 32 * tn + r, 264, 16 * s, hh);
          acc = MFMA32(a, b, acc);
        }
        float* dst = mat ? sQK : sKK;
#pragma unroll
        for (int i = 0; i < 16; ++i) dst[(32 * tm + crow(i, hh)) * 65 + 32 * tn + r] = acc[i];
      }
      __syncthreads();
      for (int e = tid; e < 8192; e += 512) {
        const int d = e >> 12, ip = (e >> 6) & 63, jp = e & 63;
        if (ip > jp) {
          const int i = d ? 63 - ip : ip, j = d ? 63 - jp : jp;
          const int q4 = (ip - 1) >> 2, r4 = (ip - 1) & 3;
          const float v = sbeta[d * 64 + i] * sKK[i * 65 + j] * __expf(fminf(sgc[d * 64 + i] - sgc[d * 64 + j], 0.f));
          sLp[(sub * 2 + d) * LP_FLOATS + 8 * q4 * (q4 + 1) + 4 * r4 * (q4 + 1) + jp] = v;
        }
      }
      for (int v = tid; v < 1024; v += 512) {
        const int d = v >> 9, i = (v >> 3) & 63, j0 = (v & 7) * 8;
        float o[8];
#pragma unroll
        for (int e = 0; e < 8; ++e) {
          const int j = j0 + e;
          const bool keep = d ? (i <= j) : (i >= j);
          o[e] = keep ? sQK[i * 65 + j] * __expf(fminf(sgc[d * 64 + i] - sgc[d * 64 + j], 0.f)) : 0.f;
        }
        u32x4 ov = {pk2(o[0], o[1]), pk2(o[2], o[3]), pk2(o[4], o[5]), pk2(o[6], o[7])};
        *(u32x4*)(((size_t)item < TA_LAT_ITEMS ? Ab_lat : Ab_ctx) + ta_off(item, d) + i * 64 + j0) = ov;
      }
      if (tid < 128) {
        const int d = tid >> 6, c = tid & 63;
        const float gl = sgc[d * 64 + (d ? 0 : 63)], gcv = sgc[d * 64 + c];
        const float e1 = __expf(gcv), be = sbeta[d * 64 + c] * e1, e2 = __expf(gl - gcv), cdv = __expf(gl);
        float* E = Eb + ((size_t)item * 2 + d) * 256;
        E[c] = e1; E[64 + c] = be; E[128 + c] = e2; E[192 + c] = cdv;
      }
      __syncthreads();
    }
    {
      const int wv = opq_v(wave), lane_l = opq_v(lane);
      const int d = wv & 1, item = ci * 8 + (grp & 1) * 4 + (wv >> 1);
      const float* Lb = sLp + wv * LP_FLOATS;
      float T[64];
#pragma unroll
      for (int ip = 0; ip < 64; ++ip) {
        f32x4 lrow[16];
#pragma unroll
        for (int j4 = 0; j4 < (ip + 3) / 4; ++j4) lrow[j4] = *(const f32x4*)(Lb + lp_off(ip) + j4 * 4);
        float a0 = (lane_l == ip) ? 1.f : 0.f, a1 = 0.f, a2 = 0.f, a3 = 0.f;
#pragma unroll
        for (int j4 = 0; j4 < (ip + 3) / 4; ++j4) {
          const f32x4 lv = lrow[j4];
          if (j4 * 4 + 0 < ip) a0 -= lv.x * T[j4 * 4 + 0];
          if (j4 * 4 + 1 < ip) a1 -= lv.y * T[j4 * 4 + 1];
          if (j4 * 4 + 2 < ip) a2 -= lv.z * T[j4 * 4 + 2];
          if (j4 * 4 + 3 < ip) a3 -= lv.w * T[j4 * 4 + 3];
        }
        T[ip] = (a0 + a1) + (a2 + a3);
        __builtin_amdgcn_sched_barrier(0);
      }
      u16* To = ((size_t)item < TA_LAT_ITEMS ? Tb_lat : Tb_ctx) + ta_off(item, d);
      const int cidx = d ? 63 - lane_l : lane_l;
#pragma unroll
      for (int ip = 0; ip < 64; ++ip) {
        const int i = d ? 63 - ip : ip;
        To[i * 64 + cidx] = f2bf(T[ip]);
      }
    }
    __syncthreads();
  }
}

constexpr int SC_QS = 272;
constexpr int SC_Q = 0, SC_K = 17408, SC_KT = 34816, SC_T = 52224, SC_A = 60928, SC_E = 69632, SC_BUF = 70656;
DI s16x8 ldA16(const char* base, int row, int strideB, int kofs, int q) {
  const char* p = base + row * strideB + (kofs + 4 * q) * 2;
  u32x2 lo = *(const u32x2*)p, hi = *(const u32x2*)(p + 32);
  return cat8(lo, hi);
}
DI s16x8 pack16(const f32x4& a, const f32x4& b) {
  u32x4 v = {pk2(a.x, a.y), pk2(a.z, a.w), pk2(b.x, b.y), pk2(b.z, b.w)};
  return __builtin_bit_cast(s16x8, v);
}

template <bool DELTA, bool DRY = false>
DI void scan_phase(char* shm, const Params& p, const int wave_s_) {
  const int bid = blockIdx.x;
  if (bid >= 256) return;
  const int tid = TIDX(), wave = tid >> 6, lane = tid & 63, n16 = lane & 15, q4 = lane >> 4;
  int cgp, d, h, b;
  if (DELTA) { cgp = (bid >> 3) & 3; const int cid = (bid & 7) + 8 * (bid >> 5); d = cid & 1; h = (cid >> 1) & 7; b = cid >> 4; }
  else { cgp = (bid >> 3) & 7; const int cid = (bid & 7) + 8 * (bid >> 6); d = cid & 1; h = (cid >> 1) & 3; b = cid >> 3; }
  const bool compute = wave < 4;
  const int col0 = (DELTA ? h * 256 : h * 512) + cgp * 64 + (wave & 3) * 16;
  u16* Ub = (u16*)(p.ws + (DELTA ? (d ? OFF_U1 : OFF_U0) : (d ? OFF_V1 : OFF_V0)));
  const u16* qk = (const u16*)(p.ws + OFF_QK0);
  const u16* Ag_lat = (const u16*)p.out;
  const u16* Tb_lat = (const u16*)p.out + (size_t)32 * MiB;
  const u16* Ag_ctx = (const u16*)(p.ws + OFF_AC);
  const u16* Tb_ctx = (const u16*)(p.ws + OFF_TC);
  const float* Eb = (const float*)(p.ws + OFF_X);
  const u16* QD = (const u16*)(p.ws + OFF_QD);
  const u16* AS = (const u16*)(p.ws + OFF_ASUM);
  const float* CD = (const float*)(p.ws + OFF_CD1);

  auto chunk_of = [&](int st) -> int {
    if (st < 4) return 512 + b * 4 + (d ? 3 - st : st);
    return b * 128 + (d ? 127 - (st - 4) : (st - 4));
  };

  auto stage_all = [&](int st, int buf) {
    const int sid = tid - 256;
    const int ci = chunk_of(st), row0 = ci * 64;
    char* sb = shm + buf * SC_BUF;
    if (DELTA) {
      const size_t it = ((size_t)ci * 8 + h) * 2 + d;
      const float* E = Eb + it * 256;
      const int c = sid >> 2, cc = (sid & 3) * 32;
      const u16* qsrc = qk + (size_t)(row0 + c) * 2048 + h * 128 + cc;
      const int c0 = (sid >> 4) * 4, dk0 = (sid & 15) * 8;
      const u16* ksrc = qk + (size_t)(row0 + c0) * 2048 + 1024 + h * 128 + dk0;
      u32x4 gq[4], gk[4], gT[2], gA[2];
#pragma unroll
      for (int u = 0; u < 4; ++u) gq[u] = *(const u32x4*)(qsrc + u * 8);
#pragma unroll
      for (int u = 0; u < 4; ++u) gk[u] = *(const u32x4*)(ksrc + (size_t)u * 2048);
#pragma unroll
      for (int u = 0; u < 2; ++u) {
        const int chunk = sid * 2 + u, tr = chunk >> 3, tc = (chunk & 7) * 8;
        const size_t itm = (size_t)ci * 8 + h;
        gT[u] = *(const u32x4*)((itm < TA_LAT_ITEMS ? Tb_lat : Tb_ctx) + ta_off(itm, d) + tr * 64 + tc);
        gA[u] = *(const u32x4*)((itm < TA_LAT_ITEMS ? Ag_lat : Ag_ctx) + ta_off(itm, d) + tr * 64 + tc);
      }
      const float e1 = E[c];
      const f32x4 bev = *(const f32x4*)(E + 64 + c0), e2v = *(const f32x4*)(E + 128 + c0);
      if (sid == 0) *(float*)(sb + SC_E) = E[192];
#pragma unroll
      for (int u = 0; u < 4; ++u) st8(sb + SC_Q + c * SC_QS + (cc + u * 8) * 2, scale8(gq[u], e1));
      const float be[4] = {bev.x, bev.y, bev.z, bev.w}, e2[4] = {e2v.x, e2v.y, e2v.z, e2v.w};
      u32x4 kt[4];
#pragma unroll
      for (int u = 0; u < 4; ++u) {
        st8(sb + SC_K + (c0 + u) * SC_QS + dk0 * 2, scale8(gk[u], -be[u]));
        kt[u] = scale8(gk[u], e2[u]);
      }
      const unsigned w[4][4] = {{kt[0].x, kt[0].y, kt[0].z, kt[0].w}, {kt[1].x, kt[1].y, kt[1].z, kt[1].w},
                                {kt[2].x, kt[2].y, kt[2].z, kt[2].w}, {kt[3].x, kt[3].y, kt[3].z, kt[3].w}};
#pragma unroll
      for (int jp = 0; jp < 4; ++jp) {
        u32x2 lo = {(w[0][jp] & 0xffffu) | (w[1][jp] << 16), (w[2][jp] & 0xffffu) | (w[3][jp] << 16)};
        u32x2 hi = {(w[0][jp] >> 16) | (w[1][jp] & 0xffff0000u), (w[2][jp] >> 16) | (w[3][jp] & 0xffff0000u)};
        *(u32x2*)(sb + SC_KT + (dk0 + 2 * jp) * 136 + c0 * 2) = lo;
        *(u32x2*)(sb + SC_KT + (dk0 + 2 * jp + 1) * 136 + c0 * 2) = hi;
      }
#pragma unroll
      for (int u = 0; u < 2; ++u) {
        const int chunk = sid * 2 + u, tr = chunk >> 3, tc = (chunk & 7) * 8;
        st8(sb + SC_T + tr * 136 + tc * 2, gT[u]);
        st8(sb + SC_A + tr * 136 + tc * 2, gA[u]);
      }
    } else {
      const size_t it = ((size_t)ci * 4 + h) * 2 + d;
      const u16* qd = QD + it * 16384;
      const int c = sid >> 2, cc = (sid & 3) * 32;
      const int kr = sid >> 1, kc = (sid & 1) * 32;
      u32x4 gq[4], gk[4], gA[2];
#pragma unroll
      for (int u = 0; u < 4; ++u) gq[u] = *(const u32x4*)(qd + c * 128 + cc + u * 8);
#pragma unroll
      for (int u = 0; u < 4; ++u) gk[u] = *(const u32x4*)(qd + 8192 + kr * 64 + kc + u * 8);
      if (d == 0) {
#pragma unroll
        for (int u = 0; u < 2; ++u) {
          const int chunk = sid * 2 + u, tr = chunk >> 3, tc = (chunk & 7) * 8;
          gA[u] = *(const u32x4*)(AS + ((size_t)ci * 4 + h) * 4096 + tr * 64 + tc);
        }
      }
      if (sid < 32) *(f32x4*)(sb + SC_E + sid * 16) = *(const f32x4*)(CD + it * 128 + sid * 4);
#pragma unroll
      for (int u = 0; u < 4; ++u) st8(sb + SC_Q + c * SC_QS + (cc + u * 8) * 2, gq[u]);
#pragma unroll
      for (int u = 0; u < 4; ++u) st8(sb + SC_KT + kr * 136 + (kc + u * 8) * 2, gk[u]);
      if (d == 0) {
#pragma unroll
        for (int u = 0; u < 2; ++u) {
          const int chunk = sid * 2 + u, tr = chunk >> 3, tc = (chunk & 7) * 8;
          st8(sb + SC_A + tr * 136 + tc * 2, gA[u]);
        }
      }
    }
  };

  f32x4 S[8];
#pragma unroll
  for (int t = 0; t < 8; ++t) S[t] = (f32x4){0.f, 0.f, 0.f, 0.f};
  u16 uraw[4][4];
  const int loff = (4 * q4) * 2048 + col0 + n16;
  auto u_issue = [&](int st) {
    const u16* up = Ub + (size_t)chunk_of(st) * (64 * 2048);
    const int lo = opq_v(loff);
#pragma unroll
    for (int mt = 0; mt < 4; ++mt)
#pragma unroll
      for (int i = 0; i < 4; ++i) uraw[mt][i] = up[lo + (16 * mt + i) * 2048];
  };

  if (compute) u_issue(0); else stage_all(0, 0);
  __syncthreads();

  for (int st = 0; st < 132; ++st) {
    const int buf = st & 1;
    const char* sb = shm + buf * SC_BUF;
    if (compute) {
      const int row0 = chunk_of(st) * 64;
      f32x4 Y[4], O[4];
#pragma unroll
      for (int mt = 0; mt < 4; ++mt) {
        Y[mt] = (f32x4){bf2f(uraw[mt][0]), bf2f(uraw[mt][1]), bf2f(uraw[mt][2]), bf2f(uraw[mt][3])};
        O[mt] = (f32x4){0.f, 0.f, 0.f, 0.f};
      }
#define SCHED_FENCE() __builtin_amdgcn_sched_barrier(0)
      s16x8 fT[8];
      if (DELTA) {
#pragma unroll
        for (int mt = 0; mt < 4; ++mt)
#pragma unroll
          for (int kc = 0; kc < 2; ++kc) fT[mt * 2 + kc] = ldA16(sb + SC_T, 16 * mt + n16, 136, 32 * kc, q4);
      }
      s16x8 fa[2][8];
#pragma unroll
      for (int mt = 0; mt < 4; ++mt) {
        if (DELTA) fa[0][mt] = ldA16(sb + SC_K, 16 * mt + n16, SC_QS, 0, q4);
        fa[0][4 + mt] = ldA16(sb + SC_Q, 16 * mt + n16, SC_QS, 0, q4);
      }
      SCHED_FENCE();
#pragma unroll
      for (int t = 0; t < 4; ++t) {
        if (t < 3) {
#pragma unroll
          for (int mt = 0; mt < 4; ++mt) {
            if (DELTA) fa[(t + 1) & 1][mt] = ldA16(sb + SC_K, 16 * mt + n16, SC_QS, 32 * (t + 1), q4);
            fa[(t + 1) & 1][4 + mt] = ldA16(sb + SC_Q, 16 * mt + n16, SC_QS, 32 * (t + 1), q4);
          }
        }
        SCHED_FENCE();
        const s16x8 Sb = pack16(S[2 * t], S[2 * t + 1]);
#pragma unroll
        for (int mt = 0; mt < 4; ++mt) {
          if (DELTA) Y[mt] = MFMA16(fa[t & 1][mt], Sb, Y[mt]);
          O[mt] = MFMA16(fa[t & 1][4 + mt], Sb, O[mt]);
        }
        SCHED_FENCE();
      }
      s16x8 fA[8];
      if (DELTA || d == 0) {
#pragma unroll
        for (int mt = 0; mt < 4; ++mt)
#pragma unroll
          for (int kc = 0; kc < 2; ++kc) fA[mt * 2 + kc] = ldA16(sb + SC_A, 16 * mt + n16, 136, 32 * kc, q4);
      }
      SCHED_FENCE();
      s16x8 vnb[2];
      if (DELTA) {
        s16x8 Yb[2];
        Yb[0] = pack16(Y[0], Y[1]); Yb[1] = pack16(Y[2], Y[3]);
        f32x4 vn[4];
#pragma unroll
        for (int mt = 0; mt < 4; ++mt) {
          vn[mt] = (f32x4){0.f, 0.f, 0.f, 0.f};
#pragma unroll
          for (int kc = 0; kc < 2; ++kc) vn[mt] = MFMA16(fT[mt * 2 + kc], Yb[kc], vn[mt]);
        }
        vnb[0] = pack16(vn[0], vn[1]); vnb[1] = pack16(vn[2], vn[3]);
      } else {
        vnb[0] = pack16(Y[0], Y[1]); vnb[1] = pack16(Y[2], Y[3]);
      }
      SCHED_FENCE();
      s16x8 fK[8];
#pragma unroll
      for (int t = 0; t < 4; ++t)
#pragma unroll
        for (int kc = 0; kc < 2; ++kc) fK[t * 2 + kc] = ldA16(sb + SC_KT, 16 * t + n16, 136, 32 * kc, q4);
      if (st + 1 < 132) u_issue(st + 1);
      SCHED_FENCE();
      if (DELTA || d == 0) {
#pragma unroll
        for (int mt = 0; mt < 4; ++mt)
#pragma unroll
          for (int kc = 0; kc < 2; ++kc) O[mt] = MFMA16(fA[mt * 2 + kc], vnb[kc], O[mt]);
      }
      if (DELTA) {
        const float cd = *(const float*)(sb + SC_E);
#pragma unroll
        for (int t = 0; t < 8; ++t) S[t] *= cd;
      } else {
#pragma unroll
        for (int t = 0; t < 8; ++t) {
          const f32x4 cv = *(const f32x4*)(sb + SC_E + (16 * t + 4 * q4) * 4);
          S[t] *= cv;
        }
      }
      SCHED_FENCE();
      s16x8 fK2[8];
#pragma unroll
      for (int t = 0; t < 4; ++t)
#pragma unroll
        for (int kc = 0; kc < 2; ++kc) fK2[t * 2 + kc] = ldA16(sb + SC_KT, 16 * (4 + t) + n16, 136, 32 * kc, q4);
      SCHED_FENCE();
#pragma unroll
      for (int t = 0; t < 4; ++t)
#pragma unroll
        for (int kc = 0; kc < 2; ++kc) S[t] = MFMA16(fK[t * 2 + kc], vnb[kc], S[t]);
      SCHED_FENCE();
#pragma unroll
      for (int t = 0; t < 4; ++t)
#pragma unroll
        for (int kc = 0; kc < 2; ++kc) S[4 + t] = MFMA16(fK2[t * 2 + kc], vnb[kc], S[4 + t]);
#undef SCHED_FENCE
      if (!DRY || p.out == nullptr)
#pragma unroll
      for (int mt = 0; mt < 4; ++mt) {
        const float ov[4] = {O[mt].x, O[mt].y, O[mt].z, O[mt].w};
        u16* op = Ub + (size_t)row0 * 2048;
        const int lo = opq_v(loff);
#pragma unroll
        for (int i = 0; i < 4; ++i) op[lo + (16 * mt + i) * 2048] = f2bf(ov[i]);
      }
    }
    else if (st + 1 < 132) stage_all(st + 1, buf ^ 1);
    asm volatile("s_waitcnt lgkmcnt(0)" ::: "memory");
    __builtin_amdgcn_s_barrier();
    asm volatile("" ::: "memory");
  }
}

DI void gla_prep_phase(char* shm, const Params& p, const int wave_s_) {
  const int tid = TIDX(), wave = tid >> 6, lane = tid & 63, r = lane & 31, hh = lane >> 5;
  char* sq = shm;
  char* sk = shm + 16896;
  char* sQa = shm + 33792;
  char* sKb = shm + 50688;
  float* sBC = (float*)(shm + 67584);
  float* sgl = (float*)(shm + 133120);
  const u16* qk1 = (const u16*)(p.ws + OFF_QK1);
  const float* gl = (const float*)(p.ws + OFF_ABT);
  u16* QD = (u16*)(p.ws + OFF_QD);
  u16* AS = (u16*)(p.ws + OFF_ASUM);
  float* CD = (float*)(p.ws + OFF_CD1);
  const float qscale = 0.08838834764831845f;
  for (int item = blockIdx.x; item < NCHUNK * 4; item += gridDim.x) {
    const int ci = item >> 2, h = item & 3, row0 = ci * 64;
#pragma unroll
    for (int u = 0; u < 2; ++u) {
      const int chunk = tid * 2 + u, c = chunk >> 4, cc = (chunk & 15) * 8;
      const u16* src = qk1 + (size_t)(row0 + c) * 1024 + h * 128 + cc;
      u32x4 vq = *(const u32x4*)src, vk = *(const u32x4*)(src + 512);
      st8(sq + c * 264 + cc * 2, vq);
      st8(sk + c * 264 + cc * 2, vk);
    }
    {
      const int rr = tid >> 3, cc = (tid & 7) * 4;
      *(f32x4*)(sgl + rr * 32 + cc) = *(const f32x4*)(gl + (size_t)(row0 + rr) * 32 + cc);
    }
    __syncthreads();
    {
      const int kk = tid & 127, d = (tid >> 7) & 1, chalf = tid >> 8;
      float w[16];
#pragma unroll
      for (int q = 0; q < 16; ++q) w[q] = p.gla_w_g2[(d * 16 + q) * 512 + h * 128 + kk];
      const float bg = p.gla_b_g[d * 512 + h * 128 + kk];
#pragma unroll 4
      for (int cc = 0; cc < 32; ++cc) {
        const int c = chalf * 32 + cc;
        const f32x4* gp = (const f32x4*)(sgl + c * 32 + d * 16);
        const f32x4 g0 = gp[0], g1 = gp[1], g2 = gp[2], g3 = gp[3];
        float z = bg;
        z += g0.x * w[0] + g0.y * w[1] + g0.z * w[2] + g0.w * w[3];
        z += g1.x * w[4] + g1.y * w[5] + g1.z * w[6] + g1.w * w[7];
        z += g2.x * w[8] + g2.y * w[9] + g2.z * w[10] + g2.w * w[11];
        z += g3.x * w[12] + g3.y * w[13] + g3.z * w[14] + g3.w * w[15];
        sBC[(d * 64 + c) * 128 + kk] = (fminf(z, 0.f) - __logf(1.f + __expf(-fabsf(z)))) * (1.f / 16.f);
      }
    }
    __syncthreads();
    if (tid < 256) {
      const int d = tid >> 7, kk = tid & 127;
      float* col = sBC + d * 64 * 128 + kk;
      float v[64];
#pragma unroll
      for (int c = 0; c < 64; ++c) v[c] = col[c * 128];
      if (d == 0) {
        float acc = 0.f;
#pragma unroll
        for (int c = 0; c < 64; ++c) { acc += v[c]; col[c * 128] = acc; }
      } else {
        float acc = 0.f;
#pragma unroll
        for (int c = 63; c >= 0; --c) { acc += v[c]; col[c * 128] = acc; }
      }
    }
    __syncthreads();
    f32x16 asum;
    for (int i = 0; i < 16; ++i) asum[i] = 0.f;
    for (int d = 0; d < 2; ++d) {
      const int cref = d ? 31 : 32, clast = d ? 0 : 63;
      const float* bcd = sBC + d * 64 * 128;
      u16* qd_o = QD + ((size_t)item * 2 + d) * 16384;
      float er[8], ern[8];
      {
        const int k0 = (tid & 15) * 8;
#pragma unroll
        for (int e = 0; e < 8; ++e) { const float rf = bcd[cref * 128 + k0 + e]; er[e] = __expf(rf); ern[e] = __expf(-rf); }
      }
      for (int v = tid; v < 1024; v += 512) {
        const int c = v >> 4, k0 = (v & 15) * 8;
        const u32x4 qv = *(const u32x4*)(sq + c * 264 + k0 * 2), kv = *(const u32x4*)(sk + c * 264 + k0 * 2);
        const unsigned qa[4] = {qv.x, qv.y, qv.z, qv.w}, ka[4] = {kv.x, kv.y, kv.z, kv.w};
        float oqa[8], okb[8], oqd[8];
#pragma unroll
        for (int e = 0; e < 8; ++e) {
          const float ebc = __expf(bcd[c * 128 + k0 + e]);
          const float qf = ((e & 1) ? bfhi(qa[e >> 1]) : bflo(qa[e >> 1])) * qscale;
          const float kf = (e & 1) ? bfhi(ka[e >> 1]) : bflo(ka[e >> 1]);
          oqd[e] = qf * ebc;
          oqa[e] = oqd[e] * ern[e];
          okb[e] = kf * er[e] * __builtin_amdgcn_rcpf(ebc);
        }
        st8(sQa + c * 264 + k0 * 2, (u32x4){pk2(oqa[0], oqa[1]), pk2(oqa[2], oqa[3]), pk2(oqa[4], oqa[5]), pk2(oqa[6], oqa[7])});
        st8(sKb + c * 264 + k0 * 2, (u32x4){pk2(okb[0], okb[1]), pk2(okb[2], okb[3]), pk2(okb[4], okb[5]), pk2(okb[6], okb[7])});
        *(u32x4*)(qd_o + c * 128 + k0) = (u32x4){pk2(oqd[0], oqd[1]), pk2(oqd[2], oqd[3]), pk2(oqd[4], oqd[5]), pk2(oqd[6], oqd[7])};
      }
      for (int v = tid; v < 1024; v += 512) {
        const int kk = v >> 3, c0 = (v & 7) * 8;
        const float last = bcd[clast * 128 + kk];
        float o[8];
#pragma unroll
        for (int e = 0; e < 8; ++e) {
          const int c = c0 + e;
          const float kf = bf2f(*(const u16*)(sk + c * 264 + kk * 2));
          o[e] = kf * __expf(last - bcd[c * 128 + kk]);
        }
        *(u32x4*)(qd_o + 8192 + kk * 64 + c0) = (u32x4){pk2(o[0], o[1]), pk2(o[2], o[3]), pk2(o[4], o[5]), pk2(o[6], o[7])};
      }
      if (tid < 128) CD[((size_t)item * 2 + d) * 128 + tid] = __expf(bcd[clast * 128 + tid]);
      __syncthreads();
      if (wave < 4) {
        const int tm = wave >> 1, tn = wave & 1;
        f32x16 acc;
        for (int i = 0; i < 16; ++i) acc[i] = 0.f;
#pragma unroll
        for (int s = 0; s < 8; ++s) {
          s16x8 a = ldA_nat(sQa, 32 * tm + r, 264, 16 * s, hh), bb = ldA_nat(sKb, 32 * tn + r, 264, 16 * s, hh);
          acc = MFMA32(a, bb, acc);
        }
#pragma unroll
        for (int i = 0; i < 16; ++i) {
          const int ii = 32 * tm + crow(i, hh), jj = 32 * tn + r;
          const bool keep = d ? (ii <= jj) : (ii >= jj);
          asum[i] += keep ? acc[i] : 0.f;
        }
      }
      __syncthreads();
    }
    if (wave < 4) {
      const int tm = wave >> 1, tn = wave & 1;
#pragma unroll
      for (int i = 0; i < 16; ++i) AS[(size_t)item * 4096 + (32 * tm + crow(i, hh)) * 64 + 32 * tn + r] = f2bf(asum[i]);
    }
  }
}

template <int GROUP>
DI void yg_phase(u16* o0, const u16* o1, const u16* z, const u16* zctx, const float* ng, int nrows, const int wave_s_) {
  const int gt = blockIdx.x * 512 + TIDX(), nthr = gridDim.x * 512;
  const int total = nrows * 256;
  for (int idx0 = gt; idx0 < total; idx0 += 2 * nthr) {
    const bool ok1 = idx0 + nthr < total;
    u32x4 a[2], bq[2], zz[2];
#pragma unroll
    for (int u = 0; u < 2; ++u) {
      const int idx = (u == 0 || ok1) ? idx0 + u * nthr : idx0;
      const size_t off = (size_t)(idx >> 8) * 2048 + (idx & 255) * 8;
      const int zrow = idx >> 8;
      const u16* zp = (zrow < RL) ? z + off : zctx + (size_t)(zrow - RL) * 2048 + (idx & 255) * 8;
      a[u] = __builtin_nontemporal_load((const u32x4*)(o0 + off)); bq[u] = __builtin_nontemporal_load((const u32x4*)(o1 + off)); zz[u] = __builtin_nontemporal_load((const u32x4*)zp);
    }
#pragma unroll
    for (int u = 0; u < 2; ++u) {
      if (u == 1 && !ok1) break;
      const int idx = idx0 + u * nthr, ch = (idx & 255) * 8;
      const size_t off = (size_t)(idx >> 8) * 2048 + ch;
      float o[8] = {bflo(a[u].x) + bflo(bq[u].x), bfhi(a[u].x) + bfhi(bq[u].x), bflo(a[u].y) + bflo(bq[u].y), bfhi(a[u].y) + bfhi(bq[u].y),
                    bflo(a[u].z) + bflo(bq[u].z), bfhi(a[u].z) + bfhi(bq[u].z), bflo(a[u].w) + bflo(bq[u].w), bfhi(a[u].w) + bfhi(bq[u].w)};
      const float zf[8] = {bflo(zz[u].x), bfhi(zz[u].x), bflo(zz[u].y), bfhi(zz[u].y), bflo(zz[u].z), bfhi(zz[u].z), bflo(zz[u].w), bfhi(zz[u].w)};
      float ss = 0.f;
#pragma unroll
      for (int e = 0; e < 8; ++e) ss += o[e] * o[e];
#pragma unroll
      for (int of = 1; of < GROUP; of <<= 1) ss += __shfl_xor(ss, of, 64);
      const float rstd = rsqrtf(ss * (1.f / (GROUP * 8)) + EPSF);
      const int gi = ch & (GROUP * 8 - 1);
      const f32x4 g0 = *(const f32x4*)(ng + gi), g1 = *(const f32x4*)(ng + gi + 4);
      const float gg[8] = {g0.x, g0.y, g0.z, g0.w, g1.x, g1.y, g1.z, g1.w};
#pragma unroll
      for (int e = 0; e < 8; ++e) o[e] = o[e] * rstd * gg[e] * siluf(zf[e]);
      *(u32x4*)(o0 + off) = (u32x4){pk2(o[0], o[1]), pk2(o[2], o[3]), pk2(o[4], o[5]), pk2(o[6], o[7])};
    }
  }
}

DI void final_phase(float* out, const float* g, const int wave_s_) {
  const int tidx_ = TIDX();
  const int lane = tidx_ & 63, gw = blockIdx.x * 8 + (tidx_ >> 6), nw = gridDim.x * 8;
  for (int row0 = gw; row0 < RL; row0 += 2 * nw) {
    const int rows[2] = {row0, row0 + nw};
    const bool ok1 = rows[1] < RL;
    f32x4 v[2][4];
#pragma unroll
    for (int u = 0; u < 2; ++u) {
      const float* s = out + (size_t)((u == 0 || ok1) ? rows[u] : rows[0]) * DM;
#pragma unroll
      for (int q = 0; q < 4; ++q) v[u][q] = __builtin_nontemporal_load((const f32x4*)(s + q * 256 + lane * 4));
    }
#pragma unroll
    for (int u = 0; u < 2; ++u) {
      if (u == 1 && !ok1) break;
      float* s = out + (size_t)rows[u] * DM;
      float ss = 0.f;
#pragma unroll
      for (int q = 0; q < 4; ++q) ss += v[u][q].x * v[u][q].x + v[u][q].y * v[u][q].y + v[u][q].z * v[u][q].z + v[u][q].w * v[u][q].w;
      ss = wave_sum(ss);
      const float rstd = rsqrtf(ss * (1.f / 1024.f) + EPSF);
#pragma unroll
      for (int q = 0; q < 4; ++q) {
        const f32x4 gg = *(const f32x4*)(g + q * 256 + lane * 4);
        f32x4 o = {v[u][q].x * rstd * gg.x, v[u][q].y * rstd * gg.y, v[u][q].z * rstd * gg.z, v[u][q].w * rstd * gg.w};
        __builtin_nontemporal_store(o, (f32x4*)(s + q * 256 + lane * 4));
      }
    }
  }
}

#define XB_XSUB(j)  (64 * (j))
#define XB_XGEN(j)  (1024 + 64 * (j))
#define XB_TOP      2048
#define XB_TOPGEN   2112
#define XCD_BAR_WORDS 2176
DI unsigned xb_ld(unsigned* p) { return __hip_atomic_load(p, __ATOMIC_RELAXED, __HIP_MEMORY_SCOPE_AGENT); }
DI unsigned xb_add(unsigned* p, unsigned v) { return __hip_atomic_fetch_add(p, v, __ATOMIC_RELAXED, __HIP_MEMORY_SCOPE_AGENT); }
DI void gbar(char* ws, const int wave_s_) {
  asm volatile("s_waitcnt vmcnt(0)" ::: "memory");
  __syncthreads();
  if (wave_s_ == 0 && lane_id() == 0) {
    unsigned* bar = (unsigned*)(ws + OFF_BAR);
    __builtin_amdgcn_s_waitcnt(0);
    const unsigned x = (unsigned)__builtin_amdgcn_s_getreg((3 << 11) | 20) & 0xFu;
    const unsigned nloc = gridDim.x >> 3, nx = 8u;
    const unsigned old = xb_add(&bar[XB_XSUB(x)], 1u);
    const unsigned gen = old / nloc;
    if (old + 1u == (gen + 1u) * nloc) {
      __builtin_amdgcn_fence(__ATOMIC_RELEASE, "agent");
      asm volatile("s_waitcnt vmcnt(0)" ::: "memory");
      const unsigned og = xb_add(&bar[XB_TOP], 1u);
      const unsigned tg = og / nx;
      if (og + 1u == (tg + 1u) * nx) xb_add(&bar[XB_TOPGEN], 1u);
      else while (xb_ld(&bar[XB_TOPGEN]) == tg) __builtin_amdgcn_s_sleep(1);
      __builtin_amdgcn_fence(__ATOMIC_ACQUIRE, "agent");
      xb_add(&bar[XB_XGEN(x)], 1u);
      asm volatile("s_waitcnt vmcnt(0)" ::: "memory");
    } else {
      while (xb_ld(&bar[XB_XGEN(x)]) == gen) __builtin_amdgcn_s_sleep(1);
      __builtin_amdgcn_fence(__ATOMIC_ACQUIRE, "agent");
      asm volatile("s_waitcnt vmcnt(0)" ::: "memory");
    }
  }
  __syncthreads();
}
#ifndef REP_GEMM
#define REP_GEMM 1
#endif
#ifndef REP_PREP
#define REP_PREP 1
#endif
#ifndef REP_GLP
#define REP_GLP 1
#endif
#ifndef REP_SCAN
#define REP_SCAN 0
#endif
#ifndef REP_SYNC
#define REP_SYNC 0
#endif
#ifndef REP_EW
#define REP_EW 1
#endif
__global__ void __launch_bounds__(512, 2) fwd_megakernel(Params p) {
  __shared__ __attribute__((aligned(1024))) char shm[141312];
  cg::grid_group grid = cg::this_grid();
  const int wave_s_ = __builtin_amdgcn_readfirstlane((int)(threadIdx.x >> 6));
  char* ws = p.ws;
  float* mods = (float*)(ws + OFF_MOD);
  u16* W0T = (u16*)(ws + OFF_W0T);
  u16* WO0T = (u16*)(ws + OFF_WO0T);
  u16* W1T = (u16*)(ws + OFF_W1T);
  u16* WO1T = (u16*)(ws + OFF_WO1T);
  u16* outb = (u16*)p.out;
  float* ctx1 = (float*)(ws + OFF_X);

  mods_phase(shm, p, wave_s_);
  wtrans_phase<0>(shm, p, wave_s_);
  if (gridDim.x == 256) gbar(ws, wave_s_); else grid.sync();
  {
    u16* H0 = (u16*)(ws + OFF_T);
    h_phase(p.x, p.ctx, p.norm_g, mods, H0, R, wave_s_);
    gbar(ws, wave_s_);
#if REP_EW > 1
    h_phase(p.x, p.ctx, p.norm_g, mods, H0, R, wave_s_);
    gbar(ws, wave_s_);
#endif
    small_gemm(H0, W0T + (size_t)6144 * 1024, (float*)(ws + OFF_ABT), wave_s_);
    wtrans_phase<2>(shm, p, wave_s_, 3);
    EpiArgs e{};
    e.mode = 0; e.lat = outb; e.ctx = (u16*)(ws + OFF_X); e.ld = 2048;
    gemm_phase<0>(shm, H0, H0 + (size_t)RL * 1024, 1024, W0T, 0, 128, 8, e, wave_s_);
    {
      EpiArgs ec{};
      ec.mode = 4; ec.ctx = (u16*)(ws + OFF_X);
      gemm_phase<4>(shm, H0, H0 + (size_t)RL * 1024, 1024, W0T, 128, 4, 24, ec, wave_s_);
    }
    gbar(ws, wave_s_);
#if REP_GEMM > 1
    gemm_phase<0>(shm, H0, H0 + (size_t)RL * 1024, 1024, W0T, 0, 132, 8, e, wave_s_);
    gbar(ws, wave_s_);
#endif
    conv_phase<false>(p, wave_s_);
    gbar(ws, wave_s_);
#if REP_EW > 1
    conv_phase<false>(p, wave_s_);
    gbar(ws, wave_s_);
#endif
    gemm_phase<0>(shm, H0, H0 + (size_t)RL * 1024, 1024, W0T + (size_t)2048 * 1024, 0, 128, 8, e, wave_s_);
    gbar(ws, wave_s_);
#if REP_GEMM > 1
    gemm_phase<0>(shm, H0, H0 + (size_t)RL * 1024, 1024, W0T + (size_t)2048 * 1024, 0, 132, 8, e, wave_s_);
    gbar(ws, wave_s_);
#endif
    conv_phase<true>(p, wave_s_);
    gbar(ws, wave_s_);
#if REP_EW > 1
    conv_phase<true>(p, wave_s_);
    gbar(ws, wave_s_);
#endif
    for (int rep_ = 0; rep_ < REP_PREP; ++rep_) {
    dn_prep_phase(shm, p, wave_s_);
    gbar(ws, wave_s_);
    }
    for (int rep_ = 0; rep_ < REP_SCAN; ++rep_) { scan_phase<true, true>(shm, p, wave_s_); gbar(ws, wave_s_); }
    for (int rep_ = 0; rep_ < REP_SYNC; ++rep_) gbar(ws, wave_s_);
    scan_phase<true>(shm, p, wave_s_);
    gbar(ws, wave_s_);
    u16* H0b = H0;
    u16* Z = (u16*)(ws + OFF_QK0);
    EpiArgs ez{};
    ez.mode = 0; ez.lat = Z; ez.ctx = Z + (size_t)RL * 2048; ez.ld = 2048;
    gemm_phase<0>(shm, H0b, H0b + (size_t)RL * 1024, 1024, W0T + (size_t)4096 * 1024, 0, 128, 8, ez, wave_s_);
    gbar(ws, wave_s_);
#if REP_GEMM > 1
    gemm_phase<0>(shm, H0b, H0b + (size_t)RL * 1024, 1024, W0T + (size_t)4096 * 1024, 0, 132, 8, ez, wave_s_);
    gbar(ws, wave_s_);
#endif
    u16* U0 = (u16*)(ws + OFF_U0);
    yg_phase<32>(U0, (const u16*)(ws + OFF_U1), Z, (const u16*)(ws + OFF_ZC), p.dn_norm_g, R, wave_s_);
    gbar(ws, wave_s_);
    EpiArgs eo{};
    eo.mode = 2; eo.res_lat = p.x; eo.res_ctx = p.ctx; eo.mods_i = mods; eo.out_lat = p.out; eo.out_ctx = ctx1;
    wtrans_phase<1>(shm, p, wave_s_, 1);
    gemm_phase<2>(shm, U0, U0 + (size_t)RL * 2048, 2048, WO0T, 0, 132, 4, eo, wave_s_);
    gbar(ws, wave_s_);
#if REP_GEMM > 1
    gemm_phase<2>(shm, U0, U0 + (size_t)RL * 2048, 2048, WO0T, 0, 132, 4, eo, wave_s_);
    gbar(ws, wave_s_);
#endif
  }
  {
    const float* mods1 = mods + 5 * 3072;
    u16* H1 = (u16*)(ws + OFF_QD);
    h_phase(p.out, ctx1, p.norm_g + 1024, mods1, H1, R, wave_s_);
    gbar(ws, wave_s_);
    small_gemm(H1, W1T + (size_t)5120 * 1024, (float*)(ws + OFF_ABT), wave_s_);
    EpiArgs e{};
    e.mode = 1; e.lat = (u16*)(ws + OFF_QK1); e.b1 = (u16*)(ws + OFF_V0); e.b2 = (u16*)(ws + OFF_V1);
    gemm_phase<1>(shm, H1, H1 + (size_t)RL * 1024, 1024, W1T, 0, 132, 12, e, wave_s_);
    gbar(ws, wave_s_);
    for (int rep_ = 0; rep_ < REP_GLP; ++rep_) {
    gla_prep_phase(shm, p, wave_s_);
    gbar(ws, wave_s_);
    }
    for (int rep_ = 0; rep_ < REP_SCAN; ++rep_) { scan_phase<false, true>(shm, p, wave_s_); gbar(ws, wave_s_); }
    scan_phase<false>(shm, p, wave_s_);
    u16* H1b = (u16*)(ws + OFF_QK1);
    h_phase(p.out, ctx1, p.norm_g + 1024, mods1, H1b, RL, wave_s_);
    gbar(ws, wave_s_);
    u16* RB = (u16*)(ws + OFF_QD);
    EpiArgs er{};
    er.mode = 0; er.lat = RB; er.ctx = RB; er.ld = 2048;
    gemm_phase<0>(shm, H1b, H1b, 1024, W1T + (size_t)3072 * 1024, 0, 128, 8, er, wave_s_);
    gbar(ws, wave_s_);
    u16* V0 = (u16*)(ws + OFF_V0);
    yg_phase<64>(V0, (const u16*)(ws + OFF_V1), RB, RB, p.gla_norm_g, RL, wave_s_);
    gbar(ws, wave_s_);
    EpiArgs eo{};
    eo.mode = 2; eo.res_lat = p.out; eo.res_ctx = p.out; eo.mods_i = mods1; eo.out_lat = p.out; eo.out_ctx = p.out;
    gemm_phase<2>(shm, V0, V0, 2048, WO1T, 0, 128, 4, eo, wave_s_);
    gbar(ws, wave_s_);
    final_phase(p.out, p.final_g, wave_s_);
  }
}

extern "C" void kernel_launch(void* const* d_in, const int* in_sizes, int n_in, void* d_out, int out_size, void* d_ws,
                              size_t ws_size, hipStream_t stream) {
  static int grid_blocks = 0;
  if (!grid_blocks) {
    int dev = 0, cus = 0, per_cu = 0;
    hipGetDevice(&dev);
    hipDeviceGetAttribute(&cus, hipDeviceAttributeMultiprocessorCount, dev);
    hipOccupancyMaxActiveBlocksPerMultiprocessor(&per_cu, fwd_megakernel, 512, 0);
    if (per_cu < 1) per_cu = 1;
    grid_blocks = cus;
    if (grid_blocks > 256) grid_blocks = 256;
  }
  Params p{};
  p.x = (const float*)d_in[0]; p.c = (const float*)d_in[1]; p.ctx = (const float*)d_in[2]; p.c_ctx = (const float*)d_in[3];
  p.mod_w = (const float*)d_in[4]; p.mod_b = (const float*)d_in[5]; p.norm_g = (const float*)d_in[6];
  p.dn_w_in = (const float*)d_in[7]; p.dn_conv_w = (const float*)d_in[8]; p.dn_a_log = (const float*)d_in[9];
  p.dn_dt_bias = (const float*)d_in[10]; p.dn_norm_g = (const float*)d_in[11]; p.dn_w_out = (const float*)d_in[12];
  p.gla_w_in = (const float*)d_in[13]; p.gla_w_g2 = (const float*)d_in[14]; p.gla_b_g = (const float*)d_in[15];
  p.gla_norm_g = (const float*)d_in[16]; p.gla_w_out = (const float*)d_in[17]; p.final_g = (const float*)d_in[18];
  p.out = (float*)d_out;
  p.ws = (char*)d_ws;
  (void)hipMemsetAsync((char*)d_ws + OFF_BAR, 0, XCD_BAR_WORDS * sizeof(unsigned), stream);
  void* args[] = {&p};
  hipError_t e = hipLaunchCooperativeKernel((void*)fwd_megakernel, dim3(grid_blocks), dim3(512), args, 0, stream);
  if (e != hipSuccess) fprintf(stderr, "cooperative launch failed: %s (grid %d)\n", hipGetErrorString(e), grid_blocks);
}
```
